# Optimizing an MI355X kernel written in HIP

```python
import math
import jax, jax.numpy as jnp
from jax import lax
import numpy as np

D_MODEL = 1024
BATCH = 2
SEQ = 8192
DEPTH = 2

RET_HEADS = 4
RET_HEAD_DIM = 64
RET_WIDTH = RET_HEADS * RET_HEAD_DIM
RET_CHUNK = 128
SSM_GROUP_CH = 16
SSM_GROUPS = 16
SSM_WIDTH = SSM_GROUPS * SSM_GROUP_CH
SSM_STATE = 64
MLA_HEADS = 4
MLA_NOPE = 128
MLA_ROPE = 64
MLA_V = 128
MLA_QK = MLA_NOPE + MLA_ROPE
MLA_WIDTH = MLA_HEADS * MLA_V
MLA_Q_RANK = 256
MLA_KV_RANK = 128
ATTN_BLOCK = 128

D_MIX = RET_WIDTH + SSM_WIDTH + MLA_WIDTH
ROPE_DIM = 64
ROPE_BASE = 10000.0

D_FF = 3584
N_EXPERTS = 8
TOP_K = 2
MOE_BLOCK = 128
N_DENSE = (DEPTH + 1) // 2
N_MOE = DEPTH // 2
EPS = 1e-6
NEG_INF = -1e30

IN_SPLITS = (RET_WIDTH, RET_WIDTH, RET_WIDTH, RET_WIDTH, SSM_WIDTH, MLA_Q_RANK, MLA_KV_RANK, MLA_ROPE)
IN_COLS = sum(IN_SPLITS)

kernel_name = 'hybrid_retnet_s5_mla_moe_block'


def rms_norm(x, g):
    xf = x.astype(jnp.float32)
    y = xf * lax.rsqrt(jnp.mean(xf * xf, axis=-1, keepdims=True) + EPS)
    return (y * g.astype(jnp.float32)).astype(x.dtype)


def rope_tables(positions):
    inv = ROPE_BASE ** (-jnp.arange(0, ROPE_DIM, 2, dtype=jnp.float32) / ROPE_DIM)
    ang = positions.astype(jnp.float32)[..., None] * inv
    return jnp.cos(ang), jnp.sin(ang)


def apply_rope(x, cos, sin):
    shp = cos.shape[:2] + (1,) * (x.ndim - 3) + cos.shape[2:]
    cos = cos.reshape(shp)
    sin = sin.reshape(shp)
    x1, x2 = jnp.split(x.astype(jnp.float32), 2, axis=-1)
    return jnp.concatenate([x1 * cos - x2 * sin, x2 * cos + x1 * sin], axis=-1).astype(x.dtype)


def retention(q, k, v, cos, sin):
    bsz, L, H, dk = q.shape
    dv = v.shape[-1]
    C = RET_CHUNK
    N = L // C
    q = apply_rope(q, cos, sin)
    k = apply_rope(k, cos, sin) * (dk ** -0.5)
    log_g = jnp.log1p(-(2.0 ** (-5.0 - jnp.arange(H, dtype=jnp.float32))))
    i = jnp.arange(C, dtype=jnp.float32)
    diff = i[:, None] - i[None, :]
    dmask = jnp.where(diff >= 0, jnp.exp(log_g[:, None, None] * jnp.maximum(diff, 0.0)), 0.0)
    qc = q.reshape(bsz, N, C, H, dk)
    kc = k.reshape(bsz, N, C, H, dk)
    vc = v.reshape(bsz, N, C, H, dv)
    s = jnp.einsum('bnihd,bnjhd->bnhij', qc, kc) * dmask
    inner = jnp.einsum('bnhij,bnjhe->bnihe', s, vc)
    k_dec = jnp.exp(log_g[None, :] * (C - 1 - i)[:, None])
    kv = jnp.einsum('bnjhd,bnjhe->nbhde', kc * k_dec[:, :, None], vc)
    chunk_decay = jnp.exp(log_g * C)[:, None, None]

    def step(state, kv_n):
        return chunk_decay * state + kv_n, state

    _, states = lax.scan(step, jnp.zeros((bsz, H, dk, dv), kv.dtype), kv)
    q_dec = jnp.exp(log_g[None, :] * (i + 1.0)[:, None])
    cross = jnp.einsum('bnihd,nbhde->bnihe', qc * q_dec[:, :, None], states)
    return (inner + cross).reshape(bsz, L, H, dv).astype(v.dtype)


def s5_ssm(u, a_re, a_im, b_re, b_im, c_re, c_im, d, log_dt, glu_w, glu_b):
    bsz, L, _ = u.shape
    uf = u.astype(jnp.float32).reshape(bsz, L, SSM_GROUPS, SSM_GROUP_CH)
    lam = lax.complex(a_re.astype(jnp.float32), a_im.astype(jnp.float32))
    dt = jnp.exp(log_dt.astype(jnp.float32))[:, None]
    lam_bar = jnp.exp(lam * dt)
    b = lax.complex(b_re.astype(jnp.float32), b_im.astype(jnp.float32))
    b_bar = ((lam_bar - 1.0) / lam)[..., None] * b
    bu = jnp.einsum('blgh,gph->blgp', uf.astype(jnp.complex64), b_bar)
    a = jnp.broadcast_to(lam_bar, bu.shape)

    def combine(e1, e2):
        a1, b1 = e1
        a2, b2 = e2
        return a1 * a2, a2 * b1 + b2

    _, states = lax.associative_scan(combine, (a, bu), axis=1)
    cm = lax.complex(c_re.astype(jnp.float32), c_im.astype(jnp.float32))
    y = jnp.real(jnp.einsum('blgp,ghp->blgh', states, cm)) + d.astype(jnp.float32) * uf
    y = jax.nn.gelu(y.reshape(bsz, L, SSM_WIDTH))
    y = y * jax.nn.sigmoid(y @ glu_w.astype(jnp.float32) + glu_b.astype(jnp.float32))
    return y.astype(u.dtype)


def mla(c_q, c_kv, k_rope, q_norm, w_uq, kv_norm, w_ukv, cos, sin):
    bsz, L, _ = c_q.shape
    q = (rms_norm(c_q, q_norm) @ w_uq).reshape(bsz, L, MLA_HEADS, MLA_QK)
    q = jnp.concatenate([q[..., :MLA_NOPE], apply_rope(q[..., MLA_NOPE:], cos, sin)], axis=-1)
    kv = (rms_norm(c_kv, kv_norm) @ w_ukv).reshape(bsz, L, MLA_HEADS, MLA_NOPE + MLA_V)
    k_pe = apply_rope(k_rope, cos, sin)
    k = jnp.concatenate([kv[..., :MLA_NOPE], jnp.broadcast_to(k_pe[:, :, None, :], (bsz, L, MLA_HEADS, MLA_ROPE))], axis=-1)
    v = kv[..., MLA_NOPE:]
    scale = MLA_QK ** -0.5
    nb = L // ATTN_BLOCK
    q_blocks = q.reshape(bsz, nb, ATTN_BLOCK, MLA_HEADS, MLA_QK).transpose(1, 0, 2, 3, 4)
    k_pos = jnp.arange(L)

    def attend(args):
        qb, n = args
        s = jnp.einsum('bqhd,bkhd->bhqk', qb, k, preferred_element_type=jnp.float32) * scale
        q_pos = n * ATTN_BLOCK + jnp.arange(ATTN_BLOCK)
        s = jnp.where(k_pos[None, :] <= q_pos[:, None], s, NEG_INF)
        p = jax.nn.softmax(s, axis=-1).astype(v.dtype)
        return jnp.einsum('bhqk,bkhd->bqhd', p, v)

    o = lax.map(attend, (q_blocks, jnp.arange(nb)))
    return o.transpose(1, 0, 2, 3, 4).reshape(bsz, L, MLA_WIDTH)


def hybrid_mixer(h, cos, sin, w_in, ret_norm, a_re, a_im, b_re, b_im, c_re, c_im, d, log_dt,
                 glu_w, glu_b, ssm_norm, q_norm, w_uq, kv_norm, w_ukv, mla_norm, w_out):
    bsz, L, _ = h.shape
    offsets = np.cumsum(IN_SPLITS)[:-1].tolist()
    rq, rk, rv, rg, u, cq, ckv, kr = jnp.split(h @ w_in, offsets, axis=-1)
    ret = retention(rq.reshape(bsz, L, RET_HEADS, RET_HEAD_DIM), rk.reshape(bsz, L, RET_HEADS, RET_HEAD_DIM),
                    rv.reshape(bsz, L, RET_HEADS, RET_HEAD_DIM), cos, sin)
    ret = rms_norm(ret, ret_norm.reshape(RET_HEADS, RET_HEAD_DIM)).reshape(bsz, L, RET_WIDTH)
    ret = jax.nn.silu(rg) * ret
    ssm = rms_norm(s5_ssm(u, a_re, a_im, b_re, b_im, c_re, c_im, d, log_dt, glu_w, glu_b), ssm_norm)
    att = rms_norm(mla(cq, ckv, kr, q_norm, w_uq, kv_norm, w_ukv, cos, sin), mla_norm)
    return jnp.concatenate([ret, ssm, att], axis=-1) @ w_out


def swiglu(h, wg, wu, wd):
    return (jax.nn.silu(h @ wg) * (h @ wu)) @ wd


def routed_ffn(h, router, wg, wu, wd):
    bsz, L, D = h.shape
    t = h.reshape(-1, D)
    T = t.shape[0]
    A = T * TOP_K
    logits = (t @ router).astype(jnp.float32)
    top_v, top_i = lax.top_k(logits, TOP_K)
    top_w = jax.nn.softmax(top_v, axis=-1)
    expert = top_i.reshape(-1)
    tok = jnp.repeat(jnp.arange(T), TOP_K)
    order = jnp.argsort(expert)
    e_sorted = expert[order]
    tok_sorted = tok[order]
    w_sorted = top_w.reshape(-1)[order]
    counts = jnp.bincount(expert, length=N_EXPERTS)
    padded = ((counts + MOE_BLOCK - 1) // MOE_BLOCK) * MOE_BLOCK
    pad_end = jnp.cumsum(padded)
    pad_start = pad_end - padded
    raw_start = jnp.cumsum(counts) - counts
    dest = pad_start[e_sorted] + (jnp.arange(A) - raw_start[e_sorted])
    n_rows = A + N_EXPERTS * MOE_BLOCK
    n_blocks = n_rows // MOE_BLOCK
    x_buf = jnp.zeros((n_rows, D), t.dtype).at[dest].set(t[tok_sorted])
    block_start = jnp.arange(n_blocks) * MOE_BLOCK
    block_expert = jnp.clip(jnp.searchsorted(pad_end, block_start, side='right'), 0, N_EXPERTS - 1)

    def expert_block(args):
        xb, e = args
        return swiglu(xb, wg[e], wu[e], wd[e])

    y_buf = lax.map(expert_block, (x_buf.reshape(n_blocks, MOE_BLOCK, D), block_expert)).reshape(n_rows, D)
    y = jnp.zeros_like(t).at[tok_sorted].add(y_buf[dest] * w_sorted[:, None].astype(t.dtype))
    return y.reshape(bsz, L, D)


def setup_inputs(seed: int = 0) -> dict:
    key = jax.random.key(seed)
    ks = iter(jax.random.split(key, 64))

    def nrm(shape, scale):
        return jax.random.normal(next(ks), shape, jnp.float32) * scale

    def gain(shape):
        return 1.0 + 0.02 * jax.random.normal(next(ks), shape, jnp.float32)

    G, P, Hg = SSM_GROUPS, SSM_STATE, SSM_GROUP_CH
    x = nrm((BATCH, SEQ, D_MODEL), 1.0)
    c = nrm((BATCH, D_MODEL), 1.0)
    positions = jnp.broadcast_to(jnp.arange(SEQ, dtype=jnp.int32), (BATCH, SEQ))
    ada_w = nrm((DEPTH, D_MODEL, 6 * D_MODEL), 0.5 * D_MODEL ** -0.5)
    ada_b = nrm((DEPTH, 6 * D_MODEL), 0.01)
    norm_pre_mix = gain((DEPTH, D_MODEL))
    norm_post_mix = gain((DEPTH, D_MODEL))
    norm_pre_ffn = gain((DEPTH, D_MODEL))
    norm_post_ffn = gain((DEPTH, D_MODEL))
    w_in = nrm((DEPTH, D_MODEL, IN_COLS), D_MODEL ** -0.5)
    ret_norm = gain((DEPTH, RET_WIDTH))
    ssm_a_re = -0.5 + 0.01 * jax.random.normal(next(ks), (DEPTH, G, P), jnp.float32)
    ssm_a_im = math.pi * jnp.arange(P, dtype=jnp.float32) + 0.01 * jax.random.normal(next(ks), (DEPTH, G, P), jnp.float32)
    ssm_b_re = nrm((DEPTH, G, P, Hg), (2.0 * Hg) ** -0.5)
    ssm_b_im = nrm((DEPTH, G, P, Hg), (2.0 * Hg) ** -0.5)
    ssm_c_re = nrm((DEPTH, G, Hg, P), (2.0 * P) ** -0.5)
    ssm_c_im = nrm((DEPTH, G, Hg, P), (2.0 * P) ** -0.5)
    ssm_d = nrm((DEPTH, G, Hg), 1.0)
    ssm_log_dt = jax.random.uniform(next(ks), (DEPTH, G), jnp.float32, minval=math.log(1e-3), maxval=math.log(1e-1))
    ssm_glu_w = nrm((DEPTH, SSM_WIDTH, SSM_WIDTH), SSM_WIDTH ** -0.5)
    ssm_glu_b = nrm((DEPTH, SSM_WIDTH), 0.01)
    ssm_norm = gain((DEPTH, SSM_WIDTH))
    mla_q_norm = gain((DEPTH, MLA_Q_RANK))
    mla_w_uq = nrm((DEPTH, MLA_Q_RANK, MLA_HEADS * MLA_QK), MLA_Q_RANK ** -0.5)
    mla_kv_norm = gain((DEPTH, MLA_KV_RANK))
    mla_w_ukv = nrm((DEPTH, MLA_KV_RANK, MLA_HEADS * (MLA_NOPE + MLA_V)), MLA_KV_RANK ** -0.5)
    mla_norm = gain((DEPTH, MLA_WIDTH))
    w_out = nrm((DEPTH, D_MIX, D_MODEL), D_MIX ** -0.5)
    ffn_w_gate = nrm((N_DENSE, D_MODEL, D_FF), D_MODEL ** -0.5)
    ffn_w_up = nrm((N_DENSE, D_MODEL, D_FF), D_MODEL ** -0.5)
    ffn_w_down = nrm((N_DENSE, D_FF, D_MODEL), D_FF ** -0.5)
    moe_router = nrm((N_MOE, D_MODEL, N_EXPERTS), D_MODEL ** -0.5)
    moe_w_gate = nrm((N_MOE, N_EXPERTS, D_MODEL, D_FF), D_MODEL ** -0.5)
    moe_w_up = nrm((N_MOE, N_EXPERTS, D_MODEL, D_FF), D_MODEL ** -0.5)
    moe_w_down = nrm((N_MOE, N_EXPERTS, D_FF, D_MODEL), D_FF ** -0.5)
    return {'x': x, 'c': c, 'positions': positions, 'ada_w': ada_w, 'ada_b': ada_b,
            'norm_pre_mix': norm_pre_mix, 'norm_post_mix': norm_post_mix,
            'norm_pre_ffn': norm_pre_ffn, 'norm_post_ffn': norm_post_ffn,
            'w_in': w_in, 'ret_norm': ret_norm,
            'ssm_a_re': ssm_a_re, 'ssm_a_im': ssm_a_im, 'ssm_b_re': ssm_b_re, 'ssm_b_im': ssm_b_im,
            'ssm_c_re': ssm_c_re, 'ssm_c_im': ssm_c_im, 'ssm_d': ssm_d, 'ssm_log_dt': ssm_log_dt,
            'ssm_glu_w': ssm_glu_w, 'ssm_glu_b': ssm_glu_b, 'ssm_norm': ssm_norm,
            'mla_q_norm': mla_q_norm, 'mla_w_uq': mla_w_uq, 'mla_kv_norm': mla_kv_norm,
            'mla_w_ukv': mla_w_ukv, 'mla_norm': mla_norm, 'w_out': w_out,
            'ffn_w_gate': ffn_w_gate, 'ffn_w_up': ffn_w_up, 'ffn_w_down': ffn_w_down,
            'moe_router': moe_router, 'moe_w_gate': moe_w_gate, 'moe_w_up': moe_w_up,
            'moe_w_down': moe_w_down}


def reference(x, c, positions, ada_w, ada_b, norm_pre_mix, norm_post_mix, norm_pre_ffn, norm_post_ffn,
              w_in, ret_norm, ssm_a_re, ssm_a_im, ssm_b_re, ssm_b_im, ssm_c_re, ssm_c_im, ssm_d,
              ssm_log_dt, ssm_glu_w, ssm_glu_b, ssm_norm, mla_q_norm, mla_w_uq, mla_kv_norm,
              mla_w_ukv, mla_norm, w_out, ffn_w_gate, ffn_w_up, ffn_w_down, moe_router,
              moe_w_gate, moe_w_up, moe_w_down):
    cos, sin = rope_tables(positions)
    cond = jax.nn.silu(c)
    for layer in range(DEPTH):
        mod = (cond @ ada_w[layer] + ada_b[layer])[:, None, :]
        sh_m, sc_m, gt_m, sh_f, sc_f, gt_f = jnp.split(mod, 6, axis=-1)
        h = rms_norm(x, norm_pre_mix[layer]) * (1.0 + sc_m) + sh_m
        y = hybrid_mixer(h, cos, sin, w_in[layer], ret_norm[layer], ssm_a_re[layer], ssm_a_im[layer],
                         ssm_b_re[layer], ssm_b_im[layer], ssm_c_re[layer], ssm_c_im[layer], ssm_d[layer],
                         ssm_log_dt[layer], ssm_glu_w[layer], ssm_glu_b[layer], ssm_norm[layer],
                         mla_q_norm[layer], mla_w_uq[layer], mla_kv_norm[layer], mla_w_ukv[layer],
                         mla_norm[layer], w_out[layer])
        x = x + gt_m * rms_norm(y, norm_post_mix[layer])
        h = rms_norm(x, norm_pre_ffn[layer]) * (1.0 + sc_f) + sh_f
        j = layer // 2
        if layer % 2 == 0:
            y = swiglu(h, ffn_w_gate[j], ffn_w_up[j], ffn_w_down[j])
        else:
            y = routed_ffn(h, moe_router[j], moe_w_gate[j], moe_w_up[j], moe_w_down[j])
        x = x + gt_f * rms_norm(y, norm_post_ffn[layer])
    return x
```

```cpp
#include <hip/hip_runtime.h>
#include <stdint.h>
#include <math.h>
namespace ora {
constexpr int NB = 2, SEQ = 8192, NTOK = 16384, DM = 1024, INC = 1728, DFF = 3584, NE = 8;
constexpr float EPS = 1e-6f;
constexpr size_t MiB = 1u << 20;
constexpr size_t O_MOD = 0, O_CS = 1 * MiB, O_CNT = 5 * MiB, O_LIST = 6 * MiB, O_LW = 7 * MiB;
constexpr size_t O_H = 8 * MiB  , O_PROJ = 72 * MiB, O_HC = 72 * MiB, O_YC = 128 * MiB;
constexpr size_t O_Q = 180 * MiB, O_KV = 228 * MiB, O_KPE = 292 * MiB, O_Z = 296 * MiB, O_Y = 312 * MiB, O_END = 376 * MiB;

__device__ __forceinline__ float silu_f(float v) { return v / (1.f + expf(-v)); }
__device__ __forceinline__ float wave_sum(float v) {
#pragma unroll
    for (int o = 32; o >= 1; o >>= 1) v += __shfl_xor(v, o);
    return v;
}
__device__ __forceinline__ float block_sum256(float v) {
    __shared__ float s_[4];
    v = wave_sum(v);
    if ((threadIdx.x & 63) == 0) s_[threadIdx.x >> 6] = v;
    __syncthreads();
    float r = (s_[0] + s_[1]) + (s_[2] + s_[3]);
    __syncthreads();
    return r;
}

__global__ __launch_bounds__(256) void k_mod(const float* c, const float* ada_w, const float* ada_b, float* mod) {
    __shared__ float sc[1024];
    const int n = blockIdx.x * 256 + threadIdx.x, b = blockIdx.y, l = blockIdx.z;
    for (int k = threadIdx.x; k < 1024; k += 256) sc[k] = silu_f(c[b * 1024 + k]);
    __syncthreads();
    const float* w = ada_w + (size_t)l * 1024 * 6144 + n;
    float acc = ada_b[l * 6144 + n];
    for (int k = 0; k < 1024; ++k) acc += sc[k] * w[(size_t)k * 6144];
    mod[(l * 2 + b) * 6144 + n] = acc;
}
__global__ __launch_bounds__(256) void k_rope_table(const int* pos, float2* cs) {
    const int idx = blockIdx.x * 256 + threadIdx.x, row = idx >> 5, i = idx & 31;
    const float inv = exp2f(-(float)i * (13.287712379549449f / 32.0f));
    const float ang = (float)pos[row] * inv;
    const double rev = (double)ang * 0.15915494309189535;
    const float fr = (float)(rev - floor(rev));
    cs[idx] = make_float2(__builtin_amdgcn_cosf(fr), __builtin_amdgcn_sinf(fr));
}
__global__ __launch_bounds__(256) void k_prenorm(const float* x, const float* g, const float* modl, int sc_off, int sh_off, float* out) {
    const int row = blockIdx.x, b = row / SEQ, t = threadIdx.x;
    const float4 v = ((const float4*)(x + (size_t)row * DM))[t];
    const float ss = block_sum256(v.x * v.x + v.y * v.y + v.z * v.z + v.w * v.w);
    const float rstd = rsqrtf(ss * (1.f / DM) + EPS);
    const float4 gg = ((const float4*)g)[t], sc = ((const float4*)(modl + b * 6144 + sc_off))[t], sh = ((const float4*)(modl + b * 6144 + sh_off))[t];
    float4 o;
    o.x = v.x * rstd * gg.x * (1.f + sc.x) + sh.x; o.y = v.y * rstd * gg.y * (1.f + sc.y) + sh.y;
    o.z = v.z * rstd * gg.z * (1.f + sc.z) + sh.z; o.w = v.w * rstd * gg.w * (1.f + sc.w) + sh.w;
    ((float4*)(out + (size_t)row * DM))[t] = o;
}
__global__ __launch_bounds__(256) void k_resid(const float* xin, const float* y, const float* g, const float* modl, int gt_off, float* xout) {
    const int row = blockIdx.x, b = row / SEQ, t = threadIdx.x;
    const float4 v = ((const float4*)(y + (size_t)row * DM))[t];
    const float ss = block_sum256(v.x * v.x + v.y * v.y + v.z * v.z + v.w * v.w);
    const float rstd = rsqrtf(ss * (1.f / DM) + EPS);
    const float4 gg = ((const float4*)g)[t], gt = ((const float4*)(modl + b * 6144 + gt_off))[t], xi = ((const float4*)(xin + (size_t)row * DM))[t];
    float4 o;
    o.x = xi.x + gt.x * v.x * rstd * gg.x; o.y = xi.y + gt.y * v.y * rstd * gg.y;
    o.z = xi.z + gt.z * v.z * rstd * gg.z; o.w = xi.w + gt.w * v.w * rstd * gg.w;
    ((float4*)(xout + (size_t)row * DM))[t] = o;
}
template <int MODE>
__global__ __launch_bounds__(256) void k_gemm(const float* __restrict__ A, int lda, const float* __restrict__ B, const float* __restrict__ B2, int ldb,
                                              float* __restrict__ C, int ldc, int K, const int* __restrict__ rowidx, const int* __restrict__ cntp, int row_off, int a_sub, int c_sub) {
    __shared__ float As[16][68];
    __shared__ float Bs[16][64];
    __shared__ float B2s[MODE == 1 ? 16 : 1][64];
    const int tid = threadIdx.x, tx = tid & 15, ty = tid >> 4;
    const int gm0 = row_off + blockIdx.y * 64, n0 = blockIdx.x * 64;
    const int cnt = cntp ? *cntp : 0x7fffffff;
    if (gm0 >= cnt) return;
    const int lr = tid >> 2, kq = tid & 3;
    int gml = gm0 + lr; if (gml >= cnt) gml = cnt - 1;
    const int arow = (rowidx ? rowidx[gml] : gml) - a_sub;
    const float* ap = A + (size_t)arow * lda + kq * 4;
    const float* bp = B + (size_t)(tid >> 4) * ldb + n0 + (tid & 15) * 4;
    const float* bp2 = MODE == 1 ? B2 + (size_t)(tid >> 4) * ldb + n0 + (tid & 15) * 4 : nullptr;
    float acc[4][4], acc2[4][4];
#pragma unroll
    for (int i = 0; i < 4; ++i)
#pragma unroll
        for (int j = 0; j < 4; ++j) { acc[i][j] = 0.f; acc2[i][j] = 0.f; }
    for (int k0 = 0; k0 < K; k0 += 16) {
        const float4 av = *(const float4*)(ap + k0);
        const float4 bv = *(const float4*)(bp + (size_t)k0 * ldb);
        float4 bv2 = make_float4(0.f, 0.f, 0.f, 0.f);
        if (MODE == 1) bv2 = *(const float4*)(bp2 + (size_t)k0 * ldb);
        __syncthreads();
        As[kq * 4 + 0][lr] = av.x; As[kq * 4 + 1][lr] = av.y; As[kq * 4 + 2][lr] = av.z; As[kq * 4 + 3][lr] = av.w;
        *(float4*)&Bs[tid >> 4][(tid & 15) * 4] = bv;
        if (MODE == 1) *(float4*)&B2s[tid >> 4][(tid & 15) * 4] = bv2;
        __syncthreads();
#pragma unroll
        for (int k = 0; k < 16; ++k) {
            const float4 a = *(const float4*)&As[k][ty * 4];
            const float4 b = *(const float4*)&Bs[k][tx * 4];
            const float aa[4] = {a.x, a.y, a.z, a.w}, bb[4] = {b.x, b.y, b.z, b.w};
#pragma unroll
            for (int i = 0; i < 4; ++i)
#pragma unroll
                for (int j = 0; j < 4; ++j) acc[i][j] += aa[i] * bb[j];
            if (MODE == 1) {
                const float4 b2 = *(const float4*)&B2s[k][tx * 4];
                const float cc[4] = {b2.x, b2.y, b2.z, b2.w};
#pragma unroll
                for (int i = 0; i < 4; ++i)
#pragma unroll
                    for (int j = 0; j < 4; ++j) acc2[i][j] += aa[i] * cc[j];
            }
        }
    }
#pragma unroll
    for (int i = 0; i < 4; ++i) {
        const int gm = gm0 + ty * 4 + i;
        if (gm < cnt) {
            float4 o;
            if (MODE == 1) { o.x = silu_f(acc[i][0]) * acc2[i][0]; o.y = silu_f(acc[i][1]) * acc2[i][1]; o.z = silu_f(acc[i][2]) * acc2[i][2]; o.w = silu_f(acc[i][3]) * acc2[i][3]; }
            else { o.x = acc[i][0]; o.y = acc[i][1]; o.z = acc[i][2]; o.w = acc[i][3]; }
            *(float4*)(C + (size_t)(gm - c_sub) * ldc + n0 + tx * 4) = o;
        }
    }
}
__global__ __launch_bounds__(256) void k_rope_apply(float* buf, int ld, int col0, int gstride, int ngroups, const float2* cs, float s, float* outbuf, int ldo, int ocol0, int ogstride) {
    const int idx = blockIdx.x * 256 + threadIdx.x, i = idx & 31, g = (idx >> 5) % ngroups, row = (idx >> 5) / ngroups;
    float* p = buf + (size_t)row * ld + col0 + g * gstride;
    const float2 c = cs[row * 32 + i];
    const float x1 = p[i], x2 = p[i + 32];
    float* q = outbuf + (size_t)row * ldo + ocol0 + g * ogstride;
    q[i] = (x1 * c.x - x2 * c.y) * s; q[i + 32] = (x2 * c.x + x1 * c.y) * s;
}
__global__ __launch_bounds__(256) void k_rmsnorm_cols(float* buf, int ld, int col0, int width, int ngroups, const float* gain, const float* gate, int ldg, int gcol0) {
    const int wv = blockIdx.x * 4 + (threadIdx.x >> 6), lane = threadIdx.x & 63, g = wv % ngroups, row = wv / ngroups;
    float* p = buf + (size_t)row * ld + col0 + g * width;
    float ss = 0.f;
    for (int c = lane; c < width; c += 64) { const float v = p[c]; ss += v * v; }
    ss = wave_sum(ss);
    const float rstd = rsqrtf(ss / (float)width + EPS);
    for (int c = lane; c < width; c += 64) {
        float v = p[c] * rstd * gain[g * width + c];
        if (gate) v *= silu_f(gate[(size_t)row * ldg + gcol0 + g * width + c]);
        p[c] = v;
    }
}
template <int DQK, int DK1, int DV, bool RET>
__global__ __launch_bounds__(256) void k_causal(const float* __restrict__ Q, int ldq, int qhs, const float* __restrict__ K1, int ldk1, int k1hs, const float* __restrict__ K2, int ldk2,
                                                const float* __restrict__ V, int ldv, int vhs, float* __restrict__ O, int ldo, int ohs, float scale, int nheads) {
    extern __shared__ float sm[];
    constexpr int QS = DQK + 4, PS = 68, NC2 = DV / 64;
    float* Qs = sm; float* Ks = Qs + 64 * QS; float* Vs = Ks + 64 * QS; float* Ps = Vs + 64 * DV;
    const int tid = threadIdx.x, tx = tid & 15, ty = tid >> 4;
    const int qb = (gridDim.x - 1) - blockIdx.x, bh = blockIdx.y, b = bh / nheads, h = bh % nheads;
    const size_t row0 = (size_t)b * SEQ + (size_t)qb * 64;
    for (int idx = tid; idx < 64 * (DQK / 4); idx += 256) { const int r = idx / (DQK / 4), c4 = idx % (DQK / 4);
        *(float4*)&Qs[r * QS + 4 * c4] = *(const float4*)(Q + (row0 + r) * ldq + h * qhs + 4 * c4); }
    float m[4], l[4], o[4][NC2][4];
#pragma unroll
    for (int r = 0; r < 4; ++r) { m[r] = -INFINITY; l[r] = 0.f;
#pragma unroll
        for (int c2 = 0; c2 < NC2; ++c2)
#pragma unroll
            for (int j = 0; j < 4; ++j) o[r][c2][j] = 0.f; }
    float lg = 0.f;
    if (RET) lg = log1pf(-exp2f(-5.f - (float)h));
    for (int kt = 0; kt <= qb; ++kt) {
        const size_t kr0 = (size_t)b * SEQ + (size_t)kt * 64;
        __syncthreads();
        for (int idx = tid; idx < 64 * (DK1 / 4); idx += 256) { const int r = idx / (DK1 / 4), c4 = idx % (DK1 / 4);
            *(float4*)&Ks[r * QS + 4 * c4] = *(const float4*)(K1 + (kr0 + r) * ldk1 + h * k1hs + 4 * c4); }
        if constexpr (DQK > DK1) { for (int idx = tid; idx < 64 * ((DQK - DK1) / 4); idx += 256) { const int r = idx / ((DQK - DK1) / 4), c4 = idx % ((DQK - DK1) / 4);
            *(float4*)&Ks[r * QS + DK1 + 4 * c4] = *(const float4*)(K2 + (kr0 + r) * ldk2 + 4 * c4); } }
        for (int idx = tid; idx < 64 * (DV / 4); idx += 256) { const int r = idx / (DV / 4), c4 = idx % (DV / 4);
            *(float4*)&Vs[r * DV + 4 * c4] = *(const float4*)(V + (kr0 + r) * ldv + h * vhs + 4 * c4); }
        __syncthreads();
        float s[4][4];
#pragma unroll
        for (int r = 0; r < 4; ++r)
#pragma unroll
            for (int c = 0; c < 4; ++c) s[r][c] = 0.f;
        for (int d = 0; d < DQK; d += 4) {
            float4 q4[4], k4[4];
#pragma unroll
            for (int r = 0; r < 4; ++r) q4[r] = *(const float4*)&Qs[(4 * ty + r) * QS + d];
#pragma unroll
            for (int c = 0; c < 4; ++c) k4[c] = *(const float4*)&Ks[(tx + 16 * c) * QS + d];
#pragma unroll
            for (int r = 0; r < 4; ++r)
#pragma unroll
                for (int c = 0; c < 4; ++c) s[r][c] += q4[r].x * k4[c].x + q4[r].y * k4[c].y + q4[r].z * k4[c].z + q4[r].w * k4[c].w;
        }
#pragma unroll
        for (int r = 0; r < 4; ++r) {
            const int i = qb * 64 + 4 * ty + r;
            if (RET) {
#pragma unroll
                for (int c = 0; c < 4; ++c) { const int j = kt * 64 + tx + 16 * c; Ps[(4 * ty + r) * PS + tx + 16 * c] = (j <= i) ? s[r][c] * expf(lg * (float)(i - j)) : 0.f; }
            } else {
                float mx = -INFINITY;
#pragma unroll
                for (int c = 0; c < 4; ++c) { const int j = kt * 64 + tx + 16 * c; s[r][c] = (j <= i) ? s[r][c] * scale : -INFINITY; mx = fmaxf(mx, s[r][c]); }
                mx = fmaxf(mx, __shfl_xor(mx, 1)); mx = fmaxf(mx, __shfl_xor(mx, 2)); mx = fmaxf(mx, __shfl_xor(mx, 4)); mx = fmaxf(mx, __shfl_xor(mx, 8));
                const float mn = fmaxf(m[r], mx);
                const float alpha = expf(m[r] - mn);
                float rs = 0.f;
#pragma unroll
                for (int c = 0; c < 4; ++c) { const float p = expf(s[r][c] - mn); rs += p; Ps[(4 * ty + r) * PS + tx + 16 * c] = p; }
                rs += __shfl_xor(rs, 1); rs += __shfl_xor(rs, 2); rs += __shfl_xor(rs, 4); rs += __shfl_xor(rs, 8);
                l[r] = l[r] * alpha + rs; m[r] = mn;
#pragma unroll
                for (int c2 = 0; c2 < NC2; ++c2)
#pragma unroll
                    for (int j = 0; j < 4; ++j) o[r][c2][j] *= alpha;
            }
        }
        __syncthreads();
        for (int j0 = 0; j0 < 64; j0 += 4) {
            float4 p4[4];
#pragma unroll
            for (int r = 0; r < 4; ++r) p4[r] = *(const float4*)&Ps[(4 * ty + r) * PS + j0];
#pragma unroll
            for (int jj = 0; jj < 4; ++jj) {
#pragma unroll
                for (int c2 = 0; c2 < NC2; ++c2) {
                    const float4 v = *(const float4*)&Vs[(j0 + jj) * DV + 4 * tx + 64 * c2];
#pragma unroll
                    for (int r = 0; r < 4; ++r) { const float p = jj == 0 ? p4[r].x : jj == 1 ? p4[r].y : jj == 2 ? p4[r].z : p4[r].w;
                        o[r][c2][0] += p * v.x; o[r][c2][1] += p * v.y; o[r][c2][2] += p * v.z; o[r][c2][3] += p * v.w; }
                }
            }
        }
    }
#pragma unroll
    for (int r = 0; r < 4; ++r) {
        const float inv = RET ? 1.f : 1.f / l[r];
#pragma unroll
        for (int c2 = 0; c2 < NC2; ++c2) {
            float4 ov; ov.x = o[r][c2][0] * inv; ov.y = o[r][c2][1] * inv; ov.z = o[r][c2][2] * inv; ov.w = o[r][c2][3] * inv;
            *(float4*)(O + (row0 + 4 * ty + r) * ldo + h * ohs + 4 * tx + 64 * c2) = ov;
        }
    }
}
__global__ __launch_bounds__(64) void k_ssm(const float* __restrict__ u, int ldu, const float* a_re, const float* a_im, const float* b_re, const float* b_im,
                                           const float* c_re, const float* c_im, const float* dpar, const float* log_dt, float* __restrict__ yout, int ldo) {
    const int g = blockIdx.x, b = blockIdx.y, p = threadIdx.x, lane = p;
    const float dt = expf(log_dt[g]);
    const float lr = a_re[g * 64 + p], li = a_im[g * 64 + p];
    const float mag = expf(lr * dt);
    float sn, cn; sincosf(li * dt, &sn, &cn);
    const float lbr = mag * cn, lbi = mag * sn;
    const float nr = lbr - 1.f, ni = lbi, den = lr * lr + li * li;
    const float fr = (nr * lr + ni * li) / den, fi = (ni * lr - nr * li) / den;
    float bbr[16], bbi[16], cr[16], ci[16], dd[16];
#pragma unroll
    for (int h = 0; h < 16; ++h) {
        const float br = b_re[(g * 64 + p) * 16 + h], bi = b_im[(g * 64 + p) * 16 + h];
        bbr[h] = fr * br - fi * bi; bbi[h] = fr * bi + fi * br;
        cr[h] = c_re[(g * 16 + h) * 64 + p]; ci[h] = c_im[(g * 16 + h) * 64 + p];
        dd[h] = (p == 0) ? dpar[g * 16 + h] : 0.f;
    }
    float sr = 0.f, si = 0.f;
    const int hsel = ((lane >> 5) & 1) * 8 + ((lane >> 4) & 1) * 4 + ((lane >> 3) & 1) * 2 + ((lane >> 2) & 1);
    for (int t = 0; t < SEQ; ++t) {
        const float* up = u + (size_t)(b * SEQ + t) * ldu + g * 16;
        const float4 u0 = *(const float4*)(up), u1 = *(const float4*)(up + 4), u2 = *(const float4*)(up + 8), u3 = *(const float4*)(up + 12);
        const float uu[16] = {u0.x, u0.y, u0.z, u0.w, u1.x, u1.y, u1.z, u1.w, u2.x, u2.y, u2.z, u2.w, u3.x, u3.y, u3.z, u3.w};
        float bur = 0.f, bui = 0.f;
#pragma unroll
        for (int h = 0; h < 16; ++h) { bur += bbr[h] * uu[h]; bui += bbi[h] * uu[h]; }
        const float nsr = lbr * sr - lbi * si + bur, nsi = lbr * si + lbi * sr + bui;
        sr = nsr; si = nsi;
        float v[16];
#pragma unroll
        for (int h = 0; h < 16; ++h) v[h] = cr[h] * sr - ci[h] * si + dd[h] * uu[h];
        float w8[8], w4[4], w2[2], w1;
        { const bool hi = (lane & 32) != 0;
#pragma unroll
          for (int i = 0; i < 8; ++i) { const float keep = hi ? v[i + 8] : v[i], send = hi ? v[i] : v[i + 8]; w8[i] = keep + __shfl_xor(send, 32); } }
        { const bool hi = (lane & 16) != 0;
#pragma unroll
          for (int i = 0; i < 4; ++i) { const float keep = hi ? w8[i + 4] : w8[i], send = hi ? w8[i] : w8[i + 4]; w4[i] = keep + __shfl_xor(send, 16); } }
        { const bool hi = (lane & 8) != 0;
#pragma unroll
          for (int i = 0; i < 2; ++i) { const float keep = hi ? w4[i + 2] : w4[i], send = hi ? w4[i] : w4[i + 2]; w2[i] = keep + __shfl_xor(send, 8); } }
        { const bool hi = (lane & 4) != 0; const float keep = hi ? w2[1] : w2[0], send = hi ? w2[0] : w2[1]; w1 = keep + __shfl_xor(send, 4); }
        w1 += __shfl_xor(w1, 1); w1 += __shfl_xor(w1, 2);
        if ((lane & 3) == 0) yout[(size_t)(b * SEQ + t) * ldo + g * 16 + hsel] = w1;
    }
}
__device__ __forceinline__ float gelu_tanh(float x) { const float t = tanhf(0.7978845608028654f * (x + 0.044715f * x * x * x)); return 0.5f * x * (1.f + t); }
__global__ __launch_bounds__(256) void k_gelu_cols(float* buf, int ld, int col0, int width) {
    const int idx = blockIdx.x * 256 + threadIdx.x, c = idx % width, row = idx / width;
    float* p = buf + (size_t)row * ld + col0 + c; *p = gelu_tanh(*p);
}
__global__ __launch_bounds__(256) void k_glu_gate(float* buf, int ld, int col0, int width, const float* z, const float* bias) {
    const int idx = blockIdx.x * 256 + threadIdx.x, c = idx % width, row = idx / width;
    float* p = buf + (size_t)row * ld + col0 + c; const float zz = z[(size_t)row * width + c] + bias[c]; *p = *p / (1.f + expf(-zz));
}
__global__ __launch_bounds__(256) void k_router(const float* __restrict__ h, const float* __restrict__ router, int* cnt, int* list, float* lw) {
    const int tok = blockIdx.x * 4 + (threadIdx.x >> 6), lane = threadIdx.x & 63;
    float acc[8];
#pragma unroll
    for (int e = 0; e < 8; ++e) acc[e] = 0.f;
    for (int k = lane; k < DM; k += 64) { const float hv = h[(size_t)tok * DM + k]; const float4 r0 = *(const float4*)(router + k * 8), r1 = *(const float4*)(router + k * 8 + 4);
        acc[0] += hv * r0.x; acc[1] += hv * r0.y; acc[2] += hv * r0.z; acc[3] += hv * r0.w; acc[4] += hv * r1.x; acc[5] += hv * r1.y; acc[6] += hv * r1.z; acc[7] += hv * r1.w; }
#pragma unroll
    for (int e = 0; e < 8; ++e) acc[e] = wave_sum(acc[e]);
    if (lane == 0) {
        int i1 = 0; float v1 = acc[0];
#pragma unroll
        for (int e = 1; e < 8; ++e) if (acc[e] > v1) { v1 = acc[e]; i1 = e; }
        int i2 = -1; float v2 = -INFINITY;
#pragma unroll
        for (int e = 0; e < 8; ++e) if (e != i1 && acc[e] > v2) { v2 = acc[e]; i2 = e; }
        const float e2 = expf(v2 - v1), w1 = 1.f / (1.f + e2), w2 = e2 / (1.f + e2);
        const int p1 = atomicAdd(&cnt[i1], 1); list[i1 * NTOK + p1] = tok; lw[i1 * NTOK + p1] = w1;
        const int p2 = atomicAdd(&cnt[i2], 1); list[i2 * NTOK + p2] = tok; lw[i2 * NTOK + p2] = w2;
    }
}
__global__ __launch_bounds__(256) void k_scatter(const float* __restrict__ yc, const int* cntp, const int* list, const float* lw, int r0, float* y) {
    const int m = blockIdx.x, gm = r0 + m;
    if (gm >= *cntp) return;
    const int tok = list[gm]; const float w = lw[gm];
    const float4 v = ((const float4*)(yc + (size_t)m * DM))[threadIdx.x];
    float* yp = y + (size_t)tok * DM + threadIdx.x * 4;
    atomicAdd(yp + 0, w * v.x); atomicAdd(yp + 1, w * v.y); atomicAdd(yp + 2, w * v.z); atomicAdd(yp + 3, w * v.w);
}

struct In {
    const float *x, *c; const int* pos; const float *ada_w, *ada_b, *n_pre_mix, *n_post_mix, *n_pre_ffn, *n_post_ffn, *w_in, *ret_norm, *a_re, *a_im, *b_re, *b_im, *c_re, *c_im,
        *ssm_d, *log_dt, *glu_w, *glu_b, *ssm_norm, *q_norm, *w_uq, *kv_norm, *w_ukv, *mla_norm, *w_out, *ffn_wg, *ffn_wu, *ffn_wd, *router, *moe_wg, *moe_wu, *moe_wd;
};
inline In make_in(void* const* d) {
    In i; i.x = (const float*)d[0]; i.c = (const float*)d[1]; i.pos = (const int*)d[2]; i.ada_w = (const float*)d[3]; i.ada_b = (const float*)d[4];
    i.n_pre_mix = (const float*)d[5]; i.n_post_mix = (const float*)d[6]; i.n_pre_ffn = (const float*)d[7]; i.n_post_ffn = (const float*)d[8]; i.w_in = (const float*)d[9];
    i.ret_norm = (const float*)d[10]; i.a_re = (const float*)d[11]; i.a_im = (const float*)d[12]; i.b_re = (const float*)d[13]; i.b_im = (const float*)d[14];
    i.c_re = (const float*)d[15]; i.c_im = (const float*)d[16]; i.ssm_d = (const float*)d[17]; i.log_dt = (const float*)d[18]; i.glu_w = (const float*)d[19];
    i.glu_b = (const float*)d[20]; i.ssm_norm = (const float*)d[21]; i.q_norm = (const float*)d[22]; i.w_uq = (const float*)d[23]; i.kv_norm = (const float*)d[24];
    i.w_ukv = (const float*)d[25]; i.mla_norm = (const float*)d[26]; i.w_out = (const float*)d[27]; i.ffn_wg = (const float*)d[28]; i.ffn_wu = (const float*)d[29];
    i.ffn_wd = (const float*)d[30]; i.router = (const float*)d[31]; i.moe_wg = (const float*)d[32]; i.moe_wu = (const float*)d[33]; i.moe_wd = (const float*)d[34];
    return i;
}

inline void run(const In& I, float* out, char* ws, hipStream_t st) {
    float* MOD = (float*)(ws + O_MOD); float2* CS = (float2*)(ws + O_CS); int* CNT = (int*)(ws + O_CNT); int* LIST = (int*)(ws + O_LIST); float* LW = (float*)(ws + O_LW);
    float* H = (float*)(ws + O_H); float* MIX = H; float* PROJ = (float*)(ws + O_PROJ); float* HC = (float*)(ws + O_HC); float* YC = (float*)(ws + O_YC);
    float* Q = (float*)(ws + O_Q); float* KV = (float*)(ws + O_KV); float* KPE = (float*)(ws + O_KPE); float* Z = (float*)(ws + O_Z); float* Y = (float*)(ws + O_Y);
    static bool attr_done = false;
    if (!attr_done) { (void)hipFuncSetAttribute((const void*)k_causal<192, 128, 128, false>, hipFuncAttributeMaxDynamicSharedMemorySize, (64 * 196 * 2 + 64 * 128 + 64 * 68) * 4);
                      (void)hipFuncSetAttribute((const void*)k_causal<64, 64, 64, true>, hipFuncAttributeMaxDynamicSharedMemorySize, (64 * 68 * 2 + 64 * 64 + 64 * 68) * 4); attr_done = true; }
    k_mod<<<dim3(24, 2, 2), 256, 0, st>>>(I.c, I.ada_w, I.ada_b, MOD);
    k_rope_table<<<NTOK * 32 / 256, 256, 0, st>>>(I.pos, CS);
    const float* xin = I.x;
    for (int l = 0; l < 2; ++l) {
        const float* modl = MOD + l * 2 * 6144;
        k_prenorm<<<NTOK, 256, 0, st>>>(xin, I.n_pre_mix + l * DM, modl, 1 * DM, 0 * DM, H);
        k_gemm<0><<<dim3(INC / 64, NTOK / 64), 256, 0, st>>>(H, DM, I.w_in + (size_t)l * DM * INC, nullptr, INC, PROJ, INC, DM, nullptr, nullptr, 0, 0, 0);
        k_rope_apply<<<NTOK * 4 * 32 / 256, 256, 0, st>>>(PROJ, INC, 0, 64, 4, CS, 1.f, PROJ, INC, 0, 64);
        k_rope_apply<<<NTOK * 4 * 32 / 256, 256, 0, st>>>(PROJ, INC, 256, 64, 4, CS, 0.125f, PROJ, INC, 256, 64);
        k_causal<64, 64, 64, true><<<dim3(SEQ / 64, NB * 4), 256, (64 * 68 * 2 + 64 * 64 + 64 * 68) * 4, st>>>(PROJ, INC, 64, PROJ + 256, INC, 64, nullptr, 0, PROJ + 512, INC, 64, MIX, DM, 64, 1.f, 4);
        k_rmsnorm_cols<<<NTOK * 4 / 4, 256, 0, st>>>(MIX, DM, 0, 64, 4, I.ret_norm + l * 256, PROJ, INC, 768);
        k_ssm<<<dim3(16, NB), 64, 0, st>>>(PROJ + 1024, INC, I.a_re + l * 1024, I.a_im + l * 1024, I.b_re + l * 16384, I.b_im + l * 16384, I.c_re + l * 16384, I.c_im + l * 16384,
                                           I.ssm_d + l * 256, I.log_dt + l * 16, MIX + 256, DM);
        k_gelu_cols<<<NTOK * 256 / 256, 256, 0, st>>>(MIX, DM, 256, 256);
        k_gemm<0><<<dim3(256 / 64, NTOK / 64), 256, 0, st>>>(MIX + 256, DM, I.glu_w + l * 65536, nullptr, 256, Z, 256, 256, nullptr, nullptr, 0, 0, 0);
        k_glu_gate<<<NTOK * 256 / 256, 256, 0, st>>>(MIX, DM, 256, 256, Z, I.glu_b + l * 256);
        k_rmsnorm_cols<<<NTOK / 4, 256, 0, st>>>(MIX, DM, 256, 256, 1, I.ssm_norm + l * 256, nullptr, 0, 0);
        k_rmsnorm_cols<<<NTOK / 4, 256, 0, st>>>(PROJ, INC, 1280, 256, 1, I.q_norm + l * 256, nullptr, 0, 0);
        k_gemm<0><<<dim3(768 / 64, NTOK / 64), 256, 0, st>>>(PROJ + 1280, INC, I.w_uq + (size_t)l * 256 * 768, nullptr, 768, Q, 768, 256, nullptr, nullptr, 0, 0, 0);
        k_rope_apply<<<NTOK * 4 * 32 / 256, 256, 0, st>>>(Q, 768, 128, 192, 4, CS, 1.f, Q, 768, 128, 192);
        k_rmsnorm_cols<<<NTOK / 4, 256, 0, st>>>(PROJ, INC, 1536, 128, 1, I.kv_norm + l * 128, nullptr, 0, 0);
        k_gemm<0><<<dim3(1024 / 64, NTOK / 64), 256, 0, st>>>(PROJ + 1536, INC, I.w_ukv + (size_t)l * 128 * 1024, nullptr, 1024, KV, 1024, 128, nullptr, nullptr, 0, 0, 0);
        k_rope_apply<<<NTOK * 1 * 32 / 256, 256, 0, st>>>(PROJ, INC, 1664, 64, 1, CS, 1.f, KPE, 64, 0, 64);
        k_causal<192, 128, 128, false><<<dim3(SEQ / 64, NB * 4), 256, (64 * 196 * 2 + 64 * 128 + 64 * 68) * 4, st>>>(Q, 768, 192, KV, 1024, 256, KPE, 64, KV + 128, 1024, 256, MIX + 512, DM, 128,
                                                                                                                   0.07216878364870322f, 4);
        k_rmsnorm_cols<<<NTOK / 4, 256, 0, st>>>(MIX, DM, 512, 512, 1, I.mla_norm + l * 512, nullptr, 0, 0);
        k_gemm<0><<<dim3(DM / 64, NTOK / 64), 256, 0, st>>>(MIX, DM, I.w_out + (size_t)l * DM * DM, nullptr, DM, Y, DM, DM, nullptr, nullptr, 0, 0, 0);
        k_resid<<<NTOK, 256, 0, st>>>(xin, Y, I.n_post_mix + l * DM, modl, 2 * DM, out);
        xin = out;
        k_prenorm<<<NTOK, 256, 0, st>>>(xin, I.n_pre_ffn + l * DM, modl, 4 * DM, 3 * DM, H);
        if (l == 0) {
            for (int ch = 0; ch < 4; ++ch) {
                k_gemm<1><<<dim3(DFF / 64, 64), 256, 0, st>>>(H + (size_t)ch * 4096 * DM, DM, I.ffn_wg, I.ffn_wu, DFF, HC, DFF, DM, nullptr, nullptr, 0, 0, 0);
                k_gemm<0><<<dim3(DM / 64, 64), 256, 0, st>>>(HC, DFF, I.ffn_wd, nullptr, DM, Y + (size_t)ch * 4096 * DM, DM, DFF, nullptr, nullptr, 0, 0, 0);
            }
        } else {
            (void)hipMemsetAsync(CNT, 0, 64, st);
            (void)hipMemsetAsync(Y, 0, (size_t)NTOK * DM * 4, st);
            k_router<<<NTOK / 4, 256, 0, st>>>(H, I.router, CNT, LIST, LW);
            for (int e = 0; e < NE; ++e)
                for (int ch = 0; ch < 4; ++ch) {
                    const int r0 = ch * 4096;
                    k_gemm<1><<<dim3(DFF / 64, 64), 256, 0, st>>>(H, DM, I.moe_wg + (size_t)e * DM * DFF, I.moe_wu + (size_t)e * DM * DFF, DFF, HC, DFF, DM, LIST + e * NTOK, CNT + e, r0, 0, r0);
                    k_gemm<0><<<dim3(DM / 64, 64), 256, 0, st>>>(HC, DFF, I.moe_wd + (size_t)e * DFF * DM, nullptr, DM, YC, DM, DFF, nullptr, CNT + e, r0, r0, r0);
                    k_scatter<<<4096, 256, 0, st>>>(YC, CNT + e, LIST + e * NTOK, LW + e * NTOK, r0, Y);
                }
        }
        k_resid<<<NTOK, 256, 0, st>>>(xin, Y, I.n_post_ffn + l * DM, modl, 5 * DM, out);
    }
}
}
extern "C" void kernel_launch(void* const* d_in, const int* in_sizes, int n_in, void* d_out, int out_size, void* d_ws, size_t ws_size, hipStream_t stream) {
    (void)in_sizes; (void)n_in; (void)out_size; (void)ws_size;
    const ora::In I = ora::make_in(d_in);
    ora::run(I, (float*)d_out, (char*)d_ws, stream);
}
```

```cpp
#include <hip/hip_runtime.h>
#include <stdint.h>
#include <math.h>
#include <cstdio>
#define MK_PER_PHASE 1
#include <hip/hip_cooperative_groups.h>
#define GAS __attribute__((address_space(1)))
#define LAS __attribute__((address_space(3)))
namespace mk {
typedef unsigned short bf16;
typedef short bf16x8 __attribute__((ext_vector_type(8)));
typedef short s16x4 __attribute__((ext_vector_type(4)));
typedef float f32x2 __attribute__((ext_vector_type(2)));
typedef float f32x4 __attribute__((ext_vector_type(4)));
typedef float f32x16 __attribute__((ext_vector_type(16)));
typedef unsigned u32x2 __attribute__((ext_vector_type(2)));
typedef unsigned u32x4 __attribute__((ext_vector_type(4)));
typedef __bf16 bf16x2_t __attribute__((ext_vector_type(2)));
typedef GAS unsigned gu32;
#define RLX_AGENT __ATOMIC_RELAXED, __HIP_MEMORY_SCOPE_AGENT
__device__ __forceinline__ unsigned cvtpk(float lo, float hi) { f32x2 v = {lo, hi}; bf16x2_t b = __builtin_convertvector(v, bf16x2_t); return __builtin_bit_cast(unsigned, b); }
__device__ __forceinline__ float bf2f(unsigned short b) { return __builtin_bit_cast(float, (unsigned)b << 16); }
__device__ __forceinline__ float bflo(unsigned w) { return __builtin_bit_cast(float, w << 16); }
__device__ __forceinline__ float bfhi(unsigned w) { return __builtin_bit_cast(float, w & 0xffff0000u); }
__device__ __forceinline__ float wave_sum(float v) {
#pragma unroll
    for (int o = 1; o < 64; o <<= 1) v += __shfl_xor(v, o);
    return v;
}
__device__ __forceinline__ float fast_sigmoid(float z) { return __builtin_amdgcn_rcpf(1.f + __builtin_amdgcn_exp2f(-1.4426950408889634f * z)); }
__device__ __forceinline__ float silu_fast(float v) { return v * fast_sigmoid(v); }
__device__ __forceinline__ float gelu_tanh_fast(float x) { const float a = 0.7978845608028654f * (x + 0.044715f * x * x * x); return x * fast_sigmoid(2.f * a); }

constexpr int NB = 2, SEQ = 8192, NTOK = 16384, DM = 1024, INC = 1728, INCP = 1792, DFF = 3584, NE = 8, NWAVES = 8;
constexpr float EPS = 1e-6f;
constexpr int SSM_C = 32, SSM_NCH = NTOK / SSM_C  , SSM_K = 640;
constexpr int RET_C = 64, RET_NCH = SEQ / RET_C  ;
constexpr int MOE_MAXT = 136;
constexpr float QSCALE = 0.07216878364870322f * 1.4426950408889634f;

#define XB_TMO      128
#define XB_XCNT(j)  (256  + 64 * (j))
#define XB_XSUB(j)  (1280 + 64 * (j))
#define XB_XGEN(j)  (2304 + 64 * (j))
#define XB_TOP      3328
#define XB_TOPGEN   3392
#define XCD_BAR_WORDS 3456
#define XB_SPIN_CAP (1u << 20)
__device__ __forceinline__ unsigned xb_ld(unsigned* p)              { return __hip_atomic_load(p, __ATOMIC_RELAXED, __HIP_MEMORY_SCOPE_AGENT); }
__device__ __forceinline__ unsigned xb_add(unsigned* p, unsigned v) { return __hip_atomic_fetch_add(p, v, __ATOMIC_RELAXED, __HIP_MEMORY_SCOPE_AGENT); }
__device__ __forceinline__ unsigned xb_xcc_id() { return (unsigned)__builtin_amdgcn_s_getreg((3 << 11) | 20) & 0xFu; }
#define XB_SPIN(cond, bar) do { unsigned _sp = 0; while (cond) { __builtin_amdgcn_s_sleep(1); \
    if ((++_sp & 255u) == 0u) { if (xb_ld(&(bar)[XB_TMO])) break; if (_sp > XB_SPIN_CAP) { atomicAdd(&(bar)[XB_TMO], 1u); break; } } } } while (0)
struct XcdBarrier { unsigned* bar; unsigned x; volatile LAS unsigned* st; };
__device__ __forceinline__ XcdBarrier xcd_barrier_post(unsigned* bar, volatile LAS unsigned* st) {
    XcdBarrier b; b.bar = bar; b.x = xb_xcc_id(); b.st = st;
    if (threadIdx.x == 0) (void)xb_add(&bar[XB_XCNT(b.x)], 1u);
    return b;
}
__device__ __forceinline__ void xcd_barrier_complete(unsigned* bar, unsigned x, unsigned& nloc, unsigned& nx) {
    const unsigned G = gridDim.x * gridDim.y * gridDim.z;
    unsigned sum, cnt, mine, sp = 0u;
    for (;;) {
        sum = 0u; cnt = 0u; mine = 0u;
#pragma unroll
        for (unsigned j = 0; j < 16; ++j) { const unsigned c = xb_ld(&bar[XB_XCNT(j)]); sum += c; cnt += (c > 0u) ? 1u : 0u; mine = (j == x) ? c : mine; }
        if (sum == G) break;
        __builtin_amdgcn_s_sleep(1);
        if ((++sp & 255u) == 0u) { if (xb_ld(&bar[XB_TMO])) break; if (sp > XB_SPIN_CAP) { atomicAdd(&bar[XB_TMO], 1u); break; } }
    }
    nloc = mine > 0u ? mine : 1u; nx = cnt > 0u ? cnt : 1u;
}
__device__ __forceinline__ void xcd_barrier(const XcdBarrier& b) {
    asm volatile("s_waitcnt vmcnt(0)" ::: "memory");
    __syncthreads();
    if (threadIdx.x == 0) {
        unsigned* bar = b.bar;
        __builtin_amdgcn_s_waitcnt(0);
        unsigned nloc = b.st[0], nx = b.st[1];
        if (nloc == 0u) { xcd_barrier_complete(bar, b.x, nloc, nx); b.st[0] = nloc; b.st[1] = nx; }
        const unsigned old = xb_add(&bar[XB_XSUB(b.x)], 1u);
        const unsigned gen = old / nloc;
        if (old + 1u == (gen + 1u) * nloc) {
            __builtin_amdgcn_fence(__ATOMIC_RELEASE, "agent");
            asm volatile("s_waitcnt vmcnt(0)" ::: "memory");
            const unsigned og = xb_add(&bar[XB_TOP], 1u);
            const unsigned tg = og / nx;
            if (og + 1u == (tg + 1u) * nx) xb_add(&bar[XB_TOPGEN], 1u);
            else XB_SPIN(xb_ld(&bar[XB_TOPGEN]) == tg, bar);
            __builtin_amdgcn_fence(__ATOMIC_ACQUIRE, "agent");
            xb_add(&bar[XB_XGEN(b.x)], 1u);
            asm volatile("s_waitcnt vmcnt(0)" ::: "memory");
        } else {
            XB_SPIN(xb_ld(&bar[XB_XGEN(b.x)]) == gen, bar);
            __builtin_amdgcn_fence(__ATOMIC_ACQUIRE, "agent");
            asm volatile("s_waitcnt vmcnt(0)" ::: "memory");
        }
    }
    __syncthreads();
}
}
namespace pg8 {
#define PG8_LAS __attribute__((address_space(3)))
typedef unsigned short bf16_t;
typedef short bf16x8 __attribute__((ext_vector_type(8)));
typedef float f32x4 __attribute__((ext_vector_type(4)));
typedef unsigned u32x4 __attribute__((ext_vector_type(4)));
constexpr int BM = 256, BK = 64, HALF = 128, HTB = HALF * BK * 2, STAGE_BYTES = 8 * HTB, NXCD = 8, WGM = 8;
__host__ __device__ __forceinline__ int lds_byte(int r, int c) { const int st = (r >> 4) * 2 + (c >> 5), rr = r & 15, cc = c & 31, ob = rr * 64 + cc * 2; return st * 1024 + (ob ^ (((ob >> 9) & 1) << 5)); }
__host__ __device__ __forceinline__ void stage_rc(int b, int& R, int& C) { const int st = b / 1024, sb = b % 1024, swz = sb ^ (((sb >> 9) & 1) << 5); R = (st >> 1) * 16 + swz / 64; C = (st & 1) * 32 + (swz % 64) / 2; }
__host__ __device__ __forceinline__ int perm32(int rho) { const int n = rho >> 4, i = rho & 15; return 8 * (i >> 2) + 4 * n + (i & 3); }
struct Unit { const char* pA; const char* pB; int pm, pn; };
struct Gemm { int lda, ldb, K; };
struct TileOrder {
    const char* A; const char* Bt; size_t a_t, b_t, b_e; const int* texp; int nM, nN, nwg, G, c;
    __device__ __forceinline__ void init(const void* A_, int lda, const void* Bt_, int ldb, int nM_, int nN_, int G_, int c_) {
        A = (const char*)A_; Bt = (const char*)Bt_; a_t = (size_t)BM * lda * 2; b_t = (size_t)BM * ldb * 2; b_e = 0; texp = nullptr; nM = nM_; nN = nN_; nwg = nM * nN; G = G_; c = c_; }
    __device__ __forceinline__ bool next(int i, Unit& u) const {
        const long L = (long)i * G + c; if (L >= nwg) return false;
        int wgid = (int)L; { const int q = nwg / NXCD, r = nwg % NXCD, xcd = wgid % NXCD, off = wgid / NXCD; wgid = (xcd < r ? xcd * (q + 1) : r * (q + 1) + (xcd - r) * q) + off; }
        const int nig = WGM * nN, gid = wgid / nig, fm = gid * WGM, gsz = (nM - fm) < WGM ? (nM - fm) : WGM;
        u.pm = fm + ((wgid % nig) % gsz); u.pn = (wgid % nig) / gsz;
        u.pA = A + (size_t)u.pm * a_t; u.pB = Bt + (size_t)u.pn * b_t + (texp ? (size_t)texp[u.pm] * b_e : (size_t)0); return true;
    }
    __device__ __forceinline__ void a_ready(const Unit&) const {}
    __device__ __forceinline__ void done(const Unit&) const {}
};
struct GroupOrder {
    const char* A; const char* Bt; size_t a_t, b_t, a_g, b_g; int nM, nN, nwg, G, c;
    __device__ __forceinline__ void init(const void* A_, int lda, size_t a_g_, const void* Bt_, int ldb, size_t b_g_, int ng, int nM_, int nN_, int G_, int c_) {
        A = (const char*)A_; Bt = (const char*)Bt_; a_t = (size_t)BM * lda * 2; b_t = (size_t)BM * ldb * 2; a_g = a_g_; b_g = b_g_; nM = nM_; nN = nN_; nwg = ng * nM * nN; G = G_; c = c_; }
    __device__ __forceinline__ bool next(int i, Unit& u) const {
        const long L = (long)i * G + c; if (L >= nwg) return false;
        const int per = nM * nN, g = (int)L / per, r = (int)L % per, pm = r / nN, pn = r % nN;
        u.pm = g * nM + pm; u.pn = pn; u.pA = A + (size_t)g * a_g + (size_t)pm * a_t; u.pB = Bt + (size_t)g * b_g + (size_t)pn * b_t; return true;
    }
    __device__ __forceinline__ void a_ready(const Unit&) const {}
    __device__ __forceinline__ void done(const Unit&) const {}
};
template <class Epi, class Sched, bool ALIGN_EPI = false>
__device__ __forceinline__ void gemm_phase(PG8_LAS unsigned char* lds, const Gemm g, const Sched& S, const Epi& E) {
    int tid_ = threadIdx.x; asm volatile("" : "+v"(tid_));
    const int tid = tid_, wid = __builtin_amdgcn_readfirstlane(tid >> 6), lane = tid & 63, wr = wid >> 2, wc = wid & 3, fr = lane & 15, fq = lane >> 4;
    const int K = g.K, nt = K / BK, lda = g.lda, ldb = g.ldb;
    unsigned voffA[2], voffB[2];
#pragma unroll
    for (int i = 0; i < 2; ++i) { int R, C; stage_rc(tid * 16 + i * 8192, R, C); const int Rb = Epi::PERM ? ((R & ~31) + perm32(R & 31)) : R;
        voffA[i] = (unsigned)(R * lda + C) * 2u; voffB[i] = (unsigned)(Rb * ldb + C) * 2u; }
    const size_t kstep = (size_t)(BK * 2);
    const size_t hstepA = (size_t)HALF * lda * 2, hstepB = (size_t)HALF * ldb * 2;
    const unsigned ldsw = (unsigned)wid * 1024u;
    const int aoff = lds_byte(wr * 64 + fr, fq * 8), boff = lds_byte(wc * 32 + fr, fq * 8);
#define PG8_SA(b, h) (((b) * 2 + (h)) * HTB)
#define PG8_SB(b, h) ((4 + (b) * 2 + (h)) * HTB)
#define PG8_STAGE(bufoff, gbase, voff) do { _Pragma("unroll") for (int _i = 0; _i < 2; ++_i) \
        __builtin_amdgcn_global_load_lds((const unsigned*)((const char*)(gbase) + (voff)[_i]), (PG8_LAS unsigned*)(lds + (bufoff) + ldsw + _i * 8192), 16, 0, 0); } while (0)
#define PG8_LDA(dst, b, h) do { _Pragma("unroll") for (int m = 0; m < 4; ++m) _Pragma("unroll") for (int k = 0; k < 2; ++k) dst[m][k] = *(const PG8_LAS bf16x8*)(lds + PG8_SA(b, h) + aoff + m * 2048 + k * 1024); } while (0)
#define PG8_LDB(dst, b, h) do { _Pragma("unroll") for (int n = 0; n < 2; ++n) _Pragma("unroll") for (int k = 0; k < 2; ++k) dst[n][k] = *(const PG8_LAS bf16x8*)(lds + PG8_SB(b, h) + boff + n * 2048 + k * 1024); } while (0)
#define PG8_MMA(ai, bj, At, Bt) do { __builtin_amdgcn_s_setprio(1); _Pragma("unroll") for (int m = 0; m < 4; ++m) _Pragma("unroll") for (int n = 0; n < 2; ++n) _Pragma("unroll") for (int k = 0; k < 2; ++k) \
        acc[ai][bj][m][n] = __builtin_amdgcn_mfma_f32_16x16x32_bf16(Bt[n][k], At[m][k], acc[ai][bj][m][n], 0, 0, 0); __builtin_amdgcn_s_setprio(0); } while (0)
#define PG8_WAIT_V(n) asm volatile("s_waitcnt vmcnt(" #n ")" ::: "memory")
#define PG8_WAIT_L(n) asm volatile("s_waitcnt lgkmcnt(" #n ")" ::: "memory")
#define PG8_BAR __builtin_amdgcn_s_barrier()
#define PG8_SCHED __builtin_amdgcn_sched_barrier(0)
    Unit cur, nxt; int ui = 0;
    if (!S.next(0, cur)) return;
    f32x4 acc[2][2][4][2];
#pragma unroll
    for (int a = 0; a < 2; ++a)
#pragma unroll
        for (int b = 0; b < 2; ++b)
#pragma unroll
            for (int m = 0; m < 4; ++m)
#pragma unroll
                for (int n = 0; n < 2; ++n) acc[a][b][m][n] = (f32x4){0.f, 0.f, 0.f, 0.f};
    bf16x8 At[4][2], B0[2][2], B1[2][2];
    const char* cA = cur.pA; const char* cB = cur.pB;
    S.a_ready(cur);
    {
        PG8_STAGE(PG8_SB(0, 0), cB, voffB); PG8_STAGE(PG8_SB(0, 1), cB + hstepB, voffB); PG8_STAGE(PG8_SA(0, 0), cA, voffA); PG8_STAGE(PG8_SA(0, 1), cA + hstepA, voffA);
        if (wr == 1) PG8_BAR;
        PG8_WAIT_V(2); PG8_BAR;
        PG8_STAGE(PG8_SB(1, 0), cB + kstep, voffB); PG8_STAGE(PG8_SA(1, 0), cA + kstep, voffA); PG8_STAGE(PG8_SB(1, 1), cB + hstepB + kstep, voffB);
        PG8_WAIT_V(6); PG8_BAR;
    }
    for (;;) {
        const bool has_next = S.next(ui + 1, nxt);
        const char* nA = has_next ? nxt.pA : cA; const char* nB = has_next ? nxt.pB : cB;
        for (int t = 0; t < nt; t += 2) {
            const bool last = (t == nt - 2);
            const char* a1 = cA + (size_t)(t + 1) * kstep;
            const char* a2 = last ? nA : cA + (size_t)(t + 2) * kstep; const char* b2 = last ? nB : cB + (size_t)(t + 2) * kstep;
            const char* a3 = a2 + kstep; const char* b3 = b2 + kstep;
            if (last && has_next) S.a_ready(nxt);
            {
            PG8_LDB(B0, 0, 0); PG8_LDB(B1, 0, 1); PG8_SCHED; PG8_LDA(At, 0, 0); PG8_STAGE(PG8_SA(1, 1), a1 + hstepA, voffA);
            PG8_WAIT_V(8); PG8_WAIT_L(0); PG8_BAR; PG8_MMA(0, 0, At, B0); PG8_MMA(0, 1, At, B1); PG8_BAR; PG8_SCHED;
            PG8_LDA(At, 0, 1); PG8_STAGE(PG8_SB(0, 0), b2, voffB); PG8_STAGE(PG8_SB(0, 1), b2 + hstepB, voffB); PG8_STAGE(PG8_SA(0, 0), a2, voffA);
            PG8_WAIT_V(8); PG8_WAIT_L(0); PG8_BAR; PG8_MMA(1, 0, At, B0); PG8_MMA(1, 1, At, B1); PG8_BAR; PG8_SCHED;
            PG8_LDB(B0, 1, 0); PG8_LDB(B1, 1, 1); PG8_SCHED; PG8_LDA(At, 1, 0); PG8_STAGE(PG8_SA(0, 1), a2 + hstepA, voffA);
            PG8_WAIT_V(8); PG8_WAIT_L(0); PG8_BAR; PG8_MMA(0, 0, At, B0); PG8_MMA(0, 1, At, B1); PG8_BAR; PG8_SCHED;
            PG8_LDA(At, 1, 1); PG8_STAGE(PG8_SB(1, 0), b3, voffB); PG8_STAGE(PG8_SB(1, 1), b3 + hstepB, voffB); PG8_STAGE(PG8_SA(1, 0), a3, voffA);
            PG8_WAIT_V(8); PG8_WAIT_L(0); PG8_BAR; PG8_MMA(1, 0, At, B0); PG8_MMA(1, 1, At, B1); PG8_BAR; PG8_SCHED;
            }
        }
        if constexpr (ALIGN_EPI) { if (wr == 0) PG8_BAR; }
        if constexpr (!Epi::AFTER_DRAIN) { E(acc, cur, wr, wc, fr, fq); S.done(cur); }
        if (!has_next) break;
#pragma unroll
        for (int a = 0; a < 2; ++a)
#pragma unroll
            for (int b = 0; b < 2; ++b)
#pragma unroll
                for (int m = 0; m < 4; ++m)
#pragma unroll
                    for (int n = 0; n < 2; ++n) acc[a][b][m][n] = (f32x4){0.f, 0.f, 0.f, 0.f};
        cur = nxt; cA = nA; cB = nB; ++ui;
        if constexpr (ALIGN_EPI) { if (wr == 1) PG8_BAR; }
    }
    PG8_WAIT_V(0);
    if constexpr (!ALIGN_EPI) { if (wr == 0) PG8_BAR; }
    PG8_BAR;
    if constexpr (Epi::AFTER_DRAIN) { E.fused(acc, cur, wr, wc, fr, fq, lds, wid, lane); S.done(cur); }
#undef PG8_SA
#undef PG8_SB
#undef PG8_STAGE
#undef PG8_LDA
#undef PG8_LDB
#undef PG8_MMA
#undef PG8_WAIT_V
#undef PG8_WAIT_L
#undef PG8_BAR
#undef PG8_SCHED
}
}
namespace mk {
using pg8::Unit;
typedef f32x4 Acc[2][2][4][2];
__device__ __forceinline__ void st8(bf16* p, f32x4 v) { u32x2 w; w.x = cvtpk(v[0], v[1]); w.y = cvtpk(v[2], v[3]); *(u32x2*)p = w; }
__device__ __forceinline__ void st16(bf16* p, f32x4 a, f32x4 b) { u32x4 w; w.x = cvtpk(a[0], a[1]); w.y = cvtpk(a[2], a[3]); w.z = cvtpk(b[0], b[1]); w.w = cvtpk(b[2], b[3]); *(u32x4*)p = w; }
__device__ __forceinline__ f32x4 ld4bf(const bf16* p) { const u32x2 w = *(const u32x2*)p; return (f32x4){bflo(w.x), bfhi(w.x), bflo(w.y), bfhi(w.y)}; }
__device__ __forceinline__ f32x4 rope4(f32x4 v, f32x4 cs) { return (f32x4){v[0] * cs[0] - v[1] * cs[1], v[1] * cs[0] + v[0] * cs[1], v[2] * cs[2] - v[3] * cs[3], v[3] * cs[2] + v[2] * cs[3]}; }

struct EpiWin {
    static constexpr bool PERM = false, AFTER_DRAIN = false;
    bf16 *RQ, *RK, *RKT, *RVT, *RG, *UC, *CQ, *CKV, *KPE; float *SSQQ, *SSQKV; const f32x4* CS;
    __device__ __forceinline__ void operator()(const Acc& acc, const Unit& u, int wr, int wc, int fr, int fq) const { { int t_ = threadIdx.x; asm volatile("" : "+v"(t_)); fr = t_ & 15; fq = (t_ >> 4) & 3; }
        const int pn = u.pn, row0 = u.pm * 256 + wr * 64 + fr;
        if (pn <= 1) {
#pragma unroll
            for (int ai = 0; ai < 2; ++ai)
#pragma unroll
                for (int m = 0; m < 4; ++m) { const int row = row0 + ai * 128 + m * 16; const float pl = (float)(row & (RET_C - 1));
#pragma unroll
                    for (int bj = 0; bj < 2; ++bj) { const int head = 2 * bj + (wc >> 1);
                        const float lg2 = __builtin_amdgcn_logf(1.f - __builtin_amdgcn_exp2f(-5.f - (float)head));
                        const float dec = pn == 0 ? __builtin_amdgcn_exp2f(pl * lg2) : 0.125f * __builtin_amdgcn_exp2f(-pl * lg2);
#pragma unroll
                        for (int n = 0; n < 2; ++n) { const int i0 = 16 * (wc & 1) + 8 * n + 2 * fq; const f32x4 cs = CS[(row * 32 + i0) >> 1];
                            const f32x4 o = rope4(acc[ai][bj][m][n], cs) * dec; const int col = bj * 128 + wc * 32 + n * 16 + fq * 4;
                            st8((pn == 0 ? RQ : RK) + (size_t)row * 256 + col, o);
                            if (pn == 1) {
#pragma unroll
                                for (int j = 0; j < 4; ++j) RKT[(size_t)(col + j) * NTOK + row] = (bf16)(cvtpk(o[j], 0.f) & 0xffffu); } } } }
        } else if (pn == 2) {
#pragma unroll
            for (int ai = 0; ai < 2; ++ai)
#pragma unroll
                for (int m = 0; m < 4; ++m) { const int row = row0 + ai * 128 + m * 16;
#pragma unroll
                    for (int bj = 0; bj < 2; ++bj)
#pragma unroll
                        for (int n = 0; n < 2; ++n) { const int col = bj * 128 + wc * 32 + n * 16 + fq * 4; const f32x4 v = acc[ai][bj][m][n];
#pragma unroll
                            for (int j = 0; j < 4; ++j) RVT[(size_t)(col + j) * NTOK + row] = (bf16)(cvtpk(v[j], 0.f) & 0xffffu); } }
        } else if (pn == 3) {
#pragma unroll
            for (int ai = 0; ai < 2; ++ai)
#pragma unroll
                for (int m = 0; m < 4; ++m) { const int row = row0 + ai * 128 + m * 16;
#pragma unroll
                    for (int bj = 0; bj < 2; ++bj)
#pragma unroll
                        for (int n = 0; n < 2; ++n) { const int col = bj * 128 + wc * 32 + n * 16 + fq * 4; const f32x4 v = acc[ai][bj][m][n];
                            st8(RG + (size_t)row * 256 + col, (f32x4){silu_fast(v[0]), silu_fast(v[1]), silu_fast(v[2]), silu_fast(v[3])}); } }
        } else if (pn == 4) {
#pragma unroll
            for (int ai = 0; ai < 2; ++ai)
#pragma unroll
                for (int m = 0; m < 4; ++m) { const int row = row0 + ai * 128 + m * 16, chunk = row / SSM_C, t = row % SSM_C;
#pragma unroll
                    for (int bj = 0; bj < 2; ++bj)
#pragma unroll
                        for (int n = 0; n < 2; ++n) { const int g = 8 * bj + 2 * wc + n;
                            st8(UC + ((size_t)g * SSM_NCH + chunk) * SSM_K + t * 16 + 4 * fq, acc[ai][bj][m][n]); } }
        } else if (pn == 5) {
#pragma unroll
            for (int ai = 0; ai < 2; ++ai)
#pragma unroll
                for (int m = 0; m < 4; ++m) { const int row = row0 + ai * 128 + m * 16; float ss = 0.f;
#pragma unroll
                    for (int bj = 0; bj < 2; ++bj)
#pragma unroll
                        for (int n = 0; n < 2; ++n) { const f32x4 v = acc[ai][bj][m][n]; ss += (v[0] * v[0] + v[1] * v[1]) + (v[2] * v[2] + v[3] * v[3]);
                            st8(CQ + (size_t)row * 256 + bj * 128 + wc * 32 + n * 16 + fq * 4, v); }
                    ss += __shfl_xor(ss, 16); ss += __shfl_xor(ss, 32);
                    if (fq == 0) SSQQ[row * 4 + wc] = ss; }
        } else {
#pragma unroll
            for (int ai = 0; ai < 2; ++ai)
#pragma unroll
                for (int m = 0; m < 4; ++m) { const int row = row0 + ai * 128 + m * 16; float ss = 0.f;
#pragma unroll
                    for (int n = 0; n < 2; ++n) { const f32x4 v = acc[ai][0][m][n]; ss += (v[0] * v[0] + v[1] * v[1]) + (v[2] * v[2] + v[3] * v[3]);
                        st8(CKV + (size_t)row * 128 + wc * 32 + n * 16 + fq * 4, v); }
                    ss += __shfl_xor(ss, 16); ss += __shfl_xor(ss, 32);
                    if (fq == 0) SSQKV[row * 4 + wc] = ss;
                    if (wc < 2) {
#pragma unroll
                        for (int n = 0; n < 2; ++n) { const int i0 = 16 * wc + 8 * n + 2 * fq; const f32x4 cs = CS[(row * 32 + i0) >> 1];
                            st8(KPE + (size_t)row * 64 + wc * 32 + n * 16 + fq * 4, rope4(acc[ai][1][m][n], cs)); } } }
        }
    }
};
struct EpiQup {
    static constexpr bool PERM = false, AFTER_DRAIN = false;
    bf16* Q; const float* SSQ; const f32x4* CS;
    __device__ __forceinline__ void operator()(const Acc& acc, const Unit& u, int wr, int wc, int fr, int fq) const { { int t_ = threadIdx.x; asm volatile("" : "+v"(t_)); fr = t_ & 15; fq = (t_ >> 4) & 3; }
        const int row0 = u.pm * 256 + wr * 64 + fr;
#pragma unroll
        for (int ai = 0; ai < 2; ++ai)
#pragma unroll
            for (int m = 0; m < 4; ++m) { const int row = row0 + ai * 128 + m * 16; const f32x4 s4 = *(const f32x4*)(SSQ + row * 4);
                const float rstd = __builtin_amdgcn_rsqf(((s4[0] + s4[1]) + (s4[2] + s4[3])) * (1.f / 256.f) + EPS);
#pragma unroll
                for (int bj = 0; bj < 2; ++bj) { const bool rope = ((4 * u.pn + 2 * bj + (wc >> 1)) % 3) == 2;
#pragma unroll
                    for (int n = 0; n < 2; ++n) { f32x4 v = acc[ai][bj][m][n] * rstd;
                        if (rope) { const int i0 = 16 * (wc & 1) + 8 * n + 2 * fq; v = rope4(v, CS[(row * 32 + i0) >> 1]); }
                        st8(Q + (size_t)row * 768 + u.pn * 256 + bj * 128 + wc * 32 + n * 16 + fq * 4, v); } } }
    }
};
struct EpiKVup {
    static constexpr bool PERM = false, AFTER_DRAIN = false;
    bf16 *KN, *V; const float* SSQ;
    __device__ __forceinline__ void operator()(const Acc& acc, const Unit& u, int wr, int wc, int fr, int fq) const { { int t_ = threadIdx.x; asm volatile("" : "+v"(t_)); fr = t_ & 15; fq = (t_ >> 4) & 3; }
        const int row0 = u.pm * 256 + wr * 64 + fr;
#pragma unroll
        for (int ai = 0; ai < 2; ++ai)
#pragma unroll
            for (int m = 0; m < 4; ++m) { const int row = row0 + ai * 128 + m * 16; const f32x4 s4 = *(const f32x4*)(SSQ + row * 4);
                const float rstd = __builtin_amdgcn_rsqf(((s4[0] + s4[1]) + (s4[2] + s4[3])) * (1.f / 128.f) + EPS);
#pragma unroll
                for (int bj = 0; bj < 2; ++bj)
#pragma unroll
                    for (int n = 0; n < 2; ++n) st8((bj == 0 ? KN : V) + (size_t)row * 512 + u.pn * 128 + wc * 32 + n * 16 + fq * 4, acc[ai][bj][m][n] * rstd); }
    }
};
struct EpiSsmE {
    static constexpr bool PERM = false, AFTER_DRAIN = false;
    float* E;
    __device__ __forceinline__ void operator()(const Acc& acc, const Unit& u, int wr, int wc, int fr, int fq) const { { int t_ = threadIdx.x; asm volatile("" : "+v"(t_)); fr = t_ & 15; fq = (t_ >> 4) & 3; }
        const int g = u.pm >> 1, ch0 = (u.pm & 1) * 256 + wr * 64 + fr;
#pragma unroll
        for (int ai = 0; ai < 2; ++ai)
#pragma unroll
            for (int m = 0; m < 4; ++m) { const int chunk = ch0 + ai * 128 + m * 16;
#pragma unroll
                for (int n = 0; n < 2; ++n) *(f32x4*)(E + ((size_t)g * SSM_NCH + chunk) * 128 + wc * 32 + n * 16 + fq * 4) = acc[ai][0][m][n]; }
    }
};
struct EpiSsmZ {
    static constexpr bool PERM = false, AFTER_DRAIN = false;
    bf16* G; const bf16* UC; const float* dpar;
    __device__ __forceinline__ void operator()(const Acc& acc, const Unit& u, int wr, int wc, int fr, int fq) const { { int t_ = threadIdx.x; asm volatile("" : "+v"(t_)); fr = t_ & 15; fq = (t_ >> 4) & 3; }
        const int g = u.pm >> 1, ch0 = (u.pm & 1) * 256 + wr * 64 + fr;
        const f32x4 dd = *(const f32x4*)(dpar + g * 16 + 4 * fq);
#pragma unroll
        for (int ai = 0; ai < 2; ++ai)
#pragma unroll
            for (int m = 0; m < 4; ++m) { const int chunk = ch0 + ai * 128 + m * 16;
#pragma unroll
                for (int bj = 0; bj < 2; ++bj)
#pragma unroll
                    for (int n = 0; n < 2; ++n) { const int t = u.pn * 16 + bj * 8 + wc * 2 + n;
                        const f32x4 uv = ld4bf(UC + ((size_t)g * SSM_NCH + chunk) * SSM_K + t * 16 + 4 * fq);
                        const f32x4 y = acc[ai][bj][m][n] + dd * uv;
                        st8(G + (size_t)(chunk * SSM_C + t) * 256 + g * 16 + 4 * fq, (f32x4){gelu_tanh_fast(y[0]), gelu_tanh_fast(y[1]), gelu_tanh_fast(y[2]), gelu_tanh_fast(y[3])}); } }
    }
};
struct EpiGlu {
    static constexpr bool PERM = false, AFTER_DRAIN = true;
    const bf16* G; const float *bias, *gain; bf16* MIX;
    __device__ __forceinline__ void fused(Acc& acc, const Unit& u, int wr, int wc, int fr, int fq, PG8_LAS unsigned char* lds, int wid, int lane) const { { int t_ = threadIdx.x; asm volatile("" : "+v"(t_)); fr = t_ & 15; fq = (t_ >> 4) & 3; }
        PG8_LAS float* P = (PG8_LAS float*)lds;
        const int row0 = u.pm * 256 + wr * 64 + fr;
#pragma unroll
        for (int ai = 0; ai < 2; ++ai)
#pragma unroll
            for (int m = 0; m < 4; ++m) { const int row = row0 + ai * 128 + m * 16; float ss = 0.f;
#pragma unroll
                for (int bj = 0; bj < 2; ++bj)
#pragma unroll
                    for (int n = 0; n < 2; ++n) { const int col = bj * 128 + wc * 32 + n * 16 + fq * 4; const f32x4 b4 = *(const f32x4*)(bias + col), gl = ld4bf(G + (size_t)row * 256 + col);
                        f32x4 z = acc[ai][bj][m][n] + b4;
                        z = (f32x4){gl[0] * fast_sigmoid(z[0]), gl[1] * fast_sigmoid(z[1]), gl[2] * fast_sigmoid(z[2]), gl[3] * fast_sigmoid(z[3])};
                        acc[ai][bj][m][n] = z; ss += (z[0] * z[0] + z[1] * z[1]) + (z[2] * z[2] + z[3] * z[3]); }
                ss += __shfl_xor(ss, 16); ss += __shfl_xor(ss, 32);
                if (fq == 0) P[(ai * 128 + wr * 64 + m * 16 + fr) * 4 + wc] = ss; }
        asm volatile("s_waitcnt lgkmcnt(0)" ::: "memory"); __builtin_amdgcn_s_barrier(); asm volatile("" ::: "memory");
#pragma unroll
        for (int ai = 0; ai < 2; ++ai)
#pragma unroll
            for (int m = 0; m < 4; ++m) { const int lr = ai * 128 + wr * 64 + m * 16 + fr, row = u.pm * 256 + lr;
                const float rstd = __builtin_amdgcn_rsqf(((P[lr * 4 + 0] + P[lr * 4 + 1]) + (P[lr * 4 + 2] + P[lr * 4 + 3])) * (1.f / 256.f) + EPS);
#pragma unroll
                for (int bj = 0; bj < 2; ++bj)
#pragma unroll
                    for (int n = 0; n < 2; ++n) { const int col = bj * 128 + wc * 32 + n * 16 + fq * 4; const f32x4 g4 = *(const f32x4*)(gain + col);
                        st8(MIX + (size_t)row * DM + 256 + col, acc[ai][bj][m][n] * rstd * g4); } }
        asm volatile("s_waitcnt lgkmcnt(0)" ::: "memory"); __builtin_amdgcn_s_barrier(); asm volatile("" ::: "memory");
    }
};
struct EpiStore {
    static constexpr bool PERM = true, AFTER_DRAIN = false;
    bf16* O; int ldc; const float* rowscale;
    __device__ __forceinline__ void operator()(const Acc& acc, const Unit& u, int wr, int wc, int fr, int fq) const { { int t_ = threadIdx.x; asm volatile("" : "+v"(t_)); fr = t_ & 15; fq = (t_ >> 4) & 3; }
        const int row0 = u.pm * 256 + wr * 64 + fr, col0 = u.pn * 256 + wc * 32 + 8 * fq;
#pragma unroll
        for (int ai = 0; ai < 2; ++ai)
#pragma unroll
            for (int m = 0; m < 4; ++m) { const int row = row0 + ai * 128 + m * 16; const float s = rowscale ? rowscale[row] : 1.f;
#pragma unroll
                for (int bj = 0; bj < 2; ++bj) st16(O + (size_t)row * ldc + col0 + bj * 128, acc[ai][bj][m][0] * s, acc[ai][bj][m][1] * s); }
    }
};
struct EpiSwiglu {
    static constexpr bool PERM = true, AFTER_DRAIN = false;
    bf16* H;
    __device__ __forceinline__ void operator()(const Acc& acc, const Unit& u, int wr, int wc, int fr, int fq) const { { int t_ = threadIdx.x; asm volatile("" : "+v"(t_)); fr = t_ & 15; fq = (t_ >> 4) & 3; }
        const int row0 = u.pm * 256 + wr * 64 + fr, h0 = u.pn * 128 + wc * 16 + 4 * fq;
#pragma unroll
        for (int ai = 0; ai < 2; ++ai)
#pragma unroll
            for (int m = 0; m < 4; ++m) { const int row = row0 + ai * 128 + m * 16;
#pragma unroll
                for (int bj = 0; bj < 2; ++bj) { const f32x4 g = acc[ai][bj][m][0], up = acc[ai][bj][m][1];
                    st8(H + (size_t)row * DFF + h0 + bj * 64, (f32x4){silu_fast(g[0]) * up[0], silu_fast(g[1]) * up[1], silu_fast(g[2]) * up[2], silu_fast(g[3]) * up[3]}); } }
    }
};
}
namespace att {
using namespace mk;
constexpr int KVBLK = 64, SHM_V = 64 * 128 * 2, SHM_KN = 64 * 128 * 2, SHM_KP = 64 * 64 * 2, BUF = SHM_V + SHM_KN + SHM_KP;
constexpr int OFF_V = 0, OFF_KN = SHM_V, OFF_KP = SHM_V + SHM_KN, OFF_WS = 2 * BUF, LDS_BYTES = 2 * BUF + NWAVES * 64 * 4;
constexpr float THR = 8.f;
#define KSWZ(row, colB) ((row) * 256 + ((colB) ^ (((row) & 7) << 4)))
#define KPSWZ(row, colB) ((row) * 128 + ((colB) ^ (((row) & 7) << 4)))
#define SBAR() __builtin_amdgcn_sched_barrier(0)
__device__ __forceinline__ int v_st(int k, int c) { const int kk = (k & ~0xC) | ((k & 4) << 1) | ((k & 8) >> 1); return ((kk >> 3) * 4 + (c >> 5)) * 512 + ((kk & 7) * 32 + (c & 31)) * 2; }
__device__ __forceinline__ int v_rd_base(int lane) { return ((lane & 3) << 3) | (((lane >> 2) & 3) << 6) | (((lane >> 4) & 1) << 5) | (((lane >> 5) & 1) << 8); }
constexpr int v_rd_off(int d0, int ks, int half) { return d0 * 512 + ks * 4096 + half * 2048; }
__device__ __forceinline__ int crow(int r, int hi) { return (r & 3) + 8 * (r >> 2) + 4 * hi; }

struct Tensors { const bf16* Q; const bf16* KN; const bf16* KP; const bf16* V; bf16* O; };

template <int B_>
__device__ __forceinline__ void qkt(f32x16& p, const char* lds, int r32, int hi, int kh, const bf16x8* qr) {
    p = f32x16{};
    const char* kb[4];
#pragma unroll
    for (int dd = 0; dd < 4; ++dd) kb[dd] = lds + B_ * BUF + OFF_KN + kh * 8192 + KSWZ(r32, (dd * 16 + hi * 8) * 2);
#pragma unroll
    for (int d0 = 0; d0 < 8; ++d0) { const bf16x8 a = *reinterpret_cast<const bf16x8*>(kb[d0 & 3] + (d0 >> 2) * 128); p = __builtin_amdgcn_mfma_f32_32x32x16_bf16(a, qr[d0], p, 0, 0, 0); }
#pragma unroll
    for (int dd = 0; dd < 4; ++dd) { const bf16x8 a = *reinterpret_cast<const bf16x8*>(lds + B_ * BUF + OFF_KP + kh * 4096 + KPSWZ(r32, (dd * 16 + hi * 8) * 2)); p = __builtin_amdgcn_mfma_f32_32x32x16_bf16(a, qr[8 + dd], p, 0, 0, 0); }
}
template <int B_>
__device__ __forceinline__ void pv_tile(f32x16* o, int vb0, bf16x8 pa0, bf16x8 pa1) {
#define TRRD(dst, off) asm volatile("ds_read_b64_tr_b16 %0, %1 offset:%2" : "=&v"(dst) : "v"(vb0), "i"(off) : "memory")
#define PV_D0(d0) do { s16x4 l0, l1, h0, h1; constexpr int b_ = B_ * BUF + OFF_V + v_rd_off(d0, 0, 0); \
        TRRD(l0, b_); TRRD(h0, b_ + 2048); TRRD(l1, b_ + 4096); TRRD(h1, b_ + 6144); \
        asm volatile("s_waitcnt lgkmcnt(0)" ::: "memory"); SBAR(); \
        o[d0] = __builtin_amdgcn_mfma_f32_32x32x16_bf16(pa0, (bf16x8){l0[0], l0[1], l0[2], l0[3], h0[0], h0[1], h0[2], h0[3]}, o[d0], 0, 0, 0); \
        o[d0] = __builtin_amdgcn_mfma_f32_32x32x16_bf16(pa1, (bf16x8){l1[0], l1[1], l1[2], l1[3], h1[0], h1[1], h1[2], h1[3]}, o[d0], 0, 0, 0); } while (0)
    PV_D0(0); PV_D0(1); PV_D0(2); PV_D0(3);
#undef PV_D0
#undef TRRD
}
__device__ __forceinline__ void softmax_tile(f32x16& p, float& m_reg, float& l_reg, float& alpha, bf16x8& pa0, bf16x8& pa1) {
    float pmax = p[0];
#pragma unroll
    for (int r = 1; r < 16; ++r) pmax = fmaxf(pmax, p[r]);
    { auto rr = __builtin_amdgcn_permlane32_swap(__float_as_uint(pmax), __float_as_uint(pmax), false, false); pmax = fmaxf(__uint_as_float(rr[0]), __uint_as_float(rr[1])); }
    float mn;
    if (__builtin_expect(__all((pmax - m_reg) <= THR), 1)) { mn = m_reg; alpha = 1.f; }
    else { mn = fmaxf(m_reg, pmax); alpha = __builtin_amdgcn_exp2f(m_reg - mn); m_reg = mn; }
    float ps = 0.f;
#pragma unroll
    for (int r = 0; r < 16; ++r) { p[r] = __builtin_amdgcn_exp2f(p[r] - mn); ps += p[r]; }
    { auto rr = __builtin_amdgcn_permlane32_swap(__float_as_uint(ps), __float_as_uint(ps), false, false); ps = __uint_as_float(rr[0]) + __uint_as_float(rr[1]); }
    l_reg = l_reg * alpha + ps;
#define PK4(B__, OUT) do { unsigned a0 = cvtpk(p[B__ + 0], p[B__ + 1]), a1 = cvtpk(p[B__ + 2], p[B__ + 3]), b0 = cvtpk(p[B__ + 4], p[B__ + 5]), b1 = cvtpk(p[B__ + 6], p[B__ + 7]); \
        auto r0 = __builtin_amdgcn_permlane32_swap(a0, b0, false, false); auto r1 = __builtin_amdgcn_permlane32_swap(a1, b1, false, false); \
        u32x4 w = {r0[0], r1[0], r0[1], r1[1]}; OUT = *reinterpret_cast<bf16x8*>(&w); } while (0)
    PK4(0, pa0); PK4(8, pa1);
#undef PK4
}
__device__ __forceinline__ void attn_unit(int b, int h, int qb, const Tensors& T, char* lds) {
    int tid_ = threadIdx.x; asm volatile("" : "+v"(tid_));
    const int tid = tid_, wid = __builtin_amdgcn_readfirstlane(tid >> 6), lane = tid & 63, r32 = lane & 31, hi = lane >> 5;
    const int rg = wid & 3, kh = wid >> 2;
    const size_t tok0 = (size_t)b * SEQ; const int q0 = qb * 128, NT = 2 * qb + 2;
    float* ws = (float*)(lds + OFF_WS) + wid * 64;
    const int sr = tid >> 4, sc = (tid & 15) * 8, kws = KSWZ(sr, sc * 2), vst0 = v_st(sr, sc), vst1 = v_st(32 + sr, sc);
    const int pr = tid >> 3, pc = (tid & 7) * 8, kpw = KPSWZ(pr, pc * 2);
    const bf16* gKN = T.KN + (tok0 + sr) * 512 + h * 128 + sc; const bf16* gV = T.V + (tok0 + sr) * 512 + h * 128 + sc; const bf16* gKP = T.KP + (tok0 + pr) * 64 + pc;
    bf16x8 st_k0, st_k1, st_v0, st_v1, st_p;
#define SLOAD(t) do { const size_t ko = (size_t)(t) * KVBLK; st_k0 = *(const bf16x8*)(gKN + ko * 512); st_k1 = *(const bf16x8*)(gKN + (ko + 32) * 512); \
        st_v0 = *(const bf16x8*)(gV + ko * 512); st_v1 = *(const bf16x8*)(gV + (ko + 32) * 512); st_p = *(const bf16x8*)(gKP + ko * 64); } while (0)
#define SWRITE(bf) do { char* bb = lds + (bf) * BUF; *(bf16x8*)(bb + OFF_KN + kws) = st_k0; *(bf16x8*)(bb + OFF_KN + kws + 32 * 256) = st_k1; \
        *(bf16x8*)(bb + OFF_V + vst0) = st_v0; *(bf16x8*)(bb + OFF_V + vst1) = st_v1; *(bf16x8*)(bb + OFF_KP + kpw) = st_p; } while (0)
    SLOAD(0);
    bf16x8 qr[12];
    { const bf16* qp = T.Q + (tok0 + q0 + rg * 32 + r32) * 768 + h * 192 + hi * 8;
#pragma unroll
      for (int d0 = 0; d0 < 12; ++d0) qr[d0] = *(const bf16x8*)(qp + d0 * 16); }
    float m_reg = -1e30f, l_reg = 0.f; f32x16 o[4] = {};
    const int vb0 = (int)(uintptr_t)lds + v_rd_base(lane) + kh * 8192;
    const int qpos = q0 + rg * 32 + r32;
    asm volatile("s_waitcnt vmcnt(0)" ::: "memory"); SWRITE(0);
    __syncthreads();
#define RESC(a) do { if (__any((a) < 1.f)) { if (hi == 0) ws[r32] = (a); asm volatile("s_waitcnt lgkmcnt(0)" ::: "memory"); \
        _Pragma("unroll") for (int d_ = 0; d_ < 4; ++d_) _Pragma("unroll") for (int r = 0; r < 16; ++r) o[d_][r] *= ws[crow(r, hi)]; } } while (0)
#define STEP(t, B__) do { if ((t) + 1 < NT) SLOAD((t) + 1); SBAR(); \
        f32x16 p; qkt<B__>(p, lds, r32, hi, kh, qr); \
        if ((t) >= NT - 2) { const int kb_ = (t) * KVBLK + kh * 32 + 4 * hi; const float NEG = -__builtin_inff(); \
            _Pragma("unroll") for (int r = 0; r < 16; ++r) { const int key = kb_ + (r & 3) + 8 * (r >> 2); if (key > qpos) p[r] = NEG; } } \
        float alpha; bf16x8 pa0, pa1; softmax_tile(p, m_reg, l_reg, alpha, pa0, pa1); RESC(alpha); SBAR(); \
        pv_tile<B__>(o, vb0, pa0, pa1); \
        if ((t) + 1 < NT) { asm volatile("s_waitcnt vmcnt(0)" ::: "memory"); SWRITE(1 - B__); } \
        __syncthreads(); } while (0)
    for (int t = 0; t < NT; t += 2) { STEP(t, 0); STEP(t + 1, 1); }
#undef STEP
#undef RESC
#undef SLOAD
#undef SWRITE
    float* XO = (float*)lds;
    float* XM = (float*)(lds + 65536);
    if (kh == 1) {
#pragma unroll
        for (int d0 = 0; d0 < 4; ++d0)
#pragma unroll
            for (int r = 0; r < 16; ++r) XO[((rg * 64) + d0 * 16 + r) * 64 + lane] = o[d0][r];
        if (hi == 0) { XM[rg * 32 + r32] = m_reg; XM[128 + rg * 32 + r32] = l_reg; }
    }
    __syncthreads();
    if (kh == 0) {
        const float m1 = XM[rg * 32 + r32], l1 = XM[128 + rg * 32 + r32];
        const float mn = fmaxf(m_reg, m1), a0 = __builtin_amdgcn_exp2f(m_reg - mn), a1 = __builtin_amdgcn_exp2f(m1 - mn);
        const float inv = __builtin_amdgcn_rcpf(l_reg * a0 + l1 * a1);
        if (hi == 0) { ws[r32] = a0 * inv; ws[32 + r32] = a1 * inv; }
        asm volatile("s_waitcnt lgkmcnt(0)" ::: "memory");
        bf16* Ow = T.O + (tok0 + q0 + rg * 32) * 512 + h * 128;
#pragma unroll
        for (int r = 0; r < 16; ++r) { const int orow = crow(r, hi); const float f0 = ws[orow], f1 = ws[32 + orow];
#pragma unroll
            for (int d0 = 0; d0 < 4; ++d0) { const float v = o[d0][r] * f0 + XO[((rg * 64) + d0 * 16 + r) * 64 + lane] * f1; const float vn = __shfl_xor(v, 1);
                if ((r32 & 1) == 0) *(unsigned*)(Ow + (size_t)orow * 512 + d0 * 32 + r32) = cvtpk(v, vn); } }
    }
    __syncthreads();
}
#undef KSWZ
#undef KPSWZ
#undef SBAR
}
namespace ret {
using namespace mk;
__device__ __forceinline__ int crow(int r, int hi) { return (r & 3) + 8 * (r >> 2) + 4 * hi; }
struct Tensors { const bf16 *RQ, *RK, *RKT, *RVT, *RG; float* KVT; bf16* STATE; bf16* MIX; const float* gain; };
__device__ __forceinline__ void x_unit(int u, const Tensors& T, int lane) {
    asm volatile("" : "+v"(lane));
    const int n = u & 127, bh = u >> 7, h = bh & 3, b = bh >> 2, r32 = lane & 31, hi = lane >> 5;
    const size_t tok0 = (size_t)b * SEQ + (size_t)n * RET_C;
    f32x16 acc[2][2] = {};
#pragma unroll
    for (int s = 0; s < 4; ++s) {
        bf16x8 a[2], bb[2];
#pragma unroll
        for (int i = 0; i < 2; ++i) { a[i] = *(const bf16x8*)(T.RVT + (size_t)(h * 64 + i * 32 + r32) * NTOK + tok0 + s * 16 + hi * 8);
                                      bb[i] = *(const bf16x8*)(T.RKT + (size_t)(h * 64 + i * 32 + r32) * NTOK + tok0 + s * 16 + hi * 8); }
#pragma unroll
        for (int i = 0; i < 2; ++i)
#pragma unroll
            for (int j = 0; j < 2; ++j) acc[i][j] = __builtin_amdgcn_mfma_f32_32x32x16_bf16(a[i], bb[j], acc[i][j], 0, 0, 0);
    }
    float* out = T.KVT + (size_t)u * 4096;
#pragma unroll
    for (int i = 0; i < 2; ++i)
#pragma unroll
        for (int j = 0; j < 2; ++j)
#pragma unroll
            for (int r = 0; r < 16; ++r) out[(i * 32 + crow(r, hi)) * 64 + j * 32 + r32] = acc[i][j][r];
}
__device__ __forceinline__ void scan_elem(int e, const Tensors& T) {
    const int bh = e >> 12, el = e & 4095, h = bh & 3;
    const float gam = 1.f - __builtin_amdgcn_exp2f(-5.f - (float)h), lg2 = __builtin_amdgcn_logf(gam);
    const float g64 = __builtin_amdgcn_exp2f(64.f * lg2), g63 = __builtin_amdgcn_exp2f(63.f * lg2);
    const float* kv = T.KVT + (size_t)bh * 128 * 4096 + el; bf16* st = T.STATE + (size_t)bh * 128 * 4096 + el;
    float S = 0.f;
    for (int n0 = 0; n0 < 128; n0 += 16) {
        float v[16];
#pragma unroll
        for (int i = 0; i < 16; ++i) v[i] = kv[(size_t)(n0 + i) * 4096];
#pragma unroll
        for (int i = 0; i < 16; ++i) { st[(size_t)(n0 + i) * 4096] = (bf16)(cvtpk(gam * S, 0.f) & 0xffffu); S = g64 * S + g63 * v[i]; }
    }
}
__device__ __forceinline__ void z_unit(int u, const Tensors& T, int lane) {
    asm volatile("" : "+v"(lane));
    const int n = u & 127, bh = u >> 7, h = bh & 3, b = bh >> 2, r32 = lane & 31, hi = lane >> 5;
    const size_t tok0 = (size_t)b * SEQ + (size_t)n * RET_C;
    bf16x8 qf[2][4];
#pragma unroll
    for (int qb = 0; qb < 2; ++qb)
#pragma unroll
        for (int s = 0; s < 4; ++s) qf[qb][s] = *(const bf16x8*)(T.RQ + (tok0 + qb * 32 + r32) * 256 + h * 64 + s * 16 + hi * 8);
    f32x16 o[2][2] = {};
    const bf16* stp = T.STATE + (size_t)u * 4096;
#pragma unroll
    for (int s = 0; s < 4; ++s) {
        bf16x8 a[2];
#pragma unroll
        for (int i = 0; i < 2; ++i) a[i] = *(const bf16x8*)(stp + (i * 32 + r32) * 64 + s * 16 + hi * 8);
#pragma unroll
        for (int i = 0; i < 2; ++i)
#pragma unroll
            for (int qb = 0; qb < 2; ++qb) o[i][qb] = __builtin_amdgcn_mfma_f32_32x32x16_bf16(a[i], qf[qb][s], o[i][qb], 0, 0, 0);
    }
#pragma unroll
    for (int kb = 0; kb < 2; ++kb) {
        bf16x8 kf[4];
#pragma unroll
        for (int s = 0; s < 4; ++s) kf[s] = *(const bf16x8*)(T.RK + (tok0 + kb * 32 + r32) * 256 + h * 64 + s * 16 + hi * 8);
#pragma unroll
        for (int qb = kb; qb < 2; ++qb) {
            f32x16 st = {};
#pragma unroll
            for (int s = 0; s < 4; ++s) st = __builtin_amdgcn_mfma_f32_32x32x16_bf16(kf[s], qf[qb][s], st, 0, 0, 0);
            if (kb == qb) {
#pragma unroll
                for (int r = 0; r < 16; ++r) if (crow(r, hi) > r32) st[r] = 0.f;
            }
#pragma unroll
            for (int s2 = 0; s2 < 2; ++s2) {
                u32x4 w; w.x = cvtpk(st[8 * s2 + 0], st[8 * s2 + 1]); w.y = cvtpk(st[8 * s2 + 2], st[8 * s2 + 3]); w.z = cvtpk(st[8 * s2 + 4], st[8 * s2 + 5]); w.w = cvtpk(st[8 * s2 + 6], st[8 * s2 + 7]);
                const bf16x8 pb = __builtin_bit_cast(bf16x8, w);
#pragma unroll
                for (int i = 0; i < 2; ++i) {
                    const bf16* vp = T.RVT + (size_t)(h * 64 + i * 32 + r32) * NTOK + tok0 + kb * 32 + s2 * 16 + 4 * hi;
                    const u32x2 lo = *(const u32x2*)vp, hh = *(const u32x2*)(vp + 8);
                    const u32x4 av = {lo.x, lo.y, hh.x, hh.y};
                    o[i][qb] = __builtin_amdgcn_mfma_f32_32x32x16_bf16(__builtin_bit_cast(bf16x8, av), pb, o[i][qb], 0, 0, 0);
                }
            }
        }
    }
#pragma unroll
    for (int qb = 0; qb < 2; ++qb) {
        float ss = 0.f;
#pragma unroll
        for (int i = 0; i < 2; ++i)
#pragma unroll
            for (int r = 0; r < 16; ++r) ss += o[i][qb][r] * o[i][qb][r];
        { auto rr = __builtin_amdgcn_permlane32_swap(__float_as_uint(ss), __float_as_uint(ss), false, false); ss = __uint_as_float(rr[0]) + __uint_as_float(rr[1]); }
        const float rstd = __builtin_amdgcn_rsqf(ss * (1.f / 64.f) + EPS);
        const size_t row = tok0 + qb * 32 + r32;
#pragma unroll
        for (int i = 0; i < 2; ++i)
#pragma unroll
            for (int r4 = 0; r4 < 4; ++r4) { const int dv = i * 32 + 8 * r4 + 4 * hi;
                const f32x4 gt = ld4bf(T.RG + row * 256 + h * 64 + dv), gn = *(const f32x4*)(T.gain + h * 64 + dv);
                const f32x4 v = {o[i][qb][4 * r4 + 0], o[i][qb][4 * r4 + 1], o[i][qb][4 * r4 + 2], o[i][qb][4 * r4 + 3]};
                st8(T.MIX + row * DM + h * 64 + dv, v * rstd * gn * gt); }
    }
}
}
namespace mk {
constexpr size_t MiB = 1u << 20;
constexpr size_t W_CTL = 0, CTL_ZERO_BYTES = 64 * 1024;
constexpr size_t W_WGCNT = 128 * 1024;
constexpr size_t W_TILE = 192 * 1024;
constexpr size_t W_MOD = 1 * MiB;
constexpr size_t W_LAMC = 1 * MiB + 256 * 1024;
constexpr size_t W_TOP = 1 * MiB + 512 * 1024;
constexpr size_t W_CS = 2 * MiB;
constexpr size_t W_ROWW = 6 * MiB;
constexpr size_t W_SSQQ = 6 * MiB + 256 * 1024, W_SSQKV = 6 * MiB + 512 * 1024;
constexpr size_t W_MOEUP = 8 * MiB, W_MOEDN = 120 * MiB;
constexpr size_t W_WIN = 176 * MiB, W_WOUT = 183 * MiB, W_FFUP = 187 * MiB, W_FFDN = 201 * MiB, W_MW = 208 * MiB, W_WEND = 228 * MiB;
constexpr size_t W_WUQ = 233 * MiB, W_WUKV = 234 * MiB, W_GLUW = 235 * MiB;
constexpr size_t W_Y = 236 * MiB, W_MIX = 268 * MiB, W_T = 300 * MiB;
constexpr size_t W_RQ = W_T, W_RK = W_T + 8 * MiB, W_RKT = W_T + 16 * MiB, W_RVT = W_T + 24 * MiB, W_RG = W_T + 32 * MiB, W_UC = W_T + 40 * MiB, W_CQ = W_T + 50 * MiB,
                 W_CKV = W_T + 58 * MiB, W_KPE = W_T + 62 * MiB, W_Q = W_T + 64 * MiB, W_KN = W_T + 88 * MiB, W_V = W_T + 104 * MiB, W_O = W_T + 120 * MiB, W_G = W_T + 136 * MiB,
                 W_KVT = W_T + 144 * MiB, W_STATE = W_T + 160 * MiB, W_E = W_T + 168 * MiB;
constexpr size_t W_HB = W_T;
constexpr size_t W_XN = 480 * MiB;
constexpr size_t W_XG = 176 * MiB;
constexpr size_t W_HBM = 244 * MiB;
constexpr size_t W_END = 512 * MiB;

struct Args { const void* in[35]; float* out; unsigned char* ws; int ph_lo, ph_hi, never, pad; };

template <class SrcF>
__device__ __forceinline__ void transpose_item(const SrcF src, int ld, int K, bf16* WT, const float* kscale, float cscale, LAS float* scr, int kb, int nb, int lane) {
    const int k0 = 64 * kb, n0 = 32 * nb;
    const float* sp = src(n0 + (lane & 31));
#pragma unroll 8
    for (int i = 0; i < 32; ++i) { const int kk = 2 * i + (lane >> 5); float v = sp[(size_t)(k0 + kk) * ld] * cscale; if (kscale) v *= kscale[k0 + kk]; scr[kk * 33 + (lane & 31)] = v; }
    asm volatile("s_waitcnt lgkmcnt(0)" ::: "memory");
    const int c = lane & 7;
#pragma unroll
    for (int j = 0; j < 4; ++j) { const int n = (lane >> 3) + 8 * j; const LAS float* s = scr + (8 * c) * 33 + n;
        u32x4 o; o.x = cvtpk(s[0 * 33], s[1 * 33]); o.y = cvtpk(s[2 * 33], s[3 * 33]); o.z = cvtpk(s[4 * 33], s[5 * 33]); o.w = cvtpk(s[6 * 33], s[7 * 33]);
        *(u32x4*)(WT + (size_t)(n0 + n) * K + k0 + 8 * c) = o; }
    asm volatile("s_waitcnt lgkmcnt(0)" ::: "memory");
}
struct SrcPlain { const float* W; __device__ __forceinline__ const float* operator()(int n) const { return W + n; } };
struct SrcWin { const float* W; __device__ __forceinline__ const float* operator()(int n) const {
        const bool rp = (n < 512) || (n >= 1664); const int g = n & ~63, cg = n & 63; return W + (rp ? g + (cg >> 1) + 32 * (cg & 1) : n); } };
struct SrcWuq { const float* W; __device__ __forceinline__ const float* operator()(int n) const { const int hh = n / 192, w = n % 192; const int cg = w - 128; return W + (w < 128 ? n : hh * 192 + 128 + (cg >> 1) + 32 * (cg & 1)); } };
struct SrcGU { const float* Wg; const float* Wu; __device__ __forceinline__ const float* operator()(int n) const { const int hid = (n >> 3) * 4 + (n & 3);
        const long long du = (const char*)Wu - (const char*)Wg; return (const float*)((const char*)Wg + (((n >> 2) & 1) ? du : 0ll)) + hid; } };

__device__ __forceinline__ f32x2 lam_pow(float a_re, float a_im, float dt, float e) {
    const float mag = __builtin_amdgcn_exp2f(1.4426950408889634f * a_re * dt * e);
    const double rev = (double)(a_im * dt) * (double)e * 0.15915494309189535;
    const float fr = (float)(rev - floor(rev));
    return (f32x2){mag * __builtin_amdgcn_cosf(fr), mag * __builtin_amdgcn_sinf(fr)};
}
__device__ __forceinline__ f32x2 cmul(f32x2 a, f32x2 b) { return (f32x2){a.x * b.x - a.y * b.y, a.x * b.y + a.y * b.x}; }
}
namespace mk {
struct SsmPar { const float *a_re, *a_im, *b_re, *b_im, *c_re, *c_im, *log_dt; };
__device__ __forceinline__ f32x2 ssm_fw(const SsmPar& P, int g, int p, float e, bool with_f) {
    const float dt = __builtin_amdgcn_exp2f(1.4426950408889634f * P.log_dt[g]);
    const float ar = P.a_re[g * 64 + p], ai = P.a_im[g * 64 + p];
    f32x2 w = lam_pow(ar, ai, dt, e);
    if (with_f) { const f32x2 lb = lam_pow(ar, ai, dt, 1.f); const float nr = lb.x - 1.f, ni = lb.y, den = ar * ar + ai * ai;
        const f32x2 f = {(nr * ar + ni * ai) / den, (ni * ar - nr * ai) / den}; w = cmul(w, f); }
    return w;
}
__device__ __forceinline__ void ssm_unit_toep(const SsmPar& P, bf16* MW, int g, int dd, LAS float* scr, int lane) {
    const int d = dd - 31, h = lane >> 2, hp0 = (lane & 3) * 4;
    f32x4 acc = {0.f, 0.f, 0.f, 0.f};
    if (d >= 0) {
        const f32x2 w = ssm_fw(P, g, lane, (float)d, true);
        scr[2 * lane] = w.x; scr[2 * lane + 1] = w.y;
        asm volatile("s_waitcnt lgkmcnt(0)" ::: "memory");
        for (int p = 0; p < 64; ++p) {
            const f32x2 wp = {scr[2 * p], scr[2 * p + 1]};
            const f32x2 cm = {P.c_re[(g * 16 + h) * 64 + p], P.c_im[(g * 16 + h) * 64 + p]};
            const f32x2 t = cmul(cm, wp);
            const f32x4 br = *(const f32x4*)(P.b_re + (g * 64 + p) * 16 + hp0), bi = *(const f32x4*)(P.b_im + (g * 64 + p) * 16 + hp0);
            acc += br * t.x - bi * t.y;
        }
        asm volatile("s_waitcnt lgkmcnt(0)" ::: "memory");
    }
    const int tlo = d >= 0 ? d : 0, thi = d >= 0 ? 32 : 32 + d;
    for (int t = tlo; t < thi; ++t) st8(MW + ((size_t)g * 512 + t * 16 + h) * SSM_K + (t - d) * 16 + hp0, acc);
}
__device__ __forceinline__ void ssm_unit_cross(const SsmPar& P, bf16* MW, f32x2* LAMC, int g, int t, int lane) {
    const f32x2 lp = ssm_fw(P, g, lane, (float)(t + 1), false);
    if (t == 31) LAMC[g * 64 + lane] = lp;
#pragma unroll 4
    for (int h = 0; h < 16; ++h) { const f32x2 cm = {P.c_re[(g * 16 + h) * 64 + lane], P.c_im[(g * 16 + h) * 64 + lane]}; const f32x2 v = cmul(cm, lp);
        *(unsigned*)(MW + ((size_t)g * 512 + t * 16 + h) * SSM_K + 512 + 2 * lane) = cvtpk(v.x, -v.y); }
}
__device__ __forceinline__ void ssm_unit_end(const SsmPar& P, bf16* WEND, int g, int j, int lane) {
    const f32x2 w = ssm_fw(P, g, lane, (float)(31 - j), true);
    float re[16], im[16];
#pragma unroll
    for (int q = 0; q < 4; ++q) { const f32x4 br = *(const f32x4*)(P.b_re + (g * 64 + lane) * 16 + 4 * q), bi = *(const f32x4*)(P.b_im + (g * 64 + lane) * 16 + 4 * q);
#pragma unroll
        for (int k = 0; k < 4; ++k) { re[4 * q + k] = w.x * br[k] - w.y * bi[k]; im[4 * q + k] = w.x * bi[k] + w.y * br[k]; } }
    bf16* r0 = WEND + ((size_t)g * 128 + 2 * lane) * 512 + j * 16;
    st16(r0, (f32x4){re[0], re[1], re[2], re[3]}, (f32x4){re[4], re[5], re[6], re[7]}); st16(r0 + 8, (f32x4){re[8], re[9], re[10], re[11]}, (f32x4){re[12], re[13], re[14], re[15]});
    st16(r0 + 512, (f32x4){im[0], im[1], im[2], im[3]}, (f32x4){im[4], im[5], im[6], im[7]}); st16(r0 + 520, (f32x4){im[8], im[9], im[10], im[11]}, (f32x4){im[12], im[13], im[14], im[15]});
}
__device__ __forceinline__ void ssm_scan(int bg, const float* E, const f32x2* LAMC, bf16* UC, int lane) {
    const int b = bg >> 4, g = bg & 15;
    const f32x2 lc = LAMC[g * 64 + lane];
    f32x2 c = {0.f, 0.f};
    for (int n0 = 0; n0 < 256; n0 += 16) {
        f32x2 e[16];
#pragma unroll
        for (int i = 0; i < 16; ++i) e[i] = *(const f32x2*)(E + ((size_t)g * SSM_NCH + b * 256 + n0 + i) * 128 + 2 * lane);
#pragma unroll
        for (int i = 0; i < 16; ++i) { *(unsigned*)(UC + ((size_t)g * SSM_NCH + b * 256 + n0 + i) * SSM_K + 512 + 2 * lane) = cvtpk(c.x, c.y); c = cmul(lc, c) + e[i]; }
    }
}
struct Row { f32x4 v[4]; };
__device__ __forceinline__ Row row_ld_f32(const float* p, int lane) { Row r;
#pragma unroll
    for (int j = 0; j < 4; ++j) r.v[j] = *(const f32x4*)(p + 4 * lane + 256 * j);
    return r; }
__device__ __forceinline__ Row row_ld_bf16(const bf16* p, int lane) { Row r;
#pragma unroll
    for (int j = 0; j < 4; ++j) r.v[j] = ld4bf(p + 4 * lane + 256 * j);
    return r; }
__device__ __forceinline__ float row_ssq(const Row& r) { float s = 0.f;
#pragma unroll
    for (int j = 0; j < 4; ++j) s += (r.v[j][0] * r.v[j][0] + r.v[j][1] * r.v[j][1]) + (r.v[j][2] * r.v[j][2] + r.v[j][3] * r.v[j][3]);
    return wave_sum(s); }
__device__ __forceinline__ Row adaln(const Row& x, const float* g, const float* sc, const float* sh, bf16* xn, int lane) {
    const float rstd = __builtin_amdgcn_rsqf(row_ssq(x) * (1.f / DM) + EPS); Row o;
#pragma unroll
    for (int j = 0; j < 4; ++j) { const int c = 4 * lane + 256 * j; const f32x4 g4 = *(const f32x4*)(g + c), s4 = *(const f32x4*)(sc + c), h4 = *(const f32x4*)(sh + c);
        o.v[j] = x.v[j] * rstd * g4 * (s4 + 1.f) + h4; st8(xn + c, o.v[j]); }
    return o; }
__device__ __forceinline__ Row resid(const Row& xin, const Row& y, const float* g, const float* gt, float* xout, int lane) {
    const float rstd = __builtin_amdgcn_rsqf(row_ssq(y) * (1.f / DM) + EPS); Row o;
#pragma unroll
    for (int j = 0; j < 4; ++j) { const int c = 4 * lane + 256 * j; const f32x4 g4 = *(const f32x4*)(g + c), t4 = *(const f32x4*)(gt + c);
        o.v[j] = xin.v[j] + t4 * y.v[j] * rstd * g4; *(f32x4*)(xout + c) = o.v[j]; }
    return o; }
__device__ __forceinline__ void route(const Row& h, const float* router, int lane, int& e1, int& e2, float& w1, float& w2) {
    float acc[8];
#pragma unroll
    for (int e = 0; e < 8; ++e) acc[e] = 0.f;
#pragma unroll
    for (int j = 0; j < 4; ++j)
#pragma unroll
        for (int k = 0; k < 4; ++k) { const int c = 4 * lane + 256 * j + k; const f32x4 r0 = *(const f32x4*)(router + c * 8), r1 = *(const f32x4*)(router + c * 8 + 4); const float hv = h.v[j][k];
            acc[0] += hv * r0[0]; acc[1] += hv * r0[1]; acc[2] += hv * r0[2]; acc[3] += hv * r0[3]; acc[4] += hv * r1[0]; acc[5] += hv * r1[1]; acc[6] += hv * r1[2]; acc[7] += hv * r1[3]; }
#pragma unroll
    for (int e = 0; e < 8; ++e) acc[e] = wave_sum(acc[e]);
    e1 = 0; float v1 = acc[0];
#pragma unroll
    for (int e = 1; e < 8; ++e) if (acc[e] > v1) { v1 = acc[e]; e1 = e; }
    e2 = -1; float v2 = -__builtin_inff();
#pragma unroll
    for (int e = 0; e < 8; ++e) if (e != e1 && acc[e] > v2) { v2 = acc[e]; e2 = e; }
    const float ex = __builtin_amdgcn_exp2f(1.4426950408889634f * (v2 - v1)); w1 = 1.f / (1.f + ex); w2 = ex / (1.f + ex);
}
}
#ifndef MK_MASK
#define MK_MASK 0x1fff
#endif
#define PH_ON(n) (((MK_MASK) >> (n)) & 1)
#ifndef MK_SUB
#define MK_SUB 0xff
#endif
#define SUB_ON(n) (((MK_SUB) >> (n)) & 1)
namespace mk {
constexpr int RING_BYTES = 131072, MISC_OFF = RING_BYTES + 320, LDS_BYTES = 147456;
constexpr int NPHASE = 25;
__device__ __forceinline__ bool phase_active(int ph) { if (ph == 0) return true; const int l = (ph - 1) / 12, k = (ph - 1) % 12; if (k == 0) return l == 0; if (k == 8) return l == 1; return true; }

__device__ __forceinline__ const float* inp(const Args& a, int i) { asm volatile("" : "+s"(i)); return (const float*)a.in[i]; }
__global__ void __launch_bounds__(NWAVES * 64, 2) mk_fwd(Args args) {
    extern __shared__ __attribute__((aligned(16))) unsigned char lds[];
    LAS unsigned char* L = (LAS unsigned char*)lds;
    volatile LAS unsigned* MISC = (volatile LAS unsigned*)(L + MISC_OFF);
    const int tid0 = threadIdx.x;
    const int G = gridDim.x, NGW = G * NWAVES;
    for (int u = tid0; u < (LDS_BYTES - RING_BYTES) / 4; u += NWAVES * 64) ((LAS unsigned*)(L + RING_BYTES))[u] = 0u;
    __syncthreads();
    unsigned char* ws = args.ws;
    XcdBarrier bar; bar.bar = (unsigned*)(ws + W_CTL) + 1024; bar.x = 0; bar.st = nullptr;
    if (args.ph_hi - args.ph_lo > 1) bar = xcd_barrier_post((unsigned*)(ws + W_CTL) + 1024, MISC + 8);
    if (args.never) cooperative_groups::this_grid().sync();
#define INF(i) (inp(args, (i)))
#define x_in INF(0)
#define out (args.out)
#define MOD ((float*)(ws + W_MOD))
#define CS4 ((const f32x4*)(ws + W_CS))
#define XN ((bf16*)(ws + W_XN))
#define Yb ((bf16*)(ws + W_Y))
#define MIX ((bf16*)(ws + W_MIX))
#define RQ ((bf16*)(ws + W_RQ))
#define RK ((bf16*)(ws + W_RK))
#define RKT ((bf16*)(ws + W_RKT))
#define RVT ((bf16*)(ws + W_RVT))
#define RG ((bf16*)(ws + W_RG))
#define UC ((bf16*)(ws + W_UC))
#define CQ ((bf16*)(ws + W_CQ))
#define CKV ((bf16*)(ws + W_CKV))
#define KPE ((bf16*)(ws + W_KPE))
#define Qb ((bf16*)(ws + W_Q))
#define KN ((bf16*)(ws + W_KN))
#define Vb ((bf16*)(ws + W_V))
#define Ob ((bf16*)(ws + W_O))
#define GB ((bf16*)(ws + W_G))
#define STATE ((bf16*)(ws + W_STATE))
#define HB ((bf16*)(ws + W_HB))
#define XG ((bf16*)(ws + W_XG))
#define HBM ((bf16*)(ws + W_HBM))
#define KVT ((float*)(ws + W_KVT))
#define EB ((float*)(ws + W_E))
#define SSQQ ((float*)(ws + W_SSQQ))
#define SSQKV ((float*)(ws + W_SSQKV))
#define ROWW ((float*)(ws + W_ROWW))
#define WGCNT ((int*)(ws + W_WGCNT))
#define TILE ((int*)(ws + W_TILE))
#define TOPI ((int*)(ws + W_TOP))
#define TOPW ((float*)(ws + W_TOP + 128 * 1024))
#define TPOS ((int*)(ws + W_TOP + 256 * 1024))
#define WIN ((bf16*)(ws + W_WIN + (size_t)l * (7 * MiB / 2)))
#define WOUT ((bf16*)(ws + W_WOUT + (size_t)l * 2 * MiB))
#define MW ((bf16*)(ws + W_MW + (size_t)l * 10 * MiB))
#define WEND ((bf16*)(ws + W_WEND + (size_t)l * 2 * MiB))
#define WUQ ((bf16*)(ws + W_WUQ + (size_t)l * 384 * 1024))
#define WUKV ((bf16*)(ws + W_WUKV + (size_t)l * 256 * 1024))
#define GLUW ((bf16*)(ws + W_GLUW + (size_t)l * 128 * 1024))
#define LAMC ((f32x2*)(ws + W_LAMC) + l * 1024)
#define modl (MOD + l * 2 * 6144)
    for (int ph = args.ph_lo; ph < args.ph_hi; ++ph) {
        if (!phase_active(ph)) continue;
        int tid = threadIdx.x, bx = blockIdx.x; asm volatile("" : "+v"(tid), "+s"(bx));
        const int lane = tid & 63, wave = __builtin_amdgcn_readfirstlane(tid >> 6), vcu = (G % 8 == 0) ? (bx % 8) * (G / 8) + bx / 8 : bx, gw = bx * NWAVES + wave;
        const int l = ph == 0 ? 0 : (ph - 1) / 12, k = ph == 0 ? -1 : (ph - 1) % 12;
        if (ph == 0 && PH_ON(0)) {
            LAS float* scr = (LAS float*)(L + wave * 16384);
#define CONV(SRC, LD, KK, NN, DST, KSC, CSC) do { const int nb_ = (NN) / 32, ni_ = ((KK) / 64) * nb_; for (int it = gw; it < ni_; it += NGW) transpose_item(SRC, LD, KK, DST, KSC, CSC, scr, it / nb_, it % nb_, lane); } while (0)
            for (int ll = 0; ll < 2; ++ll) {
                CONV((SrcWin{INF(9) + (size_t)ll * DM * INC}), INC, DM, INC, (bf16*)(ws + W_WIN + (size_t)ll * (7 * MiB / 2)), nullptr, 1.f);
                CONV((SrcWuq{INF(23) + (size_t)ll * 256 * 768}), 768, 256, 768, (bf16*)(ws + W_WUQ + (size_t)ll * 384 * 1024), INF(22) + ll * 256, QSCALE);
                CONV((SrcPlain{INF(25) + (size_t)ll * 128 * 1024}), 1024, 128, 1024, (bf16*)(ws + W_WUKV + (size_t)ll * 256 * 1024), INF(24) + ll * 128, 1.f);
                CONV((SrcPlain{INF(19) + (size_t)ll * 65536}), 256, 256, 256, (bf16*)(ws + W_GLUW + (size_t)ll * 128 * 1024), nullptr, 1.f);
                CONV((SrcPlain{INF(27) + (size_t)ll * DM * DM}), DM, DM, DM, (bf16*)(ws + W_WOUT + (size_t)ll * 2 * MiB), nullptr, 1.f);
            }
            CONV((SrcGU{INF(28), INF(29)}), DFF, DM, 2 * DFF, (bf16*)(ws + W_FFUP), nullptr, 1.f);
            CONV((SrcPlain{INF(30)}), DM, DFF, DM, (bf16*)(ws + W_FFDN), nullptr, 1.f);
            for (int e = 0; e < NE; ++e) {
                CONV((SrcGU{INF(32) + (size_t)e * DM * DFF, INF(33) + (size_t)e * DM * DFF}), DFF, DM, 2 * DFF, (bf16*)(ws + W_MOEUP) + (size_t)e * 2 * DFF * DM, nullptr, 1.f);
                CONV((SrcPlain{INF(34) + (size_t)e * DFF * DM}), DM, DFF, DM, (bf16*)(ws + W_MOEDN) + (size_t)e * DM * DFF, nullptr, 1.f);
            }
#undef CONV
            { const int* pos = (const int*)INF(2); f32x2* cs = (f32x2*)(ws + W_CS);
              for (int it = gw; it < NTOK * 32 / 64; it += NGW) { const int idx = it * 64 + lane, row = idx >> 5, i = idx & 31;
                  const float inv = __builtin_amdgcn_exp2f(-(float)i * (13.287712379549449f / 32.0f)); const float ang = (float)pos[row] * inv;
                  const double rev = (double)ang * 0.15915494309189535; const float fr = (float)(rev - floor(rev));
                  cs[idx] = (f32x2){__builtin_amdgcn_cosf(fr), __builtin_amdgcn_sinf(fr)}; } }
            for (int ll = 0; ll < 2; ++ll) {
                const SsmPar P{INF(11) + ll * 1024, INF(12) + ll * 1024, INF(13) + ll * 16384, INF(14) + ll * 16384, INF(15) + ll * 16384, INF(16) + ll * 16384, INF(18) + ll * 16};
                bf16* mw = (bf16*)(ws + W_MW + (size_t)ll * 10 * MiB); bf16* we = (bf16*)(ws + W_WEND + (size_t)ll * 2 * MiB); f32x2* lc = (f32x2*)(ws + W_LAMC) + ll * 1024;
                for (int it = gw; it < 2032; it += NGW) {
                    if (it < 1008) ssm_unit_toep(P, mw, it / 63, it % 63, scr, lane);
                    else if (it < 1520) ssm_unit_cross(P, mw, lc, (it - 1008) >> 5, (it - 1008) & 31, lane);
                    else ssm_unit_end(P, we, (it - 1520) >> 5, (it - 1520) & 31, lane);
                }
            }
            __syncthreads();
            for (int u = bx; u < 192; u += G) {
                const int ll = u / 96, n0 = (u % 96) * 64; const float* aw = INF(3) + (size_t)ll * DM * 6144 + n0 + lane; const float* c = INF(1);
                float a0 = 0.f, a1 = 0.f;
#pragma unroll 8
                for (int kk = 0; kk < 128; ++kk) { const int kq = wave * 128 + kk; const float w = aw[(size_t)kq * 6144]; a0 += silu_fast(c[kq]) * w; a1 += silu_fast(c[DM + kq]) * w; }
                LAS float* red = (LAS float*)L;
                red[(wave * 2 + 0) * 64 + lane] = a0; red[(wave * 2 + 1) * 64 + lane] = a1;
                __syncthreads();
                if (wave < 2) { float s = INF(4)[ll * 6144 + n0 + lane];
#pragma unroll
                    for (int w8 = 0; w8 < 8; ++w8) s += red[(w8 * 2 + wave) * 64 + lane];
                    MOD[(ll * 2 + wave) * 6144 + n0 + lane] = s; }
                __syncthreads();
            }
        } else if (k == 0 && PH_ON(1)) {
            for (int i = 0; i < 8; ++i) { const int row = bx * 64 + wave * 8 + i, b = row / SEQ; const float* md = modl + b * 6144;
                const Row xr = row_ld_f32(x_in + (size_t)row * DM, lane); (void)adaln(xr, INF(5) + l * DM, md + 1 * DM, md + 0 * DM, XN + (size_t)row * DM, lane); }
        } else if (k == 1 && PH_ON(2)) {
            pg8::Gemm g{DM, DM, DM}; pg8::TileOrder S; S.init(XN, DM, WIN, DM, 64, 7, G, bx);
            EpiWin E{RQ, RK, RKT, RVT, RG, UC, CQ, CKV, KPE, SSQQ, SSQKV, CS4};
            pg8::gemm_phase<EpiWin, pg8::TileOrder, true>(L, g, S, E);
        } else if (k == 2 && PH_ON(3)) {
            if (SUB_ON(0)) { pg8::Gemm g{256, 256, 256}; pg8::TileOrder S; S.init(CQ, 256, WUQ, 256, 64, 3, G, bx); EpiQup E{Qb, SSQQ, CS4}; pg8::gemm_phase<EpiQup, pg8::TileOrder, true>(L, g, S, E); }
            if (SUB_ON(1)) { pg8::Gemm g{128, 128, 128}; pg8::TileOrder S; S.init(CKV, 128, WUKV, 128, 64, 4, G, (bx + 64) % G); EpiKVup E{KN, Vb, SSQKV}; pg8::gemm_phase<EpiKVup, pg8::TileOrder, true>(L, g, S, E); }
            if (SUB_ON(2)) { pg8::Gemm g{SSM_K, 512, 512}; pg8::GroupOrder S; S.init(UC, SSM_K, (size_t)SSM_NCH * SSM_K * 2, WEND, 512, (size_t)128 * 512 * 2, 16, 2, 1, G, (bx + 64) % G);
              EpiSsmE E{EB}; pg8::gemm_phase<EpiSsmE, pg8::GroupOrder, false>(L, g, S, E); }
            if (SUB_ON(3)) { const ret::Tensors T{RQ, RK, RKT, RVT, RG, KVT, STATE, MIX, INF(10) + l * 256};
              for (int u = gw; u < 1024; u += NGW) ret::x_unit(u, T, lane); }
        } else if (k == 3 && PH_ON(4)) {
            { const ret::Tensors T{RQ, RK, RKT, RVT, RG, KVT, STATE, MIX, INF(10) + l * 256}; if (tid < 128) ret::scan_elem(bx * 128 + tid, T); }
            if (wave == 7 && bx < 32) ssm_scan(bx, EB, LAMC, UC, lane);
            __syncthreads();
            { const att::Tensors T{Qb, KN, KPE, Vb, Ob}; const int bh = vcu >> 5, xx = vcu & 31;
              att::attn_unit(bh >> 2, bh & 3, 63 - xx, T, (char*)lds); att::attn_unit(bh >> 2, bh & 3, xx, T, (char*)lds); }
        } else if (k == 4 && PH_ON(5)) {
            if (SUB_ON(4)) { pg8::Gemm g{SSM_K, SSM_K, SSM_K}; pg8::GroupOrder S; S.init(UC, SSM_K, (size_t)SSM_NCH * SSM_K * 2, MW, SSM_K, (size_t)512 * SSM_K * 2, 16, 2, 2, G, bx);
              EpiSsmZ E{GB, UC, INF(17) + l * 256}; pg8::gemm_phase<EpiSsmZ, pg8::GroupOrder, false>(L, g, S, E); }
            if (SUB_ON(5) && bx >= 64) { const ret::Tensors T{RQ, RK, RKT, RVT, RG, KVT, STATE, MIX, INF(10) + l * 256}; for (int u = (bx - 64) * NWAVES + wave; u < 1024; u += (G - 64) * NWAVES) ret::z_unit(u, T, lane); }
            if (SUB_ON(6)) for (int i = 0; i < 8; ++i) { const int row = bx * 64 + wave * 8 + i; const u32x4 w = *(const u32x4*)(Ob + (size_t)row * 512 + 8 * lane);
                const f32x4 a = {bflo(w.x), bfhi(w.x), bflo(w.y), bfhi(w.y)}, c = {bflo(w.z), bfhi(w.z), bflo(w.w), bfhi(w.w)};
                float ss = (a[0] * a[0] + a[1] * a[1]) + (a[2] * a[2] + a[3] * a[3]) + (c[0] * c[0] + c[1] * c[1]) + (c[2] * c[2] + c[3] * c[3]); ss = wave_sum(ss);
                const float rstd = __builtin_amdgcn_rsqf(ss * (1.f / 512.f) + EPS); const float* gn = INF(26) + l * 512 + 8 * lane;
                st16(MIX + (size_t)row * DM + 512 + 8 * lane, a * rstd * *(const f32x4*)gn, c * rstd * *(const f32x4*)(gn + 4)); }
        } else if (k == 5 && PH_ON(6)) {
            pg8::Gemm g{256, 256, 256}; pg8::TileOrder S; S.init(GB, 256, GLUW, 256, 64, 1, G, bx); EpiGlu E{GB, INF(20) + l * 256, INF(21) + l * 256, MIX};
            pg8::gemm_phase<EpiGlu, pg8::TileOrder, false>(L, g, S, E);
        } else if (k == 6 && PH_ON(7)) {
            pg8::Gemm g{DM, DM, DM}; pg8::TileOrder S; S.init(MIX, DM, WOUT, DM, 64, 4, G, bx); EpiStore E{Yb, DM, nullptr};
            pg8::gemm_phase<EpiStore, pg8::TileOrder, false>(L, g, S, E);
        } else if (k == 7 && PH_ON(8)) {
            LAS int* cnt = (LAS int*)L;
            if (l == 1) { if (tid < 8) cnt[tid] = 0; __syncthreads(); }
            const float* xsrc = l == 0 ? x_in : out;
            for (int i = 0; i < 8; ++i) { const int row = bx * 64 + wave * 8 + i, b = row / SEQ; const float* md = modl + b * 6144;
                const Row xr = row_ld_f32(xsrc + (size_t)row * DM, lane), yr = row_ld_bf16(Yb + (size_t)row * DM, lane);
                const Row x1 = resid(xr, yr, INF(6) + l * DM, md + 2 * DM, out + (size_t)row * DM, lane);
                const Row h = adaln(x1, INF(7) + l * DM, md + 4 * DM, md + 3 * DM, XN + (size_t)row * DM, lane);
                if (l == 1) { int e1, e2; float w1, w2; route(h, INF(31), lane, e1, e2, w1, w2);
                    if (lane == 0) { TOPI[row * 2] = e1; TOPI[row * 2 + 1] = e2; TOPW[row * 2] = w1; TOPW[row * 2 + 1] = w2; __hip_atomic_fetch_add(&cnt[e1], 1, __ATOMIC_RELAXED, __HIP_MEMORY_SCOPE_WORKGROUP); __hip_atomic_fetch_add(&cnt[e2], 1, __ATOMIC_RELAXED, __HIP_MEMORY_SCOPE_WORKGROUP); } } }
            if (l == 1) { __syncthreads(); if (tid < 8) WGCNT[bx * 8 + tid] = cnt[tid]; }
        } else if (k == 8 && PH_ON(9)) {
            LAS int* sc = (LAS int*)L;
            for (int i = tid; i < 2048; i += NWAVES * 64) sc[i] = WGCNT[i];
            __syncthreads();
            if (tid < 8) { int base = 0, tot = 0; for (int w = 0; w < G; ++w) { const int c = sc[w * 8 + tid]; if (w < bx) base += c; tot += c; } sc[2048 + tid] = base; sc[2064 + tid] = tot; }
            __syncthreads();
            if (tid == 0) { int st = 0, nt = 0;
#pragma unroll 1
                for (int e = 0; e < 8; ++e) { sc[2056 + e] = st; const int t = (sc[2064 + e] + 255) >> 8; if (bx == 0) for (int q = 0; q < t; ++q) TILE[16 + nt + q] = e; nt += t; st += t << 8; } if (bx == 0) TILE[0] = nt; }
            __syncthreads();
            if (wave == 0) { const int row = bx * 64 + lane; const int e1 = TOPI[row * 2], e2 = TOPI[row * 2 + 1]; int p1 = 0, p2 = 0;
                const unsigned long long lt = (1ull << lane) - 1ull;
#pragma unroll
                for (int e = 0; e < 8; ++e) { const unsigned long long m1 = __ballot(e1 == e), m2 = __ballot(e2 == e); const int r = __popcll(m1 & lt) + __popcll(m2 & lt) + sc[2056 + e] + sc[2048 + e];
                    if (e1 == e) p1 = r; if (e2 == e) p2 = r; }
                sc[2080 + lane * 2] = p1; sc[2080 + lane * 2 + 1] = p2; TPOS[row * 2] = p1; TPOS[row * 2 + 1] = p2; ROWW[p1] = TOPW[row * 2]; ROWW[p2] = TOPW[row * 2 + 1]; }
            __syncthreads();
            for (int i = 0; i < 8; ++i) { const int lr = wave * 8 + i, row = bx * 64 + lr; const int p1 = sc[2080 + lr * 2], p2 = sc[2080 + lr * 2 + 1];
                const u32x4 a = *(const u32x4*)(XN + (size_t)row * DM + 8 * lane), c = *(const u32x4*)(XN + (size_t)row * DM + 512 + 8 * lane);
                *(u32x4*)(XG + (size_t)p1 * DM + 8 * lane) = a; *(u32x4*)(XG + (size_t)p1 * DM + 512 + 8 * lane) = c;
                *(u32x4*)(XG + (size_t)p2 * DM + 8 * lane) = a; *(u32x4*)(XG + (size_t)p2 * DM + 512 + 8 * lane) = c; }
            if (bx < 8) { const int tot = sc[2064 + bx], st = sc[2056 + bx], pe = st + (((tot + 255) >> 8) << 8);
                for (int r = st + tot + wave; r < pe; r += NWAVES) { const u32x4 z = {0u, 0u, 0u, 0u}; *(u32x4*)(XG + (size_t)r * DM + 8 * lane) = z; *(u32x4*)(XG + (size_t)r * DM + 512 + 8 * lane) = z; if (lane == 0) ROWW[r] = 0.f; } }
        } else if (k == 9 && PH_ON(10)) {
            pg8::Gemm g{DM, DM, DM}; pg8::TileOrder S;
            if (l == 0) S.init(XN, DM, (bf16*)(ws + W_FFUP), DM, 64, 28, G, bx);
            else { S.init(XG, DM, (bf16*)(ws + W_MOEUP), DM, TILE[0], 28, G, bx); S.texp = TILE + 16; S.b_e = (size_t)2 * DFF * DM * 2; }
            EpiSwiglu E{l == 0 ? HB : HBM};
            pg8::gemm_phase<EpiSwiglu, pg8::TileOrder, true>(L, g, S, E);
        } else if (k == 10 && PH_ON(11)) {
            pg8::Gemm g{DFF, DFF, DFF}; pg8::TileOrder S; EpiStore E{Yb, DM, nullptr};
            if (l == 0) S.init(HB, DFF, (bf16*)(ws + W_FFDN), DFF, 64, 4, G, bx);
            else { S.init(HBM, DFF, (bf16*)(ws + W_MOEDN), DFF, TILE[0], 4, G, bx); S.texp = TILE + 16; S.b_e = (size_t)DM * DFF * 2; E.O = XG; E.rowscale = ROWW; }
            pg8::gemm_phase<EpiStore, pg8::TileOrder, true>(L, g, S, E);
        } else if (k == 11 && PH_ON(12)) {
            for (int i = 0; i < 8; ++i) { const int row = bx * 64 + wave * 8 + i, b = row / SEQ; const float* md = modl + b * 6144;
                const Row xr = row_ld_f32(out + (size_t)row * DM, lane); Row yr;
                if (l == 0) yr = row_ld_bf16(Yb + (size_t)row * DM, lane);
                else { const int p1 = TPOS[row * 2], p2 = TPOS[row * 2 + 1]; const Row ya = row_ld_bf16(XG + (size_t)p1 * DM, lane), yb = row_ld_bf16(XG + (size_t)p2 * DM, lane);
#pragma unroll
                    for (int j = 0; j < 4; ++j) yr.v[j] = ya.v[j] + yb.v[j]; }
                const Row x2 = resid(xr, yr, INF(8) + l * DM, md + 5 * DM, out + (size_t)row * DM, lane);
                if (l == 0) { const float* md1 = MOD + 2 * 6144 + b * 6144; (void)adaln(x2, INF(5) + DM, md1 + 1 * DM, md1 + 0 * DM, XN + (size_t)row * DM, lane); } }
        }
        bool more = false; for (int q = ph + 1; q < args.ph_hi; ++q) more |= phase_active(q);
        if (more) xcd_barrier(bar);
    }
#undef INF
#undef MOD
#undef Qb
#undef Vb
#undef Ob
#undef Yb
#undef out
#undef modl
}
}
#ifndef MK_PER_PHASE
#define MK_PER_PHASE 0
#endif
static int mk_setup() {
    static int grid = 0;
    if (grid == 0) {
        int dev = 0, cus = 0, per_cu = 0;
        if (hipGetDevice(&dev) != hipSuccess || hipDeviceGetAttribute(&cus, hipDeviceAttributeMultiprocessorCount, dev) != hipSuccess) { fprintf(stderr, "kernel_launch: device query failed\n"); grid = -1; return grid; }
        if (hipFuncSetAttribute((const void*)mk::mk_fwd, hipFuncAttributeMaxDynamicSharedMemorySize, mk::LDS_BYTES) != hipSuccess) { fprintf(stderr, "kernel_launch: hipFuncSetAttribute failed\n"); grid = -1; return grid; }
        if (hipOccupancyMaxActiveBlocksPerMultiprocessor(&per_cu, (const void*)mk::mk_fwd, mk::NWAVES * 64, mk::LDS_BYTES) != hipSuccess || per_cu < 1) fprintf(stderr, "kernel_launch: occupancy query reports %d blocks per CU\n", per_cu);
        (void)hipGetLastError();
        grid = cus;
        if (grid != 256) fprintf(stderr, "kernel_launch: this kernel is written for a 256-CU device (got %d)\n", grid);
    }
    return grid;
}
static void mk_launch(void* const* d_in, void* d_out, void* d_ws, hipStream_t stream, int lo, int hi, bool coop) {
    const int grid = mk_setup(); if (grid <= 0) return;
    mk::Args a{};
    for (int i = 0; i < 35; ++i) a.in[i] = d_in[i];
    a.out = (float*)d_out; a.ws = (unsigned char*)d_ws; a.ph_lo = lo; a.ph_hi = hi; a.never = 0; a.pad = 0;
    if (coop) { void* args[] = {&a}; hipError_t e = hipLaunchCooperativeKernel((const void*)mk::mk_fwd, dim3(grid), dim3(mk::NWAVES * 64), args, mk::LDS_BYTES, stream);
        if (e != hipSuccess) fprintf(stderr, "cooperative launch failed: %s (grid %d)\n", hipGetErrorString(e), grid); }
    else hipLaunchKernelGGL(mk::mk_fwd, dim3(grid), dim3(mk::NWAVES * 64), mk::LDS_BYTES, stream, a);
}
extern "C" void kernel_launch(void* const* d_in, const int* in_sizes, int n_in, void* d_out, int out_size, void* d_ws, size_t ws_size, hipStream_t stream) {
    (void)in_sizes; (void)n_in; (void)out_size;
    if (ws_size < mk::W_END) { fprintf(stderr, "kernel_launch: workspace too small (%zu < %zu)\n", ws_size, (size_t)mk::W_END); return; }
    (void)hipMemsetAsync((char*)d_ws + mk::W_CTL, 0, mk::CTL_ZERO_BYTES, stream);
#if MK_PER_PHASE
    for (int ph = 0; ph < mk::NPHASE; ++ph) mk_launch(d_in, d_out, d_ws, stream, ph, ph + 1, false);
#else
    mk_launch(d_in, d_out, d_ws, stream, 0, mk::NPHASE, true);
#endif
}
```

```cpp
#include <hip/hip_runtime.h>
#include <stdint.h>
#include <math.h>
#include <cstdio>
#include <hip/hip_cooperative_groups.h>
#define GAS __attribute__((address_space(1)))
#define LAS __attribute__((address_space(3)))
namespace mk {
typedef unsigned short bf16;
typedef short bf16x8 __attribute__((ext_vector_type(8)));
typedef short s16x4 __attribute__((ext_vector_type(4)));
typedef float f32x2 __attribute__((ext_vector_type(2)));
typedef float f32x4 __attribute__((ext_vector_type(4)));
typedef float f32x16 __attribute__((ext_vector_type(16)));
typedef unsigned u32x2 __attribute__((ext_vector_type(2)));
typedef unsigned u32x4 __attribute__((ext_vector_type(4)));
typedef __bf16 bf16x2_t __attribute__((ext_vector_type(2)));
typedef GAS unsigned gu32;
#define RLX_AGENT __ATOMIC_RELAXED, __HIP_MEMORY_SCOPE_AGENT
__device__ __forceinline__ unsigned cvtpk(float lo, float hi) { f32x2 v = {lo, hi}; bf16x2_t b = __builtin_convertvector(v, bf16x2_t); return __builtin_bit_cast(unsigned, b); }
__device__ __forceinline__ float bf2f(unsigned short b) { return __builtin_bit_cast(float, (unsigned)b << 16); }
__device__ __forceinline__ float bflo(unsigned w) { return __builtin_bit_cast(float, w << 16); }
__device__ __forceinline__ float bfhi(unsigned w) { return __builtin_bit_cast(float, w & 0xffff0000u); }
__device__ __forceinline__ float wave_sum(float v) {
#pragma unroll
    for (int o = 1; o < 64; o <<= 1) v += __shfl_xor(v, o);
    return v;
}
__device__ __forceinline__ float fast_sigmoid(float z) { return __builtin_amdgcn_rcpf(1.f + __builtin_amdgcn_exp2f(-1.4426950408889634f * z)); }
__device__ __forceinline__ float silu_fast(float v) { return v * fast_sigmoid(v); }
__device__ __forceinline__ float gelu_tanh_fast(float x) { const float a = 0.7978845608028654f * (x + 0.044715f * x * x * x); return x * fast_sigmoid(2.f * a); }

constexpr int NB = 2, SEQ = 8192, NTOK = 16384, DM = 1024, INC = 1728, INCP = 1792, DFF = 3584, NE = 8, NWAVES = 8;
constexpr float EPS = 1e-6f;
constexpr int SSM_C = 32, SSM_NCH = NTOK / SSM_C  , SSM_K = 640;
constexpr int RET_C = 64, RET_NCH = SEQ / RET_C  ;
constexpr int MOE_MAXT = 136;
constexpr float QSCALE = 0.07216878364870322f * 1.4426950408889634f;

#define XB_TMO      128
#define XB_XCNT(j)  (256  + 64 * (j))
#define XB_XSUB(j)  (1280 + 64 * (j))
#define XB_XGEN(j)  (2304 + 64 * (j))
#define XB_TOP      3328
#define XB_TOPGEN   3392
#define XCD_BAR_WORDS 3456
#define XB_SPIN_CAP (1u << 20)
__device__ __forceinline__ unsigned xb_ld(unsigned* p)              { return __hip_atomic_load(p, __ATOMIC_RELAXED, __HIP_MEMORY_SCOPE_AGENT); }
__device__ __forceinline__ unsigned xb_add(unsigned* p, unsigned v) { return __hip_atomic_fetch_add(p, v, __ATOMIC_RELAXED, __HIP_MEMORY_SCOPE_AGENT); }
__device__ __forceinline__ unsigned xb_xcc_id() { return (unsigned)__builtin_amdgcn_s_getreg((3 << 11) | 20) & 0xFu; }
#define XB_SPIN(cond, bar) do { unsigned _sp = 0; while (cond) { __builtin_amdgcn_s_sleep(1); \
    if ((++_sp & 255u) == 0u) { if (xb_ld(&(bar)[XB_TMO])) break; if (_sp > XB_SPIN_CAP) { atomicAdd(&(bar)[XB_TMO], 1u); break; } } } } while (0)
struct XcdBarrier { unsigned* bar; unsigned x; volatile LAS unsigned* st; };
__device__ __forceinline__ XcdBarrier xcd_barrier_post(unsigned* bar, volatile LAS unsigned* st) {
    XcdBarrier b; b.bar = bar; b.x = xb_xcc_id(); b.st = st;
    if (threadIdx.x == 0) (void)xb_add(&bar[XB_XCNT(b.x)], 1u);
    return b;
}
__device__ __forceinline__ void xcd_barrier_complete(unsigned* bar, unsigned x, unsigned& nloc, unsigned& nx) {
    const unsigned G = gridDim.x * gridDim.y * gridDim.z;
    unsigned sum, cnt, mine, sp = 0u;
    for (;;) {
        sum = 0u; cnt = 0u; mine = 0u;
#pragma unroll
        for (unsigned j = 0; j < 16; ++j) { const unsigned c = xb_ld(&bar[XB_XCNT(j)]); sum += c; cnt += (c > 0u) ? 1u : 0u; mine = (j == x) ? c : mine; }
        if (sum == G) break;
        __builtin_amdgcn_s_sleep(1);
        if ((++sp & 255u) == 0u) { if (xb_ld(&bar[XB_TMO])) break; if (sp > XB_SPIN_CAP) { atomicAdd(&bar[XB_TMO], 1u); break; } }
    }
    nloc = mine > 0u ? mine : 1u; nx = cnt > 0u ? cnt : 1u;
}
__device__ __forceinline__ void xcd_barrier(const XcdBarrier& b) {
    asm volatile("s_waitcnt vmcnt(0)" ::: "memory");
    __syncthreads();
    if (threadIdx.x == 0) {
        unsigned* bar = b.bar;
        __builtin_amdgcn_s_waitcnt(0);
        unsigned nloc = b.st[0], nx = b.st[1];
        if (nloc == 0u) { xcd_barrier_complete(bar, b.x, nloc, nx); b.st[0] = nloc; b.st[1] = nx; }
        const unsigned old = xb_add(&bar[XB_XSUB(b.x)], 1u);
        const unsigned gen = old / nloc;
        if (old + 1u == (gen + 1u) * nloc) {
            __builtin_amdgcn_fence(__ATOMIC_RELEASE, "agent");
            asm volatile("s_waitcnt vmcnt(0)" ::: "memory");
            const unsigned og = xb_add(&bar[XB_TOP], 1u);
            const unsigned tg = og / nx;
            if (og + 1u == (tg + 1u) * nx) xb_add(&bar[XB_TOPGEN], 1u);
            else XB_SPIN(xb_ld(&bar[XB_TOPGEN]) == tg, bar);
            __builtin_amdgcn_fence(__ATOMIC_ACQUIRE, "agent");
            xb_add(&bar[XB_XGEN(b.x)], 1u);
            asm volatile("s_waitcnt vmcnt(0)" ::: "memory");
        } else {
            XB_SPIN(xb_ld(&bar[XB_XGEN(b.x)]) == gen, bar);
            __builtin_amdgcn_fence(__ATOMIC_ACQUIRE, "agent");
            asm volatile("s_waitcnt vmcnt(0)" ::: "memory");
        }
    }
    __syncthreads();
}
}
namespace pg8 {
#define PG8_LAS __attribute__((address_space(3)))
typedef unsigned short bf16_t;
typedef short bf16x8 __attribute__((ext_vector_type(8)));
typedef float f32x4 __attribute__((ext_vector_type(4)));
typedef unsigned u32x4 __attribute__((ext_vector_type(4)));
constexpr int BM = 256, BK = 64, HALF = 128, HTB = HALF * BK * 2, STAGE_BYTES = 8 * HTB, NXCD = 8, WGM = 8;
__host__ __device__ __forceinline__ int lds_byte(int r, int c) { const int st = (r >> 4) * 2 + (c >> 5), rr = r & 15, cc = c & 31, ob = rr * 64 + cc * 2; return st * 1024 + (ob ^ (((ob >> 9) & 1) << 5)); }
__host__ __device__ __forceinline__ void stage_rc(int b, int& R, int& C) { const int st = b / 1024, sb = b % 1024, swz = sb ^ (((sb >> 9) & 1) << 5); R = (st >> 1) * 16 + swz / 64; C = (st & 1) * 32 + (swz % 64) / 2; }
__host__ __device__ __forceinline__ int perm32(int rho) { const int n = rho >> 4, i = rho & 15; return 8 * (i >> 2) + 4 * n + (i & 3); }
struct Unit { const char* pA; const char* pB; int pm, pn; };
struct Gemm { int lda, ldb, K; };
struct TileOrder {
    const char* A; const char* Bt; size_t a_t, b_t, b_e; const int* texp; int nM, nN, nwg, G, c;
    __device__ __forceinline__ void init(const void* A_, int lda, const void* Bt_, int ldb, int nM_, int nN_, int G_, int c_) {
        A = (const char*)A_; Bt = (const char*)Bt_; a_t = (size_t)BM * lda * 2; b_t = (size_t)BM * ldb * 2; b_e = 0; texp = nullptr; nM = nM_; nN = nN_; nwg = nM * nN; G = G_; c = c_; }
    __device__ __forceinline__ bool next(int i, Unit& u) const {
        const long L = (long)i * G + c; if (L >= nwg) return false;
        int wgid = (int)L; { const int q = nwg / NXCD, r = nwg % NXCD, xcd = wgid % NXCD, off = wgid / NXCD; wgid = (xcd < r ? xcd * (q + 1) : r * (q + 1) + (xcd - r) * q) + off; }
        const int nig = WGM * nN, gid = wgid / nig, fm = gid * WGM, gsz = (nM - fm) < WGM ? (nM - fm) : WGM;
        u.pm = fm + ((wgid % nig) % gsz); u.pn = (wgid % nig) / gsz;
        u.pA = A + (size_t)u.pm * a_t; u.pB = Bt + (size_t)u.pn * b_t + (texp ? (size_t)texp[u.pm] * b_e : (size_t)0); return true;
    }
    __device__ __forceinline__ void a_ready(const Unit&) const {}
    __device__ __forceinline__ void done(const Unit&) const {}
};
struct GroupOrder {
    const char* A; const char* Bt; size_t a_t, b_t, a_g, b_g; int nM, nN, nwg, G, c;
    __device__ __forceinline__ void init(const void* A_, int lda, size_t a_g_, const void* Bt_, int ldb, size_t b_g_, int ng, int nM_, int nN_, int G_, int c_) {
        A = (const char*)A_; Bt = (const char*)Bt_; a_t = (size_t)BM * lda * 2; b_t = (size_t)BM * ldb * 2; a_g = a_g_; b_g = b_g_; nM = nM_; nN = nN_; nwg = ng * nM * nN; G = G_; c = c_; }
    __device__ __forceinline__ bool next(int i, Unit& u) const {
        const long L = (long)i * G + c; if (L >= nwg) return false;
        const int per = nM * nN, g = (int)L / per, r = (int)L % per, pm = r / nN, pn = r % nN;
        u.pm = g * nM + pm; u.pn = pn; u.pA = A + (size_t)g * a_g + (size_t)pm * a_t; u.pB = Bt + (size_t)g * b_g + (size_t)pn * b_t; return true;
    }
    __device__ __forceinline__ void a_ready(const Unit&) const {}
    __device__ __forceinline__ void done(const Unit&) const {}
};
template <class Epi, class Sched, bool ALIGN_EPI = false>
__device__ __forceinline__ void gemm_phase(PG8_LAS unsigned char* lds, const Gemm g, const Sched& S, const Epi& E) {
    int tid_ = threadIdx.x; asm volatile("" : "+v"(tid_));
    const int tid = tid_, wid = __builtin_amdgcn_readfirstlane(tid >> 6), lane = tid & 63, wr = wid >> 2, wc = wid & 3, fr = lane & 15, fq = lane >> 4;
    const int K = g.K, nt = K / BK, lda = g.lda, ldb = g.ldb;
    unsigned voffA[2], voffB[2];
#pragma unroll
    for (int i = 0; i < 2; ++i) { int R, C; stage_rc(tid * 16 + i * 8192, R, C); const int Rb = Epi::PERM ? ((R & ~31) + perm32(R & 31)) : R;
        voffA[i] = (unsigned)(R * lda + C) * 2u; voffB[i] = (unsigned)(Rb * ldb + C) * 2u; }
    const size_t kstep = (size_t)(BK * 2);
    const size_t hstepA = (size_t)HALF * lda * 2, hstepB = (size_t)HALF * ldb * 2;
    const unsigned ldsw = (unsigned)wid * 1024u;
    const int aoff = lds_byte(wr * 64 + fr, fq * 8), boff = lds_byte(wc * 32 + fr, fq * 8);
#define PG8_SA(b, h) (((b) * 2 + (h)) * HTB)
#define PG8_SB(b, h) ((4 + (b) * 2 + (h)) * HTB)
#define PG8_STAGE(bufoff, gbase, voff) do { _Pragma("unroll") for (int _i = 0; _i < 2; ++_i) \
        __builtin_amdgcn_global_load_lds((const unsigned*)((const char*)(gbase) + (voff)[_i]), (PG8_LAS unsigned*)(lds + (bufoff) + ldsw + _i * 8192), 16, 0, 0); } while (0)
#define PG8_LDA(dst, b, h) do { _Pragma("unroll") for (int m = 0; m < 4; ++m) _Pragma("unroll") for (int k = 0; k < 2; ++k) dst[m][k] = *(const PG8_LAS bf16x8*)(lds + PG8_SA(b, h) + aoff + m * 2048 + k * 1024); } while (0)
#define PG8_LDB(dst, b, h) do { _Pragma("unroll") for (int n = 0; n < 2; ++n) _Pragma("unroll") for (int k = 0; k < 2; ++k) dst[n][k] = *(const PG8_LAS bf16x8*)(lds + PG8_SB(b, h) + boff + n * 2048 + k * 1024); } while (0)
#define PG8_MMA(ai, bj, At, Bt) do { __builtin_amdgcn_s_setprio(1); _Pragma("unroll") for (int m = 0; m < 4; ++m) _Pragma("unroll") for (int n = 0; n < 2; ++n) _Pragma("unroll") for (int k = 0; k < 2; ++k) \
        acc[ai][bj][m][n] = __builtin_amdgcn_mfma_f32_16x16x32_bf16(Bt[n][k], At[m][k], acc[ai][bj][m][n], 0, 0, 0); __builtin_amdgcn_s_setprio(0); } while (0)
#define PG8_WAIT_V(n) asm volatile("s_waitcnt vmcnt(" #n ")" ::: "memory")
#define PG8_WAIT_L(n) asm volatile("s_waitcnt lgkmcnt(" #n ")" ::: "memory")
#define PG8_BAR __builtin_amdgcn_s_barrier()
#define PG8_SCHED __builtin_amdgcn_sched_barrier(0)
    Unit cur, nxt; int ui = 0;
    if (!S.next(0, cur)) return;
    f32x4 acc[2][2][4][2];
#pragma unroll
    for (int a = 0; a < 2; ++a)
#pragma unroll
        for (int b = 0; b < 2; ++b)
#pragma unroll
            for (int m = 0; m < 4; ++m)
#pragma unroll
                for (int n = 0; n < 2; ++n) acc[a][b][m][n] = (f32x4){0.f, 0.f, 0.f, 0.f};
    bf16x8 At[4][2], B0[2][2], B1[2][2];
    const char* cA = cur.pA; const char* cB = cur.pB;
    S.a_ready(cur);
    {
        PG8_STAGE(PG8_SB(0, 0), cB, voffB); PG8_STAGE(PG8_SB(0, 1), cB + hstepB, voffB); PG8_STAGE(PG8_SA(0, 0), cA, voffA); PG8_STAGE(PG8_SA(0, 1), cA + hstepA, voffA);
        if (wr == 1) PG8_BAR;
        PG8_WAIT_V(2); PG8_BAR;
        PG8_STAGE(PG8_SB(1, 0), cB + kstep, voffB); PG8_STAGE(PG8_SA(1, 0), cA + kstep, voffA); PG8_STAGE(PG8_SB(1, 1), cB + hstepB + kstep, voffB);
        PG8_WAIT_V(6); PG8_BAR;
    }
    for (;;) {
        const bool has_next = S.next(ui + 1, nxt);
        const char* nA = has_next ? nxt.pA : cA; const char* nB = has_next ? nxt.pB : cB;
        for (int t = 0; t < nt; t += 2) {
            const bool last = (t == nt - 2);
            const char* a1 = cA + (size_t)(t + 1) * kstep;
            const char* a2 = last ? nA : cA + (size_t)(t + 2) * kstep; const char* b2 = last ? nB : cB + (size_t)(t + 2) * kstep;
            const char* a3 = a2 + kstep; const char* b3 = b2 + kstep;
            if (last && has_next) S.a_ready(nxt);
            {
            PG8_LDB(B0, 0, 0); PG8_LDB(B1, 0, 1); PG8_SCHED; PG8_LDA(At, 0, 0); PG8_STAGE(PG8_SA(1, 1), a1 + hstepA, voffA);
            PG8_WAIT_V(8); PG8_WAIT_L(0); PG8_BAR; PG8_MMA(0, 0, At, B0); PG8_MMA(0, 1, At, B1); PG8_BAR; PG8_SCHED;
            PG8_LDA(At, 0, 1); PG8_STAGE(PG8_SB(0, 0), b2, voffB); PG8_STAGE(PG8_SB(0, 1), b2 + hstepB, voffB); PG8_STAGE(PG8_SA(0, 0), a2, voffA);
            PG8_WAIT_V(8); PG8_WAIT_L(0); PG8_BAR; PG8_MMA(1, 0, At, B0); PG8_MMA(1, 1, At, B1); PG8_BAR; PG8_SCHED;
            PG8_LDB(B0, 1, 0); PG8_LDB(B1, 1, 1); PG8_SCHED; PG8_LDA(At, 1, 0); PG8_STAGE(PG8_SA(0, 1), a2 + hstepA, voffA);
            PG8_WAIT_V(8); PG8_WAIT_L(0); PG8_BAR; PG8_MMA(0, 0, At, B0); PG8_MMA(0, 1, At, B1); PG8_BAR; PG8_SCHED;
            PG8_LDA(At, 1, 1); PG8_STAGE(PG8_SB(1, 0), b3, voffB); PG8_STAGE(PG8_SB(1, 1), b3 + hstepB, voffB); PG8_STAGE(PG8_SA(1, 0), a3, voffA);
            PG8_WAIT_V(8); PG8_WAIT_L(0); PG8_BAR; PG8_MMA(1, 0, At, B0); PG8_MMA(1, 1, At, B1); PG8_BAR; PG8_SCHED;
            }
        }
        if constexpr (ALIGN_EPI) { if (wr == 0) PG8_BAR; }
        if constexpr (!Epi::AFTER_DRAIN) { E(acc, cur, wr, wc, fr, fq); S.done(cur); }
        if (!has_next) break;
#pragma unroll
        for (int a = 0; a < 2; ++a)
#pragma unroll
            for (int b = 0; b < 2; ++b)
#pragma unroll
                for (int m = 0; m < 4; ++m)
#pragma unroll
                    for (int n = 0; n < 2; ++n) acc[a][b][m][n] = (f32x4){0.f, 0.f, 0.f, 0.f};
        cur = nxt; cA = nA; cB = nB; ++ui;
        if constexpr (ALIGN_EPI) { if (wr == 1) PG8_BAR; }
    }
    PG8_WAIT_V(0);
    if constexpr (!ALIGN_EPI) { if (wr == 0) PG8_BAR; }
    PG8_BAR;
    if constexpr (Epi::AFTER_DRAIN) { E.fused(acc, cur, wr, wc, fr, fq, lds, wid, lane); S.done(cur); }
#undef PG8_SA
#undef PG8_SB
#undef PG8_STAGE
#undef PG8_LDA
#undef PG8_LDB
#undef PG8_MMA
#undef PG8_WAIT_V
#undef PG8_WAIT_L
#undef PG8_BAR
#undef PG8_SCHED
}
}
namespace mk {
using pg8::Unit;
typedef f32x4 Acc[2][2][4][2];
__device__ __forceinline__ void st8(bf16* p, f32x4 v) { u32x2 w; w.x = cvtpk(v[0], v[1]); w.y = cvtpk(v[2], v[3]); *(u32x2*)p = w; }
__device__ __forceinline__ void st16(bf16* p, f32x4 a, f32x4 b) { u32x4 w; w.x = cvtpk(a[0], a[1]); w.y = cvtpk(a[2], a[3]); w.z = cvtpk(b[0], b[1]); w.w = cvtpk(b[2], b[3]); *(u32x4*)p = w; }
__device__ __forceinline__ f32x4 ld4bf(const bf16* p) { const u32x2 w = *(const u32x2*)p; return (f32x4){bflo(w.x), bfhi(w.x), bflo(w.y), bfhi(w.y)}; }
__device__ __forceinline__ f32x4 rope4(f32x4 v, f32x4 cs) { return (f32x4){v[0] * cs[0] - v[1] * cs[1], v[1] * cs[0] + v[0] * cs[1], v[2] * cs[2] - v[3] * cs[3], v[3] * cs[2] + v[2] * cs[3]}; }

struct EpiWin {
    static constexpr bool PERM = false, AFTER_DRAIN = false;
    bf16 *RQ, *RK, *RKT, *RVT, *RG, *UC, *CQ, *CKV, *KPE; float *SSQQ, *SSQKV; const f32x4* CS;
    __device__ __forceinline__ void operator()(const Acc& acc, const Unit& u, int wr, int wc, int fr, int fq) const { { int t_ = threadIdx.x; asm volatile("" : "+v"(t_)); fr = t_ & 15; fq = (t_ >> 4) & 3; }
        const int pn = u.pn, row0 = u.pm * 256 + wr * 64 + fr;
        if (pn <= 1) {
#pragma unroll
            for (int ai = 0; ai < 2; ++ai)
#pragma unroll
                for (int m = 0; m < 4; ++m) { const int row = row0 + ai * 128 + m * 16; const float pl = (float)(row & (RET_C - 1));
#pragma unroll
                    for (int bj = 0; bj < 2; ++bj) { const int head = 2 * bj + (wc >> 1);
                        const float lg2 = __builtin_amdgcn_logf(1.f - __builtin_amdgcn_exp2f(-5.f - (float)head));
                        const float dec = pn == 0 ? __builtin_amdgcn_exp2f(pl * lg2) : 0.125f * __builtin_amdgcn_exp2f(-pl * lg2);
#pragma unroll
                        for (int n = 0; n < 2; ++n) { const int i0 = 16 * (wc & 1) + 8 * n + 2 * fq; const f32x4 cs = CS[(row * 32 + i0) >> 1];
                            const f32x4 o = rope4(acc[ai][bj][m][n], cs) * dec; const int col = bj * 128 + wc * 32 + n * 16 + fq * 4;
                            st8((pn == 0 ? RQ : RK) + (size_t)row * 256 + col, o);
                            if (pn == 1) {
#pragma unroll
                                for (int j = 0; j < 4; ++j) RKT[(size_t)(col + j) * NTOK + row] = (bf16)(cvtpk(o[j], 0.f) & 0xffffu); } } } }
        } else if (pn == 2) {
#pragma unroll
            for (int ai = 0; ai < 2; ++ai)
#pragma unroll
                for (int m = 0; m < 4; ++m) { const int row = row0 + ai * 128 + m * 16;
#pragma unroll
                    for (int bj = 0; bj < 2; ++bj)
#pragma unroll
                        for (int n = 0; n < 2; ++n) { const int col = bj * 128 + wc * 32 + n * 16 + fq * 4; const f32x4 v = acc[ai][bj][m][n];
#pragma unroll
                            for (int j = 0; j < 4; ++j) RVT[(size_t)(col + j) * NTOK + row] = (bf16)(cvtpk(v[j], 0.f) & 0xffffu); } }
        } else if (pn == 3) {
#pragma unroll
            for (int ai = 0; ai < 2; ++ai)
#pragma unroll
                for (int m = 0; m < 4; ++m) { const int row = row0 + ai * 128 + m * 16;
#pragma unroll
                    for (int bj = 0; bj < 2; ++bj)
#pragma unroll
                        for (int n = 0; n < 2; ++n) { const int col = bj * 128 + wc * 32 + n * 16 + fq * 4; const f32x4 v = acc[ai][bj][m][n];
                            st8(RG + (size_t)row * 256 + col, (f32x4){silu_fast(v[0]), silu_fast(v[1]), silu_fast(v[2]), silu_fast(v[3])}); } }
        } else if (pn == 4) {
#pragma unroll
            for (int ai = 0; ai < 2; ++ai)
#pragma unroll
                for (int m = 0; m < 4; ++m) { const int row = row0 + ai * 128 + m * 16, chunk = row / SSM_C, t = row % SSM_C;
#pragma unroll
                    for (int bj = 0; bj < 2; ++bj)
#pragma unroll
                        for (int n = 0; n < 2; ++n) { const int g = 8 * bj + 2 * wc + n;
                            st8(UC + ((size_t)g * SSM_NCH + chunk) * SSM_K + t * 16 + 4 * fq, acc[ai][bj][m][n]); } }
        } else if (pn == 5) {
#pragma unroll
            for (int ai = 0; ai < 2; ++ai)
#pragma unroll
                for (int m = 0; m < 4; ++m) { const int row = row0 + ai * 128 + m * 16; float ss = 0.f;
#pragma unroll
                    for (int bj = 0; bj < 2; ++bj)
#pragma unroll
                        for (int n = 0; n < 2; ++n) { const f32x4 v = acc[ai][bj][m][n]; ss += (v[0] * v[0] + v[1] * v[1]) + (v[2] * v[2] + v[3] * v[3]);
                            st8(CQ + (size_t)row * 256 + bj * 128 + wc * 32 + n * 16 + fq * 4, v); }
                    ss += __shfl_xor(ss, 16); ss += __shfl_xor(ss, 32);
                    if (fq == 0) SSQQ[row * 4 + wc] = ss; }
        } else {
#pragma unroll
            for (int ai = 0; ai < 2; ++ai)
#pragma unroll
                for (int m = 0; m < 4; ++m) { const int row = row0 + ai * 128 + m * 16; float ss = 0.f;
#pragma unroll
                    for (int n = 0; n < 2; ++n) { const f32x4 v = acc[ai][0][m][n]; ss += (v[0] * v[0] + v[1] * v[1]) + (v[2] * v[2] + v[3] * v[3]);
                        st8(CKV + (size_t)row * 128 + wc * 32 + n * 16 + fq * 4, v); }
                    ss += __shfl_xor(ss, 16); ss += __shfl_xor(ss, 32);
                    if (fq == 0) SSQKV[row * 4 + wc] = ss;
                    if (wc < 2) {
#pragma unroll
                        for (int n = 0; n < 2; ++n) { const int i0 = 16 * wc + 8 * n + 2 * fq; const f32x4 cs = CS[(row * 32 + i0) >> 1];
                            st8(KPE + (size_t)row * 64 + wc * 32 + n * 16 + fq * 4, rope4(acc[ai][1][m][n], cs)); } } }
        }
    }
};
struct EpiQup {
    static constexpr bool PERM = false, AFTER_DRAIN = false;
    bf16* Q; const float* SSQ; const f32x4* CS;
    __device__ __forceinline__ void operator()(const Acc& acc, const Unit& u, int wr, int wc, int fr, int fq) const { { int t_ = threadIdx.x; asm volatile("" : "+v"(t_)); fr = t_ & 15; fq = (t_ >> 4) & 3; }
        const int row0 = u.pm * 256 + wr * 64 + fr;
#pragma unroll
        for (int ai = 0; ai < 2; ++ai)
#pragma unroll
            for (int m = 0; m < 4; ++m) { const int row = row0 + ai * 128 + m * 16; const f32x4 s4 = *(const f32x4*)(SSQ + row * 4);
                const float rstd = __builtin_amdgcn_rsqf(((s4[0] + s4[1]) + (s4[2] + s4[3])) * (1.f / 256.f) + EPS);
#pragma unroll
                for (int bj = 0; bj < 2; ++bj) { const bool rope = ((4 * u.pn + 2 * bj + (wc >> 1)) % 3) == 2;
#pragma unroll
                    for (int n = 0; n < 2; ++n) { f32x4 v = acc[ai][bj][m][n] * rstd;
                        if (rope) { const int i0 = 16 * (wc & 1) + 8 * n + 2 * fq; v = rope4(v, CS[(row * 32 + i0) >> 1]); }
                        st8(Q + (size_t)row * 768 + u.pn * 256 + bj * 128 + wc * 32 + n * 16 + fq * 4, v); } } }
    }
};
struct EpiKVup {
    static constexpr bool PERM = false, AFTER_DRAIN = false;
    bf16 *KN, *V; const float* SSQ;
    __device__ __forceinline__ void operator()(const Acc& acc, const Unit& u, int wr, int wc, int fr, int fq) const { { int t_ = threadIdx.x; asm volatile("" : "+v"(t_)); fr = t_ & 15; fq = (t_ >> 4) & 3; }
        const int row0 = u.pm * 256 + wr * 64 + fr;
#pragma unroll
        for (int ai = 0; ai < 2; ++ai)
#pragma unroll
            for (int m = 0; m < 4; ++m) { const int row = row0 + ai * 128 + m * 16; const f32x4 s4 = *(const f32x4*)(SSQ + row * 4);
                const float rstd = __builtin_amdgcn_rsqf(((s4[0] + s4[1]) + (s4[2] + s4[3])) * (1.f / 128.f) + EPS);
#pragma unroll
                for (int bj = 0; bj < 2; ++bj)
#pragma unroll
                    for (int n = 0; n < 2; ++n) st8((bj == 0 ? KN : V) + (size_t)row * 512 + u.pn * 128 + wc * 32 + n * 16 + fq * 4, acc[ai][bj][m][n] * rstd); }
    }
};
struct EpiSsmE {
    static constexpr bool PERM = false, AFTER_DRAIN = false;
    float* E;
    __device__ __forceinline__ void operator()(const Acc& acc, const Unit& u, int wr, int wc, int fr, int fq) const { { int t_ = threadIdx.x; asm volatile("" : "+v"(t_)); fr = t_ & 15; fq = (t_ >> 4) & 3; }
        const int g = u.pm >> 1, ch0 = (u.pm & 1) * 256 + wr * 64 + fr;
#pragma unroll
        for (int ai = 0; ai < 2; ++ai)
#pragma unroll
            for (int m = 0; m < 4; ++m) { const int chunk = ch0 + ai * 128 + m * 16;
#pragma unroll
                for (int n = 0; n < 2; ++n) *(f32x4*)(E + ((size_t)g * SSM_NCH + chunk) * 128 + wc * 32 + n * 16 + fq * 4) = acc[ai][0][m][n]; }
    }
};
struct EpiSsmZ {
    static constexpr bool PERM = false, AFTER_DRAIN = false;
    bf16* G; const bf16* UC; const float* dpar;
    __device__ __forceinline__ void operator()(const Acc& acc, const Unit& u, int wr, int wc, int fr, int fq) const { { int t_ = threadIdx.x; asm volatile("" : "+v"(t_)); fr = t_ & 15; fq = (t_ >> 4) & 3; }
        const int g = u.pm >> 1, ch0 = (u.pm & 1) * 256 + wr * 64 + fr;
        const f32x4 dd = *(const f32x4*)(dpar + g * 16 + 4 * fq);
#pragma unroll
        for (int ai = 0; ai < 2; ++ai)
#pragma unroll
            for (int m = 0; m < 4; ++m) { const int chunk = ch0 + ai * 128 + m * 16;
#pragma unroll
                for (int bj = 0; bj < 2; ++bj)
#pragma unroll
                    for (int n = 0; n < 2; ++n) { const int t = u.pn * 16 + bj * 8 + wc * 2 + n;
                        const f32x4 uv = ld4bf(UC + ((size_t)g * SSM_NCH + chunk) * SSM_K + t * 16 + 4 * fq);
                        const f32x4 y = acc[ai][bj][m][n] + dd * uv;
                        st8(G + (size_t)(chunk * SSM_C + t) * 256 + g * 16 + 4 * fq, (f32x4){gelu_tanh_fast(y[0]), gelu_tanh_fast(y[1]), gelu_tanh_fast(y[2]), gelu_tanh_fast(y[3])}); } }
    }
};
struct EpiGlu {
    static constexpr bool PERM = false, AFTER_DRAIN = true;
    const bf16* G; const float *bias, *gain; bf16* MIX;
    __device__ __forceinline__ void fused(Acc& acc, const Unit& u, int wr, int wc, int fr, int fq, PG8_LAS unsigned char* lds, int wid, int lane) const { { int t_ = threadIdx.x; asm volatile("" : "+v"(t_)); fr = t_ & 15; fq = (t_ >> 4) & 3; }
        PG8_LAS float* P = (PG8_LAS float*)lds;
        const int row0 = u.pm * 256 + wr * 64 + fr;
#pragma unroll
        for (int ai = 0; ai < 2; ++ai)
#pragma unroll
            for (int m = 0; m < 4; ++m) { const int row = row0 + ai * 128 + m * 16; float ss = 0.f;
#pragma unroll
                for (int bj = 0; bj < 2; ++bj)
#pragma unroll
                    for (int n = 0; n < 2; ++n) { const int col = bj * 128 + wc * 32 + n * 16 + fq * 4; const f32x4 b4 = *(const f32x4*)(bias + col), gl = ld4bf(G + (size_t)row * 256 + col);
                        f32x4 z = acc[ai][bj][m][n] + b4;
                        z = (f32x4){gl[0] * fast_sigmoid(z[0]), gl[1] * fast_sigmoid(z[1]), gl[2] * fast_sigmoid(z[2]), gl[3] * fast_sigmoid(z[3])};
                        acc[ai][bj][m][n] = z; ss += (z[0] * z[0] + z[1] * z[1]) + (z[2] * z[2] + z[3] * z[3]); }
                ss += __shfl_xor(ss, 16); ss += __shfl_xor(ss, 32);
                if (fq == 0) P[(ai * 128 + wr * 64 + m * 16 + fr) * 4 + wc] = ss; }
        asm volatile("s_waitcnt lgkmcnt(0)" ::: "memory"); __builtin_amdgcn_s_barrier(); asm volatile("" ::: "memory");
#pragma unroll
        for (int ai = 0; ai < 2; ++ai)
#pragma unroll
            for (int m = 0; m < 4; ++m) { const int lr = ai * 128 + wr * 64 + m * 16 + fr, row = u.pm * 256 + lr;
                const float rstd = __builtin_amdgcn_rsqf(((P[lr * 4 + 0] + P[lr * 4 + 1]) + (P[lr * 4 + 2] + P[lr * 4 + 3])) * (1.f / 256.f) + EPS);
#pragma unroll
                for (int bj = 0; bj < 2; ++bj)
#pragma unroll
                    for (int n = 0; n < 2; ++n) { const int col = bj * 128 + wc * 32 + n * 16 + fq * 4; const f32x4 g4 = *(const f32x4*)(gain + col);
                        st8(MIX + (size_t)row * DM + 256 + col, acc[ai][bj][m][n] * rstd * g4); } }
        asm volatile("s_waitcnt lgkmcnt(0)" ::: "memory"); __builtin_amdgcn_s_barrier(); asm volatile("" ::: "memory");
    }
};
struct EpiStore {
    static constexpr bool PERM = true, AFTER_DRAIN = false;
    bf16* O; int ldc; const float* rowscale;
    __device__ __forceinline__ void operator()(const Acc& acc, const Unit& u, int wr, int wc, int fr, int fq) const { { int t_ = threadIdx.x; asm volatile("" : "+v"(t_)); fr = t_ & 15; fq = (t_ >> 4) & 3; }
        const int row0 = u.pm * 256 + wr * 64 + fr, col0 = u.pn * 256 + wc * 32 + 8 * fq;
#pragma unroll
        for (int ai = 0; ai < 2; ++ai)
#pragma unroll
            for (int m = 0; m < 4; ++m) { const int row = row0 + ai * 128 + m * 16; const float s = rowscale ? rowscale[row] : 1.f;
#pragma unroll
                for (int bj = 0; bj < 2; ++bj) st16(O + (size_t)row * ldc + col0 + bj * 128, acc[ai][bj][m][0] * s, acc[ai][bj][m][1] * s); }
    }
};
struct EpiSwiglu {
    static constexpr bool PERM = true, AFTER_DRAIN = false;
    bf16* H;
    __device__ __forceinline__ void operator()(const Acc& acc, const Unit& u, int wr, int wc, int fr, int fq) const { { int t_ = threadIdx.x; asm volatile("" : "+v"(t_)); fr = t_ & 15; fq = (t_ >> 4) & 3; }
        const int row0 = u.pm * 256 + wr * 64 + fr, h0 = u.pn * 128 + wc * 16 + 4 * fq;
#pragma unroll
        for (int ai = 0; ai < 2; ++ai)
#pragma unroll
            for (int m = 0; m < 4; ++m) { const int row = row0 + ai * 128 + m * 16;
#pragma unroll
                for (int bj = 0; bj < 2; ++bj) { const f32x4 g = acc[ai][bj][m][0], up = acc[ai][bj][m][1];
                    st8(H + (size_t)row * DFF + h0 + bj * 64, (f32x4){silu_fast(g[0]) * up[0], silu_fast(g[1]) * up[1], silu_fast(g[2]) * up[2], silu_fast(g[3]) * up[3]}); } }
    }
};
}
namespace att {
using namespace mk;
constexpr int KVBLK = 64, SHM_V = 64 * 128 * 2, SHM_KN = 64 * 128 * 2, SHM_KP = 64 * 64 * 2, BUF = SHM_V + SHM_KN + SHM_KP;
constexpr int OFF_V = 0, OFF_KN = SHM_V, OFF_KP = SHM_V + SHM_KN, OFF_WS = 2 * BUF, LDS_BYTES = 2 * BUF + NWAVES * 64 * 4;
constexpr float THR = 8.f;
#define KSWZ(row, colB) ((row) * 256 + ((colB) ^ (((row) & 7) << 4)))
#define KPSWZ(row, colB) ((row) * 128 + ((colB) ^ (((row) & 7) << 4)))
#define SBAR() __builtin_amdgcn_sched_barrier(0)
__device__ __forceinline__ int v_st(int k, int c) { const int kk = (k & ~0xC) | ((k & 4) << 1) | ((k & 8) >> 1); return ((kk >> 3) * 4 + (c >> 5)) * 512 + ((kk & 7) * 32 + (c & 31)) * 2; }
__device__ __forceinline__ int v_rd_base(int lane) { return ((lane & 3) << 3) | (((lane >> 2) & 3) << 6) | (((lane >> 4) & 1) << 5) | (((lane >> 5) & 1) << 8); }
constexpr int v_rd_off(int d0, int ks, int half) { return d0 * 512 + ks * 4096 + half * 2048; }
__device__ __forceinline__ int crow(int r, int hi) { return (r & 3) + 8 * (r >> 2) + 4 * hi; }

struct Tensors { const bf16* Q; const bf16* KN; const bf16* KP; const bf16* V; bf16* O; };

template <int B_>
__device__ __forceinline__ void qkt(f32x16& p, const char* lds, int r32, int hi, int kh, const bf16x8* qr) {
    p = f32x16{};
    const char* kb[4];
#pragma unroll
    for (int dd = 0; dd < 4; ++dd) kb[dd] = lds + B_ * BUF + OFF_KN + kh * 8192 + KSWZ(r32, (dd * 16 + hi * 8) * 2);
#pragma unroll
    for (int d0 = 0; d0 < 8; ++d0) { const bf16x8 a = *reinterpret_cast<const bf16x8*>(kb[d0 & 3] + (d0 >> 2) * 128); p = __builtin_amdgcn_mfma_f32_32x32x16_bf16(a, qr[d0], p, 0, 0, 0); }
#pragma unroll
    for (int dd = 0; dd < 4; ++dd) { const bf16x8 a = *reinterpret_cast<const bf16x8*>(lds + B_ * BUF + OFF_KP + kh * 4096 + KPSWZ(r32, (dd * 16 + hi * 8) * 2)); p = __builtin_amdgcn_mfma_f32_32x32x16_bf16(a, qr[8 + dd], p, 0, 0, 0); }
}
template <int B_>
__device__ __forceinline__ void pv_tile(f32x16* o, int vb0, bf16x8 pa0, bf16x8 pa1) {
#define TRRD(dst, off) asm volatile("ds_read_b64_tr_b16 %0, %1 offset:%2" : "=&v"(dst) : "v"(vb0), "i"(off) : "memory")
#define PV_D0(d0) do { s16x4 l0, l1, h0, h1; constexpr int b_ = B_ * BUF + OFF_V + v_rd_off(d0, 0, 0); \
        TRRD(l0, b_); TRRD(h0, b_ + 2048); TRRD(l1, b_ + 4096); TRRD(h1, b_ + 6144); \
        asm volatile("s_waitcnt lgkmcnt(0)" ::: "memory"); SBAR(); \
        o[d0] = __builtin_amdgcn_mfma_f32_32x32x16_bf16(pa0, (bf16x8){l0[0], l0[1], l0[2], l0[3], h0[0], h0[1], h0[2], h0[3]}, o[d0], 0, 0, 0); \
        o[d0] = __builtin_amdgcn_mfma_f32_32x32x16_bf16(pa1, (bf16x8){l1[0], l1[1], l1[2], l1[3], h1[0], h1[1], h1[2], h1[3]}, o[d0], 0, 0, 0); } while (0)
    PV_D0(0); PV_D0(1); PV_D0(2); PV_D0(3);
#undef PV_D0
#undef TRRD
}
__device__ __forceinline__ void softmax_tile(f32x16& p, float& m_reg, float& l_reg, float& alpha, bf16x8& pa0, bf16x8& pa1) {
    float pmax = p[0];
#pragma unroll
    for (int r = 1; r < 16; ++r) pmax = fmaxf(pmax, p[r]);
    { auto rr = __builtin_amdgcn_permlane32_swap(__float_as_uint(pmax), __float_as_uint(pmax), false, false); pmax = fmaxf(__uint_as_float(rr[0]), __uint_as_float(rr[1])); }
    float mn;
    if (__builtin_expect(__all((pmax - m_reg) <= THR), 1)) { mn = m_reg; alpha = 1.f; }
    else { mn = fmaxf(m_reg, pmax); alpha = __builtin_amdgcn_exp2f(m_reg - mn); m_reg = mn; }
    float ps = 0.f;
#pragma unroll
    for (int r = 0; r < 16; ++r) { p[r] = __builtin_amdgcn_exp2f(p[r] - mn); ps += p[r]; }
    { auto rr = __builtin_amdgcn_permlane32_swap(__float_as_uint(ps), __float_as_uint(ps), false, false); ps = __uint_as_float(rr[0]) + __uint_as_float(rr[1]); }
    l_reg = l_reg * alpha + ps;
#define PK4(B__, OUT) do { unsigned a0 = cvtpk(p[B__ + 0], p[B__ + 1]), a1 = cvtpk(p[B__ + 2], p[B__ + 3]), b0 = cvtpk(p[B__ + 4], p[B__ + 5]), b1 = cvtpk(p[B__ + 6], p[B__ + 7]); \
        auto r0 = __builtin_amdgcn_permlane32_swap(a0, b0, false, false); auto r1 = __builtin_amdgcn_permlane32_swap(a1, b1, false, false); \
        u32x4 w = {r0[0], r1[0], r0[1], r1[1]}; OUT = *reinterpret_cast<bf16x8*>(&w); } while (0)
    PK4(0, pa0); PK4(8, pa1);
#undef PK4
}
__device__ __forceinline__ void attn_unit(int b, int h, int qb, const Tensors& T, char* lds) {
    int tid_ = threadIdx.x; asm volatile("" : "+v"(tid_));
    const int tid = tid_, wid = __builtin_amdgcn_readfirstlane(tid >> 6), lane = tid & 63, r32 = lane & 31, hi = lane >> 5;
    const int rg = wid & 3, kh = wid >> 2;
    const size_t tok0 = (size_t)b * SEQ; const int q0 = qb * 128, NT = 2 * qb + 2;
    float* ws = (float*)(lds + OFF_WS) + wid * 64;
    const int sr = tid >> 4, sc = (tid & 15) * 8, kws = KSWZ(sr, sc * 2), vst0 = v_st(sr, sc), vst1 = v_st(32 + sr, sc);
    const int pr = tid >> 3, pc = (tid & 7) * 8, kpw = KPSWZ(pr, pc * 2);
    const bf16* gKN = T.KN + (tok0 + sr) * 512 + h * 128 + sc; const bf16* gV = T.V + (tok0 + sr) * 512 + h * 128 + sc; const bf16* gKP = T.KP + (tok0 + pr) * 64 + pc;
    bf16x8 st_k0, st_k1, st_v0, st_v1, st_p;
#define SLOAD(t) do { const size_t ko = (size_t)(t) * KVBLK; st_k0 = *(const bf16x8*)(gKN + ko * 512); st_k1 = *(const bf16x8*)(gKN + (ko + 32) * 512); \
        st_v0 = *(const bf16x8*)(gV + ko * 512); st_v1 = *(const bf16x8*)(gV + (ko + 32) * 512); st_p = *(const bf16x8*)(gKP + ko * 64); } while (0)
#define SWRITE(bf) do { char* bb = lds + (bf) * BUF; *(bf16x8*)(bb + OFF_KN + kws) = st_k0; *(bf16x8*)(bb + OFF_KN + kws + 32 * 256) = st_k1; \
        *(bf16x8*)(bb + OFF_V + vst0) = st_v0; *(bf16x8*)(bb + OFF_V + vst1) = st_v1; *(bf16x8*)(bb + OFF_KP + kpw) = st_p; } while (0)
    SLOAD(0);
    bf16x8 qr[12];
    { const bf16* qp = T.Q + (tok0 + q0 + rg * 32 + r32) * 768 + h * 192 + hi * 8;
#pragma unroll
      for (int d0 = 0; d0 < 12; ++d0) qr[d0] = *(const bf16x8*)(qp + d0 * 16); }
    float m_reg = -1e30f, l_reg = 0.f; f32x16 o[4] = {};
    const int vb0 = (int)(uintptr_t)lds + v_rd_base(lane) + kh * 8192;
    const int qpos = q0 + rg * 32 + r32;
    asm volatile("s_waitcnt vmcnt(0)" ::: "memory"); SWRITE(0);
    __syncthreads();
#define RESC(a) do { if (__any((a) < 1.f)) { if (hi == 0) ws[r32] = (a); asm volatile("s_waitcnt lgkmcnt(0)" ::: "memory"); \
        _Pragma("unroll") for (int d_ = 0; d_ < 4; ++d_) _Pragma("unroll") for (int r = 0; r < 16; ++r) o[d_][r] *= ws[crow(r, hi)]; } } while (0)
#define STEP(t, B__) do { if ((t) + 1 < NT) SLOAD((t) + 1); SBAR(); \
        f32x16 p; qkt<B__>(p, lds, r32, hi, kh, qr); \
        if ((t) >= NT - 2) { const int kb_ = (t) * KVBLK + kh * 32 + 4 * hi; const float NEG = -__builtin_inff(); \
            _Pragma("unroll") for (int r = 0; r < 16; ++r) { const int key = kb_ + (r & 3) + 8 * (r >> 2); if (key > qpos) p[r] = NEG; } } \
        float alpha; bf16x8 pa0, pa1; softmax_tile(p, m_reg, l_reg, alpha, pa0, pa1); RESC(alpha); SBAR(); \
        pv_tile<B__>(o, vb0, pa0, pa1); \
        if ((t) + 1 < NT) { asm volatile("s_waitcnt vmcnt(0)" ::: "memory"); SWRITE(1 - B__); } \
        __syncthreads(); } while (0)
    for (int t = 0; t < NT; t += 2) { STEP(t, 0); STEP(t + 1, 1); }
#undef STEP
#undef RESC
#undef SLOAD
#undef SWRITE
    float* XO = (float*)lds;
    float* XM = (float*)(lds + 65536);
    if (kh == 1) {
#pragma unroll
        for (int d0 = 0; d0 < 4; ++d0)
#pragma unroll
            for (int r = 0; r < 16; ++r) XO[((rg * 64) + d0 * 16 + r) * 64 + lane] = o[d0][r];
        if (hi == 0) { XM[rg * 32 + r32] = m_reg; XM[128 + rg * 32 + r32] = l_reg; }
    }
    __syncthreads();
    if (kh == 0) {
        const float m1 = XM[rg * 32 + r32], l1 = XM[128 + rg * 32 + r32];
        const float mn = fmaxf(m_reg, m1), a0 = __builtin_amdgcn_exp2f(m_reg - mn), a1 = __builtin_amdgcn_exp2f(m1 - mn);
        const float inv = __builtin_amdgcn_rcpf(l_reg * a0 + l1 * a1);
        if (hi == 0) { ws[r32] = a0 * inv; ws[32 + r32] = a1 * inv; }
        asm volatile("s_waitcnt lgkmcnt(0)" ::: "memory");
        bf16* Ow = T.O + (tok0 + q0 + rg * 32) * 512 + h * 128;
#pragma unroll
        for (int r = 0; r < 16; ++r) { const int orow = crow(r, hi); const float f0 = ws[orow], f1 = ws[32 + orow];
#pragma unroll
            for (int d0 = 0; d0 < 4; ++d0) { const float v = o[d0][r] * f0 + XO[((rg * 64) + d0 * 16 + r) * 64 + lane] * f1; const float vn = __shfl_xor(v, 1);
                if ((r32 & 1) == 0) *(unsigned*)(Ow + (size_t)orow * 512 + d0 * 32 + r32) = cvtpk(v, vn); } }
    }
    __syncthreads();
}
#undef KSWZ
#undef KPSWZ
#undef SBAR
}
namespace ret {
using namespace mk;
__device__ __forceinline__ int crow(int r, int hi) { return (r & 3) + 8 * (r >> 2) + 4 * hi; }
struct Tensors { const bf16 *RQ, *RK, *RKT, *RVT, *RG; float* KVT; bf16* STATE; bf16* MIX; const float* gain; };
__device__ __forceinline__ void x_unit(int u, const Tensors& T, int lane) {
    asm volatile("" : "+v"(lane));
    const int n = u & 127, bh = u >> 7, h = bh & 3, b = bh >> 2, r32 = lane & 31, hi = lane >> 5;
    const size_t tok0 = (size_t)b * SEQ + (size_t)n * RET_C;
    f32x16 acc[2][2] = {};
#pragma unroll
    for (int s = 0; s < 4; ++s) {
        bf16x8 a[2], bb[2];
#pragma unroll
        for (int i = 0; i < 2; ++i) { a[i] = *(const bf16x8*)(T.RVT + (size_t)(h * 64 + i * 32 + r32) * NTOK + tok0 + s * 16 + hi * 8);
                                      bb[i] = *(const bf16x8*)(T.RKT + (size_t)(h * 64 + i * 32 + r32) * NTOK + tok0 + s * 16 + hi * 8); }
#pragma unroll
        for (int i = 0; i < 2; ++i)
#pragma unroll
            for (int j = 0; j < 2; ++j) acc[i][j] = __builtin_amdgcn_mfma_f32_32x32x16_bf16(a[i], bb[j], acc[i][j], 0, 0, 0);
    }
    float* out = T.KVT + (size_t)u * 4096;
#pragma unroll
    for (int i = 0; i < 2; ++i)
#pragma unroll
        for (int j = 0; j < 2; ++j)
#pragma unroll
            for (int r = 0; r < 16; ++r) out[(i * 32 + crow(r, hi)) * 64 + j * 32 + r32] = acc[i][j][r];
}
__device__ __forceinline__ void scan_elem(int e, const Tensors& T) {
    const int bh = e >> 12, el = e & 4095, h = bh & 3;
    const float gam = 1.f - __builtin_amdgcn_exp2f(-5.f - (float)h), lg2 = __builtin_amdgcn_logf(gam);
    const float g64 = __builtin_amdgcn_exp2f(64.f * lg2), g63 = __builtin_amdgcn_exp2f(63.f * lg2);
    const float* kv = T.KVT + (size_t)bh * 128 * 4096 + el; bf16* st = T.STATE + (size_t)bh * 128 * 4096 + el;
    float S = 0.f;
    for (int n0 = 0; n0 < 128; n0 += 16) {
        float v[16];
#pragma unroll
        for (int i = 0; i < 16; ++i) v[i] = kv[(size_t)(n0 + i) * 4096];
#pragma unroll
        for (int i = 0; i < 16; ++i) { st[(size_t)(n0 + i) * 4096] = (bf16)(cvtpk(gam * S, 0.f) & 0xffffu); S = g64 * S + g63 * v[i]; }
    }
}
__device__ __forceinline__ void z_unit(int u, const Tensors& T, int lane) {
    asm volatile("" : "+v"(lane));
    const int n = u & 127, bh = u >> 7, h = bh & 3, b = bh >> 2, r32 = lane & 31, hi = lane >> 5;
    const size_t tok0 = (size_t)b * SEQ + (size_t)n * RET_C;
    bf16x8 qf[2][4];
#pragma unroll
    for (int qb = 0; qb < 2; ++qb)
#pragma unroll
        for (int s = 0; s < 4; ++s) qf[qb][s] = *(const bf16x8*)(T.RQ + (tok0 + qb * 32 + r32) * 256 + h * 64 + s * 16 + hi * 8);
    f32x16 o[2][2] = {};
    const bf16* stp = T.STATE + (size_t)u * 4096;
#pragma unroll
    for (int s = 0; s < 4; ++s) {
        bf16x8 a[2];
#pragma unroll
        for (int i = 0; i < 2; ++i) a[i] = *(const bf16x8*)(stp + (i * 32 + r32) * 64 + s * 16 + hi * 8);
#pragma unroll
        for (int i = 0; i < 2; ++i)
#pragma unroll
            for (int qb = 0; qb < 2; ++qb) o[i][qb] = __builtin_amdgcn_mfma_f32_32x32x16_bf16(a[i], qf[qb][s], o[i][qb], 0, 0, 0);
    }
#pragma unroll
    for (int kb = 0; kb < 2; ++kb) {
        bf16x8 kf[4];
#pragma unroll
        for (int s = 0; s < 4; ++s) kf[s] = *(const bf16x8*)(T.RK + (tok0 + kb * 32 + r32) * 256 + h * 64 + s * 16 + hi * 8);
#pragma unroll
        for (int qb = kb; qb < 2; ++qb) {
            f32x16 st = {};
#pragma unroll
            for (int s = 0; s < 4; ++s) st = __builtin_amdgcn_mfma_f32_32x32x16_bf16(kf[s], qf[qb][s], st, 0, 0, 0);
            if (kb == qb) {
#pragma unroll
                for (int r = 0; r < 16; ++r) if (crow(r, hi) > r32) st[r] = 0.f;
            }
#pragma unroll
            for (int s2 = 0; s2 < 2; ++s2) {
                u32x4 w; w.x = cvtpk(st[8 * s2 + 0], st[8 * s2 + 1]); w.y = cvtpk(st[8 * s2 + 2], st[8 * s2 + 3]); w.z = cvtpk(st[8 * s2 + 4], st[8 * s2 + 5]); w.w = cvtpk(st[8 * s2 + 6], st[8 * s2 + 7]);
                const bf16x8 pb = __builtin_bit_cast(bf16x8, w);
#pragma unroll
                for (int i = 0; i < 2; ++i) {
                    const bf16* vp = T.RVT + (size_t)(h * 64 + i * 32 + r32) * NTOK + tok0 + kb * 32 + s2 * 16 + 4 * hi;
                    const u32x2 lo = *(const u32x2*)vp, hh = *(const u32x2*)(vp + 8);
                    const u32x4 av = {lo.x, lo.y, hh.x, hh.y};
                    o[i][qb] = __builtin_amdgcn_mfma_f32_32x32x16_bf16(__builtin_bit_cast(bf16x8, av), pb, o[i][qb], 0, 0, 0);
                }
            }
        }
    }
#pragma unroll
    for (int qb = 0; qb < 2; ++qb) {
        float ss = 0.f;
#pragma unroll
        for (int i = 0; i < 2; ++i)
#pragma unroll
            for (int r = 0; r < 16; ++r) ss += o[i][qb][r] * o[i][qb][r];
        { auto rr = __builtin_amdgcn_permlane32_swap(__float_as_uint(ss), __float_as_uint(ss), false, false); ss = __uint_as_float(rr[0]) + __uint_as_float(rr[1]); }
        const float rstd = __builtin_amdgcn_rsqf(ss * (1.f / 64.f) + EPS);
        const size_t row = tok0 + qb * 32 + r32;
#pragma unroll
        for (int i = 0; i < 2; ++i)
#pragma unroll
            for (int r4 = 0; r4 < 4; ++r4) { const int dv = i * 32 + 8 * r4 + 4 * hi;
                const f32x4 gt = ld4bf(T.RG + row * 256 + h * 64 + dv), gn = *(const f32x4*)(T.gain + h * 64 + dv);
                const f32x4 v = {o[i][qb][4 * r4 + 0], o[i][qb][4 * r4 + 1], o[i][qb][4 * r4 + 2], o[i][qb][4 * r4 + 3]};
                st8(T.MIX + row * DM + h * 64 + dv, v * rstd * gn * gt); }
    }
}
}
namespace mk {
constexpr size_t MiB = 1u << 20;
constexpr size_t W_CTL = 0, CTL_ZERO_BYTES = 64 * 1024;
constexpr size_t W_WGCNT = 128 * 1024;
constexpr size_t W_TILE = 192 * 1024;
constexpr size_t W_MOD = 1 * MiB;
constexpr size_t W_LAMC = 1 * MiB + 256 * 1024;
constexpr size_t W_TOP = 1 * MiB + 512 * 1024;
constexpr size_t W_CS = 2 * MiB;
constexpr size_t W_ROWW = 6 * MiB;
constexpr size_t W_SSQQ = 6 * MiB + 256 * 1024, W_SSQKV = 6 * MiB + 512 * 1024;
constexpr size_t W_MOEUP = 8 * MiB, W_MOEDN = 120 * MiB;
constexpr size_t W_WIN = 176 * MiB, W_WOUT = 183 * MiB, W_FFUP = 187 * MiB, W_FFDN = 201 * MiB, W_MW = 208 * MiB, W_WEND = 228 * MiB;
constexpr size_t W_WUQ = 233 * MiB, W_WUKV = 234 * MiB, W_GLUW = 235 * MiB;
constexpr size_t W_Y = 236 * MiB, W_MIX = 268 * MiB, W_T = 300 * MiB;
constexpr size_t W_RQ = W_T, W_RK = W_T + 8 * MiB, W_RKT = W_T + 16 * MiB, W_RVT = W_T + 24 * MiB, W_RG = W_T + 32 * MiB, W_UC = W_T + 40 * MiB, W_CQ = W_T + 50 * MiB,
                 W_CKV = W_T + 58 * MiB, W_KPE = W_T + 62 * MiB, W_Q = W_T + 64 * MiB, W_KN = W_T + 88 * MiB, W_V = W_T + 104 * MiB, W_O = W_T + 120 * MiB, W_G = W_T + 136 * MiB,
                 W_KVT = W_T + 144 * MiB, W_STATE = W_T + 160 * MiB, W_E = W_T + 168 * MiB;
constexpr size_t W_HB = W_T;
constexpr size_t W_XN = 480 * MiB;
constexpr size_t W_XG = 176 * MiB;
constexpr size_t W_HBM = 244 * MiB;
constexpr size_t W_END = 512 * MiB;

struct Args { const void* in[35]; float* out; unsigned char* ws; int ph_lo, ph_hi, never, pad; };

template <class SrcF>
__device__ __forceinline__ void transpose_item(const SrcF src, int ld, int K, bf16* WT, const float* kscale, float cscale, LAS float* scr, int kb, int nb, int lane) {
    const int k0 = 64 * kb, n0 = 32 * nb;
    const float* sp = src(n0 + (lane & 31));
#pragma unroll 8
    for (int i = 0; i < 32; ++i) { const int kk = 2 * i + (lane >> 5); float v = sp[(size_t)(k0 + kk) * ld] * cscale; if (kscale) v *= kscale[k0 + kk]; scr[kk * 33 + (lane & 31)] = v; }
    asm volatile("s_waitcnt lgkmcnt(0)" ::: "memory");
    const int c = lane & 7;
#pragma unroll
    for (int j = 0; j < 4; ++j) { const int n = (lane >> 3) + 8 * j; const LAS float* s = scr + (8 * c) * 33 + n;
        u32x4 o; o.x = cvtpk(s[0 * 33], s[1 * 33]); o.y = cvtpk(s[2 * 33], s[3 * 33]); o.z = cvtpk(s[4 * 33], s[5 * 33]); o.w = cvtpk(s[6 * 33], s[7 * 33]);
        *(u32x4*)(WT + (size_t)(n0 + n) * K + k0 + 8 * c) = o; }
    asm volatile("s_waitcnt lgkmcnt(0)" ::: "memory");
}
struct SrcPlain { const float* W; __device__ __forceinline__ const float* operator()(int n) const { return W + n; } };
struct SrcWin { const float* W; __device__ __forceinline__ const float* operator()(int n) const {
        const bool rp = (n < 512) || (n >= 1664); const int g = n & ~63, cg = n & 63; return W + (rp ? g + (cg >> 1) + 32 * (cg & 1) : n); } };
struct SrcWuq { const float* W; __device__ __forceinline__ const float* operator()(int n) const { const int hh = n / 192, w = n % 192; const int cg = w - 128; return W + (w < 128 ? n : hh * 192 + 128 + (cg >> 1) + 32 * (cg & 1)); } };
struct SrcGU { const float* Wg; const float* Wu; __device__ __forceinline__ const float* operator()(int n) const { const int hid = (n >> 3) * 4 + (n & 3);
        const long long du = (const char*)Wu - (const char*)Wg; return (const float*)((const char*)Wg + (((n >> 2) & 1) ? du : 0ll)) + hid; } };

__device__ __forceinline__ f32x2 lam_pow(float a_re, float a_im, float dt, float e) {
    const float mag = __builtin_amdgcn_exp2f(1.4426950408889634f * a_re * dt * e);
    const double rev = (double)(a_im * dt) * (double)e * 0.15915494309189535;
    const float fr = (float)(rev - floor(rev));
    return (f32x2){mag * __builtin_amdgcn_cosf(fr), mag * __builtin_amdgcn_sinf(fr)};
}
__device__ __forceinline__ f32x2 cmul(f32x2 a, f32x2 b) { return (f32x2){a.x * b.x - a.y * b.y, a.x * b.y + a.y * b.x}; }
}
namespace mk {
struct SsmPar { const float *a_re, *a_im, *b_re, *b_im, *c_re, *c_im, *log_dt; };
__device__ __forceinline__ f32x2 ssm_fw(const SsmPar& P, int g, int p, float e, bool with_f) {
    const float dt = __builtin_amdgcn_exp2f(1.4426950408889634f * P.log_dt[g]);
    const float ar = P.a_re[g * 64 + p], ai = P.a_im[g * 64 + p];
    f32x2 w = lam_pow(ar, ai, dt, e);
    if (with_f) { const f32x2 lb = lam_pow(ar, ai, dt, 1.f); const float nr = lb.x - 1.f, ni = lb.y, den = ar * ar + ai * ai;
        const f32x2 f = {(nr * ar + ni * ai) / den, (ni * ar - nr * ai) / den}; w = cmul(w, f); }
    return w;
}
__device__ __forceinline__ void ssm_unit_toep(const SsmPar& P, bf16* MW, int g, int dd, LAS float* scr, int lane) {
    const int d = dd - 31, h = lane >> 2, hp0 = (lane & 3) * 4;
    f32x4 acc = {0.f, 0.f, 0.f, 0.f};
    if (d >= 0) {
        const f32x2 w = ssm_fw(P, g, lane, (float)d, true);
        scr[2 * lane] = w.x; scr[2 * lane + 1] = w.y;
        asm volatile("s_waitcnt lgkmcnt(0)" ::: "memory");
        for (int p = 0; p < 64; ++p) {
            const f32x2 wp = {scr[2 * p], scr[2 * p + 1]};
            const f32x2 cm = {P.c_re[(g * 16 + h) * 64 + p], P.c_im[(g * 16 + h) * 64 + p]};
            const f32x2 t = cmul(cm, wp);
            const f32x4 br = *(const f32x4*)(P.b_re + (g * 64 + p) * 16 + hp0), bi = *(const f32x4*)(P.b_im + (g * 64 + p) * 16 + hp0);
            acc += br * t.x - bi * t.y;
        }
        asm volatile("s_waitcnt lgkmcnt(0)" ::: "memory");
    }
    const int tlo = d >= 0 ? d : 0, thi = d >= 0 ? 32 : 32 + d;
    for (int t = tlo; t < thi; ++t) st8(MW + ((size_t)g * 512 + t * 16 + h) * SSM_K + (t - d) * 16 + hp0, acc);
}
__device__ __forceinline__ void ssm_unit_cross(const SsmPar& P, bf16* MW, f32x2* LAMC, int g, int t, int lane) {
    const f32x2 lp = ssm_fw(P, g, lane, (float)(t + 1), false);
    if (t == 31) LAMC[g * 64 + lane] = lp;
#pragma unroll 4
    for (int h = 0; h < 16; ++h) { const f32x2 cm = {P.c_re[(g * 16 + h) * 64 + lane], P.c_im[(g * 16 + h) * 64 + lane]}; const f32x2 v = cmul(cm, lp);
        *(unsigned*)(MW + ((size_t)g * 512 + t * 16 + h) * SSM_K + 512 + 2 * lane) = cvtpk(v.x, -v.y); }
}
__device__ __forceinline__ void ssm_unit_end(const SsmPar& P, bf16* WEND, int g, int j, int lane) {
    const f32x2 w = ssm_fw(P, g, lane, (float)(31 - j), true);
    float re[16], im[16];
#pragma unroll
    for (int q = 0; q < 4; ++q) { const f32x4 br = *(const f32x4*)(P.b_re + (g * 64 + lane) * 16 + 4 * q), bi = *(const f32x4*)(P.b_im + (g * 64 + lane) * 16 + 4 * q);
#pragma unroll
        for (int k = 0; k < 4; ++k) { re[4 * q + k] = w.x * br[k] - w.y * bi[k]; im[4 * q + k] = w.x * bi[k] + w.y * br[k]; } }
    bf16* r0 = WEND + ((size_t)g * 128 + 2 * lane) * 512 + j * 16;
    st16(r0, (f32x4){re[0], re[1], re[2], re[3]}, (f32x4){re[4], re[5], re[6], re[7]}); st16(r0 + 8, (f32x4){re[8], re[9], re[10], re[11]}, (f32x4){re[12], re[13], re[14], re[15]});
    st16(r0 + 512, (f32x4){im[0], im[1], im[2], im[3]}, (f32x4){im[4], im[5], im[6], im[7]}); st16(r0 + 520, (f32x4){im[8], im[9], im[10], im[11]}, (f32x4){im[12], im[13], im[14], im[15]});
}
__device__ __forceinline__ void ssm_scan(int bg, const float* E, const f32x2* LAMC, bf16* UC, int lane) {
    const int b = bg >> 4, g = bg & 15;
    const f32x2 lc = LAMC[g * 64 + lane];
    f32x2 c = {0.f, 0.f};
    for (int n0 = 0; n0 < 256; n0 += 16) {
        f32x2 e[16];
#pragma unroll
        for (int i = 0; i < 16; ++i) e[i] = *(const f32x2*)(E + ((size_t)g * SSM_NCH + b * 256 + n0 + i) * 128 + 2 * lane);
#pragma unroll
        for (int i = 0; i < 16; ++i) { *(unsigned*)(UC + ((size_t)g * SSM_NCH + b * 256 + n0 + i) * SSM_K + 512 + 2 * lane) = cvtpk(c.x, c.y); c = cmul(lc, c) + e[i]; }
    }
}
struct Row { f32x4 v[4]; };
__device__ __forceinline__ Row row_ld_f32(const float* p, int lane) { Row r;
#pragma unroll
    for (int j = 0; j < 4; ++j) r.v[j] = *(const f32x4*)(p + 4 * lane + 256 * j);
    return r; }
__device__ __forceinline__ Row row_ld_bf16(const bf16* p, int lane) { Row r;
#pragma unroll
    for (int j = 0; j < 4; ++j) r.v[j] = ld4bf(p + 4 * lane + 256 * j);
    return r; }
__device__ __forceinline__ float row_ssq(const Row& r) { float s = 0.f;
#pragma unroll
    for (int j = 0; j < 4; ++j) s += (r.v[j][0] * r.v[j][0] + r.v[j][1] * r.v[j][1]) + (r.v[j][2] * r.v[j][2] + r.v[j][3] * r.v[j][3]);
    return wave_sum(s); }
__device__ __forceinline__ Row adaln(const Row& x, const float* g, const float* sc, const float* sh, bf16* xn, int lane) {
    const float rstd = __builtin_amdgcn_rsqf(row_ssq(x) * (1.f / DM) + EPS); Row o;
#pragma unroll
    for (int j = 0; j < 4; ++j) { const int c = 4 * lane + 256 * j; const f32x4 g4 = *(const f32x4*)(g + c), s4 = *(const f32x4*)(sc + c), h4 = *(const f32x4*)(sh + c);
        o.v[j] = x.v[j] * rstd * g4 * (s4 + 1.f) + h4; st8(xn + c, o.v[j]); }
    return o; }
__device__ __forceinline__ Row resid(const Row& xin, const Row& y, const float* g, const float* gt, float* xout, int lane) {
    const float rstd = __builtin_amdgcn_rsqf(row_ssq(y) * (1.f / DM) + EPS); Row o;
#pragma unroll
    for (int j = 0; j < 4; ++j) { const int c = 4 * lane + 256 * j; const f32x4 g4 = *(const f32x4*)(g + c), t4 = *(const f32x4*)(gt + c);
        o.v[j] = xin.v[j] + t4 * y.v[j] * rstd * g4; *(f32x4*)(xout + c) = o.v[j]; }
    return o; }
__device__ __forceinline__ void route(const Row& h, const float* router, int lane, int& e1, int& e2, float& w1, float& w2) {
    float acc[8];
#pragma unroll
    for (int e = 0; e < 8; ++e) acc[e] = 0.f;
#pragma unroll
    for (int j = 0; j < 4; ++j)
#pragma unroll
        for (int k = 0; k < 4; ++k) { const int c = 4 * lane + 256 * j + k; const f32x4 r0 = *(const f32x4*)(router + c * 8), r1 = *(const f32x4*)(router + c * 8 + 4); const float hv = h.v[j][k];
            acc[0] += hv * r0[0]; acc[1] += hv * r0[1]; acc[2] += hv * r0[2]; acc[3] += hv * r0[3]; acc[4] += hv * r1[0]; acc[5] += hv * r1[1]; acc[6] += hv * r1[2]; acc[7] += hv * r1[3]; }
#pragma unroll
    for (int e = 0; e < 8; ++e) acc[e] = wave_sum(acc[e]);
    e1 = 0; float v1 = acc[0];
#pragma unroll
    for (int e = 1; e < 8; ++e) if (acc[e] > v1) { v1 = acc[e]; e1 = e; }
    e2 = -1; float v2 = -__builtin_inff();
#pragma unroll
    for (int e = 0; e < 8; ++e) if (e != e1 && acc[e] > v2) { v2 = acc[e]; e2 = e; }
    const float ex = __builtin_amdgcn_exp2f(1.4426950408889634f * (v2 - v1)); w1 = 1.f / (1.f + ex); w2 = ex / (1.f + ex);
}
}
#ifndef MK_MASK
#define MK_MASK 0x1fff
#endif
#define PH_ON(n) (((MK_MASK) >> (n)) & 1)
#ifndef MK_SUB
#define MK_SUB 0xff
#endif
#define SUB_ON(n) (((MK_SUB) >> (n)) & 1)
namespace mk {
constexpr int RING_BYTES = 131072, MISC_OFF = RING_BYTES + 320, LDS_BYTES = 147456;
constexpr int NPHASE = 25;
__device__ __forceinline__ bool phase_active(int ph) { if (ph == 0) return true; const int l = (ph - 1) / 12, k = (ph - 1) % 12; if (k == 0) return l == 0; if (k == 8) return l == 1; return true; }

__device__ __forceinline__ const float* inp(const Args& a, int i) { asm volatile("" : "+s"(i)); return (const float*)a.in[i]; }
__global__ void __launch_bounds__(NWAVES * 64, 2) mk_fwd(Args args) {
    extern __shared__ __attribute__((aligned(16))) unsigned char lds[];
    LAS unsigned char* L = (LAS unsigned char*)lds;
    volatile LAS unsigned* MISC = (volatile LAS unsigned*)(L + MISC_OFF);
    const int tid0 = threadIdx.x;
    const int G = gridDim.x, NGW = G * NWAVES;
    for (int u = tid0; u < (LDS_BYTES - RING_BYTES) / 4; u += NWAVES * 64) ((LAS unsigned*)(L + RING_BYTES))[u] = 0u;
    __syncthreads();
    unsigned char* ws = args.ws;
    XcdBarrier bar; bar.bar = (unsigned*)(ws + W_CTL) + 1024; bar.x = 0; bar.st = nullptr;
    if (args.ph_hi - args.ph_lo > 1) bar = xcd_barrier_post((unsigned*)(ws + W_CTL) + 1024, MISC + 8);
    if (args.never) cooperative_groups::this_grid().sync();
#define INF(i) (inp(args, (i)))
#define x_in INF(0)
#define out (args.out)
#define MOD ((float*)(ws + W_MOD))
#define CS4 ((const f32x4*)(ws + W_CS))
#define XN ((bf16*)(ws + W_XN))
#define Yb ((bf16*)(ws + W_Y))
#define MIX ((bf16*)(ws + W_MIX))
#define RQ ((bf16*)(ws + W_RQ))
#define RK ((bf16*)(ws + W_RK))
#define RKT ((bf16*)(ws + W_RKT))
#define RVT ((bf16*)(ws + W_RVT))
#define RG ((bf16*)(ws + W_RG))
#define UC ((bf16*)(ws + W_UC))
#define CQ ((bf16*)(ws + W_CQ))
#define CKV ((bf16*)(ws + W_CKV))
#define KPE ((bf16*)(ws + W_KPE))
#define Qb ((bf16*)(ws + W_Q))
#define KN ((bf16*)(ws + W_KN))
#define Vb ((bf16*)(ws + W_V))
#define Ob ((bf16*)(ws + W_O))
#define GB ((bf16*)(ws + W_G))
#define STATE ((bf16*)(ws + W_STATE))
#define HB ((bf16*)(ws + W_HB))
#define XG ((bf16*)(ws + W_XG))
#define HBM ((bf16*)(ws + W_HBM))
#define KVT ((float*)(ws + W_KVT))
#define EB ((float*)(ws + W_E))
#define SSQQ ((float*)(ws + W_SSQQ))
#define SSQKV ((float*)(ws + W_SSQKV))
#define ROWW ((float*)(ws + W_ROWW))
#define WGCNT ((int*)(ws + W_WGCNT))
#define TILE ((int*)(ws + W_TILE))
#define TOPI ((int*)(ws + W_TOP))
#define TOPW ((float*)(ws + W_TOP + 128 * 1024))
#define TPOS ((int*)(ws + W_TOP + 256 * 1024))
#define WIN ((bf16*)(ws + W_WIN + (size_t)l * (7 * MiB / 2)))
#define WOUT ((bf16*)(ws + W_WOUT + (size_t)l * 2 * MiB))
#define MW ((bf16*)(ws + W_MW + (size_t)l * 10 * MiB))
#define WEND ((bf16*)(ws + W_WEND + (size_t)l * 2 * MiB))
#define WUQ ((bf16*)(ws + W_WUQ + (size_t)l * 384 * 1024))
#define WUKV ((bf16*)(ws + W_WUKV + (size_t)l * 256 * 1024))
#define GLUW ((bf16*)(ws + W_GLUW + (size_t)l * 128 * 1024))
#define LAMC ((f32x2*)(ws + W_LAMC) + l * 1024)
#define modl (MOD + l * 2 * 6144)
    for (int ph = args.ph_lo; ph < args.ph_hi; ++ph) {
        if (!phase_active(ph)) continue;
        int tid = threadIdx.x, bx = blockIdx.x; asm volatile("" : "+v"(tid), "+s"(bx));
        const int lane = tid & 63, wave = __builtin_amdgcn_readfirstlane(tid >> 6), vcu = (G % 8 == 0) ? (bx % 8) * (G / 8) + bx / 8 : bx, gw = bx * NWAVES + wave;
        const int l = ph == 0 ? 0 : (ph - 1) / 12, k = ph == 0 ? -1 : (ph - 1) % 12;
        if (ph == 0 && PH_ON(0)) {
            LAS float* scr = (LAS float*)(L + wave * 16384);
#define CONV(SRC, LD, KK, NN, DST, KSC, CSC) do { const int nb_ = (NN) / 32, ni_ = ((KK) / 64) * nb_; for (int it = gw; it < ni_; it += NGW) transpose_item(SRC, LD, KK, DST, KSC, CSC, scr, it / nb_, it % nb_, lane); } while (0)
            for (int ll = 0; ll < 2; ++ll) {
                CONV((SrcWin{INF(9) + (size_t)ll * DM * INC}), INC, DM, INC, (bf16*)(ws + W_WIN + (size_t)ll * (7 * MiB / 2)), nullptr, 1.f);
                CONV((SrcWuq{INF(23) + (size_t)ll * 256 * 768}), 768, 256, 768, (bf16*)(ws + W_WUQ + (size_t)ll * 384 * 1024), INF(22) + ll * 256, QSCALE);
                CONV((SrcPlain{INF(25) + (size_t)ll * 128 * 1024}), 1024, 128, 1024, (bf16*)(ws + W_WUKV + (size_t)ll * 256 * 1024), INF(24) + ll * 128, 1.f);
                CONV((SrcPlain{INF(19) + (size_t)ll * 65536}), 256, 256, 256, (bf16*)(ws + W_GLUW + (size_t)ll * 128 * 1024), nullptr, 1.f);
                CONV((SrcPlain{INF(27) + (size_t)ll * DM * DM}), DM, DM, DM, (bf16*)(ws + W_WOUT + (size_t)ll * 2 * MiB), nullptr, 1.f);
            }
            CONV((SrcGU{INF(28), INF(29)}), DFF, DM, 2 * DFF, (bf16*)(ws + W_FFUP), nullptr, 1.f);
            CONV((SrcPlain{INF(30)}), DM, DFF, DM, (bf16*)(ws + W_FFDN), nullptr, 1.f);
            for (int e = 0; e < NE; ++e) {
                CONV((SrcGU{INF(32) + (size_t)e * DM * DFF, INF(33) + (size_t)e * DM * DFF}), DFF, DM, 2 * DFF, (bf16*)(ws + W_MOEUP) + (size_t)e * 2 * DFF * DM, nullptr, 1.f);
                CONV((SrcPlain{INF(34) + (size_t)e * DFF * DM}), DM, DFF, DM, (bf16*)(ws + W_MOEDN) + (size_t)e * DM * DFF, nullptr, 1.f);
            }
#undef CONV
            { const int* pos = (const int*)INF(2); f32x2* cs = (f32x2*)(ws + W_CS);
              for (int it = gw; it < NTOK * 32 / 64; it += NGW) { const int idx = it * 64 + lane, row = idx >> 5, i = idx & 31;
                  const float inv = __builtin_amdgcn_exp2f(-(float)i * (13.287712379549449f / 32.0f)); const float ang = (float)pos[row] * inv;
                  const double rev = (double)ang * 0.15915494309189535; const float fr = (float)(rev - floor(rev));
                  cs[idx] = (f32x2){__builtin_amdgcn_cosf(fr), __builtin_amdgcn_sinf(fr)}; } }
            for (int ll = 0; ll < 2; ++ll) {
                const SsmPar P{INF(11) + ll * 1024, INF(12) + ll * 1024, INF(13) + ll * 16384, INF(14) + ll * 16384, INF(15) + ll * 16384, INF(16) + ll * 16384, INF(18) + ll * 16};
                bf16* mw = (bf16*)(ws + W_MW + (size_t)ll * 10 * MiB); bf16* we = (bf16*)(ws + W_WEND + (size_t)ll * 2 * MiB); f32x2* lc = (f32x2*)(ws + W_LAMC) + ll * 1024;
                for (int it = gw; it < 2032; it += NGW) {
                    if (it < 1008) ssm_unit_toep(P, mw, it / 63, it % 63, scr, lane);
                    else if (it < 1520) ssm_unit_cross(P, mw, lc, (it - 1008) >> 5, (it - 1008) & 31, lane);
                    else ssm_unit_end(P, we, (it - 1520) >> 5, (it - 1520) & 31, lane);
                }
            }
            __syncthreads();
            for (int u = bx; u < 192; u += G) {
                const int ll = u / 96, n0 = (u % 96) * 64; const float* aw = INF(3) + (size_t)ll * DM * 6144 + n0 + lane; const float* c = INF(1);
                float a0 = 0.f, a1 = 0.f;
#pragma unroll 8
                for (int kk = 0; kk < 128; ++kk) { const int kq = wave * 128 + kk; const float w = aw[(size_t)kq * 6144]; a0 += silu_fast(c[kq]) * w; a1 += silu_fast(c[DM + kq]) * w; }
                LAS float* red = (LAS float*)L;
                red[(wave * 2 + 0) * 64 + lane] = a0; red[(wave * 2 + 1) * 64 + lane] = a1;
                __syncthreads();
                if (wave < 2) { float s = INF(4)[ll * 6144 + n0 + lane];
#pragma unroll
                    for (int w8 = 0; w8 < 8; ++w8) s += red[(w8 * 2 + wave) * 64 + lane];
                    MOD[(ll * 2 + wave) * 6144 + n0 + lane] = s; }
                __syncthreads();
            }
        } else if (k == 0 && PH_ON(1)) {
            for (int i = 0; i < 8; ++i) { const int row = bx * 64 + wave * 8 + i, b = row / SEQ; const float* md = modl + b * 6144;
                const Row xr = row_ld_f32(x_in + (size_t)row * DM, lane); (void)adaln(xr, INF(5) + l * DM, md + 1 * DM, md + 0 * DM, XN + (size_t)row * DM, lane); }
        } else if (k == 1 && PH_ON(2)) {
            pg8::Gemm g{DM, DM, DM}; pg8::TileOrder S; S.init(XN, DM, WIN, DM, 64, 7, G, bx);
            EpiWin E{RQ, RK, RKT, RVT, RG, UC, CQ, CKV, KPE, SSQQ, SSQKV, CS4};
            pg8::gemm_phase<EpiWin, pg8::TileOrder, true>(L, g, S, E);
        } else if (k == 2 && PH_ON(3)) {
            if (SUB_ON(0)) { pg8::Gemm g{256, 256, 256}; pg8::TileOrder S; S.init(CQ, 256, WUQ, 256, 64, 3, G, bx); EpiQup E{Qb, SSQQ, CS4}; pg8::gemm_phase<EpiQup, pg8::TileOrder, true>(L, g, S, E); }
            if (SUB_ON(1)) { pg8::Gemm g{128, 128, 128}; pg8::TileOrder S; S.init(CKV, 128, WUKV, 128, 64, 4, G, (bx + 64) % G); EpiKVup E{KN, Vb, SSQKV}; pg8::gemm_phase<EpiKVup, pg8::TileOrder, true>(L, g, S, E); }
            if (SUB_ON(2)) { pg8::Gemm g{SSM_K, 512, 512}; pg8::GroupOrder S; S.init(UC, SSM_K, (size_t)SSM_NCH * SSM_K * 2, WEND, 512, (size_t)128 * 512 * 2, 16, 2, 1, G, (bx + 64) % G);
              EpiSsmE E{EB}; pg8::gemm_phase<EpiSsmE, pg8::GroupOrder, false>(L, g, S, E); }
            if (SUB_ON(3)) { const ret::Tensors T{RQ, RK, RKT, RVT, RG, KVT, STATE, MIX, INF(10) + l * 256};
              for (int u = gw; u < 1024; u += NGW) ret::x_unit(u, T, lane); }
        } else if (k == 3 && PH_ON(4)) {
            { const ret::Tensors T{RQ, RK, RKT, RVT, RG, KVT, STATE, MIX, INF(10) + l * 256}; if (tid < 128) ret::scan_elem(bx * 128 + tid, T); }
            if (wave == 7 && bx < 32) ssm_scan(bx, EB, LAMC, UC, lane);
            __syncthreads();
            { const att::Tensors T{Qb, KN, KPE, Vb, Ob}; const int bh = vcu >> 5, xx = vcu & 31;
              att::attn_unit(bh >> 2, bh & 3, 63 - xx, T, (char*)lds); att::attn_unit(bh >> 2, bh & 3, xx, T, (char*)lds); }
        } else if (k == 4 && PH_ON(5)) {
            if (SUB_ON(4)) { pg8::Gemm g{SSM_K, SSM_K, SSM_K}; pg8::GroupOrder S; S.init(UC, SSM_K, (size_t)SSM_NCH * SSM_K * 2, MW, SSM_K, (size_t)512 * SSM_K * 2, 16, 2, 2, G, bx);
              EpiSsmZ E{GB, UC, INF(17) + l * 256}; pg8::gemm_phase<EpiSsmZ, pg8::GroupOrder, false>(L, g, S, E); }
            if (SUB_ON(5) && bx >= 64) { const ret::Tensors T{RQ, RK, RKT, RVT, RG, KVT, STATE, MIX, INF(10) + l * 256}; for (int u = (bx - 64) * NWAVES + wave; u < 1024; u += (G - 64) * NWAVES) ret::z_unit(u, T, lane); }
            if (SUB_ON(6)) for (int i = 0; i < 8; ++i) { const int row = bx * 64 + wave * 8 + i; const u32x4 w = *(const u32x4*)(Ob + (size_t)row * 512 + 8 * lane);
                const f32x4 a = {bflo(w.x), bfhi(w.x), bflo(w.y), bfhi(w.y)}, c = {bflo(w.z), bfhi(w.z), bflo(w.w), bfhi(w.w)};
                float ss = (a[0] * a[0] + a[1] * a[1]) + (a[2] * a[2] + a[3] * a[3]) + (c[0] * c[0] + c[1] * c[1]) + (c[2] * c[2] + c[3] * c[3]); ss = wave_sum(ss);
                const float rstd = __builtin_amdgcn_rsqf(ss * (1.f / 512.f) + EPS); const float* gn = INF(26) + l * 512 + 8 * lane;
                st16(MIX + (size_t)row * DM + 512 + 8 * lane, a * rstd * *(const f32x4*)gn, c * rstd * *(const f32x4*)(gn + 4)); }
        } else if (k == 5 && PH_ON(6)) {
            pg8::Gemm g{256, 256, 256}; pg8::TileOrder S; S.init(GB, 256, GLUW, 256, 64, 1, G, bx); EpiGlu E{GB, INF(20) + l * 256, INF(21) + l * 256, MIX};
            pg8::gemm_phase<EpiGlu, pg8::TileOrder, false>(L, g, S, E);
        } else if (k == 6 && PH_ON(7)) {
            pg8::Gemm g{DM, DM, DM}; pg8::TileOrder S; S.init(MIX, DM, WOUT, DM, 64, 4, G, bx); EpiStore E{Yb, DM, nullptr};
            pg8::gemm_phase<EpiStore, pg8::TileOrder, false>(L, g, S, E);
        } else if (k == 7 && PH_ON(8)) {
            LAS int* cnt = (LAS int*)L;
            if (l == 1) { if (tid < 8) cnt[tid] = 0; __syncthreads(); }
            const float* xsrc = l == 0 ? x_in : out;
            for (int i = 0; i < 8; ++i) { const int row = bx * 64 + wave * 8 + i, b = row / SEQ; const float* md = modl + b * 6144;
                const Row xr = row_ld_f32(xsrc + (size_t)row * DM, lane), yr = row_ld_bf16(Yb + (size_t)row * DM, lane);
                const Row x1 = resid(xr, yr, INF(6) + l * DM, md + 2 * DM, out + (size_t)row * DM, lane);
                const Row h = adaln(x1, INF(7) + l * DM, md + 4 * DM, md + 3 * DM, XN + (size_t)row * DM, lane);
                if (l == 1) { int e1, e2; float w1, w2; route(h, INF(31), lane, e1, e2, w1, w2);
                    if (lane == 0) { TOPI[row * 2] = e1; TOPI[row * 2 + 1] = e2; TOPW[row * 2] = w1; TOPW[row * 2 + 1] = w2; __hip_atomic_fetch_add(&cnt[e1], 1, __ATOMIC_RELAXED, __HIP_MEMORY_SCOPE_WORKGROUP); __hip_atomic_fetch_add(&cnt[e2], 1, __ATOMIC_RELAXED, __HIP_MEMORY_SCOPE_WORKGROUP); } } }
            if (l == 1) { __syncthreads(); if (tid < 8) WGCNT[bx * 8 + tid] = cnt[tid]; }
        } else if (k == 8 && PH_ON(9)) {
            LAS int* sc = (LAS int*)L;
            for (int i = tid; i < 2048; i += NWAVES * 64) sc[i] = WGCNT[i];
            __syncthreads();
            if (tid < 8) { int base = 0, tot = 0; for (int w = 0; w < G; ++w) { const int c = sc[w * 8 + tid]; if (w < bx) base += c; tot += c; } sc[2048 + tid] = base; sc[2064 + tid] = tot; }
            __syncthreads();
            if (tid == 0) { int st = 0, nt = 0;
#pragma unroll 1
                for (int e = 0; e < 8; ++e) { sc[2056 + e] = st; const int t = (sc[2064 + e] + 255) >> 8; if (bx == 0) for (int q = 0; q < t; ++q) TILE[16 + nt + q] = e; nt += t; st += t << 8; } if (bx == 0) TILE[0] = nt; }
            __syncthreads();
            if (wave == 0) { const int row = bx * 64 + lane; const int e1 = TOPI[row * 2], e2 = TOPI[row * 2 + 1]; int p1 = 0, p2 = 0;
                const unsigned long long lt = (1ull << lane) - 1ull;
#pragma unroll
                for (int e = 0; e < 8; ++e) { const unsigned long long m1 = __ballot(e1 == e), m2 = __ballot(e2 == e); const int r = __popcll(m1 & lt) + __popcll(m2 & lt) + sc[2056 + e] + sc[2048 + e];
                    if (e1 == e) p1 = r; if (e2 == e) p2 = r; }
                sc[2080 + lane * 2] = p1; sc[2080 + lane * 2 + 1] = p2; TPOS[row * 2] = p1; TPOS[row * 2 + 1] = p2; ROWW[p1] = TOPW[row * 2]; ROWW[p2] = TOPW[row * 2 + 1]; }
            __syncthreads();
            for (int i = 0; i < 8; ++i) { const int lr = wave * 8 + i, row = bx * 64 + lr; const int p1 = sc[2080 + lr * 2], p2 = sc[2080 + lr * 2 + 1];
                const u32x4 a = *(const u32x4*)(XN + (size_t)row * DM + 8 * lane), c = *(const u32x4*)(XN + (size_t)row * DM + 512 + 8 * lane);
                *(u32x4*)(XG + (size_t)p1 * DM + 8 * lane) = a; *(u32x4*)(XG + (size_t)p1 * DM + 512 + 8 * lane) = c;
                *(u32x4*)(XG + (size_t)p2 * DM + 8 * lane) = a; *(u32x4*)(XG + (size_t)p2 * DM + 512 + 8 * lane) = c; }
            if (bx < 8) { const int tot = sc[2064 + bx], st = sc[2056 + bx], pe = st + (((tot + 255) >> 8) << 8);
                for (int r = st + tot + wave; r < pe; r += NWAVES) { const u32x4 z = {0u, 0u, 0u, 0u}; *(u32x4*)(XG + (size_t)r * DM + 8 * lane) = z; *(u32x4*)(XG + (size_t)r * DM + 512 + 8 * lane) = z; if (lane == 0) ROWW[r] = 0.f; } }
        } else if (k == 9 && PH_ON(10)) {
            pg8::Gemm g{DM, DM, DM}; pg8::TileOrder S;
            if (l == 0) S.init(XN, DM, (bf16*)(ws + W_FFUP), DM, 64, 28, G, bx);
            else { S.init(XG, DM, (bf16*)(ws + W_MOEUP), DM, TILE[0], 28, G, bx); S.texp = TILE + 16; S.b_e = (size_t)2 * DFF * DM * 2; }
            EpiSwiglu E{l == 0 ? HB : HBM};
            pg8::gemm_phase<EpiSwiglu, pg8::TileOrder, true>(L, g, S, E);
        } else if (k == 10 && PH_ON(11)) {
            pg8::Gemm g{DFF, DFF, DFF}; pg8::TileOrder S; EpiStore E{Yb, DM, nullptr};
            if (l == 0) S.init(HB, DFF, (bf16*)(ws + W_FFDN), DFF, 64, 4, G, bx);
            else { S.init(HBM, DFF, (bf16*)(ws + W_MOEDN), DFF, TILE[0], 4, G, bx); S.texp = TILE + 16; S.b_e = (size_t)DM * DFF * 2; E.O = XG; E.rowscale = ROWW; }
            pg8::gemm_phase<EpiStore, pg8::TileOrder, true>(L, g, S, E);
        } else if (k == 11 && PH_ON(12)) {
            for (int i = 0; i < 8; ++i) { const int row = bx * 64 + wave * 8 + i, b = row / SEQ; const float* md = modl + b * 6144;
                const Row xr = row_ld_f32(out + (size_t)row * DM, lane); Row yr;
                if (l == 0) yr = row_ld_bf16(Yb + (size_t)row * DM, lane);
                else { const int p1 = TPOS[row * 2], p2 = TPOS[row * 2 + 1]; const Row ya = row_ld_bf16(XG + (size_t)p1 * DM, lane), yb = row_ld_bf16(XG + (size_t)p2 * DM, lane);
#pragma unroll
                    for (int j = 0; j < 4; ++j) yr.v[j] = ya.v[j] + yb.v[j]; }
                const Row x2 = resid(xr, yr, INF(8) + l * DM, md + 5 * DM, out + (size_t)row * DM, lane);
                if (l == 0) { const float* md1 = MOD + 2 * 6144 + b * 6144; (void)adaln(x2, INF(5) + DM, md1 + 1 * DM, md1 + 0 * DM, XN + (size_t)row * DM, lane); } }
        }
        bool more = false; for (int q = ph + 1; q < args.ph_hi; ++q) more |= phase_active(q);
        if (more) xcd_barrier(bar);
    }
#undef INF
#undef MOD
#undef Qb
#undef Vb
#undef Ob
#undef Yb
#undef out
#undef modl
}
}
#ifndef MK_PER_PHASE
#define MK_PER_PHASE 0
#endif
static int mk_setup() {
    static int grid = 0;
    if (grid == 0) {
        int dev = 0, cus = 0, per_cu = 0;
        if (hipGetDevice(&dev) != hipSuccess || hipDeviceGetAttribute(&cus, hipDeviceAttributeMultiprocessorCount, dev) != hipSuccess) { fprintf(stderr, "kernel_launch: device query failed\n"); grid = -1; return grid; }
        if (hipFuncSetAttribute((const void*)mk::mk_fwd, hipFuncAttributeMaxDynamicSharedMemorySize, mk::LDS_BYTES) != hipSuccess) { fprintf(stderr, "kernel_launch: hipFuncSetAttribute failed\n"); grid = -1; return grid; }
        if (hipOccupancyMaxActiveBlocksPerMultiprocessor(&per_cu, (const void*)mk::mk_fwd, mk::NWAVES * 64, mk::LDS_BYTES) != hipSuccess || per_cu < 1) fprintf(stderr, "kernel_launch: occupancy query reports %d blocks per CU\n", per_cu);
        (void)hipGetLastError();
        grid = cus;
        if (grid != 256) fprintf(stderr, "kernel_launch: this kernel is written for a 256-CU device (got %d)\n", grid);
    }
    return grid;
}
static void mk_launch(void* const* d_in, void* d_out, void* d_ws, hipStream_t stream, int lo, int hi, bool coop) {
    const int grid = mk_setup(); if (grid <= 0) return;
    mk::Args a{};
    for (int i = 0; i < 35; ++i) a.in[i] = d_in[i];
    a.out = (float*)d_out; a.ws = (unsigned char*)d_ws; a.ph_lo = lo; a.ph_hi = hi; a.never = 0; a.pad = 0;
    if (coop) { void* args[] = {&a}; hipError_t e = hipLaunchCooperativeKernel((const void*)mk::mk_fwd, dim3(grid), dim3(mk::NWAVES * 64), args, mk::LDS_BYTES, stream);
        if (e != hipSuccess) fprintf(stderr, "cooperative launch failed: %s (grid %d)\n", hipGetErrorString(e), grid); }
    else hipLaunchKernelGGL(mk::mk_fwd, dim3(grid), dim3(mk::NWAVES * 64), mk::LDS_BYTES, stream, a);
}
extern "C" void kernel_launch(void* const* d_in, const int* in_sizes, int n_in, void* d_out, int out_size, void* d_ws, size_t ws_size, hipStream_t stream) {
    (void)in_sizes; (void)n_in; (void)out_size;
    if (ws_size < mk::W_END) { fprintf(stderr, "kernel_launch: workspace too small (%zu < %zu)\n", ws_size, (size_t)mk::W_END); return; }
    (void)hipMemsetAsync((char*)d_ws + mk::W_CTL, 0, mk::CTL_ZERO_BYTES, stream);
#if MK_PER_PHASE
    for (int ph = 0; ph < mk::NPHASE; ++ph) mk_launch(d_in, d_out, d_ws, stream, ph, ph + 1, false);
#else
    mk_launch(d_in, d_out, d_ws, stream, 0, mk::NPHASE, true);
#endif
}
```

```cpp
#include <hip/hip_runtime.h>
#include <stdint.h>
#include <math.h>
#include <cstdio>
#include <hip/hip_cooperative_groups.h>
#define GAS __attribute__((address_space(1)))
#define LAS __attribute__((address_space(3)))
namespace mk {
typedef unsigned short bf16;
typedef short bf16x8 __attribute__((ext_vector_type(8)));
typedef short s16x4 __attribute__((ext_vector_type(4)));
typedef float f32x2 __attribute__((ext_vector_type(2)));
typedef float f32x4 __attribute__((ext_vector_type(4)));
typedef float f32x16 __attribute__((ext_vector_type(16)));
typedef unsigned u32x2 __attribute__((ext_vector_type(2)));
typedef unsigned u32x4 __attribute__((ext_vector_type(4)));
typedef __bf16 bf16x2_t __attribute__((ext_vector_type(2)));
typedef GAS unsigned gu32;
#define RLX_AGENT __ATOMIC_RELAXED, __HIP_MEMORY_SCOPE_AGENT
__device__ __forceinline__ unsigned cvtpk(float lo, float hi) { f32x2 v = {lo, hi}; bf16x2_t b = __builtin_convertvector(v, bf16x2_t); return __builtin_bit_cast(unsigned, b); }
__device__ __forceinline__ float bf2f(unsigned short b) { return __builtin_bit_cast(float, (unsigned)b << 16); }
__device__ __forceinline__ float bflo(unsigned w) { return __builtin_bit_cast(float, w << 16); }
__device__ __forceinline__ float bfhi(unsigned w) { return __builtin_bit_cast(float, w & 0xffff0000u); }
__device__ __forceinline__ float wave_sum(float v) {
#pragma unroll
    for (int o = 1; o < 64; o <<= 1) v += __shfl_xor(v, o);
    return v;
}
__device__ __forceinline__ float fast_sigmoid(float z) { return __builtin_amdgcn_rcpf(1.f + __builtin_amdgcn_exp2f(-1.4426950408889634f * z)); }
__device__ __forceinline__ float silu_fast(float v) { return v * fast_sigmoid(v); }
__device__ __forceinline__ float gelu_tanh_fast(float x) { const float a = 0.7978845608028654f * (x + 0.044715f * x * x * x); return x * fast_sigmoid(2.f * a); }

constexpr int NB = 2, SEQ = 8192, NTOK = 16384, DM = 1024, INC = 1728, INCP = 1792, DFF = 3584, NE = 8, NWAVES = 8;
constexpr float EPS = 1e-6f;
constexpr int SSM_C = 32, SSM_NCH = NTOK / SSM_C  , SSM_K = 640;
constexpr int RET_C = 64, RET_NCH = SEQ / RET_C  ;
constexpr int MOE_MAXT = 136;
constexpr float QSCALE = 0.07216878364870322f * 1.4426950408889634f;

#define XB_TMO      128
#define XB_XCNT(j)  (256  + 64 * (j))
#define XB_XSUB(j)  (1280 + 64 * (j))
#define XB_XGEN(j)  (2304 + 64 * (j))
#define XB_TOP      3328
#define XB_TOPGEN   3392
#define XCD_BAR_WORDS 3456
#define XB_SPIN_CAP (1u << 20)
__device__ __forceinline__ unsigned xb_ld(unsigned* p)              { return __hip_atomic_load(p, __ATOMIC_RELAXED, __HIP_MEMORY_SCOPE_AGENT); }
__device__ __forceinline__ unsigned xb_add(unsigned* p, unsigned v) { return __hip_atomic_fetch_add(p, v, __ATOMIC_RELAXED, __HIP_MEMORY_SCOPE_AGENT); }
__device__ __forceinline__ unsigned xb_xcc_id() { return (unsigned)__builtin_amdgcn_s_getreg((3 << 11) | 20) & 0xFu; }
#define XB_SPIN(cond, bar) do { unsigned _sp = 0; while (cond) { __builtin_amdgcn_s_sleep(1); \
    if ((++_sp & 255u) == 0u) { if (xb_ld(&(bar)[XB_TMO])) break; if (_sp > XB_SPIN_CAP) { atomicAdd(&(bar)[XB_TMO], 1u); break; } } } } while (0)
struct XcdBarrier { unsigned* bar; unsigned x; volatile LAS unsigned* st; };
__device__ __forceinline__ XcdBarrier xcd_barrier_post(unsigned* bar, volatile LAS unsigned* st) {
    XcdBarrier b; b.bar = bar; b.x = xb_xcc_id(); b.st = st;
    if (threadIdx.x == 0) (void)xb_add(&bar[XB_XCNT(b.x)], 1u);
    return b;
}
__device__ __forceinline__ void xcd_barrier_complete(unsigned* bar, unsigned x, unsigned& nloc, unsigned& nx) {
    const unsigned G = gridDim.x * gridDim.y * gridDim.z;
    unsigned sum, cnt, mine, sp = 0u;
    for (;;) {
        sum = 0u; cnt = 0u; mine = 0u;
#pragma unroll
        for (unsigned j = 0; j < 16; ++j) { const unsigned c = xb_ld(&bar[XB_XCNT(j)]); sum += c; cnt += (c > 0u) ? 1u : 0u; mine = (j == x) ? c : mine; }
        if (sum == G) break;
        __builtin_amdgcn_s_sleep(1);
        if ((++sp & 255u) == 0u) { if (xb_ld(&bar[XB_TMO])) break; if (sp > XB_SPIN_CAP) { atomicAdd(&bar[XB_TMO], 1u); break; } }
    }
    nloc = mine > 0u ? mine : 1u; nx = cnt > 0u ? cnt : 1u;
}
__device__ __forceinline__ void xcd_barrier(const XcdBarrier& b) {
    asm volatile("s_waitcnt vmcnt(0)" ::: "memory");
    __syncthreads();
    if (threadIdx.x == 0) {
        unsigned* bar = b.bar;
        __builtin_amdgcn_s_waitcnt(0);
        unsigned nloc = b.st[0], nx = b.st[1];
        if (nloc == 0u) { xcd_barrier_complete(bar, b.x, nloc, nx); b.st[0] = nloc; b.st[1] = nx; }
        const unsigned old = xb_add(&bar[XB_XSUB(b.x)], 1u);
        const unsigned gen = old / nloc;
        if (old + 1u == (gen + 1u) * nloc) {
            __builtin_amdgcn_fence(__ATOMIC_RELEASE, "agent");
            asm volatile("s_waitcnt vmcnt(0)" ::: "memory");
            const unsigned og = xb_add(&bar[XB_TOP], 1u);
            const unsigned tg = og / nx;
            if (og + 1u == (tg + 1u) * nx) xb_add(&bar[XB_TOPGEN], 1u);
            else XB_SPIN(xb_ld(&bar[XB_TOPGEN]) == tg, bar);
            __builtin_amdgcn_fence(__ATOMIC_ACQUIRE, "agent");
            xb_add(&bar[XB_XGEN(b.x)], 1u);
            asm volatile("s_waitcnt vmcnt(0)" ::: "memory");
        } else {
            XB_SPIN(xb_ld(&bar[XB_XGEN(b.x)]) == gen, bar);
            __builtin_amdgcn_fence(__ATOMIC_ACQUIRE, "agent");
            asm volatile("s_waitcnt vmcnt(0)" ::: "memory");
        }
    }
    __syncthreads();
}
}
namespace pg8 {
#define PG8_LAS __attribute__((address_space(3)))
typedef unsigned short bf16_t;
typedef short bf16x8 __attribute__((ext_vector_type(8)));
typedef float f32x4 __attribute__((ext_vector_type(4)));
typedef unsigned u32x4 __attribute__((ext_vector_type(4)));
constexpr int BM = 256, BK = 64, HALF = 128, HTB = HALF * BK * 2, STAGE_BYTES = 8 * HTB, NXCD = 8, WGM = 8;
__host__ __device__ __forceinline__ int lds_byte(int r, int c) { const int st = (r >> 4) * 2 + (c >> 5), rr = r & 15, cc = c & 31, ob = rr * 64 + cc * 2; return st * 1024 + (ob ^ (((ob >> 9) & 1) << 5)); }
__host__ __device__ __forceinline__ void stage_rc(int b, int& R, int& C) { const int st = b / 1024, sb = b % 1024, swz = sb ^ (((sb >> 9) & 1) << 5); R = (st >> 1) * 16 + swz / 64; C = (st & 1) * 32 + (swz % 64) / 2; }
__host__ __device__ __forceinline__ int perm32(int rho) { const int n = rho >> 4, i = rho & 15; return 8 * (i >> 2) + 4 * n + (i & 3); }
struct Unit { const char* pA; const char* pB; int pm, pn; };
struct Gemm { int lda, ldb, K; };
struct TileOrder {
    const char* A; const char* Bt; size_t a_t, b_t, b_e; const int* texp; int nM, nN, nwg, G, c;
    __device__ __forceinline__ void init(const void* A_, int lda, const void* Bt_, int ldb, int nM_, int nN_, int G_, int c_) {
        A = (const char*)A_; Bt = (const char*)Bt_; a_t = (size_t)BM * lda * 2; b_t = (size_t)BM * ldb * 2; b_e = 0; texp = nullptr; nM = nM_; nN = nN_; nwg = nM * nN; G = G_; c = c_; }
    __device__ __forceinline__ bool next(int i, Unit& u) const {
        const long L = (long)i * G + c; if (L >= nwg) return false;
        int wgid = (int)L; { const int q = nwg / NXCD, r = nwg % NXCD, xcd = wgid % NXCD, off = wgid / NXCD; wgid = (xcd < r ? xcd * (q + 1) : r * (q + 1) + (xcd - r) * q) + off; }
        const int nig = WGM * nN, gid = wgid / nig, fm = gid * WGM, gsz = (nM - fm) < WGM ? (nM - fm) : WGM;
        u.pm = fm + ((wgid % nig) % gsz); u.pn = (wgid % nig) / gsz;
        u.pA = A + (size_t)u.pm * a_t; u.pB = Bt + (size_t)u.pn * b_t + (texp ? (size_t)texp[u.pm] * b_e : (size_t)0); return true;
    }
    __device__ __forceinline__ void a_ready(const Unit&) const {}
    __device__ __forceinline__ void done(const Unit&) const {}
};
struct GroupOrder {
    const char* A; const char* Bt; size_t a_t, b_t, a_g, b_g; int nM, nN, nwg, G, c;
    __device__ __forceinline__ void init(const void* A_, int lda, size_t a_g_, const void* Bt_, int ldb, size_t b_g_, int ng, int nM_, int nN_, int G_, int c_) {
        A = (const char*)A_; Bt = (const char*)Bt_; a_t = (size_t)BM * lda * 2; b_t = (size_t)BM * ldb * 2; a_g = a_g_; b_g = b_g_; nM = nM_; nN = nN_; nwg = ng * nM * nN; G = G_; c = c_; }
    __device__ __forceinline__ bool next(int i, Unit& u) const {
        const long L = (long)i * G + c; if (L >= nwg) return false;
        const int per = nM * nN, g = (int)L / per, r = (int)L % per, pm = r / nN, pn = r % nN;
        u.pm = g * nM + pm; u.pn = pn; u.pA = A + (size_t)g * a_g + (size_t)pm * a_t; u.pB = Bt + (size_t)g * b_g + (size_t)pn * b_t; return true;
    }
    __device__ __forceinline__ void a_ready(const Unit&) const {}
    __device__ __forceinline__ void done(const Unit&) const {}
};
template <class Epi, class Sched, bool ALIGN_EPI = false>
__device__ __forceinline__ void gemm_phase(PG8_LAS unsigned char* lds, const Gemm g, const Sched& S, const Epi& E) {
    int tid_ = threadIdx.x; asm volatile("" : "+v"(tid_));
    const int tid = tid_, wid = __builtin_amdgcn_readfirstlane(tid >> 6), lane = tid & 63, wr = wid >> 2, wc = wid & 3, fr = lane & 15, fq = lane >> 4;
    int K_ = g.K; asm volatile("" : "+s"(K_));
    const int K = K_, nt = K / BK, lda = g.lda, ldb = g.ldb;
    unsigned voffA[2], voffB[2];
#pragma unroll
    for (int i = 0; i < 2; ++i) { int R, C; stage_rc(tid * 16 + i * 8192, R, C); const int Rb = Epi::PERM ? ((R & ~31) + perm32(R & 31)) : R;
        voffA[i] = (unsigned)(R * lda + C) * 2u; voffB[i] = (unsigned)(Rb * ldb + C) * 2u; }
    const size_t kstep = (size_t)(BK * 2);
    const size_t hstepA = (size_t)HALF * lda * 2, hstepB = (size_t)HALF * ldb * 2;
    const unsigned ldsw = (unsigned)wid * 1024u;
    const int aoff = lds_byte(wr * 64 + fr, fq * 8), boff = lds_byte(wc * 32 + fr, fq * 8);
#define PG8_SA(b, h) (((b) * 2 + (h)) * HTB)
#define PG8_SB(b, h) ((4 + (b) * 2 + (h)) * HTB)
#define PG8_STAGE(bufoff, gbase, voff) do { _Pragma("unroll") for (int _i = 0; _i < 2; ++_i) \
        __builtin_amdgcn_global_load_lds((const unsigned*)((const char*)(gbase) + (voff)[_i]), (PG8_LAS unsigned*)(lds + (bufoff) + ldsw + _i * 8192), 16, 0, 0); } while (0)
#define PG8_LDA(dst, b, h) do { _Pragma("unroll") for (int m = 0; m < 4; ++m) _Pragma("unroll") for (int k = 0; k < 2; ++k) dst[m][k] = *(const PG8_LAS bf16x8*)(lds + PG8_SA(b, h) + aoff + m * 2048 + k * 1024); } while (0)
#define PG8_LDB(dst, b, h) do { _Pragma("unroll") for (int n = 0; n < 2; ++n) _Pragma("unroll") for (int k = 0; k < 2; ++k) dst[n][k] = *(const PG8_LAS bf16x8*)(lds + PG8_SB(b, h) + boff + n * 2048 + k * 1024); } while (0)
#define PG8_MMA(ai, bj, At, Bt) do { __builtin_amdgcn_s_setprio(1); _Pragma("unroll") for (int m = 0; m < 4; ++m) _Pragma("unroll") for (int n = 0; n < 2; ++n) _Pragma("unroll") for (int k = 0; k < 2; ++k) \
        acc[ai][bj][m][n] = __builtin_amdgcn_mfma_f32_16x16x32_bf16(Bt[n][k], At[m][k], acc[ai][bj][m][n], 0, 0, 0); __builtin_amdgcn_s_setprio(0); } while (0)
#define PG8_WAIT_V(n) asm volatile("s_waitcnt vmcnt(" #n ")" ::: "memory")
#define PG8_WAIT_L(n) asm volatile("s_waitcnt lgkmcnt(" #n ")" ::: "memory")
#define PG8_BAR __builtin_amdgcn_s_barrier()
#define PG8_SCHED __builtin_amdgcn_sched_barrier(0)
    Unit cur, nxt; int ui = 0;
    if (!S.next(0, cur)) return;
    f32x4 acc[2][2][4][2];
#pragma unroll
    for (int a = 0; a < 2; ++a)
#pragma unroll
        for (int b = 0; b < 2; ++b)
#pragma unroll
            for (int m = 0; m < 4; ++m)
#pragma unroll
                for (int n = 0; n < 2; ++n) acc[a][b][m][n] = (f32x4){0.f, 0.f, 0.f, 0.f};
    bf16x8 At[4][2], B0[2][2], B1[2][2];
    const char* cA = cur.pA; const char* cB = cur.pB;
    S.a_ready(cur);
    {
        PG8_STAGE(PG8_SB(0, 0), cB, voffB); PG8_STAGE(PG8_SB(0, 1), cB + hstepB, voffB); PG8_STAGE(PG8_SA(0, 0), cA, voffA); PG8_STAGE(PG8_SA(0, 1), cA + hstepA, voffA);
        if (wr == 1) PG8_BAR;
        PG8_WAIT_V(2); PG8_BAR;
        PG8_STAGE(PG8_SB(1, 0), cB + kstep, voffB); PG8_STAGE(PG8_SA(1, 0), cA + kstep, voffA); PG8_STAGE(PG8_SB(1, 1), cB + hstepB + kstep, voffB);
        PG8_WAIT_V(6); PG8_BAR;
    }
    for (;;) {
        const bool has_next = S.next(ui + 1, nxt);
        const char* nA = has_next ? nxt.pA : cA; const char* nB = has_next ? nxt.pB : cB;
#pragma unroll 1
        for (int t = 0; t < nt; t += 2) {
            const bool last = (t == nt - 2);
            const char* a1 = cA + (size_t)(t + 1) * kstep;
            const char* a2 = last ? nA : cA + (size_t)(t + 2) * kstep; const char* b2 = last ? nB : cB + (size_t)(t + 2) * kstep;
            const char* a3 = a2 + kstep; const char* b3 = b2 + kstep;
            if (last && has_next) S.a_ready(nxt);
            {
            PG8_LDB(B0, 0, 0); PG8_LDB(B1, 0, 1); PG8_SCHED; PG8_LDA(At, 0, 0); PG8_STAGE(PG8_SA(1, 1), a1 + hstepA, voffA);
            PG8_WAIT_V(8); PG8_WAIT_L(0); PG8_BAR; PG8_MMA(0, 0, At, B0); PG8_MMA(0, 1, At, B1); PG8_BAR; PG8_SCHED;
            PG8_LDA(At, 0, 1); PG8_STAGE(PG8_SB(0, 0), b2, voffB); PG8_STAGE(PG8_SB(0, 1), b2 + hstepB, voffB); PG8_STAGE(PG8_SA(0, 0), a2, voffA);
            PG8_WAIT_V(8); PG8_WAIT_L(0); PG8_BAR; PG8_MMA(1, 0, At, B0); PG8_MMA(1, 1, At, B1); PG8_BAR; PG8_SCHED;
            PG8_LDB(B0, 1, 0); PG8_LDB(B1, 1, 1); PG8_SCHED; PG8_LDA(At, 1, 0); PG8_STAGE(PG8_SA(0, 1), a2 + hstepA, voffA);
            PG8_WAIT_V(8); PG8_WAIT_L(0); PG8_BAR; PG8_MMA(0, 0, At, B0); PG8_MMA(0, 1, At, B1); PG8_BAR; PG8_SCHED;
            PG8_LDA(At, 1, 1); PG8_STAGE(PG8_SB(1, 0), b3, voffB); PG8_STAGE(PG8_SB(1, 1), b3 + hstepB, voffB); PG8_STAGE(PG8_SA(1, 0), a3, voffA);
            PG8_WAIT_V(8); PG8_WAIT_L(0); PG8_BAR; PG8_MMA(1, 0, At, B0); PG8_MMA(1, 1, At, B1); PG8_BAR; PG8_SCHED;
            }
        }
        if constexpr (ALIGN_EPI) { if (wr == 0) PG8_BAR; }
        if constexpr (!Epi::AFTER_DRAIN) { E(acc, cur, wr, wc, fr, fq); S.done(cur); }
        if (!has_next) break;
#pragma unroll
        for (int a = 0; a < 2; ++a)
#pragma unroll
            for (int b = 0; b < 2; ++b)
#pragma unroll
                for (int m = 0; m < 4; ++m)
#pragma unroll
                    for (int n = 0; n < 2; ++n) acc[a][b][m][n] = (f32x4){0.f, 0.f, 0.f, 0.f};
        cur = nxt; cA = nA; cB = nB; ++ui;
        if constexpr (ALIGN_EPI) { if (wr == 1) PG8_BAR; }
    }
    PG8_WAIT_V(0);
    if constexpr (!ALIGN_EPI) { if (wr == 0) PG8_BAR; }
    PG8_BAR;
    if constexpr (Epi::AFTER_DRAIN) { E.fused(acc, cur, wr, wc, fr, fq, lds, wid, lane); S.done(cur); }
#undef PG8_SA
#undef PG8_SB
#undef PG8_STAGE
#undef PG8_LDA
#undef PG8_LDB
#undef PG8_MMA
#undef PG8_WAIT_V
#undef PG8_WAIT_L
#undef PG8_BAR
#undef PG8_SCHED
}
}
namespace mk {
using pg8::Unit;
typedef f32x4 Acc[2][2][4][2];
__device__ __forceinline__ void st8(bf16* p, f32x4 v) { u32x2 w; w.x = cvtpk(v[0], v[1]); w.y = cvtpk(v[2], v[3]); *(u32x2*)p = w; }
__device__ __forceinline__ void st16(bf16* p, f32x4 a, f32x4 b) { u32x4 w; w.x = cvtpk(a[0], a[1]); w.y = cvtpk(a[2], a[3]); w.z = cvtpk(b[0], b[1]); w.w = cvtpk(b[2], b[3]); *(u32x4*)p = w; }
__device__ __forceinline__ f32x4 ld4bf(const bf16* p) { const u32x2 w = *(const u32x2*)p; return (f32x4){bflo(w.x), bfhi(w.x), bflo(w.y), bfhi(w.y)}; }
__device__ __forceinline__ f32x4 rope4(f32x4 v, f32x4 cs) { return (f32x4){v[0] * cs[0] - v[1] * cs[1], v[1] * cs[0] + v[0] * cs[1], v[2] * cs[2] - v[3] * cs[3], v[3] * cs[2] + v[2] * cs[3]}; }

struct EpiWin {
    static constexpr bool PERM = false, AFTER_DRAIN = false;
    bf16 *RQ, *RK, *RKT, *RVT, *RG, *UC, *CQ, *CKV, *KPE; float *SSQQ, *SSQKV; const f32x4* CS;
    __device__ __forceinline__ void operator()(const Acc& acc, const Unit& u, int wr, int wc, int fr, int fq) const { { int t_ = threadIdx.x; asm volatile("" : "+v"(t_)); fr = t_ & 15; fq = (t_ >> 4) & 3; }
        const int pn = u.pn, row0 = u.pm * 256 + wr * 64 + fr;
        if (pn <= 1) {
#pragma unroll
            for (int ai = 0; ai < 2; ++ai)
#pragma unroll
                for (int m = 0; m < 4; ++m) { const int row = row0 + ai * 128 + m * 16; const float pl = (float)(row & (RET_C - 1));
#pragma unroll
                    for (int bj = 0; bj < 2; ++bj) { const int head = 2 * bj + (wc >> 1);
                        const float lg2 = __builtin_amdgcn_logf(1.f - __builtin_amdgcn_exp2f(-5.f - (float)head));
                        const float dec = pn == 0 ? __builtin_amdgcn_exp2f(pl * lg2) : 0.125f * __builtin_amdgcn_exp2f(-pl * lg2);
#pragma unroll
                        for (int n = 0; n < 2; ++n) { const int i0 = 16 * (wc & 1) + 8 * n + 2 * fq; const f32x4 cs = CS[(row * 32 + i0) >> 1];
                            const f32x4 o = rope4(acc[ai][bj][m][n], cs) * dec; const int col = bj * 128 + wc * 32 + n * 16 + fq * 4;
                            st8((pn == 0 ? RQ : RK) + (size_t)row * 256 + col, o);
                            if (pn == 1) {
#pragma unroll
                                for (int j = 0; j < 4; ++j) RKT[(size_t)(col + j) * NTOK + row] = (bf16)(cvtpk(o[j], 0.f) & 0xffffu); } } } }
        } else if (pn == 2) {
#pragma unroll
            for (int ai = 0; ai < 2; ++ai)
#pragma unroll
                for (int m = 0; m < 4; ++m) { const int row = row0 + ai * 128 + m * 16;
#pragma unroll
                    for (int bj = 0; bj < 2; ++bj)
#pragma unroll
                        for (int n = 0; n < 2; ++n) { const int col = bj * 128 + wc * 32 + n * 16 + fq * 4; const f32x4 v = acc[ai][bj][m][n];
#pragma unroll
                            for (int j = 0; j < 4; ++j) RVT[(size_t)(col + j) * NTOK + row] = (bf16)(cvtpk(v[j], 0.f) & 0xffffu); } }
        } else if (pn == 3) {
#pragma unroll
            for (int ai = 0; ai < 2; ++ai)
#pragma unroll
                for (int m = 0; m < 4; ++m) { const int row = row0 + ai * 128 + m * 16;
#pragma unroll
                    for (int bj = 0; bj < 2; ++bj)
#pragma unroll
                        for (int n = 0; n < 2; ++n) { const int col = bj * 128 + wc * 32 + n * 16 + fq * 4; const f32x4 v = acc[ai][bj][m][n];
                            st8(RG + (size_t)row * 256 + col, (f32x4){silu_fast(v[0]), silu_fast(v[1]), silu_fast(v[2]), silu_fast(v[3])}); } }
        } else if (pn == 4) {
#pragma unroll
            for (int ai = 0; ai < 2; ++ai)
#pragma unroll
                for (int m = 0; m < 4; ++m) { const int row = row0 + ai * 128 + m * 16, chunk = row / SSM_C, t = row % SSM_C;
#pragma unroll
                    for (int bj = 0; bj < 2; ++bj)
#pragma unroll
                        for (int n = 0; n < 2; ++n) { const int g = 8 * bj + 2 * wc + n;
                            st8(UC + ((size_t)g * SSM_NCH + chunk) * SSM_K + t * 16 + 4 * fq, acc[ai][bj][m][n]); } }
        } else if (pn == 5) {
#pragma unroll
            for (int ai = 0; ai < 2; ++ai)
#pragma unroll
                for (int m = 0; m < 4; ++m) { const int row = row0 + ai * 128 + m * 16; float ss = 0.f;
#pragma unroll
                    for (int bj = 0; bj < 2; ++bj)
#pragma unroll
                        for (int n = 0; n < 2; ++n) { const f32x4 v = acc[ai][bj][m][n]; ss += (v[0] * v[0] + v[1] * v[1]) + (v[2] * v[2] + v[3] * v[3]);
                            st8(CQ + (size_t)row * 256 + bj * 128 + wc * 32 + n * 16 + fq * 4, v); }
                    ss += __shfl_xor(ss, 16); ss += __shfl_xor(ss, 32);
                    if (fq == 0) SSQQ[row * 4 + wc] = ss; }
        } else {
#pragma unroll
            for (int ai = 0; ai < 2; ++ai)
#pragma unroll
                for (int m = 0; m < 4; ++m) { const int row = row0 + ai * 128 + m * 16; float ss = 0.f;
#pragma unroll
                    for (int n = 0; n < 2; ++n) { const f32x4 v = acc[ai][0][m][n]; ss += (v[0] * v[0] + v[1] * v[1]) + (v[2] * v[2] + v[3] * v[3]);
                        st8(CKV + (size_t)row * 128 + wc * 32 + n * 16 + fq * 4, v); }
                    ss += __shfl_xor(ss, 16); ss += __shfl_xor(ss, 32);
                    if (fq == 0) SSQKV[row * 4 + wc] = ss;
                    if (wc < 2) {
#pragma unroll
                        for (int n = 0; n < 2; ++n) { const int i0 = 16 * wc + 8 * n + 2 * fq; const f32x4 cs = CS[(row * 32 + i0) >> 1];
                            st8(KPE + (size_t)row * 64 + wc * 32 + n * 16 + fq * 4, rope4(acc[ai][1][m][n], cs)); } } }
        }
    }
};
struct EpiQup {
    static constexpr bool PERM = false, AFTER_DRAIN = false;
    bf16* Q; const float* SSQ; const f32x4* CS;
    __device__ __forceinline__ void operator()(const Acc& acc, const Unit& u, int wr, int wc, int fr, int fq) const { { int t_ = threadIdx.x; asm volatile("" : "+v"(t_)); fr = t_ & 15; fq = (t_ >> 4) & 3; }
        const int row0 = u.pm * 256 + wr * 64 + fr;
#pragma unroll
        for (int ai = 0; ai < 2; ++ai)
#pragma unroll
            for (int m = 0; m < 4; ++m) { const int row = row0 + ai * 128 + m * 16; const f32x4 s4 = *(const f32x4*)(SSQ + row * 4);
                const float rstd = __builtin_amdgcn_rsqf(((s4[0] + s4[1]) + (s4[2] + s4[3])) * (1.f / 256.f) + EPS);
#pragma unroll
                for (int bj = 0; bj < 2; ++bj) { const bool rope = ((4 * u.pn + 2 * bj + (wc >> 1)) % 3) == 2;
#pragma unroll
                    for (int n = 0; n < 2; ++n) { f32x4 v = acc[ai][bj][m][n] * rstd;
                        if (rope) { const int i0 = 16 * (wc & 1) + 8 * n + 2 * fq; v = rope4(v, CS[(row * 32 + i0) >> 1]); }
                        st8(Q + (size_t)row * 768 + u.pn * 256 + bj * 128 + wc * 32 + n * 16 + fq * 4, v); } }
                asm volatile("" ::: "memory"); }
    }
};
struct EpiKVup {
    static constexpr bool PERM = false, AFTER_DRAIN = false;
    bf16 *KN, *V; const float* SSQ;
    __device__ __forceinline__ void operator()(const Acc& acc, const Unit& u, int wr, int wc, int fr, int fq) const { { int t_ = threadIdx.x; asm volatile("" : "+v"(t_)); fr = t_ & 15; fq = (t_ >> 4) & 3; }
        const int row0 = u.pm * 256 + wr * 64 + fr;
#pragma unroll
        for (int ai = 0; ai < 2; ++ai)
#pragma unroll
            for (int m = 0; m < 4; ++m) { const int row = row0 + ai * 128 + m * 16; const f32x4 s4 = *(const f32x4*)(SSQ + row * 4);
                const float rstd = __builtin_amdgcn_rsqf(((s4[0] + s4[1]) + (s4[2] + s4[3])) * (1.f / 128.f) + EPS);
#pragma unroll
                for (int bj = 0; bj < 2; ++bj)
#pragma unroll
                    for (int n = 0; n < 2; ++n) st8((bj == 0 ? KN : V) + (size_t)row * 512 + u.pn * 128 + wc * 32 + n * 16 + fq * 4, acc[ai][bj][m][n] * rstd);
                asm volatile("" ::: "memory"); }
    }
};
struct EpiSsmE {
    static constexpr bool PERM = false, AFTER_DRAIN = true;
    bf16* UC; const f32x2* LAMC;
    __device__ __forceinline__ void fused(Acc& acc, const Unit& u, int wr, int wc, int fr, int fq, PG8_LAS unsigned char* lds, int wid, int lane) const { { int t_ = threadIdx.x; asm volatile("" : "+v"(t_)); fr = t_ & 15; fq = (t_ >> 4) & 3; }
        PG8_LAS float* EL = (PG8_LAS float*)lds;
        const int g = u.pm >> 1, b = u.pm & 1;
#pragma unroll
        for (int ai = 0; ai < 2; ++ai)
#pragma unroll
            for (int m = 0; m < 4; ++m) { const int ch = ai * 128 + wr * 64 + m * 16 + fr;
#pragma unroll
                for (int n = 0; n < 2; ++n) *(PG8_LAS f32x4*)(EL + ch * 128 + wc * 32 + n * 16 + fq * 4) = acc[ai][0][m][n]; }
        asm volatile("s_waitcnt lgkmcnt(0)" ::: "memory"); __builtin_amdgcn_s_barrier(); asm volatile("" ::: "memory");
        if (wid == 0) {
            const f32x2 lc = LAMC[g * 64 + lane]; f32x2 c = {0.f, 0.f};
            bf16* up = UC + ((size_t)g * SSM_NCH + b * 256) * SSM_K + 512 + 2 * lane;
#pragma unroll 8
            for (int n = 0; n < 256; ++n) { const f32x2 e2 = *(const PG8_LAS f32x2*)(EL + n * 128 + 2 * lane);
                *(unsigned*)(up + (size_t)n * SSM_K) = cvtpk(c.x, c.y); c = (f32x2){lc.x * c.x - lc.y * c.y, lc.x * c.y + lc.y * c.x} + e2; }
        }
        asm volatile("s_waitcnt lgkmcnt(0)" ::: "memory"); __builtin_amdgcn_s_barrier(); asm volatile("" ::: "memory");
    }
};
struct EpiSsmZ {
    static constexpr bool PERM = false, AFTER_DRAIN = false;
    bf16* G; const bf16* UC; const float* dpar;
    __device__ __forceinline__ void operator()(const Acc& acc, const Unit& u, int wr, int wc, int fr, int fq) const { { int t_ = threadIdx.x; asm volatile("" : "+v"(t_)); fr = t_ & 15; fq = (t_ >> 4) & 3; }
        const int g = u.pm >> 1, ch0 = (u.pm & 1) * 256 + wr * 64 + fr;
        const f32x4 dd = *(const f32x4*)(dpar + g * 16 + 4 * fq);
#pragma unroll
        for (int ai = 0; ai < 2; ++ai)
#pragma unroll
            for (int m = 0; m < 4; ++m) { const int chunk = ch0 + ai * 128 + m * 16;
#pragma unroll
                for (int bj = 0; bj < 2; ++bj)
#pragma unroll
                    for (int n = 0; n < 2; ++n) { const int t = u.pn * 16 + bj * 8 + wc * 2 + n;
                        const f32x4 uv = ld4bf(UC + ((size_t)g * SSM_NCH + chunk) * SSM_K + t * 16 + 4 * fq);
                        const f32x4 y = acc[ai][bj][m][n] + dd * uv;
                        st8(G + (size_t)(chunk * SSM_C + t) * 256 + g * 16 + 4 * fq, (f32x4){gelu_tanh_fast(y[0]), gelu_tanh_fast(y[1]), gelu_tanh_fast(y[2]), gelu_tanh_fast(y[3])}); } }
    }
};
struct EpiGlu {
    static constexpr bool PERM = false, AFTER_DRAIN = true;
    const bf16* G; const float *bias, *gain; bf16* MIX;
    __device__ __forceinline__ void fused(Acc& acc, const Unit& u, int wr, int wc, int fr, int fq, PG8_LAS unsigned char* lds, int wid, int lane) const { { int t_ = threadIdx.x; asm volatile("" : "+v"(t_)); fr = t_ & 15; fq = (t_ >> 4) & 3; }
        PG8_LAS float* P = (PG8_LAS float*)lds;
        const int row0 = u.pm * 256 + wr * 64 + fr;
#pragma unroll
        for (int ai = 0; ai < 2; ++ai)
#pragma unroll
            for (int m = 0; m < 4; ++m) { const int row = row0 + ai * 128 + m * 16; float ss = 0.f;
#pragma unroll
                for (int bj = 0; bj < 2; ++bj)
#pragma unroll
                    for (int n = 0; n < 2; ++n) { const int col = bj * 128 + wc * 32 + n * 16 + fq * 4; const f32x4 b4 = *(const f32x4*)(bias + col), gl = ld4bf(G + (size_t)row * 256 + col);
                        f32x4 z = acc[ai][bj][m][n] + b4;
                        z = (f32x4){gl[0] * fast_sigmoid(z[0]), gl[1] * fast_sigmoid(z[1]), gl[2] * fast_sigmoid(z[2]), gl[3] * fast_sigmoid(z[3])};
                        acc[ai][bj][m][n] = z; ss += (z[0] * z[0] + z[1] * z[1]) + (z[2] * z[2] + z[3] * z[3]); }
                ss += __shfl_xor(ss, 16); ss += __shfl_xor(ss, 32);
                if (fq == 0) P[(ai * 128 + wr * 64 + m * 16 + fr) * 4 + wc] = ss; }
        asm volatile("s_waitcnt lgkmcnt(0)" ::: "memory"); __builtin_amdgcn_s_barrier(); asm volatile("" ::: "memory");
#pragma unroll
        for (int ai = 0; ai < 2; ++ai)
#pragma unroll
            for (int m = 0; m < 4; ++m) { const int lr = ai * 128 + wr * 64 + m * 16 + fr, row = u.pm * 256 + lr;
                const float rstd = __builtin_amdgcn_rsqf(((P[lr * 4 + 0] + P[lr * 4 + 1]) + (P[lr * 4 + 2] + P[lr * 4 + 3])) * (1.f / 256.f) + EPS);
#pragma unroll
                for (int bj = 0; bj < 2; ++bj)
#pragma unroll
                    for (int n = 0; n < 2; ++n) { const int col = bj * 128 + wc * 32 + n * 16 + fq * 4; const f32x4 g4 = *(const f32x4*)(gain + col);
                        st8(MIX + (size_t)row * DM + 256 + col, acc[ai][bj][m][n] * rstd * g4); } }
        asm volatile("s_waitcnt lgkmcnt(0)" ::: "memory"); __builtin_amdgcn_s_barrier(); asm volatile("" ::: "memory");
    }
};
struct EpiStore {
    static constexpr bool PERM = true, AFTER_DRAIN = false;
    bf16* O; int ldc; const float* rowscale;
    __device__ __forceinline__ void operator()(const Acc& acc, const Unit& u, int wr, int wc, int fr, int fq) const { { int t_ = threadIdx.x; asm volatile("" : "+v"(t_)); fr = t_ & 15; fq = (t_ >> 4) & 3; }
        const int row0 = u.pm * 256 + wr * 64 + fr, col0 = u.pn * 256 + wc * 32 + 8 * fq;
#pragma unroll
        for (int ai = 0; ai < 2; ++ai)
#pragma unroll
            for (int m = 0; m < 4; ++m) { const int row = row0 + ai * 128 + m * 16; const float s = rowscale ? rowscale[row] : 1.f;
#pragma unroll
                for (int bj = 0; bj < 2; ++bj) st16(O + (size_t)row * ldc + col0 + bj * 128, acc[ai][bj][m][0] * s, acc[ai][bj][m][1] * s); }
    }
};
struct EpiSwiglu {
    static constexpr bool PERM = true, AFTER_DRAIN = false;
    bf16* H;
    __device__ __forceinline__ void operator()(const Acc& acc, const Unit& u, int wr, int wc, int fr, int fq) const { { int t_ = threadIdx.x; asm volatile("" : "+v"(t_)); fr = t_ & 15; fq = (t_ >> 4) & 3; }
        const int row0 = u.pm * 256 + wr * 64 + fr, h0 = u.pn * 128 + wc * 16 + 4 * fq;
#pragma unroll
        for (int ai = 0; ai < 2; ++ai)
#pragma unroll
            for (int m = 0; m < 4; ++m) { const int row = row0 + ai * 128 + m * 16;
#pragma unroll
                for (int bj = 0; bj < 2; ++bj) { const f32x4 g = acc[ai][bj][m][0], up = acc[ai][bj][m][1];
                    st8(H + (size_t)row * DFF + h0 + bj * 64, (f32x4){silu_fast(g[0]) * up[0], silu_fast(g[1]) * up[1], silu_fast(g[2]) * up[2], silu_fast(g[3]) * up[3]}); } }
    }
};
}
namespace att {
using namespace mk;
constexpr int KVBLK = 64, SHM_V = 64 * 128 * 2, SHM_KN = 64 * 128 * 2, SHM_KP = 64 * 64 * 2, BUF = SHM_V + SHM_KN + SHM_KP;
constexpr int OFF_V = 0, OFF_KN = SHM_V, OFF_KP = SHM_V + SHM_KN, OFF_WS = 2 * BUF, LDS_BYTES = 2 * BUF + NWAVES * 64 * 4;
constexpr float THR = 8.f;
#define KSWZ(row, colB) ((row) * 256 + ((colB) ^ (((row) & 7) << 4)))
#define KPSWZ(row, colB) ((row) * 128 + ((colB) ^ (((row) & 7) << 4)))
#define SBAR() __builtin_amdgcn_sched_barrier(0)
__device__ __forceinline__ int v_st(int k, int c) { const int kk = (k & ~0xC) | ((k & 4) << 1) | ((k & 8) >> 1); return ((kk >> 3) * 4 + (c >> 5)) * 512 + ((kk & 7) * 32 + (c & 31)) * 2; }
__device__ __forceinline__ int v_rd_base(int lane) { return ((lane & 3) << 3) | (((lane >> 2) & 3) << 6) | (((lane >> 4) & 1) << 5) | (((lane >> 5) & 1) << 8); }
constexpr int v_rd_off(int d0, int ks, int half) { return d0 * 512 + ks * 4096 + half * 2048; }
__device__ __forceinline__ int crow(int r, int hi) { return (r & 3) + 8 * (r >> 2) + 4 * hi; }

struct Tensors { const bf16* Q; const bf16* KN; const bf16* KP; const bf16* V; bf16* O; };

template <int B_>
__device__ __forceinline__ void qkt(f32x16& p, const char* lds, int r32, int hi, int kh, const bf16x8* qr) {
    p = f32x16{};
    const char* kb[4];
#pragma unroll
    for (int dd = 0; dd < 4; ++dd) kb[dd] = lds + B_ * BUF + OFF_KN + kh * 8192 + KSWZ(r32, (dd * 16 + hi * 8) * 2);
#pragma unroll
    for (int d0 = 0; d0 < 8; ++d0) { const bf16x8 a = *reinterpret_cast<const bf16x8*>(kb[d0 & 3] + (d0 >> 2) * 128); p = __builtin_amdgcn_mfma_f32_32x32x16_bf16(a, qr[d0], p, 0, 0, 0); }
#pragma unroll
    for (int dd = 0; dd < 4; ++dd) { const bf16x8 a = *reinterpret_cast<const bf16x8*>(lds + B_ * BUF + OFF_KP + kh * 4096 + KPSWZ(r32, (dd * 16 + hi * 8) * 2)); p = __builtin_amdgcn_mfma_f32_32x32x16_bf16(a, qr[8 + dd], p, 0, 0, 0); }
}
template <int B_>
__device__ __forceinline__ void pv_tile(f32x16* o, int vb0, bf16x8 pa0, bf16x8 pa1) {
#define TRRD(dst, off) asm volatile("ds_read_b64_tr_b16 %0, %1 offset:%2" : "=&v"(dst) : "v"(vb0), "i"(off) : "memory")
#define PV_D0(d0) do { s16x4 l0, l1, h0, h1; constexpr int b_ = B_ * BUF + OFF_V + v_rd_off(d0, 0, 0); \
        TRRD(l0, b_); TRRD(h0, b_ + 2048); TRRD(l1, b_ + 4096); TRRD(h1, b_ + 6144); \
        asm volatile("s_waitcnt lgkmcnt(0)" ::: "memory"); SBAR(); \
        o[d0] = __builtin_amdgcn_mfma_f32_32x32x16_bf16(pa0, (bf16x8){l0[0], l0[1], l0[2], l0[3], h0[0], h0[1], h0[2], h0[3]}, o[d0], 0, 0, 0); \
        o[d0] = __builtin_amdgcn_mfma_f32_32x32x16_bf16(pa1, (bf16x8){l1[0], l1[1], l1[2], l1[3], h1[0], h1[1], h1[2], h1[3]}, o[d0], 0, 0, 0); } while (0)
    PV_D0(0); PV_D0(1); PV_D0(2); PV_D0(3);
#undef PV_D0
#undef TRRD
}
__device__ __forceinline__ void softmax_tile(f32x16& p, float& m_reg, float& l_reg, float& alpha, bf16x8& pa0, bf16x8& pa1) {
    float pmax = p[0];
#pragma unroll
    for (int r = 1; r < 16; ++r) pmax = fmaxf(pmax, p[r]);
    { auto rr = __builtin_amdgcn_permlane32_swap(__float_as_uint(pmax), __float_as_uint(pmax), false, false); pmax = fmaxf(__uint_as_float(rr[0]), __uint_as_float(rr[1])); }
    float mn;
    if (__builtin_expect(__all((pmax - m_reg) <= THR), 1)) { mn = m_reg; alpha = 1.f; }
    else { mn = fmaxf(m_reg, pmax); alpha = __builtin_amdgcn_exp2f(m_reg - mn); m_reg = mn; }
    float ps = 0.f;
#pragma unroll
    for (int r = 0; r < 16; ++r) { p[r] = __builtin_amdgcn_exp2f(p[r] - mn); ps += p[r]; }
    { auto rr = __builtin_amdgcn_permlane32_swap(__float_as_uint(ps), __float_as_uint(ps), false, false); ps = __uint_as_float(rr[0]) + __uint_as_float(rr[1]); }
    l_reg = l_reg * alpha + ps;
#define PK4(B__, OUT) do { unsigned a0 = cvtpk(p[B__ + 0], p[B__ + 1]), a1 = cvtpk(p[B__ + 2], p[B__ + 3]), b0 = cvtpk(p[B__ + 4], p[B__ + 5]), b1 = cvtpk(p[B__ + 6], p[B__ + 7]); \
        auto r0 = __builtin_amdgcn_permlane32_swap(a0, b0, false, false); auto r1 = __builtin_amdgcn_permlane32_swap(a1, b1, false, false); \
        u32x4 w = {r0[0], r1[0], r0[1], r1[1]}; OUT = *reinterpret_cast<bf16x8*>(&w); } while (0)
    PK4(0, pa0); PK4(8, pa1);
#undef PK4
}
__device__ __forceinline__ void attn_unit(int b, int h, int qb, const Tensors& T, char* lds) {
    int tid_ = threadIdx.x; asm volatile("" : "+v"(tid_));
    const int tid = tid_, wid = __builtin_amdgcn_readfirstlane(tid >> 6), lane = tid & 63, r32 = lane & 31, hi = lane >> 5;
    const int rg = wid & 3, kh = wid >> 2;
    const size_t tok0 = (size_t)b * SEQ; const int q0 = qb * 128, NT = 2 * qb + 2;
    float* ws = (float*)(lds + OFF_WS) + wid * 64;
    const int sr = tid >> 4, sc = (tid & 15) * 8, kws = KSWZ(sr, sc * 2), vst0 = v_st(sr, sc), vst1 = v_st(32 + sr, sc);
    const int pr = tid >> 3, pc = (tid & 7) * 8, kpw = KPSWZ(pr, pc * 2);
    const bf16* gKN = T.KN + (tok0 + sr) * 512 + h * 128 + sc; const bf16* gV = T.V + (tok0 + sr) * 512 + h * 128 + sc; const bf16* gKP = T.KP + (tok0 + pr) * 64 + pc;
    bf16x8 st_k0, st_k1, st_v0, st_v1, st_p;
#define SLOAD(t) do { const size_t ko = (size_t)(t) * KVBLK; st_k0 = *(const bf16x8*)(gKN + ko * 512); st_k1 = *(const bf16x8*)(gKN + (ko + 32) * 512); \
        st_v0 = *(const bf16x8*)(gV + ko * 512); st_v1 = *(const bf16x8*)(gV + (ko + 32) * 512); st_p = *(const bf16x8*)(gKP + ko * 64); } while (0)
#define SWRITE(bf) do { char* bb = lds + (bf) * BUF; *(bf16x8*)(bb + OFF_KN + kws) = st_k0; *(bf16x8*)(bb + OFF_KN + kws + 32 * 256) = st_k1; \
        *(bf16x8*)(bb + OFF_V + vst0) = st_v0; *(bf16x8*)(bb + OFF_V + vst1) = st_v1; *(bf16x8*)(bb + OFF_KP + kpw) = st_p; } while (0)
    SLOAD(0);
    bf16x8 qr[12];
    { const bf16* qp = T.Q + (tok0 + q0 + rg * 32 + r32) * 768 + h * 192 + hi * 8;
#pragma unroll
      for (int d0 = 0; d0 < 12; ++d0) qr[d0] = *(const bf16x8*)(qp + d0 * 16); }
    float m_reg = -1e30f, l_reg = 0.f; f32x16 o[4] = {};
    const int vb0 = (int)(uintptr_t)lds + v_rd_base(lane) + kh * 8192;
    const int qpos = q0 + rg * 32 + r32;
    asm volatile("s_waitcnt vmcnt(0)" ::: "memory"); SWRITE(0);
    __syncthreads();
#define RESC(a) do { if (__any((a) < 1.f)) { if (hi == 0) ws[r32] = (a); asm volatile("s_waitcnt lgkmcnt(0)" ::: "memory"); \
        _Pragma("unroll") for (int d_ = 0; d_ < 4; ++d_) _Pragma("unroll") for (int r = 0; r < 16; ++r) o[d_][r] *= ws[crow(r, hi)]; } } while (0)
#define STEP(t, B__) do { if ((t) + 1 < NT) SLOAD((t) + 1); SBAR(); \
        f32x16 p; qkt<B__>(p, lds, r32, hi, kh, qr); \
        if ((t) >= NT - 2) { const int kb_ = (t) * KVBLK + kh * 32 + 4 * hi; const float NEG = -__builtin_inff(); \
            _Pragma("unroll") for (int r = 0; r < 16; ++r) { const int key = kb_ + (r & 3) + 8 * (r >> 2); if (key > qpos) p[r] = NEG; } } \
        float alpha; bf16x8 pa0, pa1; softmax_tile(p, m_reg, l_reg, alpha, pa0, pa1); RESC(alpha); SBAR(); \
        pv_tile<B__>(o, vb0, pa0, pa1); \
        if ((t) + 1 < NT) { asm volatile("s_waitcnt vmcnt(0)" ::: "memory"); SWRITE(1 - B__); } \
        __syncthreads(); } while (0)
    for (int t = 0; t < NT; t += 2) { STEP(t, 0); STEP(t + 1, 1); }
#undef STEP
#undef RESC
#undef SLOAD
#undef SWRITE
    float* XO = (float*)lds;
    float* XM = (float*)(lds + 65536);
    if (kh == 1) {
#pragma unroll
        for (int d0 = 0; d0 < 4; ++d0)
#pragma unroll
            for (int r = 0; r < 16; ++r) XO[((rg * 64) + d0 * 16 + r) * 64 + lane] = o[d0][r];
        if (hi == 0) { XM[rg * 32 + r32] = m_reg; XM[128 + rg * 32 + r32] = l_reg; }
    }
    __syncthreads();
    if (kh == 0) {
        const float m1 = XM[rg * 32 + r32], l1 = XM[128 + rg * 32 + r32];
        const float mn = fmaxf(m_reg, m1), a0 = __builtin_amdgcn_exp2f(m_reg - mn), a1 = __builtin_amdgcn_exp2f(m1 - mn);
        const float inv = __builtin_amdgcn_rcpf(l_reg * a0 + l1 * a1);
        if (hi == 0) { ws[r32] = a0 * inv; ws[32 + r32] = a1 * inv; }
        asm volatile("s_waitcnt lgkmcnt(0)" ::: "memory");
        bf16* Ow = T.O + (tok0 + q0 + rg * 32) * 512 + h * 128;
#pragma unroll
        for (int r = 0; r < 16; ++r) { const int orow = crow(r, hi); const float f0 = ws[orow], f1 = ws[32 + orow];
#pragma unroll
            for (int d0 = 0; d0 < 4; ++d0) { const float v = o[d0][r] * f0 + XO[((rg * 64) + d0 * 16 + r) * 64 + lane] * f1; const float vn = __shfl_xor(v, 1);
                if ((r32 & 1) == 0) *(unsigned*)(Ow + (size_t)orow * 512 + d0 * 32 + r32) = cvtpk(v, vn); } }
    }
    __syncthreads();
}
#undef KSWZ
#undef KPSWZ
#undef SBAR
}
namespace ret {
using namespace mk;
__device__ __forceinline__ int crow(int r, int hi) { return (r & 3) + 8 * (r >> 2) + 4 * hi; }
struct Tensors { const bf16 *RQ, *RK, *RKT, *RVT, *RG; float* KVT; bf16* STATE; bf16* MIX; const float* gain; };
__device__ __forceinline__ void x_unit(int u, const Tensors& T, int lane) {
    asm volatile("" : "+v"(lane));
    const int n = u & 127, bh = u >> 7, h = bh & 3, b = bh >> 2, r32 = lane & 31, hi = lane >> 5;
    const size_t tok0 = (size_t)b * SEQ + (size_t)n * RET_C;
    f32x16 acc[2][2] = {};
#pragma unroll
    for (int s = 0; s < 4; ++s) {
        bf16x8 a[2], bb[2];
#pragma unroll
        for (int i = 0; i < 2; ++i) { a[i] = *(const bf16x8*)(T.RVT + (size_t)(h * 64 + i * 32 + r32) * NTOK + tok0 + s * 16 + hi * 8);
                                      bb[i] = *(const bf16x8*)(T.RKT + (size_t)(h * 64 + i * 32 + r32) * NTOK + tok0 + s * 16 + hi * 8); }
#pragma unroll
        for (int i = 0; i < 2; ++i)
#pragma unroll
            for (int j = 0; j < 2; ++j) acc[i][j] = __builtin_amdgcn_mfma_f32_32x32x16_bf16(a[i], bb[j], acc[i][j], 0, 0, 0);
    }
    float* out = T.KVT + (size_t)u * 4096;
#pragma unroll
    for (int i = 0; i < 2; ++i)
#pragma unroll
        for (int j = 0; j < 2; ++j)
#pragma unroll
            for (int r = 0; r < 16; ++r) out[(i * 32 + crow(r, hi)) * 64 + j * 32 + r32] = acc[i][j][r];
}
__device__ __forceinline__ void scan_elem(int e, const Tensors& T) {
    const int bh = e >> 12, el = e & 4095, h = bh & 3;
    const float gam = 1.f - __builtin_amdgcn_exp2f(-5.f - (float)h), lg2 = __builtin_amdgcn_logf(gam);
    const float g64 = __builtin_amdgcn_exp2f(64.f * lg2), g63 = __builtin_amdgcn_exp2f(63.f * lg2);
    const float* kv = T.KVT + (size_t)bh * 128 * 4096 + el; bf16* st = T.STATE + (size_t)bh * 128 * 4096 + el;
    float S = 0.f;
    for (int n0 = 0; n0 < 128; n0 += 16) {
        float v[16];
#pragma unroll
        for (int i = 0; i < 16; ++i) v[i] = kv[(size_t)(n0 + i) * 4096];
#pragma unroll
        for (int i = 0; i < 16; ++i) { st[(size_t)(n0 + i) * 4096] = (bf16)(cvtpk(gam * S, 0.f) & 0xffffu); S = g64 * S + g63 * v[i]; }
    }
}
__device__ __forceinline__ void z_unit(int u, const Tensors& T, int lane) {
    asm volatile("" : "+v"(lane));
    const int n = u & 127, bh = u >> 7, h = bh & 3, b = bh >> 2, r32 = lane & 31, hi = lane >> 5;
    const size_t tok0 = (size_t)b * SEQ + (size_t)n * RET_C;
    bf16x8 qf[2][4];
#pragma unroll
    for (int qb = 0; qb < 2; ++qb)
#pragma unroll
        for (int s = 0; s < 4; ++s) qf[qb][s] = *(const bf16x8*)(T.RQ + (tok0 + qb * 32 + r32) * 256 + h * 64 + s * 16 + hi * 8);
    f32x16 o[2][2] = {};
    const bf16* stp = T.STATE + (size_t)u * 4096;
#pragma unroll
    for (int s = 0; s < 4; ++s) {
        bf16x8 a[2];
#pragma unroll
        for (int i = 0; i < 2; ++i) a[i] = *(const bf16x8*)(stp + (i * 32 + r32) * 64 + s * 16 + hi * 8);
#pragma unroll
        for (int i = 0; i < 2; ++i)
#pragma unroll
            for (int qb = 0; qb < 2; ++qb) o[i][qb] = __builtin_amdgcn_mfma_f32_32x32x16_bf16(a[i], qf[qb][s], o[i][qb], 0, 0, 0);
    }
#pragma unroll
    for (int kb = 0; kb < 2; ++kb) {
        bf16x8 kf[4];
#pragma unroll
        for (int s = 0; s < 4; ++s) kf[s] = *(const bf16x8*)(T.RK + (tok0 + kb * 32 + r32) * 256 + h * 64 + s * 16 + hi * 8);
#pragma unroll
        for (int qb = kb; qb < 2; ++qb) {
            f32x16 st = {};
#pragma unroll
            for (int s = 0; s < 4; ++s) st = __builtin_amdgcn_mfma_f32_32x32x16_bf16(kf[s], qf[qb][s], st, 0, 0, 0);
            if (kb == qb) {
#pragma unroll
                for (int r = 0; r < 16; ++r) if (crow(r, hi) > r32) st[r] = 0.f;
            }
#pragma unroll
            for (int s2 = 0; s2 < 2; ++s2) {
                u32x4 w; w.x = cvtpk(st[8 * s2 + 0], st[8 * s2 + 1]); w.y = cvtpk(st[8 * s2 + 2], st[8 * s2 + 3]); w.z = cvtpk(st[8 * s2 + 4], st[8 * s2 + 5]); w.w = cvtpk(st[8 * s2 + 6], st[8 * s2 + 7]);
                const bf16x8 pb = __builtin_bit_cast(bf16x8, w);
#pragma unroll
                for (int i = 0; i < 2; ++i) {
                    const bf16* vp = T.RVT + (size_t)(h * 64 + i * 32 + r32) * NTOK + tok0 + kb * 32 + s2 * 16 + 4 * hi;
                    const u32x2 lo = *(const u32x2*)vp, hh = *(const u32x2*)(vp + 8);
                    const u32x4 av = {lo.x, lo.y, hh.x, hh.y};
                    o[i][qb] = __builtin_amdgcn_mfma_f32_32x32x16_bf16(__builtin_bit_cast(bf16x8, av), pb, o[i][qb], 0, 0, 0);
                }
            }
        }
    }
#pragma unroll
    for (int qb = 0; qb < 2; ++qb) {
        float ss = 0.f;
#pragma unroll
        for (int i = 0; i < 2; ++i)
#pragma unroll
            for (int r = 0; r < 16; ++r) ss += o[i][qb][r] * o[i][qb][r];
        { auto rr = __builtin_amdgcn_permlane32_swap(__float_as_uint(ss), __float_as_uint(ss), false, false); ss = __uint_as_float(rr[0]) + __uint_as_float(rr[1]); }
        const float rstd = __builtin_amdgcn_rsqf(ss * (1.f / 64.f) + EPS);
        const size_t row = tok0 + qb * 32 + r32;
#pragma unroll
        for (int i = 0; i < 2; ++i)
#pragma unroll
            for (int r4 = 0; r4 < 4; ++r4) { const int dv = i * 32 + 8 * r4 + 4 * hi;
                const f32x4 gt = ld4bf(T.RG + row * 256 + h * 64 + dv), gn = *(const f32x4*)(T.gain + h * 64 + dv);
                const f32x4 v = {o[i][qb][4 * r4 + 0], o[i][qb][4 * r4 + 1], o[i][qb][4 * r4 + 2], o[i][qb][4 * r4 + 3]};
                st8(T.MIX + row * DM + h * 64 + dv, v * rstd * gn * gt); }
    }
}
}
namespace mk {
constexpr size_t MiB = 1u << 20;
constexpr size_t W_CTL = 0, CTL_ZERO_BYTES = 64 * 1024;
constexpr size_t W_WGCNT = 128 * 1024;
constexpr size_t W_TILE = 192 * 1024;
constexpr size_t W_MOD = 1 * MiB;
constexpr size_t W_LAMC = 1 * MiB + 256 * 1024;
constexpr size_t W_TOP = 1 * MiB + 512 * 1024;
constexpr size_t W_CS = 2 * MiB;
constexpr size_t W_ROWW = 6 * MiB;
constexpr size_t W_MODP = 7 * MiB;
constexpr size_t W_SSQQ = 6 * MiB + 256 * 1024, W_SSQKV = 6 * MiB + 512 * 1024;
constexpr size_t W_MOEUP = 8 * MiB, W_MOEDN = 120 * MiB;
constexpr size_t W_WIN = 176 * MiB, W_WOUT = 183 * MiB, W_FFUP = 187 * MiB, W_FFDN = 201 * MiB, W_MW = 208 * MiB, W_WEND = 228 * MiB;
constexpr size_t W_WUQ = 233 * MiB, W_WUKV = 234 * MiB, W_GLUW = 235 * MiB;
constexpr size_t W_Y = 236 * MiB, W_MIX = 268 * MiB, W_T = 300 * MiB;
constexpr size_t W_RQ = W_T, W_RK = W_T + 8 * MiB, W_RKT = W_T + 16 * MiB, W_RVT = W_T + 24 * MiB, W_RG = W_T + 32 * MiB, W_UC = W_T + 40 * MiB, W_CQ = W_T + 50 * MiB,
                 W_CKV = W_T + 58 * MiB, W_KPE = W_T + 62 * MiB, W_Q = W_T + 64 * MiB, W_KN = W_T + 88 * MiB, W_V = W_T + 104 * MiB, W_O = W_T + 120 * MiB, W_G = W_T + 136 * MiB,
                 W_KVT = W_T + 144 * MiB, W_STATE = W_T + 160 * MiB, W_E = W_T + 168 * MiB;
constexpr size_t W_HB = W_T;
constexpr size_t W_XN = 480 * MiB;
constexpr size_t W_XG = 176 * MiB;
constexpr size_t W_HBM = 244 * MiB;
constexpr size_t W_END = 512 * MiB;

struct Args { const void* in[35]; float* out; unsigned char* ws; int ph_lo, ph_hi, never, pad; };

template <class SrcF>
__device__ __forceinline__ void transpose_item(const SrcF src, int ld, int K, bf16* WT, const float* kscale, float cscale, LAS float* scr, int kb, int nb, int lane) {
    const int k0 = 64 * kb, n0 = 32 * nb;
    const float* sp = src(n0 + (lane & 31));
#pragma unroll 8
    for (int i = 0; i < 32; ++i) { const int kk = 2 * i + (lane >> 5); float v = sp[(size_t)(k0 + kk) * ld] * cscale; if (kscale) v *= kscale[k0 + kk]; scr[kk * 33 + (lane & 31)] = v; }
    asm volatile("s_waitcnt lgkmcnt(0)" ::: "memory");
    const int c = lane & 7;
#pragma unroll
    for (int j = 0; j < 4; ++j) { const int n = (lane >> 3) + 8 * j; const LAS float* s = scr + (8 * c) * 33 + n;
        u32x4 o; o.x = cvtpk(s[0 * 33], s[1 * 33]); o.y = cvtpk(s[2 * 33], s[3 * 33]); o.z = cvtpk(s[4 * 33], s[5 * 33]); o.w = cvtpk(s[6 * 33], s[7 * 33]);
        *(u32x4*)(WT + (size_t)(n0 + n) * K + k0 + 8 * c) = o; }
    asm volatile("s_waitcnt lgkmcnt(0)" ::: "memory");
}
struct SrcPlain { const float* W; __device__ __forceinline__ const float* operator()(int n) const { return W + n; } };
struct SrcWin { const float* W; __device__ __forceinline__ const float* operator()(int n) const {
        const bool rp = (n < 512) || (n >= 1664); const int g = n & ~63, cg = n & 63; return W + (rp ? g + (cg >> 1) + 32 * (cg & 1) : n); } };
struct SrcWuq { const float* W; __device__ __forceinline__ const float* operator()(int n) const { const int hh = n / 192, w = n % 192; const int cg = w - 128; return W + (w < 128 ? n : hh * 192 + 128 + (cg >> 1) + 32 * (cg & 1)); } };
struct SrcGU { const float* Wg; const float* Wu; __device__ __forceinline__ const float* operator()(int n) const { const int hid = (n >> 3) * 4 + (n & 3);
        const long long du = (const char*)Wu - (const char*)Wg; return (const float*)((const char*)Wg + (((n >> 2) & 1) ? du : 0ll)) + hid; } };

__device__ __forceinline__ f32x2 lam_pow(float a_re, float a_im, float dt, float e) {
    const float mag = __builtin_amdgcn_exp2f(1.4426950408889634f * a_re * dt * e);
    const double rev = (double)(a_im * dt) * (double)e * 0.15915494309189535;
    const float fr = (float)(rev - floor(rev));
    return (f32x2){mag * __builtin_amdgcn_cosf(fr), mag * __builtin_amdgcn_sinf(fr)};
}
__device__ __forceinline__ f32x2 cmul(f32x2 a, f32x2 b) { return (f32x2){a.x * b.x - a.y * b.y, a.x * b.y + a.y * b.x}; }
}
namespace mk {
struct SsmPar { const float *a_re, *a_im, *b_re, *b_im, *c_re, *c_im, *log_dt; };
__device__ __forceinline__ f32x2 ssm_fw(const SsmPar& P, int g, int p, float e, bool with_f) {
    const float dt = __builtin_amdgcn_exp2f(1.4426950408889634f * P.log_dt[g]);
    const float ar = P.a_re[g * 64 + p], ai = P.a_im[g * 64 + p];
    f32x2 w = lam_pow(ar, ai, dt, e);
    if (with_f) { const f32x2 lb = lam_pow(ar, ai, dt, 1.f); const float nr = lb.x - 1.f, ni = lb.y, den = ar * ar + ai * ai;
        const f32x2 f = {(nr * ar + ni * ai) / den, (ni * ar - nr * ai) / den}; w = cmul(w, f); }
    return w;
}
__device__ __forceinline__ void ssm_unit_toep(const SsmPar& P, bf16* MW, int g, int dd, LAS float* scr, int lane) {
    const int d = dd - 31, h = lane >> 2, hp0 = (lane & 3) * 4;
    f32x4 acc = {0.f, 0.f, 0.f, 0.f};
    if (d >= 0) {
#pragma unroll
        for (int i = 0; i < 4; ++i) { const int o = 4 * (lane + 64 * i);
            *(LAS f32x4*)(scr + o) = *(const f32x4*)(P.c_re + g * 1024 + o); *(LAS f32x4*)(scr + 1024 + o) = *(const f32x4*)(P.c_im + g * 1024 + o);
            *(LAS f32x4*)(scr + 2048 + o) = *(const f32x4*)(P.b_re + g * 1024 + o); *(LAS f32x4*)(scr + 3072 + o) = *(const f32x4*)(P.b_im + g * 1024 + o); }
        const f32x2 w = ssm_fw(P, g, lane, (float)d, true);
        asm volatile("s_waitcnt lgkmcnt(0)" ::: "memory");
#pragma unroll 8
        for (int p = 0; p < 64; ++p) {
            const f32x2 wp = {__shfl(w.x, p), __shfl(w.y, p)};
            const f32x2 cm = {scr[h * 64 + p], scr[1024 + h * 64 + p]};
            const f32x2 t = cmul(cm, wp);
            const f32x4 br = *(const LAS f32x4*)(scr + 2048 + p * 16 + hp0), bi = *(const LAS f32x4*)(scr + 3072 + p * 16 + hp0);
            acc += br * t.x - bi * t.y;
        }
        asm volatile("s_waitcnt lgkmcnt(0)" ::: "memory");
    }
    const int tlo = d >= 0 ? d : 0, thi = d >= 0 ? 32 : 32 + d;
    for (int t = tlo; t < thi; ++t) st8(MW + ((size_t)g * 512 + t * 16 + h) * SSM_K + (t - d) * 16 + hp0, acc);
}
__device__ __forceinline__ void ssm_unit_cross(const SsmPar& P, bf16* MW, f32x2* LAMC, int g, int t, int lane) {
    const f32x2 lp = ssm_fw(P, g, lane, (float)(t + 1), false);
    if (t == 31) LAMC[g * 64 + lane] = lp;
#pragma unroll 4
    for (int h = 0; h < 16; ++h) { const f32x2 cm = {P.c_re[(g * 16 + h) * 64 + lane], P.c_im[(g * 16 + h) * 64 + lane]}; const f32x2 v = cmul(cm, lp);
        *(unsigned*)(MW + ((size_t)g * 512 + t * 16 + h) * SSM_K + 512 + 2 * lane) = cvtpk(v.x, -v.y); }
}
__device__ __forceinline__ void ssm_unit_end(const SsmPar& P, bf16* WEND, int g, int j, int lane) {
    const f32x2 w = ssm_fw(P, g, lane, (float)(31 - j), true);
    float re[16], im[16];
#pragma unroll
    for (int q = 0; q < 4; ++q) { const f32x4 br = *(const f32x4*)(P.b_re + (g * 64 + lane) * 16 + 4 * q), bi = *(const f32x4*)(P.b_im + (g * 64 + lane) * 16 + 4 * q);
#pragma unroll
        for (int k = 0; k < 4; ++k) { re[4 * q + k] = w.x * br[k] - w.y * bi[k]; im[4 * q + k] = w.x * bi[k] + w.y * br[k]; } }
    bf16* r0 = WEND + ((size_t)g * 128 + 2 * lane) * 512 + j * 16;
    st16(r0, (f32x4){re[0], re[1], re[2], re[3]}, (f32x4){re[4], re[5], re[6], re[7]}); st16(r0 + 8, (f32x4){re[8], re[9], re[10], re[11]}, (f32x4){re[12], re[13], re[14], re[15]});
    st16(r0 + 512, (f32x4){im[0], im[1], im[2], im[3]}, (f32x4){im[4], im[5], im[6], im[7]}); st16(r0 + 520, (f32x4){im[8], im[9], im[10], im[11]}, (f32x4){im[12], im[13], im[14], im[15]});
}
__device__ __forceinline__ void ssm_scan(int bg, const float* E, const f32x2* LAMC, bf16* UC, int lane) {
    const int b = bg >> 4, g = bg & 15;
    const f32x2 lc = LAMC[g * 64 + lane];
    f32x2 c = {0.f, 0.f};
    for (int n0 = 0; n0 < 256; n0 += 16) {
        f32x2 e[16];
#pragma unroll
        for (int i = 0; i < 16; ++i) e[i] = *(const f32x2*)(E + ((size_t)g * SSM_NCH + b * 256 + n0 + i) * 128 + 2 * lane);
#pragma unroll
        for (int i = 0; i < 16; ++i) { *(unsigned*)(UC + ((size_t)g * SSM_NCH + b * 256 + n0 + i) * SSM_K + 512 + 2 * lane) = cvtpk(c.x, c.y); c = cmul(lc, c) + e[i]; }
    }
}
struct Row { f32x4 v[4]; };
__device__ __forceinline__ Row row_ld_f32(const float* p, int lane) { Row r;
#pragma unroll
    for (int j = 0; j < 4; ++j) r.v[j] = *(const f32x4*)(p + 4 * lane + 256 * j);
    return r; }
__device__ __forceinline__ Row row_ld_bf16(const bf16* p, int lane) { Row r;
#pragma unroll
    for (int j = 0; j < 4; ++j) r.v[j] = ld4bf(p + 4 * lane + 256 * j);
    return r; }
__device__ __forceinline__ float row_ssq(const Row& r) { float s = 0.f;
#pragma unroll
    for (int j = 0; j < 4; ++j) s += (r.v[j][0] * r.v[j][0] + r.v[j][1] * r.v[j][1]) + (r.v[j][2] * r.v[j][2] + r.v[j][3] * r.v[j][3]);
    return wave_sum(s); }
__device__ __forceinline__ Row adaln(const Row& x, const float* g, const float* sc, const float* sh, bf16* xn, int lane) {
    const float rstd = __builtin_amdgcn_rsqf(row_ssq(x) * (1.f / DM) + EPS); Row o;
#pragma unroll
    for (int j = 0; j < 4; ++j) { const int c = 4 * lane + 256 * j; const f32x4 g4 = *(const f32x4*)(g + c), s4 = *(const f32x4*)(sc + c), h4 = *(const f32x4*)(sh + c);
        o.v[j] = x.v[j] * rstd * g4 * (s4 + 1.f) + h4; st8(xn + c, o.v[j]); }
    return o; }
__device__ __forceinline__ Row resid(const Row& xin, const Row& y, const float* g, const float* gt, float* xout, int lane) {
    const float rstd = __builtin_amdgcn_rsqf(row_ssq(y) * (1.f / DM) + EPS); Row o;
#pragma unroll
    for (int j = 0; j < 4; ++j) { const int c = 4 * lane + 256 * j; const f32x4 g4 = *(const f32x4*)(g + c), t4 = *(const f32x4*)(gt + c);
        o.v[j] = xin.v[j] + t4 * y.v[j] * rstd * g4; *(f32x4*)(xout + c) = o.v[j]; }
    return o; }
__device__ __forceinline__ void route(const Row& h, const float* router, int lane, int& e1, int& e2, float& w1, float& w2) {
    float acc[8];
#pragma unroll
    for (int e = 0; e < 8; ++e) acc[e] = 0.f;
#pragma unroll
    for (int j = 0; j < 4; ++j)
#pragma unroll
        for (int k = 0; k < 4; ++k) { const int c = 4 * lane + 256 * j + k; const f32x4 r0 = *(const f32x4*)(router + c * 8), r1 = *(const f32x4*)(router + c * 8 + 4); const float hv = h.v[j][k];
            acc[0] += hv * r0[0]; acc[1] += hv * r0[1]; acc[2] += hv * r0[2]; acc[3] += hv * r0[3]; acc[4] += hv * r1[0]; acc[5] += hv * r1[1]; acc[6] += hv * r1[2]; acc[7] += hv * r1[3]; }
#pragma unroll
    for (int e = 0; e < 8; ++e) acc[e] = wave_sum(acc[e]);
    e1 = 0; float v1 = acc[0];
#pragma unroll
    for (int e = 1; e < 8; ++e) if (acc[e] > v1) { v1 = acc[e]; e1 = e; }
    e2 = -1; float v2 = -__builtin_inff();
#pragma unroll
    for (int e = 0; e < 8; ++e) if (e != e1 && acc[e] > v2) { v2 = acc[e]; e2 = e; }
    const float ex = __builtin_amdgcn_exp2f(1.4426950408889634f * (v2 - v1)); w1 = 1.f / (1.f + ex); w2 = ex / (1.f + ex);
}

__device__ __forceinline__ void glu_unit(int u, const bf16* G, const bf16* GLUW, const float* bias, const float* gain, bf16* MIX, int lane) {
    asm volatile("" : "+v"(lane));
    const int r32 = lane & 31, hi = lane >> 5; const size_t tok = (size_t)u * 32 + r32;
    f32x16 acc[8] = {};
#pragma unroll 2
    for (int s = 0; s < 16; ++s) {
        const bf16x8 bf = *(const bf16x8*)(G + tok * 256 + s * 16 + hi * 8);
#pragma unroll
        for (int j = 0; j < 8; ++j) { const bf16x8 a = *(const bf16x8*)(GLUW + (size_t)(j * 32 + r32) * 256 + s * 16 + hi * 8); acc[j] = __builtin_amdgcn_mfma_f32_32x32x16_bf16(a, bf, acc[j], 0, 0, 0); }
    }
    float ss = 0.f;
#pragma unroll
    for (int j = 0; j < 8; ++j)
#pragma unroll
        for (int r4 = 0; r4 < 4; ++r4) { const int ch = j * 32 + 8 * r4 + 4 * hi; const f32x4 b4 = *(const f32x4*)(bias + ch), gl = ld4bf(G + tok * 256 + ch);
#pragma unroll
            for (int k = 0; k < 4; ++k) { const float y = gl[k] * fast_sigmoid(acc[j][4 * r4 + k] + b4[k]); acc[j][4 * r4 + k] = y; ss += y * y; } }
    { auto rr = __builtin_amdgcn_permlane32_swap(__float_as_uint(ss), __float_as_uint(ss), false, false); ss = __uint_as_float(rr[0]) + __uint_as_float(rr[1]); }
    const float rstd = __builtin_amdgcn_rsqf(ss * (1.f / 256.f) + EPS);
#pragma unroll
    for (int j = 0; j < 8; ++j)
#pragma unroll
        for (int r4 = 0; r4 < 4; ++r4) { const int ch = j * 32 + 8 * r4 + 4 * hi; const f32x4 g4 = *(const f32x4*)(gain + ch);
            st8(MIX + tok * DM + 256 + ch, (f32x4){acc[j][4 * r4 + 0], acc[j][4 * r4 + 1], acc[j][4 * r4 + 2], acc[j][4 * r4 + 3]} * rstd * g4); }
}
}
#ifndef MK_MASK
#define MK_MASK 0x1fff
#endif
#define PH_ON(n) (((MK_MASK) >> (n)) & 1)
#ifndef MK_REP_MASK
#define MK_REP_MASK 0
#endif
#ifndef MK_REP_N
#define MK_REP_N 2
#endif
#ifndef MK_SUB
#define MK_SUB 0xff
#endif
#define SUB_ON(n) (((MK_SUB) >> (n)) & 1)
namespace mk {
constexpr int RING_BYTES = 131072, MISC_OFF = RING_BYTES + 320, LDS_BYTES = 147456;
constexpr int NPHASE = 25;
__device__ __forceinline__ bool phase_active(int ph) { if (ph == 0) return true; const int l = (ph - 1) / 12, k = (ph - 1) % 12; if (k == 0) return l == 0; if (k == 8) return l == 1; return true; }

__device__ __forceinline__ const float* inp(const Args& a, int i) { asm volatile("" : "+s"(i)); return (const float*)a.in[i]; }
__global__ void __launch_bounds__(NWAVES * 64, 2) mk_fwd(Args args) {
    extern __shared__ __attribute__((aligned(16))) unsigned char lds[];
    LAS unsigned char* L = (LAS unsigned char*)lds;
    volatile LAS unsigned* MISC = (volatile LAS unsigned*)(L + MISC_OFF);
    const int tid0 = threadIdx.x;
    const int G = gridDim.x, NGW = G * NWAVES;
    for (int u = tid0; u < (LDS_BYTES - RING_BYTES) / 4; u += NWAVES * 64) ((LAS unsigned*)(L + RING_BYTES))[u] = 0u;
    __syncthreads();
    unsigned char* ws = args.ws;
    XcdBarrier bar; bar.bar = (unsigned*)(ws + W_CTL) + 1024; bar.x = 0; bar.st = nullptr;
    if (args.ph_hi - args.ph_lo > 1) bar = xcd_barrier_post((unsigned*)(ws + W_CTL) + 1024, MISC + 8);
    if (args.never) cooperative_groups::this_grid().sync();
#define INF(i) (inp(args, (i)))
#define x_in INF(0)
#define out (args.out)
#define MOD ((float*)(ws + W_MOD))
#define CS4 ((const f32x4*)(ws + W_CS))
#define XN ((bf16*)(ws + W_XN))
#define Yb ((bf16*)(ws + W_Y))
#define MIX ((bf16*)(ws + W_MIX))
#define RQ ((bf16*)(ws + W_RQ))
#define RK ((bf16*)(ws + W_RK))
#define RKT ((bf16*)(ws + W_RKT))
#define RVT ((bf16*)(ws + W_RVT))
#define RG ((bf16*)(ws + W_RG))
#define UC ((bf16*)(ws + W_UC))
#define CQ ((bf16*)(ws + W_CQ))
#define CKV ((bf16*)(ws + W_CKV))
#define KPE ((bf16*)(ws + W_KPE))
#define Qb ((bf16*)(ws + W_Q))
#define KN ((bf16*)(ws + W_KN))
#define Vb ((bf16*)(ws + W_V))
#define Ob ((bf16*)(ws + W_O))
#define GB ((bf16*)(ws + W_G))
#define STATE ((bf16*)(ws + W_STATE))
#define HB ((bf16*)(ws + W_HB))
#define XG ((bf16*)(ws + W_XG))
#define HBM ((bf16*)(ws + W_HBM))
#define KVT ((float*)(ws + W_KVT))
#define EB ((float*)(ws + W_E))
#define SSQQ ((float*)(ws + W_SSQQ))
#define SSQKV ((float*)(ws + W_SSQKV))
#define ROWW ((float*)(ws + W_ROWW))
#define WGCNT ((int*)(ws + W_WGCNT))
#define TILE ((int*)(ws + W_TILE))
#define TOPI ((int*)(ws + W_TOP))
#define TOPW ((float*)(ws + W_TOP + 128 * 1024))
#define TPOS ((int*)(ws + W_TOP + 256 * 1024))
#define WIN ((bf16*)(ws + W_WIN + (size_t)l * (7 * MiB / 2)))
#define WOUT ((bf16*)(ws + W_WOUT + (size_t)l * 2 * MiB))
#define MW ((bf16*)(ws + W_MW + (size_t)l * 10 * MiB))
#define WEND ((bf16*)(ws + W_WEND + (size_t)l * 2 * MiB))
#define WUQ ((bf16*)(ws + W_WUQ + (size_t)l * 384 * 1024))
#define WUKV ((bf16*)(ws + W_WUKV + (size_t)l * 256 * 1024))
#define GLUW ((bf16*)(ws + W_GLUW + (size_t)l * 128 * 1024))
#define LAMC ((f32x2*)(ws + W_LAMC) + l * 1024)
#define modl (MOD + l * 2 * 6144)
    int repcnt = 0;
    for (int ph = args.ph_lo; ph < args.ph_hi; ++ph) {
        if (!phase_active(ph)) continue;
        int tid = threadIdx.x, bx = blockIdx.x; asm volatile("" : "+v"(tid), "+s"(bx));
        const int lane = tid & 63, wave = __builtin_amdgcn_readfirstlane(tid >> 6), vcu = (G % 8 == 0) ? (bx % 8) * (G / 8) + bx / 8 : bx, gw = bx * NWAVES + wave;
        const int l = ph == 0 ? 0 : (ph - 1) / 12, k = ph == 0 ? -1 : (ph - 1) % 12;
        if (ph == 0 && PH_ON(0)) {
            LAS float* scr = (LAS float*)(L + wave * 16384);
            for (int u = gw; u < 1536; u += NGW) { const int ll = u / 768, r = u % 768, n0 = (r >> 3) * 64, ks = r & 7; const float* aw = INF(3) + (size_t)ll * DM * 6144 + n0 + lane; const float* c = INF(1);
                float a0 = 0.f, a1 = 0.f;
#pragma unroll 16
                for (int kk = 0; kk < 128; ++kk) { const int kq = ks * 128 + kk; const float w = aw[(size_t)kq * 6144]; a0 += silu_fast(c[kq]) * w; a1 += silu_fast(c[DM + kq]) * w; }
                float* mp = (float*)(ws + W_MODP) + (size_t)(ks * 2 + ll) * 2 * 6144 + n0 + lane; mp[0] = a0; mp[6144] = a1; }
#define CONV(SRC, LD, KK, NN, DST, KSC, CSC) do { const int nb_ = (NN) / 32, ni_ = ((KK) / 64) * nb_; for (int it = gw; it < ni_; it += NGW) transpose_item(SRC, LD, KK, DST, KSC, CSC, scr, it / nb_, it % nb_, lane); } while (0)
            for (int ll = 0; ll < 2; ++ll) {
                CONV((SrcWin{INF(9) + (size_t)ll * DM * INC}), INC, DM, INC, (bf16*)(ws + W_WIN + (size_t)ll * (7 * MiB / 2)), nullptr, 1.f);
                CONV((SrcWuq{INF(23) + (size_t)ll * 256 * 768}), 768, 256, 768, (bf16*)(ws + W_WUQ + (size_t)ll * 384 * 1024), INF(22) + ll * 256, QSCALE);
                CONV((SrcPlain{INF(25) + (size_t)ll * 128 * 1024}), 1024, 128, 1024, (bf16*)(ws + W_WUKV + (size_t)ll * 256 * 1024), INF(24) + ll * 128, 1.f);
                CONV((SrcPlain{INF(19) + (size_t)ll * 65536}), 256, 256, 256, (bf16*)(ws + W_GLUW + (size_t)ll * 128 * 1024), nullptr, 1.f);
                CONV((SrcPlain{INF(27) + (size_t)ll * DM * DM}), DM, DM, DM, (bf16*)(ws + W_WOUT + (size_t)ll * 2 * MiB), nullptr, 1.f);
            }
            CONV((SrcGU{INF(28), INF(29)}), DFF, DM, 2 * DFF, (bf16*)(ws + W_FFUP), nullptr, 1.f);
            CONV((SrcPlain{INF(30)}), DM, DFF, DM, (bf16*)(ws + W_FFDN), nullptr, 1.f);
            for (int e = 0; e < NE; ++e) {
                CONV((SrcGU{INF(32) + (size_t)e * DM * DFF, INF(33) + (size_t)e * DM * DFF}), DFF, DM, 2 * DFF, (bf16*)(ws + W_MOEUP) + (size_t)e * 2 * DFF * DM, nullptr, 1.f);
                CONV((SrcPlain{INF(34) + (size_t)e * DFF * DM}), DM, DFF, DM, (bf16*)(ws + W_MOEDN) + (size_t)e * DM * DFF, nullptr, 1.f);
            }
#undef CONV
            { const int* pos = (const int*)INF(2); f32x2* cs = (f32x2*)(ws + W_CS);
              for (int it = gw; it < NTOK * 32 / 64; it += NGW) { const int idx = it * 64 + lane, row = idx >> 5, i = idx & 31;
                  const float inv = __builtin_amdgcn_exp2f(-(float)i * (13.287712379549449f / 32.0f)); const float ang = (float)pos[row] * inv;
                  const double rev = (double)ang * 0.15915494309189535; const float fr = (float)(rev - floor(rev));
                  cs[idx] = (f32x2){__builtin_amdgcn_cosf(fr), __builtin_amdgcn_sinf(fr)}; } }
            for (int ll = 0; ll < 2; ++ll) {
                const SsmPar P{INF(11) + ll * 1024, INF(12) + ll * 1024, INF(13) + ll * 16384, INF(14) + ll * 16384, INF(15) + ll * 16384, INF(16) + ll * 16384, INF(18) + ll * 16};
                bf16* mw = (bf16*)(ws + W_MW + (size_t)ll * 10 * MiB); bf16* we = (bf16*)(ws + W_WEND + (size_t)ll * 2 * MiB); f32x2* lc = (f32x2*)(ws + W_LAMC) + ll * 1024;
                for (int it = gw; it < 2032; it += NGW) {
                    if (it < 1008) ssm_unit_toep(P, mw, it / 63, it % 63, scr, lane);
                    else if (it < 1520) ssm_unit_cross(P, mw, lc, (it - 1008) >> 5, (it - 1008) & 31, lane);
                    else ssm_unit_end(P, we, (it - 1520) >> 5, (it - 1520) & 31, lane);
                }
            }
        } else if (k == 0 && PH_ON(1)) {
            { const float* mp = (const float*)(ws + W_MODP);
              if (tid < 96) { const int idx = bx * 96 + tid, ll = idx / 12288, n = idx % 6144; float s = INF(4)[ll * 6144 + n];
#pragma unroll
                  for (int ks = 0; ks < 8; ++ks) s += mp[(size_t)ks * 24576 + idx];
                  MOD[idx] = s; }
              LAS float* ml = (LAS float*)L; const int b = (bx * 64) / SEQ;
              for (int n = tid; n < 2048; n += NWAVES * 64) { float s = INF(4)[n];
#pragma unroll
                  for (int ks = 0; ks < 8; ++ks) s += mp[(size_t)ks * 24576 + b * 6144 + n];
                  ml[n] = s; }
              __syncthreads(); }
            for (int i = 0; i < 8; ++i) { const int row = bx * 64 + wave * 8 + i; const float* md = (const float*)lds;
                const Row xr = row_ld_f32(x_in + (size_t)row * DM, lane); (void)adaln(xr, INF(5) + l * DM, md + 1 * DM, md + 0 * DM, XN + (size_t)row * DM, lane); }
        } else if (k == 1 && PH_ON(2)) {
            pg8::Gemm g{DM, DM, DM}; pg8::TileOrder S; S.init(XN, DM, WIN, DM, 64, 7, G, bx);
            EpiWin E{RQ, RK, RKT, RVT, RG, UC, CQ, CKV, KPE, SSQQ, SSQKV, CS4};
            pg8::gemm_phase<EpiWin, pg8::TileOrder, true>(L, g, S, E);
        } else if (k == 2 && PH_ON(3)) {
            if (SUB_ON(0)) { pg8::Gemm g{256, 256, 256}; pg8::TileOrder S; S.init(CQ, 256, WUQ, 256, 64, 3, G, bx); EpiQup E{Qb, SSQQ, CS4}; pg8::gemm_phase<EpiQup, pg8::TileOrder, true>(L, g, S, E); }
            if (SUB_ON(1)) { pg8::Gemm g{128, 128, 128}; pg8::TileOrder S; S.init(CKV, 128, WUKV, 128, 64, 4, G, (bx + 64) % G); EpiKVup E{KN, Vb, SSQKV}; pg8::gemm_phase<EpiKVup, pg8::TileOrder, true>(L, g, S, E); }
            if (SUB_ON(2)) { pg8::Gemm g{SSM_K, 512, 512}; pg8::GroupOrder S; S.init(UC, SSM_K, (size_t)SSM_NCH * SSM_K * 2, WEND, 512, (size_t)128 * 512 * 2, 16, 2, 1, G, (bx + 64) % G);
              EpiSsmE E{UC, LAMC}; pg8::gemm_phase<EpiSsmE, pg8::GroupOrder, false>(L, g, S, E); }
            if (SUB_ON(3)) { const ret::Tensors T{RQ, RK, RKT, RVT, RG, KVT, STATE, MIX, INF(10) + l * 256};
              for (int u = gw; u < 1024; u += NGW) ret::x_unit(u, T, lane); }
        } else if (k == 3 && PH_ON(4)) {
            { const ret::Tensors T{RQ, RK, RKT, RVT, RG, KVT, STATE, MIX, INF(10) + l * 256}; if (tid < 128) ret::scan_elem(bx * 128 + tid, T); }
            __syncthreads();
            { const att::Tensors T{Qb, KN, KPE, Vb, Ob}; const int bh = vcu >> 5, xx = vcu & 31;
              att::attn_unit(bh >> 2, bh & 3, 63 - xx, T, (char*)lds); att::attn_unit(bh >> 2, bh & 3, xx, T, (char*)lds); }
        } else if (k == 4 && PH_ON(5)) {
            if (SUB_ON(4)) { pg8::Gemm g{SSM_K, SSM_K, SSM_K}; pg8::GroupOrder S; S.init(UC, SSM_K, (size_t)SSM_NCH * SSM_K * 2, MW, SSM_K, (size_t)512 * SSM_K * 2, 16, 2, 2, G, bx);
              EpiSsmZ E{GB, UC, INF(17) + l * 256}; pg8::gemm_phase<EpiSsmZ, pg8::GroupOrder, false>(L, g, S, E); }
            if (SUB_ON(5) && bx >= 64) { const ret::Tensors T{RQ, RK, RKT, RVT, RG, KVT, STATE, MIX, INF(10) + l * 256}; for (int u = (bx - 64) * NWAVES + wave; u < 1024; u += (G - 64) * NWAVES) ret::z_unit(u, T, lane); }
            if (SUB_ON(6)) for (int i = 0; i < 8; ++i) { const int row = bx * 64 + wave * 8 + i; const u32x4 w = *(const u32x4*)(Ob + (size_t)row * 512 + 8 * lane);
                const f32x4 a = {bflo(w.x), bfhi(w.x), bflo(w.y), bfhi(w.y)}, c = {bflo(w.z), bfhi(w.z), bflo(w.w), bfhi(w.w)};
                float ss = (a[0] * a[0] + a[1] * a[1]) + (a[2] * a[2] + a[3] * a[3]) + (c[0] * c[0] + c[1] * c[1]) + (c[2] * c[2] + c[3] * c[3]); ss = wave_sum(ss);
                const float rstd = __builtin_amdgcn_rsqf(ss * (1.f / 512.f) + EPS); const float* gn = INF(26) + l * 512 + 8 * lane;
                st16(MIX + (size_t)row * DM + 512 + 8 * lane, a * rstd * *(const f32x4*)gn, c * rstd * *(const f32x4*)(gn + 4)); }
        } else if (k == 5 && PH_ON(6)) {
            if (wave < 2) glu_unit(bx + 256 * wave, GB, GLUW, INF(20) + l * 256, INF(21) + l * 256, MIX, lane);
        } else if (k == 6 && PH_ON(7)) {
            pg8::Gemm g{DM, DM, DM}; pg8::TileOrder S; S.init(MIX, DM, WOUT, DM, 64, 4, G, bx); EpiStore E{Yb, DM, nullptr};
            pg8::gemm_phase<EpiStore, pg8::TileOrder, false>(L, g, S, E);
        } else if (k == 7 && PH_ON(8)) {
            LAS int* cnt = (LAS int*)L;
            if (l == 1) { if (tid < 8) cnt[tid] = 0; __syncthreads(); }
            const float* xsrc = l == 0 ? x_in : out;
            for (int i = 0; i < 8; ++i) { const int row = bx * 64 + wave * 8 + i, b = row / SEQ; const float* md = modl + b * 6144;
                const Row xr = row_ld_f32(xsrc + (size_t)row * DM, lane), yr = row_ld_bf16(Yb + (size_t)row * DM, lane);
                const Row x1 = resid(xr, yr, INF(6) + l * DM, md + 2 * DM, out + (size_t)row * DM, lane);
                const Row h = adaln(x1, INF(7) + l * DM, md + 4 * DM, md + 3 * DM, XN + (size_t)row * DM, lane);
                if (l == 1) { int e1, e2; float w1, w2; route(h, INF(31), lane, e1, e2, w1, w2);
                    if (lane == 0) { TOPI[row * 2] = e1; TOPI[row * 2 + 1] = e2; TOPW[row * 2] = w1; TOPW[row * 2 + 1] = w2; __hip_atomic_fetch_add(&cnt[e1], 1, __ATOMIC_RELAXED, __HIP_MEMORY_SCOPE_WORKGROUP); __hip_atomic_fetch_add(&cnt[e2], 1, __ATOMIC_RELAXED, __HIP_MEMORY_SCOPE_WORKGROUP); } } }
            if (l == 1) { __syncthreads(); if (tid < 8) WGCNT[bx * 8 + tid] = cnt[tid]; }
        } else if (k == 8 && PH_ON(9)) {
            LAS int* sc = (LAS int*)L;
            for (int i = tid; i < 2048; i += NWAVES * 64) sc[i] = WGCNT[i];
            __syncthreads();
            if (tid < 8) { int base = 0, tot = 0; for (int w = 0; w < G; ++w) { const int c = sc[w * 8 + tid]; if (w < bx) base += c; tot += c; } sc[2048 + tid] = base; sc[2064 + tid] = tot; }
            __syncthreads();
            if (tid == 0) { int st = 0, nt = 0;
#pragma unroll 1
                for (int e = 0; e < 8; ++e) { sc[2056 + e] = st; const int t = (sc[2064 + e] + 255) >> 8; if (bx == 0) for (int q = 0; q < t; ++q) TILE[16 + nt + q] = e; nt += t; st += t << 8; } if (bx == 0) TILE[0] = nt; }
            __syncthreads();
            if (wave == 0) { const int row = bx * 64 + lane; const int e1 = TOPI[row * 2], e2 = TOPI[row * 2 + 1]; int p1 = 0, p2 = 0;
                const unsigned long long lt = (1ull << lane) - 1ull;
#pragma unroll
                for (int e = 0; e < 8; ++e) { const unsigned long long m1 = __ballot(e1 == e), m2 = __ballot(e2 == e); const int r = __popcll(m1 & lt) + __popcll(m2 & lt) + sc[2056 + e] + sc[2048 + e];
                    if (e1 == e) p1 = r; if (e2 == e) p2 = r; }
                sc[2080 + lane * 2] = p1; sc[2080 + lane * 2 + 1] = p2; TPOS[row * 2] = p1; TPOS[row * 2 + 1] = p2; ROWW[p1] = TOPW[row * 2]; ROWW[p2] = TOPW[row * 2 + 1]; }
            __syncthreads();
            for (int i = 0; i < 8; ++i) { const int lr = wave * 8 + i, row = bx * 64 + lr; const int p1 = sc[2080 + lr * 2], p2 = sc[2080 + lr * 2 + 1];
                const u32x4 a = *(const u32x4*)(XN + (size_t)row * DM + 8 * lane), c = *(const u32x4*)(XN + (size_t)row * DM + 512 + 8 * lane);
                *(u32x4*)(XG + (size_t)p1 * DM + 8 * lane) = a; *(u32x4*)(XG + (size_t)p1 * DM + 512 + 8 * lane) = c;
                *(u32x4*)(XG + (size_t)p2 * DM + 8 * lane) = a; *(u32x4*)(XG + (size_t)p2 * DM + 512 + 8 * lane) = c; }
            if (bx < 8) { const int tot = sc[2064 + bx], st = sc[2056 + bx], pe = st + (((tot + 255) >> 8) << 8);
                for (int r = st + tot + wave; r < pe; r += NWAVES) { const u32x4 z = {0u, 0u, 0u, 0u}; *(u32x4*)(XG + (size_t)r * DM + 8 * lane) = z; *(u32x4*)(XG + (size_t)r * DM + 512 + 8 * lane) = z; if (lane == 0) ROWW[r] = 0.f; } }
        } else if (k == 9 && PH_ON(10)) {
            pg8::Gemm g{DM, DM, DM}; pg8::TileOrder S;
            if (l == 0) S.init(XN, DM, (bf16*)(ws + W_FFUP), DM, 64, 28, G, bx);
            else { S.init(XG, DM, (bf16*)(ws + W_MOEUP), DM, TILE[0], 28, G, bx); S.texp = TILE + 16; S.b_e = (size_t)2 * DFF * DM * 2; }
            EpiSwiglu E{l == 0 ? HB : HBM};
            pg8::gemm_phase<EpiSwiglu, pg8::TileOrder, true>(L, g, S, E);
        } else if (k == 10 && PH_ON(11)) {
            pg8::Gemm g{DFF, DFF, DFF}; pg8::TileOrder S; EpiStore E{Yb, DM, nullptr};
            if (l == 0) S.init(HB, DFF, (bf16*)(ws + W_FFDN), DFF, 64, 4, G, bx);
            else { S.init(HBM, DFF, (bf16*)(ws + W_MOEDN), DFF, TILE[0], 4, G, bx); S.texp = TILE + 16; S.b_e = (size_t)DM * DFF * 2; E.O = XG; E.rowscale = ROWW; }
            pg8::gemm_phase<EpiStore, pg8::TileOrder, true>(L, g, S, E);
        } else if (k == 11 && PH_ON(12)) {
            for (int i = 0; i < 8; ++i) { const int row = bx * 64 + wave * 8 + i, b = row / SEQ; const float* md = modl + b * 6144;
                const Row xr = row_ld_f32(out + (size_t)row * DM, lane); Row yr;
                if (l == 0) yr = row_ld_bf16(Yb + (size_t)row * DM, lane);
                else { const int p1 = TPOS[row * 2], p2 = TPOS[row * 2 + 1]; const Row ya = row_ld_bf16(XG + (size_t)p1 * DM, lane), yb = row_ld_bf16(XG + (size_t)p2 * DM, lane);
#pragma unroll
                    for (int j = 0; j < 4; ++j) yr.v[j] = ya.v[j] + yb.v[j]; }
                const Row x2 = resid(xr, yr, INF(8) + l * DM, md + 5 * DM, out + (size_t)row * DM, lane);
                if (l == 0) { const float* md1 = MOD + 2 * 6144 + b * 6144; (void)adaln(x2, INF(5) + DM, md1 + 1 * DM, md1 + 0 * DM, XN + (size_t)row * DM, lane); } }
        }
        bool more = false; for (int q = ph + 1; q < args.ph_hi; ++q) more |= phase_active(q);
        if (more) xcd_barrier(bar);
        if (MK_REP_MASK != 0) { if ((((unsigned)MK_REP_MASK >> ph) & 1u) && repcnt + 1 < MK_REP_N) { ++repcnt; --ph; } else repcnt = 0; }
    }
#undef INF
#undef MOD
#undef Qb
#undef Vb
#undef Ob
#undef Yb
#undef out
#undef modl
}
}
#ifndef MK_PER_PHASE
#define MK_PER_PHASE 0
#endif
static int mk_setup() {
    static int grid = 0;
    if (grid == 0) {
        int dev = 0, cus = 0, per_cu = 0;
        if (hipGetDevice(&dev) != hipSuccess || hipDeviceGetAttribute(&cus, hipDeviceAttributeMultiprocessorCount, dev) != hipSuccess) { fprintf(stderr, "kernel_launch: device query failed\n"); grid = -1; return grid; }
        if (hipFuncSetAttribute((const void*)mk::mk_fwd, hipFuncAttributeMaxDynamicSharedMemorySize, mk::LDS_BYTES) != hipSuccess) { fprintf(stderr, "kernel_launch: hipFuncSetAttribute failed\n"); grid = -1; return grid; }
        if (hipOccupancyMaxActiveBlocksPerMultiprocessor(&per_cu, (const void*)mk::mk_fwd, mk::NWAVES * 64, mk::LDS_BYTES) != hipSuccess || per_cu < 1) fprintf(stderr, "kernel_launch: occupancy query reports %d blocks per CU\n", per_cu);
        (void)hipGetLastError();
        grid = cus;
        if (grid != 256) fprintf(stderr, "kernel_launch: this kernel is written for a 256-CU device (got %d)\n", grid);
    }
    return grid;
}
static void mk_launch(void* const* d_in, void* d_out, void* d_ws, hipStream_t stream, int lo, int hi, bool coop) {
    const int grid = mk_setup(); if (grid <= 0) return;
    mk::Args a{};
    for (int i = 0; i < 35; ++i) a.in[i] = d_in[i];
    a.out = (float*)d_out; a.ws = (unsigned char*)d_ws; a.ph_lo = lo; a.ph_hi = hi; a.never = 0; a.pad = 0;
    if (coop) { void* args[] = {&a}; hipError_t e = hipLaunchCooperativeKernel((const void*)mk::mk_fwd, dim3(grid), dim3(mk::NWAVES * 64), args, mk::LDS_BYTES, stream);
        if (e != hipSuccess) fprintf(stderr, "cooperative launch failed: %s (grid %d)\n", hipGetErrorString(e), grid); }
    else hipLaunchKernelGGL(mk::mk_fwd, dim3(grid), dim3(mk::NWAVES * 64), mk::LDS_BYTES, stream, a);
}
extern "C" void kernel_launch(void* const* d_in, const int* in_sizes, int n_in, void* d_out, int out_size, void* d_ws, size_t ws_size, hipStream_t stream) {
    (void)in_sizes; (void)n_in; (void)out_size;
    if (ws_size < mk::W_END) { fprintf(stderr, "kernel_launch: workspace too small (%zu < %zu)\n", ws_size, (size_t)mk::W_END); return; }
    (void)hipMemsetAsync((char*)d_ws + mk::W_CTL, 0, mk::CTL_ZERO_BYTES, stream);
#if MK_PER_PHASE
    for (int ph = 0; ph < mk::NPHASE; ++ph) mk_launch(d_in, d_out, d_ws, stream, ph, ph + 1, false);
#else
    mk_launch(d_in, d_out, d_ws, stream, 0, mk::NPHASE, true);
#endif
}
```

```cpp
#include <hip/hip_runtime.h>
#include <stdint.h>
#include <math.h>
#include <cstdio>
#include <hip/hip_cooperative_groups.h>
#define GAS __attribute__((address_space(1)))
#define LAS __attribute__((address_space(3)))
namespace mk {
typedef unsigned short bf16;
typedef short bf16x8 __attribute__((ext_vector_type(8)));
typedef short s16x4 __attribute__((ext_vector_type(4)));
typedef float f32x2 __attribute__((ext_vector_type(2)));
typedef float f32x4 __attribute__((ext_vector_type(4)));
typedef float f32x16 __attribute__((ext_vector_type(16)));
typedef unsigned u32x2 __attribute__((ext_vector_type(2)));
typedef unsigned u32x4 __attribute__((ext_vector_type(4)));
typedef __bf16 bf16x2_t __attribute__((ext_vector_type(2)));
typedef GAS unsigned gu32;
#define RLX_AGENT __ATOMIC_RELAXED, __HIP_MEMORY_SCOPE_AGENT
__device__ __forceinline__ unsigned cvtpk(float lo, float hi) { f32x2 v = {lo, hi}; bf16x2_t b = __builtin_convertvector(v, bf16x2_t); return __builtin_bit_cast(unsigned, b); }
__device__ __forceinline__ float bf2f(unsigned short b) { return __builtin_bit_cast(float, (unsigned)b << 16); }
__device__ __forceinline__ float bflo(unsigned w) { return __builtin_bit_cast(float, w << 16); }
__device__ __forceinline__ float bfhi(unsigned w) { return __builtin_bit_cast(float, w & 0xffff0000u); }
__device__ __forceinline__ float wave_sum(float v) {
#pragma unroll
    for (int o = 1; o < 64; o <<= 1) v += __shfl_xor(v, o);
    return v;
}
__device__ __forceinline__ float fast_sigmoid(float z) { return __builtin_amdgcn_rcpf(1.f + __builtin_amdgcn_exp2f(-1.4426950408889634f * z)); }
__device__ __forceinline__ float silu_fast(float v) { return v * fast_sigmoid(v); }
__device__ __forceinline__ float gelu_tanh_fast(float x) { const float a = 0.7978845608028654f * (x + 0.044715f * x * x * x); return x * fast_sigmoid(2.f * a); }

constexpr int NB = 2, SEQ = 8192, NTOK = 16384, DM = 1024, INC = 1728, INCP = 1792, DFF = 3584, NE = 8, NWAVES = 8;
constexpr float EPS = 1e-6f;
constexpr int SSM_C = 32, SSM_NCH = NTOK / SSM_C  , SSM_K = 640;
constexpr int RET_C = 64, RET_NCH = SEQ / RET_C  ;
constexpr int MOE_MAXT = 136;
constexpr float QSCALE = 0.07216878364870322f * 1.4426950408889634f;

#define XB_TMO      128
#define XB_XCNT(j)  (256  + 64 * (j))
#define XB_XSUB(j)  (1280 + 64 * (j))
#define XB_XGEN(j)  (2304 + 64 * (j))
#define XB_TOP      3328
#define XB_TOPGEN   3392
#define XCD_BAR_WORDS 3456
#define XB_SPIN_CAP (1u << 20)
__device__ __forceinline__ unsigned xb_ld(unsigned* p)              { return __hip_atomic_load(p, __ATOMIC_RELAXED, __HIP_MEMORY_SCOPE_AGENT); }
__device__ __forceinline__ unsigned xb_add(unsigned* p, unsigned v) { return __hip_atomic_fetch_add(p, v, __ATOMIC_RELAXED, __HIP_MEMORY_SCOPE_AGENT); }
__device__ __forceinline__ unsigned xb_xcc_id() { return (unsigned)__builtin_amdgcn_s_getreg((3 << 11) | 20) & 0xFu; }
#define XB_SPIN(cond, bar) do { unsigned _sp = 0; while (cond) { __builtin_amdgcn_s_sleep(1); \
    if ((++_sp & 255u) == 0u) { if (xb_ld(&(bar)[XB_TMO])) break; if (_sp > XB_SPIN_CAP) { atomicAdd(&(bar)[XB_TMO], 1u); break; } } } } while (0)
struct XcdBarrier { unsigned* bar; unsigned x; volatile LAS unsigned* st; };
__device__ __forceinline__ XcdBarrier xcd_barrier_post(unsigned* bar, volatile LAS unsigned* st) {
    XcdBarrier b; b.bar = bar; b.x = xb_xcc_id(); b.st = st;
    if (threadIdx.x == 0) (void)xb_add(&bar[XB_XCNT(b.x)], 1u);
    return b;
}
__device__ __forceinline__ void xcd_barrier_complete(unsigned* bar, unsigned x, unsigned& nloc, unsigned& nx) {
    const unsigned G = gridDim.x * gridDim.y * gridDim.z;
    unsigned sum, cnt, mine, sp = 0u;
    for (;;) {
        sum = 0u; cnt = 0u; mine = 0u;
#pragma unroll
        for (unsigned j = 0; j < 16; ++j) { const unsigned c = xb_ld(&bar[XB_XCNT(j)]); sum += c; cnt += (c > 0u) ? 1u : 0u; mine = (j == x) ? c : mine; }
        if (sum == G) break;
        __builtin_amdgcn_s_sleep(1);
        if ((++sp & 255u) == 0u) { if (xb_ld(&bar[XB_TMO])) break; if (sp > XB_SPIN_CAP) { atomicAdd(&bar[XB_TMO], 1u); break; } }
    }
    nloc = mine > 0u ? mine : 1u; nx = cnt > 0u ? cnt : 1u;
}
__device__ __forceinline__ void xcd_barrier(const XcdBarrier& b) {
    asm volatile("s_waitcnt vmcnt(0)" ::: "memory");
    __syncthreads();
    if (threadIdx.x == 0) {
        unsigned* bar = b.bar;
        __builtin_amdgcn_s_waitcnt(0);
        unsigned nloc = b.st[0], nx = b.st[1];
        if (nloc == 0u) { xcd_barrier_complete(bar, b.x, nloc, nx); b.st[0] = nloc; b.st[1] = nx; }
        const unsigned old = xb_add(&bar[XB_XSUB(b.x)], 1u);
        const unsigned gen = old / nloc;
        if (old + 1u == (gen + 1u) * nloc) {
            __builtin_amdgcn_fence(__ATOMIC_RELEASE, "agent");
            asm volatile("s_waitcnt vmcnt(0)" ::: "memory");
            const unsigned og = xb_add(&bar[XB_TOP], 1u);
            const unsigned tg = og / nx;
            if (og + 1u == (tg + 1u) * nx) xb_add(&bar[XB_TOPGEN], 1u);
            else XB_SPIN(xb_ld(&bar[XB_TOPGEN]) == tg, bar);
            __builtin_amdgcn_fence(__ATOMIC_ACQUIRE, "agent");
            xb_add(&bar[XB_XGEN(b.x)], 1u);
            asm volatile("s_waitcnt vmcnt(0)" ::: "memory");
        } else {
            XB_SPIN(xb_ld(&bar[XB_XGEN(b.x)]) == gen, bar);
            __builtin_amdgcn_fence(__ATOMIC_ACQUIRE, "agent");
            asm volatile("s_waitcnt vmcnt(0)" ::: "memory");
        }
    }
    __syncthreads();
}
}
namespace pg8 {
#define PG8_LAS __attribute__((address_space(3)))
typedef unsigned short bf16_t;
typedef short bf16x8 __attribute__((ext_vector_type(8)));
typedef float f32x4 __attribute__((ext_vector_type(4)));
typedef unsigned u32x4 __attribute__((ext_vector_type(4)));
constexpr int BM = 256, BK = 64, HALF = 128, HTB = HALF * BK * 2, STAGE_BYTES = 8 * HTB, NXCD = 8, WGM = 8;
__host__ __device__ __forceinline__ int lds_byte(int r, int c) { const int st = (r >> 4) * 2 + (c >> 5), rr = r & 15, cc = c & 31, ob = rr * 64 + cc * 2; return st * 1024 + (ob ^ (((ob >> 9) & 1) << 5)); }
__host__ __device__ __forceinline__ void stage_rc(int b, int& R, int& C) { const int st = b / 1024, sb = b % 1024, swz = sb ^ (((sb >> 9) & 1) << 5); R = (st >> 1) * 16 + swz / 64; C = (st & 1) * 32 + (swz % 64) / 2; }
__host__ __device__ __forceinline__ int perm32(int rho) { const int n = rho >> 4, i = rho & 15; return 8 * (i >> 2) + 4 * n + (i & 3); }
struct Unit { const char* pA; const char* pB; int pm, pn; };
struct Gemm { int lda, ldb, K; };
struct TileOrder {
    const char* A; const char* Bt; size_t a_t, b_t, b_e; const int* texp; int nM, nN, nwg, G, c;
    __device__ __forceinline__ void init(const void* A_, int lda, const void* Bt_, int ldb, int nM_, int nN_, int G_, int c_) {
        A = (const char*)A_; Bt = (const char*)Bt_; a_t = (size_t)BM * lda * 2; b_t = (size_t)BM * ldb * 2; b_e = 0; texp = nullptr; nM = nM_; nN = nN_; nwg = nM * nN; G = G_; c = c_; }
    __device__ __forceinline__ bool next(int i, Unit& u) const {
        const long L = (long)i * G + c; if (L >= nwg) return false;
        int wgid = (int)L; { const int q = nwg / NXCD, r = nwg % NXCD, xcd = wgid % NXCD, off = wgid / NXCD; wgid = (xcd < r ? xcd * (q + 1) : r * (q + 1) + (xcd - r) * q) + off; }
        const int nig = WGM * nN, gid = wgid / nig, fm = gid * WGM, gsz = (nM - fm) < WGM ? (nM - fm) : WGM;
        u.pm = fm + ((wgid % nig) % gsz); u.pn = (wgid % nig) / gsz;
        u.pA = A + (size_t)u.pm * a_t; u.pB = Bt + (size_t)u.pn * b_t + (texp ? (size_t)texp[u.pm] * b_e : (size_t)0); return true;
    }
    __device__ __forceinline__ void a_ready(const Unit&) const {}
    __device__ __forceinline__ void done(const Unit&) const {}
};
struct GroupOrder {
    const char* A; const char* Bt; size_t a_t, b_t, a_g, b_g; int nM, nN, nwg, G, c;
    __device__ __forceinline__ void init(const void* A_, int lda, size_t a_g_, const void* Bt_, int ldb, size_t b_g_, int ng, int nM_, int nN_, int G_, int c_) {
        A = (const char*)A_; Bt = (const char*)Bt_; a_t = (size_t)BM * lda * 2; b_t = (size_t)BM * ldb * 2; a_g = a_g_; b_g = b_g_; nM = nM_; nN = nN_; nwg = ng * nM * nN; G = G_; c = c_; }
    __device__ __forceinline__ bool next(int i, Unit& u) const {
        const long L = (long)i * G + c; if (L >= nwg) return false;
        const int per = nM * nN, g = (int)L / per, r = (int)L % per, pm = r / nN, pn = r % nN;
        u.pm = g * nM + pm; u.pn = pn; u.pA = A + (size_t)g * a_g + (size_t)pm * a_t; u.pB = Bt + (size_t)g * b_g + (size_t)pn * b_t; return true;
    }
    __device__ __forceinline__ void a_ready(const Unit&) const {}
    __device__ __forceinline__ void done(const Unit&) const {}
};
template <class Epi, class Sched, bool ALIGN_EPI = false, bool SMALLK = false>
__device__ __forceinline__ void gemm_phase(PG8_LAS unsigned char* lds, const Gemm g, const Sched& S, const Epi& E) {
    int tid_ = threadIdx.x; asm volatile("" : "+v"(tid_));
    const int tid = tid_, wid = __builtin_amdgcn_readfirstlane(tid >> 6), lane = tid & 63, wr = wid >> 2, wc = wid & 3, fr = lane & 15, fq = lane >> 4;
    int K_ = g.K; if constexpr (SMALLK) asm volatile("" : "+s"(K_));
    const int K = K_, nt = K / BK, lda = g.lda, ldb = g.ldb;
    unsigned voffA[2], voffB[2];
#pragma unroll
    for (int i = 0; i < 2; ++i) { int R, C; stage_rc(tid * 16 + i * 8192, R, C); const int Rb = Epi::PERM ? ((R & ~31) + perm32(R & 31)) : R;
        voffA[i] = (unsigned)(R * lda + C) * 2u; voffB[i] = (unsigned)(Rb * ldb + C) * 2u; }
    const size_t kstep = (size_t)(BK * 2);
    const size_t hstepA = (size_t)HALF * lda * 2, hstepB = (size_t)HALF * ldb * 2;
    const unsigned ldsw = (unsigned)wid * 1024u;
    const int aoff = lds_byte(wr * 64 + fr, fq * 8), boff = lds_byte(wc * 32 + fr, fq * 8);
#define PG8_SA(b, h) (((b) * 2 + (h)) * HTB)
#define PG8_SB(b, h) ((4 + (b) * 2 + (h)) * HTB)
#define PG8_STAGE(bufoff, gbase, voff) do { _Pragma("unroll") for (int _i = 0; _i < 2; ++_i) \
        __builtin_amdgcn_global_load_lds((const unsigned*)((const char*)(gbase) + (voff)[_i]), (PG8_LAS unsigned*)(lds + (bufoff) + ldsw + _i * 8192), 16, 0, 0); } while (0)
#define PG8_LDA(dst, b, h) do { _Pragma("unroll") for (int m = 0; m < 4; ++m) _Pragma("unroll") for (int k = 0; k < 2; ++k) dst[m][k] = *(const PG8_LAS bf16x8*)(lds + PG8_SA(b, h) + aoff + m * 2048 + k * 1024); } while (0)
#define PG8_LDB(dst, b, h) do { _Pragma("unroll") for (int n = 0; n < 2; ++n) _Pragma("unroll") for (int k = 0; k < 2; ++k) dst[n][k] = *(const PG8_LAS bf16x8*)(lds + PG8_SB(b, h) + boff + n * 2048 + k * 1024); } while (0)
#define PG8_MMA(ai, bj, At, Bt) do { __builtin_amdgcn_s_setprio(1); _Pragma("unroll") for (int m = 0; m < 4; ++m) _Pragma("unroll") for (int n = 0; n < 2; ++n) _Pragma("unroll") for (int k = 0; k < 2; ++k) \
        acc[ai][bj][m][n] = __builtin_amdgcn_mfma_f32_16x16x32_bf16(Bt[n][k], At[m][k], acc[ai][bj][m][n], 0, 0, 0); __builtin_amdgcn_s_setprio(0); } while (0)
#define PG8_WAIT_V(n) asm volatile("s_waitcnt vmcnt(" #n ")" ::: "memory")
#define PG8_WAIT_L(n) asm volatile("s_waitcnt lgkmcnt(" #n ")" ::: "memory")
#define PG8_BAR __builtin_amdgcn_s_barrier()
#define PG8_SCHED __builtin_amdgcn_sched_barrier(0)
    Unit cur, nxt; int ui = 0;
    if (!S.next(0, cur)) return;
    f32x4 acc[2][2][4][2];
#pragma unroll
    for (int a = 0; a < 2; ++a)
#pragma unroll
        for (int b = 0; b < 2; ++b)
#pragma unroll
            for (int m = 0; m < 4; ++m)
#pragma unroll
                for (int n = 0; n < 2; ++n) acc[a][b][m][n] = (f32x4){0.f, 0.f, 0.f, 0.f};
    bf16x8 At[4][2], B0[2][2], B1[2][2];
    const char* cA = cur.pA; const char* cB = cur.pB;
    S.a_ready(cur);
    {
        PG8_STAGE(PG8_SB(0, 0), cB, voffB); PG8_STAGE(PG8_SB(0, 1), cB + hstepB, voffB); PG8_STAGE(PG8_SA(0, 0), cA, voffA); PG8_STAGE(PG8_SA(0, 1), cA + hstepA, voffA);
        if (wr == 1) PG8_BAR;
        PG8_WAIT_V(2); PG8_BAR;
        PG8_STAGE(PG8_SB(1, 0), cB + kstep, voffB); PG8_STAGE(PG8_SA(1, 0), cA + kstep, voffA); PG8_STAGE(PG8_SB(1, 1), cB + hstepB + kstep, voffB);
        PG8_WAIT_V(6); PG8_BAR;
    }
    for (;;) {
        const bool has_next = S.next(ui + 1, nxt);
        const char* nA = has_next ? nxt.pA : cA; const char* nB = has_next ? nxt.pB : cB;
        for (int t = 0; t < nt; t += 2) {
            const bool last = (t == nt - 2);
            const char* a1 = cA + (size_t)(t + 1) * kstep;
            const char* a2 = last ? nA : cA + (size_t)(t + 2) * kstep; const char* b2 = last ? nB : cB + (size_t)(t + 2) * kstep;
            const char* a3 = a2 + kstep; const char* b3 = b2 + kstep;
            if (last && has_next) S.a_ready(nxt);
            {
            PG8_LDB(B0, 0, 0); PG8_LDB(B1, 0, 1); PG8_SCHED; PG8_LDA(At, 0, 0); PG8_STAGE(PG8_SA(1, 1), a1 + hstepA, voffA);
            PG8_WAIT_V(8); PG8_WAIT_L(0); PG8_BAR; PG8_MMA(0, 0, At, B0); PG8_MMA(0, 1, At, B1); PG8_BAR; PG8_SCHED;
            PG8_LDA(At, 0, 1); PG8_STAGE(PG8_SB(0, 0), b2, voffB); PG8_STAGE(PG8_SB(0, 1), b2 + hstepB, voffB); PG8_STAGE(PG8_SA(0, 0), a2, voffA);
            PG8_WAIT_V(8); PG8_WAIT_L(0); PG8_BAR; PG8_MMA(1, 0, At, B0); PG8_MMA(1, 1, At, B1); PG8_BAR; PG8_SCHED;
            PG8_LDB(B0, 1, 0); PG8_LDB(B1, 1, 1); PG8_SCHED; PG8_LDA(At, 1, 0); PG8_STAGE(PG8_SA(0, 1), a2 + hstepA, voffA);
            PG8_WAIT_V(8); PG8_WAIT_L(0); PG8_BAR; PG8_MMA(0, 0, At, B0); PG8_MMA(0, 1, At, B1); PG8_BAR; PG8_SCHED;
            PG8_LDA(At, 1, 1); PG8_STAGE(PG8_SB(1, 0), b3, voffB); PG8_STAGE(PG8_SB(1, 1), b3 + hstepB, voffB); PG8_STAGE(PG8_SA(1, 0), a3, voffA);
            PG8_WAIT_V(8); PG8_WAIT_L(0); PG8_BAR; PG8_MMA(1, 0, At, B0); PG8_MMA(1, 1, At, B1); PG8_BAR; PG8_SCHED;
            }
        }
        if constexpr (ALIGN_EPI) { if (wr == 0) PG8_BAR; }
        if constexpr (!Epi::AFTER_DRAIN) { E(acc, cur, wr, wc, fr, fq); S.done(cur); }
        if (!has_next) break;
#pragma unroll
        for (int a = 0; a < 2; ++a)
#pragma unroll
            for (int b = 0; b < 2; ++b)
#pragma unroll
                for (int m = 0; m < 4; ++m)
#pragma unroll
                    for (int n = 0; n < 2; ++n) acc[a][b][m][n] = (f32x4){0.f, 0.f, 0.f, 0.f};
        cur = nxt; cA = nA; cB = nB; ++ui;
        if constexpr (ALIGN_EPI) { if (wr == 1) PG8_BAR; }
    }
    PG8_WAIT_V(0);
    if constexpr (!ALIGN_EPI) { if (wr == 0) PG8_BAR; }
    PG8_BAR;
    if constexpr (Epi::AFTER_DRAIN) { E.fused(acc, cur, wr, wc, fr, fq, lds, wid, lane); S.done(cur); }
#undef PG8_SA
#undef PG8_SB
#undef PG8_STAGE
#undef PG8_LDA
#undef PG8_LDB
#undef PG8_MMA
#undef PG8_WAIT_V
#undef PG8_WAIT_L
#undef PG8_BAR
#undef PG8_SCHED
}
}
namespace mk {
using pg8::Unit;
typedef f32x4 Acc[2][2][4][2];
__device__ __forceinline__ void st8(bf16* p, f32x4 v) { u32x2 w; w.x = cvtpk(v[0], v[1]); w.y = cvtpk(v[2], v[3]); *(u32x2*)p = w; }
__device__ __forceinline__ void st16(bf16* p, f32x4 a, f32x4 b) { u32x4 w; w.x = cvtpk(a[0], a[1]); w.y = cvtpk(a[2], a[3]); w.z = cvtpk(b[0], b[1]); w.w = cvtpk(b[2], b[3]); *(u32x4*)p = w; }
__device__ __forceinline__ f32x4 ld4bf(const bf16* p) { const u32x2 w = *(const u32x2*)p; return (f32x4){bflo(w.x), bfhi(w.x), bflo(w.y), bfhi(w.y)}; }
__device__ __forceinline__ f32x4 rope4(f32x4 v, f32x4 cs) { return (f32x4){v[0] * cs[0] - v[1] * cs[1], v[1] * cs[0] + v[0] * cs[1], v[2] * cs[2] - v[3] * cs[3], v[3] * cs[2] + v[2] * cs[3]}; }

struct EpiWin {
    static constexpr bool PERM = false, AFTER_DRAIN = false;
    bf16 *RQ, *RK, *RKT, *RVT, *RG, *UC, *CQ, *CKV, *KPE; float *SSQQ, *SSQKV; const f32x4* CS;
    __device__ __forceinline__ void operator()(const Acc& acc, const Unit& u, int wr, int wc, int fr, int fq) const { { int t_ = threadIdx.x; asm volatile("" : "+v"(t_)); fr = t_ & 15; fq = (t_ >> 4) & 3; }
        const int pn = u.pn, row0 = u.pm * 256 + wr * 64 + fr;
        if (pn <= 1) {
#pragma unroll
            for (int ai = 0; ai < 2; ++ai)
#pragma unroll
                for (int m = 0; m < 4; ++m) { const int row = row0 + ai * 128 + m * 16; const float pl = (float)(row & (RET_C - 1));
#pragma unroll
                    for (int bj = 0; bj < 2; ++bj) { const int head = 2 * bj + (wc >> 1);
                        const float lg2 = __builtin_amdgcn_logf(1.f - __builtin_amdgcn_exp2f(-5.f - (float)head));
                        const float dec = pn == 0 ? __builtin_amdgcn_exp2f(pl * lg2) : 0.125f * __builtin_amdgcn_exp2f(-pl * lg2);
#pragma unroll
                        for (int n = 0; n < 2; ++n) { const int i0 = 16 * (wc & 1) + 8 * n + 2 * fq; const f32x4 cs = CS[(row * 32 + i0) >> 1];
                            const f32x4 o = rope4(acc[ai][bj][m][n], cs) * dec; const int col = bj * 128 + wc * 32 + n * 16 + fq * 4;
                            st8((pn == 0 ? RQ : RK) + (size_t)row * 256 + col, o);
                            if (pn == 1) {
#pragma unroll
                                for (int j = 0; j < 4; ++j) RKT[(size_t)(col + j) * NTOK + row] = (bf16)(cvtpk(o[j], 0.f) & 0xffffu); } } } }
        } else if (pn == 2) {
#pragma unroll
            for (int ai = 0; ai < 2; ++ai)
#pragma unroll
                for (int m = 0; m < 4; ++m) { const int row = row0 + ai * 128 + m * 16;
#pragma unroll
                    for (int bj = 0; bj < 2; ++bj)
#pragma unroll
                        for (int n = 0; n < 2; ++n) { const int col = bj * 128 + wc * 32 + n * 16 + fq * 4; const f32x4 v = acc[ai][bj][m][n];
#pragma unroll
                            for (int j = 0; j < 4; ++j) RVT[(size_t)(col + j) * NTOK + row] = (bf16)(cvtpk(v[j], 0.f) & 0xffffu); } }
        } else if (pn == 3) {
#pragma unroll
            for (int ai = 0; ai < 2; ++ai)
#pragma unroll
                for (int m = 0; m < 4; ++m) { const int row = row0 + ai * 128 + m * 16;
#pragma unroll
                    for (int bj = 0; bj < 2; ++bj)
#pragma unroll
                        for (int n = 0; n < 2; ++n) { const int col = bj * 128 + wc * 32 + n * 16 + fq * 4; const f32x4 v = acc[ai][bj][m][n];
                            st8(RG + (size_t)row * 256 + col, (f32x4){silu_fast(v[0]), silu_fast(v[1]), silu_fast(v[2]), silu_fast(v[3])}); } }
        } else if (pn == 4) {
#pragma unroll
            for (int ai = 0; ai < 2; ++ai)
#pragma unroll
                for (int m = 0; m < 4; ++m) { const int row = row0 + ai * 128 + m * 16, chunk = row / SSM_C, t = row % SSM_C;
#pragma unroll
                    for (int bj = 0; bj < 2; ++bj)
#pragma unroll
                        for (int n = 0; n < 2; ++n) { const int g = 8 * bj + 2 * wc + n;
                            st8(UC + ((size_t)g * SSM_NCH + chunk) * SSM_K + t * 16 + 4 * fq, acc[ai][bj][m][n]); } }
        } else if (pn == 5) {
#pragma unroll
            for (int ai = 0; ai < 2; ++ai)
#pragma unroll
                for (int m = 0; m < 4; ++m) { const int row = row0 + ai * 128 + m * 16; float ss = 0.f;
#pragma unroll
                    for (int bj = 0; bj < 2; ++bj)
#pragma unroll
                        for (int n = 0; n < 2; ++n) { const f32x4 v = acc[ai][bj][m][n]; ss += (v[0] * v[0] + v[1] * v[1]) + (v[2] * v[2] + v[3] * v[3]);
                            st8(CQ + (size_t)row * 256 + bj * 128 + wc * 32 + n * 16 + fq * 4, v); }
                    ss += __shfl_xor(ss, 16); ss += __shfl_xor(ss, 32);
                    if (fq == 0) SSQQ[row * 4 + wc] = ss; }
        } else {
#pragma unroll
            for (int ai = 0; ai < 2; ++ai)
#pragma unroll
                for (int m = 0; m < 4; ++m) { const int row = row0 + ai * 128 + m * 16; float ss = 0.f;
#pragma unroll
                    for (int n = 0; n < 2; ++n) { const f32x4 v = acc[ai][0][m][n]; ss += (v[0] * v[0] + v[1] * v[1]) + (v[2] * v[2] + v[3] * v[3]);
                        st8(CKV + (size_t)row * 128 + wc * 32 + n * 16 + fq * 4, v); }
                    ss += __shfl_xor(ss, 16); ss += __shfl_xor(ss, 32);
                    if (fq == 0) SSQKV[row * 4 + wc] = ss;
                    if (wc < 2) {
#pragma unroll
                        for (int n = 0; n < 2; ++n) { const int i0 = 16 * wc + 8 * n + 2 * fq; const f32x4 cs = CS[(row * 32 + i0) >> 1];
                            st8(KPE + (size_t)row * 64 + wc * 32 + n * 16 + fq * 4, rope4(acc[ai][1][m][n], cs)); } } }
        }
    }
};
struct EpiQup {
    static constexpr bool PERM = false, AFTER_DRAIN = false;
    bf16* Q; const float* SSQ; const f32x4* CS;
    __device__ __forceinline__ void operator()(const Acc& acc, const Unit& u, int wr, int wc, int fr, int fq) const { { int t_ = threadIdx.x; asm volatile("" : "+v"(t_)); fr = t_ & 15; fq = (t_ >> 4) & 3; }
        const int row0 = u.pm * 256 + wr * 64 + fr;
#pragma unroll
        for (int ai = 0; ai < 2; ++ai)
#pragma unroll
            for (int m = 0; m < 4; ++m) { const int row = row0 + ai * 128 + m * 16; const f32x4 s4 = *(const f32x4*)(SSQ + row * 4);
                const float rstd = __builtin_amdgcn_rsqf(((s4[0] + s4[1]) + (s4[2] + s4[3])) * (1.f / 256.f) + EPS);
#pragma unroll
                for (int bj = 0; bj < 2; ++bj) { const bool rope = ((4 * u.pn + 2 * bj + (wc >> 1)) % 3) == 2;
#pragma unroll
                    for (int n = 0; n < 2; ++n) { f32x4 v = acc[ai][bj][m][n] * rstd;
                        if (rope) { const int i0 = 16 * (wc & 1) + 8 * n + 2 * fq; v = rope4(v, CS[(row * 32 + i0) >> 1]); }
                        st8(Q + (size_t)row * 768 + u.pn * 256 + bj * 128 + wc * 32 + n * 16 + fq * 4, v); } }
                asm volatile("" ::: "memory"); }
    }
};
struct EpiKVup {
    static constexpr bool PERM = false, AFTER_DRAIN = false;
    bf16 *KN, *V; const float* SSQ;
    __device__ __forceinline__ void operator()(const Acc& acc, const Unit& u, int wr, int wc, int fr, int fq) const { { int t_ = threadIdx.x; asm volatile("" : "+v"(t_)); fr = t_ & 15; fq = (t_ >> 4) & 3; }
        const int row0 = u.pm * 256 + wr * 64 + fr;
#pragma unroll
        for (int ai = 0; ai < 2; ++ai)
#pragma unroll
            for (int m = 0; m < 4; ++m) { const int row = row0 + ai * 128 + m * 16; const f32x4 s4 = *(const f32x4*)(SSQ + row * 4);
                const float rstd = __builtin_amdgcn_rsqf(((s4[0] + s4[1]) + (s4[2] + s4[3])) * (1.f / 128.f) + EPS);
#pragma unroll
                for (int bj = 0; bj < 2; ++bj)
#pragma unroll
                    for (int n = 0; n < 2; ++n) st8((bj == 0 ? KN : V) + (size_t)row * 512 + u.pn * 128 + wc * 32 + n * 16 + fq * 4, acc[ai][bj][m][n] * rstd);
                asm volatile("" ::: "memory"); }
    }
};
struct EpiSsmE {
    static constexpr bool PERM = false, AFTER_DRAIN = true;
    bf16* UC; const f32x2* LAMC;
    __device__ __forceinline__ void fused(Acc& acc, const Unit& u, int wr, int wc, int fr, int fq, PG8_LAS unsigned char* lds, int wid, int lane) const { { int t_ = threadIdx.x; asm volatile("" : "+v"(t_)); fr = t_ & 15; fq = (t_ >> 4) & 3; }
        PG8_LAS float* EL = (PG8_LAS float*)lds;
        const int g = u.pm >> 1, b = u.pm & 1;
#pragma unroll
        for (int ai = 0; ai < 2; ++ai)
#pragma unroll
            for (int m = 0; m < 4; ++m) { const int ch = ai * 128 + wr * 64 + m * 16 + fr;
#pragma unroll
                for (int n = 0; n < 2; ++n) *(PG8_LAS f32x4*)(EL + ch * 128 + wc * 32 + n * 16 + fq * 4) = acc[ai][0][m][n]; }
        asm volatile("s_waitcnt lgkmcnt(0)" ::: "memory"); __builtin_amdgcn_s_barrier(); asm volatile("" ::: "memory");
        {
            const f32x2 lc = LAMC[g * 64 + lane]; f32x2 c = {0.f, 0.f};
            f32x2 loc[32];
#pragma unroll
            for (int n = 0; n < 32; ++n) { const f32x2 e2 = *(const PG8_LAS f32x2*)(EL + (wid * 32 + n) * 128 + 2 * lane); loc[n] = c; c = (f32x2){lc.x * c.x - lc.y * c.y, lc.x * c.y + lc.y * c.x} + e2; }
            f32x2 pw = {1.f, 0.f};
#pragma unroll
            for (int n = 0; n < 32; ++n) pw = (f32x2){pw.x * lc.x - pw.y * lc.y, pw.x * lc.y + pw.y * lc.x};
            asm volatile("s_waitcnt lgkmcnt(0)" ::: "memory"); __builtin_amdgcn_s_barrier(); asm volatile("" ::: "memory");
            *(PG8_LAS f32x2*)(EL + wid * 128 + 2 * lane) = c;
            asm volatile("s_waitcnt lgkmcnt(0)" ::: "memory"); __builtin_amdgcn_s_barrier(); asm volatile("" ::: "memory");
            f32x2 cin = {0.f, 0.f};
            for (int s = 0; s < wid; ++s) { const f32x2 es = *(const PG8_LAS f32x2*)(EL + s * 128 + 2 * lane); cin = (f32x2){pw.x * cin.x - pw.y * cin.y, pw.x * cin.y + pw.y * cin.x} + es; }
            bf16* up = UC + ((size_t)g * SSM_NCH + b * 256 + wid * 32) * SSM_K + 512 + 2 * lane;
            f32x2 q = cin;
#pragma unroll
            for (int n = 0; n < 32; ++n) { const f32x2 v = loc[n] + q; *(unsigned*)(up + (size_t)n * SSM_K) = cvtpk(v.x, v.y); q = (f32x2){lc.x * q.x - lc.y * q.y, lc.x * q.y + lc.y * q.x}; }
        }
        asm volatile("s_waitcnt lgkmcnt(0)" ::: "memory"); __builtin_amdgcn_s_barrier(); asm volatile("" ::: "memory");
    }
};
struct EpiSsmZ {
    static constexpr bool PERM = false, AFTER_DRAIN = false;
    bf16* G; const bf16* UC; const float* dpar;
    __device__ __forceinline__ void operator()(const Acc& acc, const Unit& u, int wr, int wc, int fr, int fq) const { { int t_ = threadIdx.x; asm volatile("" : "+v"(t_)); fr = t_ & 15; fq = (t_ >> 4) & 3; }
        const int g = u.pm >> 1, ch0 = (u.pm & 1) * 256 + wr * 64 + fr;
        const f32x4 dd = *(const f32x4*)(dpar + g * 16 + 4 * fq);
#pragma unroll
        for (int ai = 0; ai < 2; ++ai)
#pragma unroll
            for (int m = 0; m < 4; ++m) { const int chunk = ch0 + ai * 128 + m * 16;
#pragma unroll
                for (int bj = 0; bj < 2; ++bj)
#pragma unroll
                    for (int n = 0; n < 2; ++n) { const int t = u.pn * 16 + bj * 8 + wc * 2 + n;
                        const f32x4 uv = ld4bf(UC + ((size_t)g * SSM_NCH + chunk) * SSM_K + t * 16 + 4 * fq);
                        const f32x4 y = acc[ai][bj][m][n] + dd * uv;
                        st8(G + (size_t)(chunk * SSM_C + t) * 256 + g * 16 + 4 * fq, (f32x4){gelu_tanh_fast(y[0]), gelu_tanh_fast(y[1]), gelu_tanh_fast(y[2]), gelu_tanh_fast(y[3])}); } }
    }
};
struct EpiGlu {
    static constexpr bool PERM = false, AFTER_DRAIN = true;
    const bf16* G; const float *bias, *gain; bf16* MIX;
    __device__ __forceinline__ void fused(Acc& acc, const Unit& u, int wr, int wc, int fr, int fq, PG8_LAS unsigned char* lds, int wid, int lane) const { { int t_ = threadIdx.x; asm volatile("" : "+v"(t_)); fr = t_ & 15; fq = (t_ >> 4) & 3; }
        PG8_LAS float* P = (PG8_LAS float*)lds;
        const int row0 = u.pm * 256 + wr * 64 + fr;
#pragma unroll
        for (int ai = 0; ai < 2; ++ai)
#pragma unroll
            for (int m = 0; m < 4; ++m) { const int row = row0 + ai * 128 + m * 16; float ss = 0.f;
#pragma unroll
                for (int bj = 0; bj < 2; ++bj)
#pragma unroll
                    for (int n = 0; n < 2; ++n) { const int col = bj * 128 + wc * 32 + n * 16 + fq * 4; const f32x4 b4 = *(const f32x4*)(bias + col), gl = ld4bf(G + (size_t)row * 256 + col);
                        f32x4 z = acc[ai][bj][m][n] + b4;
                        z = (f32x4){gl[0] * fast_sigmoid(z[0]), gl[1] * fast_sigmoid(z[1]), gl[2] * fast_sigmoid(z[2]), gl[3] * fast_sigmoid(z[3])};
                        acc[ai][bj][m][n] = z; ss += (z[0] * z[0] + z[1] * z[1]) + (z[2] * z[2] + z[3] * z[3]); }
                ss += __shfl_xor(ss, 16); ss += __shfl_xor(ss, 32);
                if (fq == 0) P[(ai * 128 + wr * 64 + m * 16 + fr) * 4 + wc] = ss; }
        asm volatile("s_waitcnt lgkmcnt(0)" ::: "memory"); __builtin_amdgcn_s_barrier(); asm volatile("" ::: "memory");
#pragma unroll
        for (int ai = 0; ai < 2; ++ai)
#pragma unroll
            for (int m = 0; m < 4; ++m) { const int lr = ai * 128 + wr * 64 + m * 16 + fr, row = u.pm * 256 + lr;
                const float rstd = __builtin_amdgcn_rsqf(((P[lr * 4 + 0] + P[lr * 4 + 1]) + (P[lr * 4 + 2] + P[lr * 4 + 3])) * (1.f / 256.f) + EPS);
#pragma unroll
                for (int bj = 0; bj < 2; ++bj)
#pragma unroll
                    for (int n = 0; n < 2; ++n) { const int col = bj * 128 + wc * 32 + n * 16 + fq * 4; const f32x4 g4 = *(const f32x4*)(gain + col);
                        st8(MIX + (size_t)row * DM + 256 + col, acc[ai][bj][m][n] * rstd * g4); } }
        asm volatile("s_waitcnt lgkmcnt(0)" ::: "memory"); __builtin_amdgcn_s_barrier(); asm volatile("" ::: "memory");
    }
};
struct EpiStore {
    static constexpr bool PERM = true, AFTER_DRAIN = false;
    bf16* O; int ldc; const float* rowscale;
    __device__ __forceinline__ void operator()(const Acc& acc, const Unit& u, int wr, int wc, int fr, int fq) const { { int t_ = threadIdx.x; asm volatile("" : "+v"(t_)); fr = t_ & 15; fq = (t_ >> 4) & 3; }
        const int row0 = u.pm * 256 + wr * 64 + fr, col0 = u.pn * 256 + wc * 32 + 8 * fq;
#pragma unroll
        for (int ai = 0; ai < 2; ++ai)
#pragma unroll
            for (int m = 0; m < 4; ++m) { const int row = row0 + ai * 128 + m * 16; const float s = rowscale ? rowscale[row] : 1.f;
#pragma unroll
                for (int bj = 0; bj < 2; ++bj) st16(O + (size_t)row * ldc + col0 + bj * 128, acc[ai][bj][m][0] * s, acc[ai][bj][m][1] * s); }
    }
};
struct EpiSwiglu {
    static constexpr bool PERM = true, AFTER_DRAIN = false;
    bf16* H;
    __device__ __forceinline__ void operator()(const Acc& acc, const Unit& u, int wr, int wc, int fr, int fq) const { { int t_ = threadIdx.x; asm volatile("" : "+v"(t_)); fr = t_ & 15; fq = (t_ >> 4) & 3; }
        const int row0 = u.pm * 256 + wr * 64 + fr, h0 = u.pn * 128 + wc * 16 + 4 * fq;
#pragma unroll
        for (int ai = 0; ai < 2; ++ai)
#pragma unroll
            for (int m = 0; m < 4; ++m) { const int row = row0 + ai * 128 + m * 16;
#pragma unroll
                for (int bj = 0; bj < 2; ++bj) { const f32x4 g = acc[ai][bj][m][0], up = acc[ai][bj][m][1];
                    st8(H + (size_t)row * DFF + h0 + bj * 64, (f32x4){silu_fast(g[0]) * up[0], silu_fast(g[1]) * up[1], silu_fast(g[2]) * up[2], silu_fast(g[3]) * up[3]}); } }
    }
};
}
namespace att {
using namespace mk;
constexpr int KVBLK = 64, SHM_V = 64 * 128 * 2, SHM_KN = 64 * 128 * 2, SHM_KP = 64 * 64 * 2, KBUF = SHM_KN + SHM_KP;
constexpr int OFF_V = 0  , OFF_K = 3 * SHM_V  , OFF_WS = 3 * SHM_V + 2 * KBUF, LDS_BYTES = OFF_WS + NWAVES * 64 * 4;
constexpr float THR = 8.f;
#define KSWZ(row, colB) ((row) * 256 + ((colB) ^ (((row) & 7) << 4)))
#define KPSWZ(row, colB) ((row) * 128 + ((colB) ^ (((row) & 7) << 4)))
#define SBAR() __builtin_amdgcn_sched_barrier(0)
__device__ __forceinline__ int v_st(int k, int c) { const int kk = (k & ~0xC) | ((k & 4) << 1) | ((k & 8) >> 1); return ((kk >> 3) * 4 + (c >> 5)) * 512 + ((kk & 7) * 32 + (c & 31)) * 2; }
__device__ __forceinline__ int v_rd_base(int lane) { return ((lane & 3) << 3) | (((lane >> 2) & 3) << 6) | (((lane >> 4) & 1) << 5) | (((lane >> 5) & 1) << 8); }
constexpr int v_rd_off(int d0, int ks, int half) { return d0 * 512 + ks * 4096 + half * 2048; }
__device__ __forceinline__ int crow(int r, int hi) { return (r & 3) + 8 * (r >> 2) + 4 * hi; }

struct Tensors { const bf16* Q; const bf16* KN; const bf16* KP; const bf16* V; bf16* O; };

template <int B_>
__device__ __forceinline__ void qkt(f32x16& p, const char* lds, int r32, int hi, int kh, const bf16x8* qr) {
    p = f32x16{};
    const char* kb[4];
#pragma unroll
    for (int dd = 0; dd < 4; ++dd) kb[dd] = lds + OFF_K + B_ * KBUF + kh * 8192 + KSWZ(r32, (dd * 16 + hi * 8) * 2);
#pragma unroll
    for (int d0 = 0; d0 < 8; ++d0) { const bf16x8 a = *reinterpret_cast<const bf16x8*>(kb[d0 & 3] + (d0 >> 2) * 128); p = __builtin_amdgcn_mfma_f32_32x32x16_bf16(a, qr[d0], p, 0, 0, 0); }
#pragma unroll
    for (int dd = 0; dd < 4; ++dd) { const bf16x8 a = *reinterpret_cast<const bf16x8*>(lds + OFF_K + B_ * KBUF + SHM_KN + kh * 4096 + KPSWZ(r32, (dd * 16 + hi * 8) * 2)); p = __builtin_amdgcn_mfma_f32_32x32x16_bf16(a, qr[8 + dd], p, 0, 0, 0); }
}
__device__ __forceinline__ void pv_tile(f32x16* o, int vb0, bf16x8 pa0, bf16x8 pa1) {
#define TRRD(dst, off) asm volatile("ds_read_b64_tr_b16 %0, %1 offset:%2" : "=&v"(dst) : "v"(vb0), "i"(off) : "memory")
#define PV_D2(d0) do { s16x4 l0, l1, h0, h1, l2, l3, h2, h3; constexpr int b_ = v_rd_off(d0, 0, 0), c_ = v_rd_off(d0 + 1, 0, 0); \
        TRRD(l0, b_); TRRD(h0, b_ + 2048); TRRD(l1, b_ + 4096); TRRD(h1, b_ + 6144); TRRD(l2, c_); TRRD(h2, c_ + 2048); TRRD(l3, c_ + 4096); TRRD(h3, c_ + 6144); \
        asm volatile("s_waitcnt lgkmcnt(0)" ::: "memory"); SBAR(); \
        o[d0] = __builtin_amdgcn_mfma_f32_32x32x16_bf16(pa0, (bf16x8){l0[0], l0[1], l0[2], l0[3], h0[0], h0[1], h0[2], h0[3]}, o[d0], 0, 0, 0); \
        o[d0 + 1] = __builtin_amdgcn_mfma_f32_32x32x16_bf16(pa0, (bf16x8){l2[0], l2[1], l2[2], l2[3], h2[0], h2[1], h2[2], h2[3]}, o[d0 + 1], 0, 0, 0); \
        o[d0] = __builtin_amdgcn_mfma_f32_32x32x16_bf16(pa1, (bf16x8){l1[0], l1[1], l1[2], l1[3], h1[0], h1[1], h1[2], h1[3]}, o[d0], 0, 0, 0); \
        o[d0 + 1] = __builtin_amdgcn_mfma_f32_32x32x16_bf16(pa1, (bf16x8){l3[0], l3[1], l3[2], l3[3], h3[0], h3[1], h3[2], h3[3]}, o[d0 + 1], 0, 0, 0); } while (0)
    PV_D2(0); PV_D2(2);
#undef PV_D2
#undef TRRD
}
__device__ __forceinline__ void softmax_tile(f32x16& p, float& m_reg, float& l_reg, float& alpha, bf16x8& pa0, bf16x8& pa1) {
    float pmax = p[0];
#pragma unroll
    for (int r = 1; r < 16; ++r) pmax = fmaxf(pmax, p[r]);
    { auto rr = __builtin_amdgcn_permlane32_swap(__float_as_uint(pmax), __float_as_uint(pmax), false, false); pmax = fmaxf(__uint_as_float(rr[0]), __uint_as_float(rr[1])); }
    float mn;
    if (__builtin_expect(__all((pmax - m_reg) <= THR), 1)) { mn = m_reg; alpha = 1.f; }
    else { mn = fmaxf(m_reg, pmax); alpha = __builtin_amdgcn_exp2f(m_reg - mn); m_reg = mn; }
    float ps = 0.f;
#pragma unroll
    for (int r = 0; r < 16; ++r) { p[r] = __builtin_amdgcn_exp2f(p[r] - mn); ps += p[r]; }
    { auto rr = __builtin_amdgcn_permlane32_swap(__float_as_uint(ps), __float_as_uint(ps), false, false); ps = __uint_as_float(rr[0]) + __uint_as_float(rr[1]); }
    l_reg = l_reg * alpha + ps;
#define PK4(B__, OUT) do { unsigned a0 = cvtpk(p[B__ + 0], p[B__ + 1]), a1 = cvtpk(p[B__ + 2], p[B__ + 3]), b0 = cvtpk(p[B__ + 4], p[B__ + 5]), b1 = cvtpk(p[B__ + 6], p[B__ + 7]); \
        auto r0 = __builtin_amdgcn_permlane32_swap(a0, b0, false, false); auto r1 = __builtin_amdgcn_permlane32_swap(a1, b1, false, false); \
        u32x4 w = {r0[0], r1[0], r0[1], r1[1]}; OUT = *reinterpret_cast<bf16x8*>(&w); } while (0)
    PK4(0, pa0); PK4(8, pa1);
#undef PK4
}
template <int ABL>
__device__ __forceinline__ void attn_unit(int b, int h, int qb, const Tensors& T, char* lds) {
    int tid_ = threadIdx.x; asm volatile("" : "+v"(tid_));
    const int tid = tid_, wid = __builtin_amdgcn_readfirstlane(tid >> 6), lane = tid & 63, r32 = lane & 31, hi = lane >> 5;
    const int rg = wid & 3, kh = wid >> 2;
    const size_t tok0 = (size_t)b * SEQ; const int q0 = qb * 128, NT = 2 * qb + 2;
    float* ws = (float*)(lds + OFF_WS) + wid * 64;
    const int sr = tid >> 4, sc = (tid & 15) * 8, kws = KSWZ(sr, sc * 2), vst0 = v_st(sr, sc), vst1 = v_st(32 + sr, sc);
    const int pr = tid >> 3, pc = (tid & 7) * 8, kpw = KPSWZ(pr, pc * 2);
    const bf16* gKN = T.KN + (tok0 + sr) * 512 + h * 128 + sc; const bf16* gV = T.V + (tok0 + sr) * 512 + h * 128 + sc; const bf16* gKP = T.KP + (tok0 + pr) * 64 + pc;
    bf16x8 st_k0, st_k1, st_v0, st_v1, st_p;
#define SLOAD(t) do { const size_t ko = ABL == 1 ? (size_t)0 : (size_t)(t) * KVBLK; st_k0 = *(const bf16x8*)(gKN + ko * 512); st_k1 = *(const bf16x8*)(gKN + (ko + 32) * 512); \
        st_v0 = *(const bf16x8*)(gV + ko * 512); st_v1 = *(const bf16x8*)(gV + (ko + 32) * 512); st_p = *(const bf16x8*)(gKP + ko * 64); } while (0)
#define SWRITE(bf, vslot) do { char* bb = lds + OFF_K + (bf) * KBUF; *(bf16x8*)(bb + kws) = st_k0; *(bf16x8*)(bb + kws + 32 * 256) = st_k1; *(bf16x8*)(bb + SHM_KN + kpw) = st_p; \
        *(bf16x8*)(lds + (vslot) + vst0) = st_v0; *(bf16x8*)(lds + (vslot) + vst1) = st_v1; } while (0)
    SLOAD(0);
    bf16x8 qr[12];
    { const bf16* qp = T.Q + (tok0 + q0 + rg * 32 + r32) * 768 + h * 192 + hi * 8;
#pragma unroll
      for (int d0 = 0; d0 < 12; ++d0) qr[d0] = *(const bf16x8*)(qp + d0 * 16); }
    float m_reg = -1e30f, l_reg = 0.f; f32x16 o[4] = {};
    const int vb0 = (int)(uintptr_t)lds + v_rd_base(lane) + kh * 8192;
    const int qpos = q0 + rg * 32 + r32;
    asm volatile("s_waitcnt vmcnt(0)" ::: "memory"); SWRITE(0, 0);
    __syncthreads();
    int vs_prev = 0, vs_cur = 0, vs_next = SHM_V; bf16x8 pa0 = {}, pa1 = {};
#define RESC(a) do { if (__any((a) < 1.f)) { if (hi == 0) ws[r32] = (a); asm volatile("s_waitcnt lgkmcnt(0)" ::: "memory"); \
        _Pragma("unroll") for (int d_ = 0; d_ < 4; ++d_) _Pragma("unroll") for (int r = 0; r < 16; ++r) o[d_][r] *= ws[crow(r, hi)]; } } while (0)
#define MASKP(t) do { if ((t) >= NT - 2) { const int kb_ = (t) * KVBLK + kh * 32 + 4 * hi; const float NEG = -__builtin_inff(); \
            _Pragma("unroll") for (int r = 0; r < 16; ++r) { const int key = kb_ + (r & 3) + 8 * (r >> 2); if (key > qpos) p[r] = NEG; } } } while (0)
#define STEP(t, B__) do { if ((t) + 1 < NT) SLOAD((t) + 1); SBAR(); \
        f32x16 p; float alpha; \
        if (ABL != 2 && kh == 1 && (t) > 0) pv_tile(o, vb0 + vs_prev, pa0, pa1); \
        SBAR(); if (ABL != 4) qkt<B__>(p, lds, r32, hi, kh, qr); else { p = o[0]; } MASKP(t); \
        if (ABL != 3) { softmax_tile(p, m_reg, l_reg, alpha, pa0, pa1); RESC(alpha); } else { u32x4 w0 = {cvtpk(p[0], p[1]), cvtpk(p[2], p[3]), cvtpk(p[4], p[5]), cvtpk(p[6], p[7])}, w1 = {cvtpk(p[8], p[9]), cvtpk(p[10], p[11]), cvtpk(p[12], p[13]), cvtpk(p[14], p[15])}; pa0 = __builtin_bit_cast(bf16x8, w0); pa1 = __builtin_bit_cast(bf16x8, w1); } SBAR(); \
        if (ABL == 2) { asm volatile("" :: "v"(pa0), "v"(pa1)); } \
        if (ABL != 2 && kh == 0) pv_tile(o, vb0 + vs_cur, pa0, pa1); \
        if ((t) + 1 < NT) { asm volatile("s_waitcnt vmcnt(0)" ::: "memory"); if (ABL != 5) SWRITE(1 - B__, vs_next); } \
        if (ABL != 5) __syncthreads(); vs_prev = vs_cur; vs_cur = vs_next; vs_next = (vs_next == 2 * SHM_V) ? 0 : vs_next + SHM_V; } while (0)
    for (int t = 0; t < NT; t += 2) { STEP(t, 0); STEP(t + 1, 1); }
    if (kh == 1) pv_tile(o, vb0 + vs_prev, pa0, pa1);
    __syncthreads();
#undef MASKP
#undef STEP
#undef RESC
#undef SLOAD
#undef SWRITE
    float* XO = (float*)lds;
    float* XM = (float*)(lds + 65536);
    if (kh == 1) {
#pragma unroll
        for (int d0 = 0; d0 < 4; ++d0)
#pragma unroll
            for (int r = 0; r < 16; ++r) XO[((rg * 64) + d0 * 16 + r) * 64 + lane] = o[d0][r];
        if (hi == 0) { XM[rg * 32 + r32] = m_reg; XM[128 + rg * 32 + r32] = l_reg; }
    }
    __syncthreads();
    if (kh == 0) {
        const float m1 = XM[rg * 32 + r32], l1 = XM[128 + rg * 32 + r32];
        const float mn = fmaxf(m_reg, m1), a0 = __builtin_amdgcn_exp2f(m_reg - mn), a1 = __builtin_amdgcn_exp2f(m1 - mn);
        const float inv = __builtin_amdgcn_rcpf(l_reg * a0 + l1 * a1);
        if (hi == 0) { ws[r32] = a0 * inv; ws[32 + r32] = a1 * inv; }
        asm volatile("s_waitcnt lgkmcnt(0)" ::: "memory");
        bf16* Ow = T.O + (tok0 + q0 + rg * 32) * 512 + h * 128;
#pragma unroll
        for (int r = 0; r < 16; ++r) { const int orow = crow(r, hi); const float f0 = ws[orow], f1 = ws[32 + orow];
#pragma unroll
            for (int d0 = 0; d0 < 4; ++d0) { const float v = o[d0][r] * f0 + XO[((rg * 64) + d0 * 16 + r) * 64 + lane] * f1; const float vn = __shfl_xor(v, 1);
                if ((r32 & 1) == 0) *(unsigned*)(Ow + (size_t)orow * 512 + d0 * 32 + r32) = cvtpk(v, vn); } }
    }
    __syncthreads();
}
#undef KSWZ
#undef KPSWZ
#undef SBAR
}
namespace ret {
using namespace mk;
__device__ __forceinline__ int crow(int r, int hi) { return (r & 3) + 8 * (r >> 2) + 4 * hi; }
struct Tensors { const bf16 *RQ, *RK, *RKT, *RVT, *RG; float* KVT; bf16* STATE; bf16* MIX; const float* gain; };
__device__ __forceinline__ void x_unit(int u, const Tensors& T, int lane) {
    asm volatile("" : "+v"(lane));
    const int n = u & 127, bh = u >> 7, h = bh & 3, b = bh >> 2, r32 = lane & 31, hi = lane >> 5;
    const size_t tok0 = (size_t)b * SEQ + (size_t)n * RET_C;
    f32x16 acc[2][2] = {};
#pragma unroll
    for (int s = 0; s < 4; ++s) {
        bf16x8 a[2], bb[2];
#pragma unroll
        for (int i = 0; i < 2; ++i) { a[i] = *(const bf16x8*)(T.RVT + (size_t)(h * 64 + i * 32 + r32) * NTOK + tok0 + s * 16 + hi * 8);
                                      bb[i] = *(const bf16x8*)(T.RKT + (size_t)(h * 64 + i * 32 + r32) * NTOK + tok0 + s * 16 + hi * 8); }
#pragma unroll
        for (int i = 0; i < 2; ++i)
#pragma unroll
            for (int j = 0; j < 2; ++j) acc[i][j] = __builtin_amdgcn_mfma_f32_32x32x16_bf16(a[i], bb[j], acc[i][j], 0, 0, 0);
    }
    float* out = T.KVT + (size_t)u * 4096;
#pragma unroll
    for (int i = 0; i < 2; ++i)
#pragma unroll
        for (int j = 0; j < 2; ++j)
#pragma unroll
            for (int r = 0; r < 16; ++r) out[(i * 32 + crow(r, hi)) * 64 + j * 32 + r32] = acc[i][j][r];
}
__device__ __forceinline__ void scan_elem(int e, const Tensors& T) {
    const int bh = e >> 12, el = e & 4095, h = bh & 3;
    const float gam = 1.f - __builtin_amdgcn_exp2f(-5.f - (float)h), lg2 = __builtin_amdgcn_logf(gam);
    const float g64 = __builtin_amdgcn_exp2f(64.f * lg2), g63 = __builtin_amdgcn_exp2f(63.f * lg2);
    const float* kv = T.KVT + (size_t)bh * 128 * 4096 + el; bf16* st = T.STATE + (size_t)bh * 128 * 4096 + el;
    float S = 0.f;
    for (int n0 = 0; n0 < 128; n0 += 16) {
        float v[16];
#pragma unroll
        for (int i = 0; i < 16; ++i) v[i] = kv[(size_t)(n0 + i) * 4096];
#pragma unroll
        for (int i = 0; i < 16; ++i) { st[(size_t)(n0 + i) * 4096] = (bf16)(cvtpk(gam * S, 0.f) & 0xffffu); S = g64 * S + g63 * v[i]; }
    }
}
__device__ __forceinline__ void z_unit(int u, const Tensors& T, int lane) {
    asm volatile("" : "+v"(lane));
    const int n = u & 127, bh = u >> 7, h = bh & 3, b = bh >> 2, r32 = lane & 31, hi = lane >> 5;
    const size_t tok0 = (size_t)b * SEQ + (size_t)n * RET_C;
    bf16x8 qf[2][4];
#pragma unroll
    for (int qb = 0; qb < 2; ++qb)
#pragma unroll
        for (int s = 0; s < 4; ++s) qf[qb][s] = *(const bf16x8*)(T.RQ + (tok0 + qb * 32 + r32) * 256 + h * 64 + s * 16 + hi * 8);
    f32x16 o[2][2] = {};
    const bf16* stp = T.STATE + (size_t)u * 4096;
#pragma unroll
    for (int s = 0; s < 4; ++s) {
        bf16x8 a[2];
#pragma unroll
        for (int i = 0; i < 2; ++i) a[i] = *(const bf16x8*)(stp + (i * 32 + r32) * 64 + s * 16 + hi * 8);
#pragma unroll
        for (int i = 0; i < 2; ++i)
#pragma unroll
            for (int qb = 0; qb < 2; ++qb) o[i][qb] = __builtin_amdgcn_mfma_f32_32x32x16_bf16(a[i], qf[qb][s], o[i][qb], 0, 0, 0);
    }
#pragma unroll
    for (int kb = 0; kb < 2; ++kb) {
        bf16x8 kf[4];
#pragma unroll
        for (int s = 0; s < 4; ++s) kf[s] = *(const bf16x8*)(T.RK + (tok0 + kb * 32 + r32) * 256 + h * 64 + s * 16 + hi * 8);
#pragma unroll
        for (int qb = kb; qb < 2; ++qb) {
            f32x16 st = {};
#pragma unroll
            for (int s = 0; s < 4; ++s) st = __builtin_amdgcn_mfma_f32_32x32x16_bf16(kf[s], qf[qb][s], st, 0, 0, 0);
            if (kb == qb) {
#pragma unroll
                for (int r = 0; r < 16; ++r) if (crow(r, hi) > r32) st[r] = 0.f;
            }
#pragma unroll
            for (int s2 = 0; s2 < 2; ++s2) {
                u32x4 w; w.x = cvtpk(st[8 * s2 + 0], st[8 * s2 + 1]); w.y = cvtpk(st[8 * s2 + 2], st[8 * s2 + 3]); w.z = cvtpk(st[8 * s2 + 4], st[8 * s2 + 5]); w.w = cvtpk(st[8 * s2 + 6], st[8 * s2 + 7]);
                const bf16x8 pb = __builtin_bit_cast(bf16x8, w);
#pragma unroll
                for (int i = 0; i < 2; ++i) {
                    const bf16* vp = T.RVT + (size_t)(h * 64 + i * 32 + r32) * NTOK + tok0 + kb * 32 + s2 * 16 + 4 * hi;
                    const u32x2 lo = *(const u32x2*)vp, hh = *(const u32x2*)(vp + 8);
                    const u32x4 av = {lo.x, lo.y, hh.x, hh.y};
                    o[i][qb] = __builtin_amdgcn_mfma_f32_32x32x16_bf16(__builtin_bit_cast(bf16x8, av), pb, o[i][qb], 0, 0, 0);
                }
            }
        }
    }
#pragma unroll
    for (int qb = 0; qb < 2; ++qb) {
        float ss = 0.f;
#pragma unroll
        for (int i = 0; i < 2; ++i)
#pragma unroll
            for (int r = 0; r < 16; ++r) ss += o[i][qb][r] * o[i][qb][r];
        { auto rr = __builtin_amdgcn_permlane32_swap(__float_as_uint(ss), __float_as_uint(ss), false, false); ss = __uint_as_float(rr[0]) + __uint_as_float(rr[1]); }
        const float rstd = __builtin_amdgcn_rsqf(ss * (1.f / 64.f) + EPS);
        const size_t row = tok0 + qb * 32 + r32;
#pragma unroll
        for (int i = 0; i < 2; ++i)
#pragma unroll
            for (int r4 = 0; r4 < 4; ++r4) { const int dv = i * 32 + 8 * r4 + 4 * hi;
                const f32x4 gt = ld4bf(T.RG + row * 256 + h * 64 + dv), gn = *(const f32x4*)(T.gain + h * 64 + dv);
                const f32x4 v = {o[i][qb][4 * r4 + 0], o[i][qb][4 * r4 + 1], o[i][qb][4 * r4 + 2], o[i][qb][4 * r4 + 3]};
                st8(T.MIX + row * DM + h * 64 + dv, v * rstd * gn * gt); }
    }
}
}
namespace mk {
constexpr size_t MiB = 1u << 20;
constexpr size_t W_CTL = 0, CTL_ZERO_BYTES = 64 * 1024;
constexpr size_t W_WGCNT = 128 * 1024;
constexpr size_t W_TILE = 192 * 1024;
constexpr size_t W_MOD = 1 * MiB;
constexpr size_t W_LAMC = 1 * MiB + 256 * 1024;
constexpr size_t W_TOP = 1 * MiB + 512 * 1024;
constexpr size_t W_CS = 2 * MiB;
constexpr size_t W_ROWW = 6 * MiB;
constexpr size_t W_MODP = 7 * MiB;
constexpr size_t W_SSQQ = 6 * MiB + 256 * 1024, W_SSQKV = 6 * MiB + 512 * 1024;
constexpr size_t W_MOEUP = 8 * MiB, W_MOEDN = 120 * MiB;
constexpr size_t W_WIN = 176 * MiB, W_WOUT = 183 * MiB, W_FFUP = 187 * MiB, W_FFDN = 201 * MiB, W_MW = 208 * MiB, W_WEND = 228 * MiB;
constexpr size_t W_WUQ = 233 * MiB, W_WUKV = 234 * MiB, W_GLUW = 235 * MiB;
constexpr size_t W_Y = 236 * MiB, W_MIX = 268 * MiB, W_T = 300 * MiB;
constexpr size_t W_RQ = W_T, W_RK = W_T + 8 * MiB, W_RKT = W_T + 16 * MiB, W_RVT = W_T + 24 * MiB, W_RG = W_T + 32 * MiB, W_UC = W_T + 40 * MiB, W_CQ = W_T + 50 * MiB,
                 W_CKV = W_T + 58 * MiB, W_KPE = W_T + 62 * MiB, W_Q = W_T + 64 * MiB, W_KN = W_T + 88 * MiB, W_V = W_T + 104 * MiB, W_O = W_T + 120 * MiB, W_G = W_T + 136 * MiB,
                 W_KVT = W_T + 144 * MiB, W_STATE = W_T + 160 * MiB, W_E = W_T + 168 * MiB;
constexpr size_t W_HB = W_T;
constexpr size_t W_XN = 480 * MiB;
constexpr size_t W_XG = 176 * MiB;
constexpr size_t W_HBM = 244 * MiB;
constexpr size_t W_END = 512 * MiB;

struct Args { const void* in[35]; float* out; unsigned char* ws; int ph_lo, ph_hi, never, pad; };

template <class SrcF>
__device__ __forceinline__ void transpose_item(const SrcF src, int ld, int K, bf16* WT, const float* kscale, float cscale, LAS float* scr, int kb, int nb, int lane) {
    const int k0 = 64 * kb, n0 = 32 * nb;
    const float* sp = src(n0 + (lane & 31));
    float tv[32];
#pragma unroll
    for (int i = 0; i < 32; ++i) tv[i] = sp[(size_t)(k0 + 2 * i + (lane >> 5)) * ld];
#pragma unroll
    for (int i = 0; i < 32; ++i) { const int kk = 2 * i + (lane >> 5); float v = tv[i] * cscale; if (kscale) v *= kscale[k0 + kk]; scr[kk * 33 + (lane & 31)] = v; }
    asm volatile("s_waitcnt lgkmcnt(0)" ::: "memory");
    const int c = lane & 7;
#pragma unroll
    for (int j = 0; j < 4; ++j) { const int n = (lane >> 3) + 8 * j; const LAS float* s = scr + (8 * c) * 33 + n;
        u32x4 o; o.x = cvtpk(s[0 * 33], s[1 * 33]); o.y = cvtpk(s[2 * 33], s[3 * 33]); o.z = cvtpk(s[4 * 33], s[5 * 33]); o.w = cvtpk(s[6 * 33], s[7 * 33]);
        *(u32x4*)(WT + (size_t)(n0 + n) * K + k0 + 8 * c) = o; }
    asm volatile("s_waitcnt lgkmcnt(0)" ::: "memory");
}
struct SrcPlain { const float* W; __device__ __forceinline__ const float* operator()(int n) const { return W + n; } };
struct SrcWin { const float* W; __device__ __forceinline__ const float* operator()(int n) const {
        const bool rp = (n < 512) || (n >= 1664); const int g = n & ~63, cg = n & 63; return W + (rp ? g + (cg >> 1) + 32 * (cg & 1) : n); } };
struct SrcWuq { const float* W; __device__ __forceinline__ const float* operator()(int n) const { const int hh = n / 192, w = n % 192; const int cg = w - 128; return W + (w < 128 ? n : hh * 192 + 128 + (cg >> 1) + 32 * (cg & 1)); } };
struct SrcGU { const float* Wg; const float* Wu; __device__ __forceinline__ const float* operator()(int n) const { const int hid = (n >> 3) * 4 + (n & 3);
        const long long du = (const char*)Wu - (const char*)Wg; return (const float*)((const char*)Wg + (((n >> 2) & 1) ? du : 0ll)) + hid; } };

__device__ __forceinline__ f32x2 lam_pow(float a_re, float a_im, float dt, float e) {
    const float mag = __builtin_amdgcn_exp2f(1.4426950408889634f * a_re * dt * e);
    const double rev = (double)(a_im * dt) * (double)e * 0.15915494309189535;
    const float fr = (float)(rev - floor(rev));
    return (f32x2){mag * __builtin_amdgcn_cosf(fr), mag * __builtin_amdgcn_sinf(fr)};
}
__device__ __forceinline__ f32x2 cmul(f32x2 a, f32x2 b) { return (f32x2){a.x * b.x - a.y * b.y, a.x * b.y + a.y * b.x}; }
}
namespace mk {
struct SsmPar { const float *a_re, *a_im, *b_re, *b_im, *c_re, *c_im, *log_dt; };
__device__ __forceinline__ f32x2 ssm_fw(const SsmPar& P, int g, int p, float e, bool with_f) {
    const float dt = __builtin_amdgcn_exp2f(1.4426950408889634f * P.log_dt[g]);
    const float ar = P.a_re[g * 64 + p], ai = P.a_im[g * 64 + p];
    f32x2 w = lam_pow(ar, ai, dt, e);
    if (with_f) { const f32x2 lb = lam_pow(ar, ai, dt, 1.f); const float nr = lb.x - 1.f, ni = lb.y, den = ar * ar + ai * ai;
        const f32x2 f = {(nr * ar + ni * ai) / den, (ni * ar - nr * ai) / den}; w = cmul(w, f); }
    return w;
}
__device__ __forceinline__ void ssm_unit_toep(const SsmPar& P, bf16* MW, int g, int dd, LAS float* scr, int lane) {
    const int d = dd - 31, h = lane >> 2, hp0 = (lane & 3) * 4;
    f32x4 acc = {0.f, 0.f, 0.f, 0.f};
    if (d >= 0) {
#pragma unroll
        for (int i = 0; i < 4; ++i) { const int o = 4 * (lane + 64 * i);
            *(LAS f32x4*)(scr + o) = *(const f32x4*)(P.c_re + g * 1024 + o); *(LAS f32x4*)(scr + 1024 + o) = *(const f32x4*)(P.c_im + g * 1024 + o);
            *(LAS f32x4*)(scr + 2048 + o) = *(const f32x4*)(P.b_re + g * 1024 + o); *(LAS f32x4*)(scr + 3072 + o) = *(const f32x4*)(P.b_im + g * 1024 + o); }
        const f32x2 w = ssm_fw(P, g, lane, (float)d, true);
        asm volatile("s_waitcnt lgkmcnt(0)" ::: "memory");
#pragma unroll 8
        for (int p = 0; p < 64; ++p) {
            const f32x2 wp = {__shfl(w.x, p), __shfl(w.y, p)};
            const f32x2 cm = {scr[h * 64 + p], scr[1024 + h * 64 + p]};
            const f32x2 t = cmul(cm, wp);
            const f32x4 br = *(const LAS f32x4*)(scr + 2048 + p * 16 + hp0), bi = *(const LAS f32x4*)(scr + 3072 + p * 16 + hp0);
            acc += br * t.x - bi * t.y;
        }
        asm volatile("s_waitcnt lgkmcnt(0)" ::: "memory");
    }
    const int tlo = d >= 0 ? d : 0, thi = d >= 0 ? 32 : 32 + d;
    for (int t = tlo; t < thi; ++t) st8(MW + ((size_t)g * 512 + t * 16 + h) * SSM_K + (t - d) * 16 + hp0, acc);
}
__device__ __forceinline__ void ssm_unit_cross(const SsmPar& P, bf16* MW, f32x2* LAMC, int g, int t, int lane) {
    const f32x2 lp = ssm_fw(P, g, lane, (float)(t + 1), false);
    if (t == 31) LAMC[g * 64 + lane] = lp;
#pragma unroll 4
    for (int h = 0; h < 16; ++h) { const f32x2 cm = {P.c_re[(g * 16 + h) * 64 + lane], P.c_im[(g * 16 + h) * 64 + lane]}; const f32x2 v = cmul(cm, lp);
        *(unsigned*)(MW + ((size_t)g * 512 + t * 16 + h) * SSM_K + 512 + 2 * lane) = cvtpk(v.x, -v.y); }
}
__device__ __forceinline__ void ssm_unit_end(const SsmPar& P, bf16* WEND, int g, int j, int lane) {
    const f32x2 w = ssm_fw(P, g, lane, (float)(31 - j), true);
    float re[16], im[16];
#pragma unroll
    for (int q = 0; q < 4; ++q) { const f32x4 br = *(const f32x4*)(P.b_re + (g * 64 + lane) * 16 + 4 * q), bi = *(const f32x4*)(P.b_im + (g * 64 + lane) * 16 + 4 * q);
#pragma unroll
        for (int k = 0; k < 4; ++k) { re[4 * q + k] = w.x * br[k] - w.y * bi[k]; im[4 * q + k] = w.x * bi[k] + w.y * br[k]; } }
    bf16* r0 = WEND + ((size_t)g * 128 + 2 * lane) * 512 + j * 16;
    st16(r0, (f32x4){re[0], re[1], re[2], re[3]}, (f32x4){re[4], re[5], re[6], re[7]}); st16(r0 + 8, (f32x4){re[8], re[9], re[10], re[11]}, (f32x4){re[12], re[13], re[14], re[15]});
    st16(r0 + 512, (f32x4){im[0], im[1], im[2], im[3]}, (f32x4){im[4], im[5], im[6], im[7]}); st16(r0 + 520, (f32x4){im[8], im[9], im[10], im[11]}, (f32x4){im[12], im[13], im[14], im[15]});
}
__device__ __forceinline__ void ssm_scan(int bg, const float* E, const f32x2* LAMC, bf16* UC, int lane) {
    const int b = bg >> 4, g = bg & 15;
    const f32x2 lc = LAMC[g * 64 + lane];
    f32x2 c = {0.f, 0.f};
    for (int n0 = 0; n0 < 256; n0 += 16) {
        f32x2 e[16];
#pragma unroll
        for (int i = 0; i < 16; ++i) e[i] = *(const f32x2*)(E + ((size_t)g * SSM_NCH + b * 256 + n0 + i) * 128 + 2 * lane);
#pragma unroll
        for (int i = 0; i < 16; ++i) { *(unsigned*)(UC + ((size_t)g * SSM_NCH + b * 256 + n0 + i) * SSM_K + 512 + 2 * lane) = cvtpk(c.x, c.y); c = cmul(lc, c) + e[i]; }
    }
}
struct Row { f32x4 v[4]; };
__device__ __forceinline__ Row row_ld_f32(const float* p, int lane) { Row r;
#pragma unroll
    for (int j = 0; j < 4; ++j) r.v[j] = *(const f32x4*)(p + 4 * lane + 256 * j);
    return r; }
__device__ __forceinline__ Row row_ld_bf16(const bf16* p, int lane) { Row r;
#pragma unroll
    for (int j = 0; j < 4; ++j) r.v[j] = ld4bf(p + 4 * lane + 256 * j);
    return r; }
__device__ __forceinline__ float row_ssq(const Row& r) { float s = 0.f;
#pragma unroll
    for (int j = 0; j < 4; ++j) s += (r.v[j][0] * r.v[j][0] + r.v[j][1] * r.v[j][1]) + (r.v[j][2] * r.v[j][2] + r.v[j][3] * r.v[j][3]);
    return wave_sum(s); }
__device__ __forceinline__ Row adaln(const Row& x, const float* g, const float* sc, const float* sh, bf16* xn, int lane) {
    const float rstd = __builtin_amdgcn_rsqf(row_ssq(x) * (1.f / DM) + EPS); Row o;
#pragma unroll
    for (int j = 0; j < 4; ++j) { const int c = 4 * lane + 256 * j; const f32x4 g4 = *(const f32x4*)(g + c), s4 = *(const f32x4*)(sc + c), h4 = *(const f32x4*)(sh + c);
        o.v[j] = x.v[j] * rstd * g4 * (s4 + 1.f) + h4; st8(xn + c, o.v[j]); }
    return o; }
__device__ __forceinline__ Row resid(const Row& xin, const Row& y, const float* g, const float* gt, float* xout, int lane) {
    const float rstd = __builtin_amdgcn_rsqf(row_ssq(y) * (1.f / DM) + EPS); Row o;
#pragma unroll
    for (int j = 0; j < 4; ++j) { const int c = 4 * lane + 256 * j; const f32x4 g4 = *(const f32x4*)(g + c), t4 = *(const f32x4*)(gt + c);
        o.v[j] = xin.v[j] + t4 * y.v[j] * rstd * g4; *(f32x4*)(xout + c) = o.v[j]; }
    return o; }
__device__ __forceinline__ void route(const Row& h, const float* router, int lane, int& e1, int& e2, float& w1, float& w2) {
    float acc[8];
#pragma unroll
    for (int e = 0; e < 8; ++e) acc[e] = 0.f;
#pragma unroll
    for (int j = 0; j < 4; ++j)
#pragma unroll
        for (int k = 0; k < 4; ++k) { const int c = 4 * lane + 256 * j + k; const f32x4 r0 = *(const f32x4*)(router + c * 8), r1 = *(const f32x4*)(router + c * 8 + 4); const float hv = h.v[j][k];
            acc[0] += hv * r0[0]; acc[1] += hv * r0[1]; acc[2] += hv * r0[2]; acc[3] += hv * r0[3]; acc[4] += hv * r1[0]; acc[5] += hv * r1[1]; acc[6] += hv * r1[2]; acc[7] += hv * r1[3]; }
#pragma unroll
    for (int e = 0; e < 8; ++e) acc[e] = wave_sum(acc[e]);
    e1 = 0; float v1 = acc[0];
#pragma unroll
    for (int e = 1; e < 8; ++e) if (acc[e] > v1) { v1 = acc[e]; e1 = e; }
    e2 = -1; float v2 = -__builtin_inff();
#pragma unroll
    for (int e = 0; e < 8; ++e) if (e != e1 && acc[e] > v2) { v2 = acc[e]; e2 = e; }
    const float ex = __builtin_amdgcn_exp2f(1.4426950408889634f * (v2 - v1)); w1 = 1.f / (1.f + ex); w2 = ex / (1.f + ex);
}

__device__ __forceinline__ void glu_unit(int u, const bf16* G, const bf16* GLUW, const float* bias, const float* gain, bf16* MIX, int lane) {
    asm volatile("" : "+v"(lane));
    const int r32 = lane & 31, hi = lane >> 5; const size_t tok = (size_t)u * 32 + r32;
    f32x16 acc[8] = {};
#pragma unroll 2
    for (int s = 0; s < 16; ++s) {
        const bf16x8 bf = *(const bf16x8*)(G + tok * 256 + s * 16 + hi * 8);
#pragma unroll
        for (int j = 0; j < 8; ++j) { const bf16x8 a = *(const bf16x8*)(GLUW + (size_t)(j * 32 + r32) * 256 + s * 16 + hi * 8); acc[j] = __builtin_amdgcn_mfma_f32_32x32x16_bf16(a, bf, acc[j], 0, 0, 0); }
    }
    float ss = 0.f;
#pragma unroll
    for (int j = 0; j < 8; ++j)
#pragma unroll
        for (int r4 = 0; r4 < 4; ++r4) { const int ch = j * 32 + 8 * r4 + 4 * hi; const f32x4 b4 = *(const f32x4*)(bias + ch), gl = ld4bf(G + tok * 256 + ch);
#pragma unroll
            for (int k = 0; k < 4; ++k) { const float y = gl[k] * fast_sigmoid(acc[j][4 * r4 + k] + b4[k]); acc[j][4 * r4 + k] = y; ss += y * y; } }
    { auto rr = __builtin_amdgcn_permlane32_swap(__float_as_uint(ss), __float_as_uint(ss), false, false); ss = __uint_as_float(rr[0]) + __uint_as_float(rr[1]); }
    const float rstd = __builtin_amdgcn_rsqf(ss * (1.f / 256.f) + EPS);
#pragma unroll
    for (int j = 0; j < 8; ++j)
#pragma unroll
        for (int r4 = 0; r4 < 4; ++r4) { const int ch = j * 32 + 8 * r4 + 4 * hi; const f32x4 g4 = *(const f32x4*)(gain + ch);
            st8(MIX + tok * DM + 256 + ch, (f32x4){acc[j][4 * r4 + 0], acc[j][4 * r4 + 1], acc[j][4 * r4 + 2], acc[j][4 * r4 + 3]} * rstd * g4); }
}
}
#ifndef MK_MASK
#define MK_MASK 0x1fff
#endif
#define PH_ON(n) (((MK_MASK) >> (n)) & 1)
#ifndef MK_REP_MASK
#define MK_REP_MASK 0
#endif
#ifndef MK_REP_N
#define MK_REP_N 2
#endif
#ifndef MK_SUB
#define MK_SUB 0xff
#endif
#define SUB_ON(n) (((MK_SUB) >> (n)) & 1)
namespace mk {
constexpr int RING_BYTES = 131072, MISC_OFF = RING_BYTES + 320, LDS_BYTES = 147456;
constexpr int NPHASE = 25;
__device__ __forceinline__ bool phase_active(int ph) { if (ph == 0) return true; const int l = (ph - 1) / 12, k = (ph - 1) % 12; if (k == 0) return l == 0; if (k == 8) return l == 1; return true; }

__device__ __forceinline__ const float* inp(const Args& a, int i) { asm volatile("" : "+s"(i)); return (const float*)a.in[i]; }
__global__ void __launch_bounds__(NWAVES * 64, 2) mk_fwd(Args args) {
    extern __shared__ __attribute__((aligned(16))) unsigned char lds[];
    LAS unsigned char* L = (LAS unsigned char*)lds;
    volatile LAS unsigned* MISC = (volatile LAS unsigned*)(L + MISC_OFF);
    const int tid0 = threadIdx.x;
    const int G = gridDim.x, NGW = G * NWAVES;
    for (int u = tid0; u < (LDS_BYTES - RING_BYTES) / 4; u += NWAVES * 64) ((LAS unsigned*)(L + RING_BYTES))[u] = 0u;
    __syncthreads();
    unsigned char* ws = args.ws;
    XcdBarrier bar; bar.bar = (unsigned*)(ws + W_CTL) + 1024; bar.x = 0; bar.st = nullptr;
    if (args.ph_hi - args.ph_lo > 1) bar = xcd_barrier_post((unsigned*)(ws + W_CTL) + 1024, MISC + 8);
    if (args.never) cooperative_groups::this_grid().sync();
#define INF(i) (inp(args, (i)))
#define x_in INF(0)
#define out (args.out)
#define MOD ((float*)(ws + W_MOD))
#define CS4 ((const f32x4*)(ws + W_CS))
#define XN ((bf16*)(ws + W_XN))
#define Yb ((bf16*)(ws + W_Y))
#define MIX ((bf16*)(ws + W_MIX))
#define RQ ((bf16*)(ws + W_RQ))
#define RK ((bf16*)(ws + W_RK))
#define RKT ((bf16*)(ws + W_RKT))
#define RVT ((bf16*)(ws + W_RVT))
#define RG ((bf16*)(ws + W_RG))
#define UC ((bf16*)(ws + W_UC))
#define CQ ((bf16*)(ws + W_CQ))
#define CKV ((bf16*)(ws + W_CKV))
#define KPE ((bf16*)(ws + W_KPE))
#define Qb ((bf16*)(ws + W_Q))
#define KN ((bf16*)(ws + W_KN))
#define Vb ((bf16*)(ws + W_V))
#define Ob ((bf16*)(ws + W_O))
#define GB ((bf16*)(ws + W_G))
#define STATE ((bf16*)(ws + W_STATE))
#define HB ((bf16*)(ws + W_HB))
#define XG ((bf16*)(ws + W_XG))
#define HBM ((bf16*)(ws + W_HBM))
#define KVT ((float*)(ws + W_KVT))
#define EB ((float*)(ws + W_E))
#define SSQQ ((float*)(ws + W_SSQQ))
#define SSQKV ((float*)(ws + W_SSQKV))
#define ROWW ((float*)(ws + W_ROWW))
#define WGCNT ((int*)(ws + W_WGCNT))
#define TILE ((int*)(ws + W_TILE))
#define TOPI ((int*)(ws + W_TOP))
#define TOPW ((float*)(ws + W_TOP + 128 * 1024))
#define TPOS ((int*)(ws + W_TOP + 256 * 1024))
#define WIN ((bf16*)(ws + W_WIN + (size_t)l * (7 * MiB / 2)))
#define WOUT ((bf16*)(ws + W_WOUT + (size_t)l * 2 * MiB))
#define MW ((bf16*)(ws + W_MW + (size_t)l * 10 * MiB))
#define WEND ((bf16*)(ws + W_WEND + (size_t)l * 2 * MiB))
#define WUQ ((bf16*)(ws + W_WUQ + (size_t)l * 384 * 1024))
#define WUKV ((bf16*)(ws + W_WUKV + (size_t)l * 256 * 1024))
#define GLUW ((bf16*)(ws + W_GLUW + (size_t)l * 128 * 1024))
#define LAMC ((f32x2*)(ws + W_LAMC) + l * 1024)
#define modl (MOD + l * 2 * 6144)
    int repcnt = 0;
    for (int ph = args.ph_lo; ph < args.ph_hi; ++ph) {
        if (!phase_active(ph)) continue;
        int tid = threadIdx.x, bx = blockIdx.x; asm volatile("" : "+v"(tid), "+s"(bx));
        const int lane = tid & 63, wave = __builtin_amdgcn_readfirstlane(tid >> 6), vcu = (G % 8 == 0) ? (bx % 8) * (G / 8) + bx / 8 : bx, gw = bx * NWAVES + wave;
        const int l = ph == 0 ? 0 : (ph - 1) / 12, k = ph == 0 ? -1 : (ph - 1) % 12;
        if (ph == 0 && PH_ON(0)) {
            LAS float* scr = (LAS float*)(L + wave * 16384);
            for (int u = gw; u < 1536; u += NGW) { const int ll = u / 768, r = u % 768, n0 = (r >> 3) * 64, ks = r & 7; const float* aw = INF(3) + (size_t)ll * DM * 6144 + n0 + lane; const float* c = INF(1);
                float a0 = 0.f, a1 = 0.f;
#pragma unroll 16
                for (int kk = 0; kk < 128; ++kk) { const int kq = ks * 128 + kk; const float w = aw[(size_t)kq * 6144]; a0 += silu_fast(c[kq]) * w; a1 += silu_fast(c[DM + kq]) * w; }
                float* mp = (float*)(ws + W_MODP) + (size_t)(ks * 2 + ll) * 2 * 6144 + n0 + lane; mp[0] = a0; mp[6144] = a1; }
#define CONV(SRC, LD, KK, NN, DST, KSC, CSC) do { const int nb_ = (NN) / 32, ni_ = ((KK) / 64) * nb_; for (int it = gw; it < ni_; it += NGW) transpose_item(SRC, LD, KK, DST, KSC, CSC, scr, it / nb_, it % nb_, lane); } while (0)
            for (int ll = 0; ll < 2; ++ll) {
                CONV((SrcWin{INF(9) + (size_t)ll * DM * INC}), INC, DM, INC, (bf16*)(ws + W_WIN + (size_t)ll * (7 * MiB / 2)), nullptr, 1.f);
                CONV((SrcWuq{INF(23) + (size_t)ll * 256 * 768}), 768, 256, 768, (bf16*)(ws + W_WUQ + (size_t)ll * 384 * 1024), INF(22) + ll * 256, QSCALE);
                CONV((SrcPlain{INF(25) + (size_t)ll * 128 * 1024}), 1024, 128, 1024, (bf16*)(ws + W_WUKV + (size_t)ll * 256 * 1024), INF(24) + ll * 128, 1.f);
                CONV((SrcPlain{INF(19) + (size_t)ll * 65536}), 256, 256, 256, (bf16*)(ws + W_GLUW + (size_t)ll * 128 * 1024), nullptr, 1.f);
                CONV((SrcPlain{INF(27) + (size_t)ll * DM * DM}), DM, DM, DM, (bf16*)(ws + W_WOUT + (size_t)ll * 2 * MiB), nullptr, 1.f);
            }
            CONV((SrcGU{INF(28), INF(29)}), DFF, DM, 2 * DFF, (bf16*)(ws + W_FFUP), nullptr, 1.f);
            CONV((SrcPlain{INF(30)}), DM, DFF, DM, (bf16*)(ws + W_FFDN), nullptr, 1.f);
            for (int e = 0; e < NE; ++e) {
                CONV((SrcGU{INF(32) + (size_t)e * DM * DFF, INF(33) + (size_t)e * DM * DFF}), DFF, DM, 2 * DFF, (bf16*)(ws + W_MOEUP) + (size_t)e * 2 * DFF * DM, nullptr, 1.f);
                CONV((SrcPlain{INF(34) + (size_t)e * DFF * DM}), DM, DFF, DM, (bf16*)(ws + W_MOEDN) + (size_t)e * DM * DFF, nullptr, 1.f);
            }
#undef CONV
            { const int* pos = (const int*)INF(2); f32x2* cs = (f32x2*)(ws + W_CS);
              for (int it = gw; it < NTOK * 32 / 64; it += NGW) { const int idx = it * 64 + lane, row = idx >> 5, i = idx & 31;
                  const float inv = __builtin_amdgcn_exp2f(-(float)i * (13.287712379549449f / 32.0f)); const float ang = (float)pos[row] * inv;
                  const double rev = (double)ang * 0.15915494309189535; const float fr = (float)(rev - floor(rev));
                  cs[idx] = (f32x2){__builtin_amdgcn_cosf(fr), __builtin_amdgcn_sinf(fr)}; } }
            for (int ll = 0; ll < 2; ++ll) {
                const SsmPar P{INF(11) + ll * 1024, INF(12) + ll * 1024, INF(13) + ll * 16384, INF(14) + ll * 16384, INF(15) + ll * 16384, INF(16) + ll * 16384, INF(18) + ll * 16};
                bf16* mw = (bf16*)(ws + W_MW + (size_t)ll * 10 * MiB); bf16* we = (bf16*)(ws + W_WEND + (size_t)ll * 2 * MiB); f32x2* lc = (f32x2*)(ws + W_LAMC) + ll * 1024;
                for (int it = gw; it < 2032; it += NGW) {
                    if (it < 1008) ssm_unit_toep(P, mw, it / 63, it % 63, scr, lane);
                    else if (it < 1520) ssm_unit_cross(P, mw, lc, (it - 1008) >> 5, (it - 1008) & 31, lane);
                    else ssm_unit_end(P, we, (it - 1520) >> 5, (it - 1520) & 31, lane);
                }
            }
        } else if (k == 0 && PH_ON(1)) {
            { const float* mp = (const float*)(ws + W_MODP);
              if (tid < 96) { const int idx = bx * 96 + tid, ll = idx / 12288, n = idx % 6144; float s = INF(4)[ll * 6144 + n];
#pragma unroll
                  for (int ks = 0; ks < 8; ++ks) s += mp[(size_t)ks * 24576 + idx];
                  MOD[idx] = s; }
              LAS float* ml = (LAS float*)L; const int b = (bx * 64) / SEQ;
              for (int n = tid; n < 2048; n += NWAVES * 64) { float s = INF(4)[n];
#pragma unroll
                  for (int ks = 0; ks < 8; ++ks) s += mp[(size_t)ks * 24576 + b * 6144 + n];
                  ml[n] = s; }
              __syncthreads(); }
            for (int i = 0; i < 8; ++i) { const int row = bx * 64 + wave * 8 + i; const float* md = (const float*)lds;
                const Row xr = row_ld_f32(x_in + (size_t)row * DM, lane); (void)adaln(xr, INF(5) + l * DM, md + 1 * DM, md + 0 * DM, XN + (size_t)row * DM, lane); }
        } else if (k == 1 && PH_ON(2)) {
            pg8::Gemm g{DM, DM, DM}; pg8::TileOrder S; S.init(XN, DM, WIN, DM, 64, 7, G, bx);
            EpiWin E{RQ, RK, RKT, RVT, RG, UC, CQ, CKV, KPE, SSQQ, SSQKV, CS4};
            pg8::gemm_phase<EpiWin, pg8::TileOrder, true>(L, g, S, E);
        } else if (k == 2 && PH_ON(3)) {
            if (SUB_ON(0)) { pg8::Gemm g{256, 256, 256}; pg8::TileOrder S; S.init(CQ, 256, WUQ, 256, 64, 3, G, bx); EpiQup E{Qb, SSQQ, CS4}; pg8::gemm_phase<EpiQup, pg8::TileOrder, true, true>(L, g, S, E); }
            if (SUB_ON(1)) { pg8::Gemm g{128, 128, 128}; pg8::TileOrder S; S.init(CKV, 128, WUKV, 128, 64, 4, G, (bx + 64) % G); EpiKVup E{KN, Vb, SSQKV}; pg8::gemm_phase<EpiKVup, pg8::TileOrder, true, true>(L, g, S, E); }
            if (SUB_ON(2)) { pg8::Gemm g{SSM_K, 512, 512}; pg8::GroupOrder S; S.init(UC, SSM_K, (size_t)SSM_NCH * SSM_K * 2, WEND, 512, (size_t)128 * 512 * 2, 16, 2, 1, G, (bx + 64) % G);
              EpiSsmE E{UC, LAMC}; pg8::gemm_phase<EpiSsmE, pg8::GroupOrder, false, true>(L, g, S, E); }
            if (SUB_ON(3)) { const ret::Tensors T{RQ, RK, RKT, RVT, RG, KVT, STATE, MIX, INF(10) + l * 256};
              for (int u = gw; u < 1024; u += NGW) ret::x_unit(u, T, lane); }
        } else if (k == 3 && PH_ON(4)) {
            { const ret::Tensors T{RQ, RK, RKT, RVT, RG, KVT, STATE, MIX, INF(10) + l * 256}; if (tid < 128) ret::scan_elem(bx * 128 + tid, T); }
            __syncthreads();
            { const att::Tensors T{Qb, KN, KPE, Vb, Ob}; const int bh = vcu >> 5, xx = vcu & 31;
#if defined(MK_ABL)
              if (repcnt > 0) { const att::Tensors T2{Qb, KN, KPE, Vb, Yb}; att::attn_unit<MK_ABL>(bh >> 2, bh & 3, 63 - xx, T2, (char*)lds); att::attn_unit<MK_ABL>(bh >> 2, bh & 3, xx, T2, (char*)lds); } else
#endif
              { att::attn_unit<0>(bh >> 2, bh & 3, 63 - xx, T, (char*)lds); att::attn_unit<0>(bh >> 2, bh & 3, xx, T, (char*)lds); } }
        } else if (k == 4 && PH_ON(5)) {
            if (SUB_ON(4)) { pg8::Gemm g{SSM_K, SSM_K, SSM_K}; pg8::GroupOrder S; S.init(UC, SSM_K, (size_t)SSM_NCH * SSM_K * 2, MW, SSM_K, (size_t)512 * SSM_K * 2, 16, 2, 2, G, bx);
              EpiSsmZ E{GB, UC, INF(17) + l * 256}; pg8::gemm_phase<EpiSsmZ, pg8::GroupOrder, false, true>(L, g, S, E); }
            if (SUB_ON(5) && bx >= 64) { const ret::Tensors T{RQ, RK, RKT, RVT, RG, KVT, STATE, MIX, INF(10) + l * 256}; for (int u = (bx - 64) * NWAVES + wave; u < 1024; u += (G - 64) * NWAVES) ret::z_unit(u, T, lane); }
            if (SUB_ON(6) && bx >= 64) for (int row = (bx - 64) * NWAVES + wave; row < NTOK; row += (G - 64) * NWAVES) { const u32x4 w = *(const u32x4*)(Ob + (size_t)row * 512 + 8 * lane);
                const f32x4 a = {bflo(w.x), bfhi(w.x), bflo(w.y), bfhi(w.y)}, c = {bflo(w.z), bfhi(w.z), bflo(w.w), bfhi(w.w)};
                float ss = (a[0] * a[0] + a[1] * a[1]) + (a[2] * a[2] + a[3] * a[3]) + (c[0] * c[0] + c[1] * c[1]) + (c[2] * c[2] + c[3] * c[3]); ss = wave_sum(ss);
                const float rstd = __builtin_amdgcn_rsqf(ss * (1.f / 512.f) + EPS); const float* gn = INF(26) + l * 512 + 8 * lane;
                st16(MIX + (size_t)row * DM + 512 + 8 * lane, a * rstd * *(const f32x4*)gn, c * rstd * *(const f32x4*)(gn + 4)); }
        } else if (k == 5 && PH_ON(6)) {
            if (wave < 2) glu_unit(bx + 256 * wave, GB, GLUW, INF(20) + l * 256, INF(21) + l * 256, MIX, lane);
        } else if (k == 6 && PH_ON(7)) {
            pg8::Gemm g{DM, DM, DM}; pg8::TileOrder S; S.init(MIX, DM, WOUT, DM, 64, 4, G, bx); EpiStore E{Yb, DM, nullptr};
            pg8::gemm_phase<EpiStore, pg8::TileOrder, false>(L, g, S, E);
        } else if (k == 7 && PH_ON(8)) {
            LAS int* cnt = (LAS int*)L;
            if (l == 1) { if (tid < 8) cnt[tid] = 0; __syncthreads(); }
            const float* xsrc = l == 0 ? x_in : out;
            for (int i = 0; i < 8; ++i) { const int row = bx * 64 + wave * 8 + i, b = row / SEQ; const float* md = modl + b * 6144;
                const Row xr = row_ld_f32(xsrc + (size_t)row * DM, lane), yr = row_ld_bf16(Yb + (size_t)row * DM, lane);
                const Row x1 = resid(xr, yr, INF(6) + l * DM, md + 2 * DM, out + (size_t)row * DM, lane);
                const Row h = adaln(x1, INF(7) + l * DM, md + 4 * DM, md + 3 * DM, XN + (size_t)row * DM, lane);
                if (l == 1) { int e1, e2; float w1, w2; route(h, INF(31), lane, e1, e2, w1, w2);
                    if (lane == 0) { TOPI[row * 2] = e1; TOPI[row * 2 + 1] = e2; TOPW[row * 2] = w1; TOPW[row * 2 + 1] = w2; __hip_atomic_fetch_add(&cnt[e1], 1, __ATOMIC_RELAXED, __HIP_MEMORY_SCOPE_WORKGROUP); __hip_atomic_fetch_add(&cnt[e2], 1, __ATOMIC_RELAXED, __HIP_MEMORY_SCOPE_WORKGROUP); } } }
            if (l == 1) { __syncthreads(); if (tid < 8) WGCNT[bx * 8 + tid] = cnt[tid]; }
        } else if (k == 8 && PH_ON(9)) {
            LAS int* sc = (LAS int*)L;
            for (int i = tid; i < 2048; i += NWAVES * 64) sc[i] = WGCNT[i];
            __syncthreads();
            if (tid < 8) { int base = 0, tot = 0; for (int w = 0; w < G; ++w) { const int c = sc[w * 8 + tid]; if (w < bx) base += c; tot += c; } sc[2048 + tid] = base; sc[2064 + tid] = tot; }
            __syncthreads();
            if (tid == 0) { int st = 0, nt = 0;
#pragma unroll 1
                for (int e = 0; e < 8; ++e) { sc[2056 + e] = st; const int t = (sc[2064 + e] + 255) >> 8; if (bx == 0) for (int q = 0; q < t; ++q) TILE[16 + nt + q] = e; nt += t; st += t << 8; } if (bx == 0) TILE[0] = nt; }
            __syncthreads();
            if (wave == 0) { const int row = bx * 64 + lane; const int e1 = TOPI[row * 2], e2 = TOPI[row * 2 + 1]; int p1 = 0, p2 = 0;
                const unsigned long long lt = (1ull << lane) - 1ull;
#pragma unroll
                for (int e = 0; e < 8; ++e) { const unsigned long long m1 = __ballot(e1 == e), m2 = __ballot(e2 == e); const int r = __popcll(m1 & lt) + __popcll(m2 & lt) + sc[2056 + e] + sc[2048 + e];
                    if (e1 == e) p1 = r; if (e2 == e) p2 = r; }
                sc[2080 + lane * 2] = p1; sc[2080 + lane * 2 + 1] = p2; TPOS[row * 2] = p1; TPOS[row * 2 + 1] = p2; ROWW[p1] = TOPW[row * 2]; ROWW[p2] = TOPW[row * 2 + 1]; }
            __syncthreads();
            for (int i = 0; i < 8; ++i) { const int lr = wave * 8 + i, row = bx * 64 + lr; const int p1 = sc[2080 + lr * 2], p2 = sc[2080 + lr * 2 + 1];
                const u32x4 a = *(const u32x4*)(XN + (size_t)row * DM + 8 * lane), c = *(const u32x4*)(XN + (size_t)row * DM + 512 + 8 * lane);
                *(u32x4*)(XG + (size_t)p1 * DM + 8 * lane) = a; *(u32x4*)(XG + (size_t)p1 * DM + 512 + 8 * lane) = c;
                *(u32x4*)(XG + (size_t)p2 * DM + 8 * lane) = a; *(u32x4*)(XG + (size_t)p2 * DM + 512 + 8 * lane) = c; }
            if (bx < 8) { const int tot = sc[2064 + bx], st = sc[2056 + bx], pe = st + (((tot + 255) >> 8) << 8);
                for (int r = st + tot + wave; r < pe; r += NWAVES) { const u32x4 z = {0u, 0u, 0u, 0u}; *(u32x4*)(XG + (size_t)r * DM + 8 * lane) = z; *(u32x4*)(XG + (size_t)r * DM + 512 + 8 * lane) = z; if (lane == 0) ROWW[r] = 0.f; } }
        } else if (k == 9 && PH_ON(10)) {
            pg8::Gemm g{DM, DM, DM}; pg8::TileOrder S;
            if (l == 0) S.init(XN, DM, (bf16*)(ws + W_FFUP), DM, 64, 28, G, bx);
            else { S.init(XG, DM, (bf16*)(ws + W_MOEUP), DM, TILE[0], 28, G, bx); S.texp = TILE + 16; S.b_e = (size_t)2 * DFF * DM * 2; }
            EpiSwiglu E{l == 0 ? HB : HBM};
            pg8::gemm_phase<EpiSwiglu, pg8::TileOrder, true>(L, g, S, E);
        } else if (k == 10 && PH_ON(11)) {
            pg8::Gemm g{DFF, DFF, DFF}; pg8::TileOrder S; EpiStore E{Yb, DM, nullptr};
            if (l == 0) S.init(HB, DFF, (bf16*)(ws + W_FFDN), DFF, 64, 4, G, bx);
            else { S.init(HBM, DFF, (bf16*)(ws + W_MOEDN), DFF, TILE[0], 4, G, bx); S.texp = TILE + 16; S.b_e = (size_t)DM * DFF * 2; E.O = XG; E.rowscale = ROWW; }
            pg8::gemm_phase<EpiStore, pg8::TileOrder, true>(L, g, S, E);
        } else if (k == 11 && PH_ON(12)) {
            for (int i = 0; i < 8; ++i) { const int row = bx * 64 + wave * 8 + i, b = row / SEQ; const float* md = modl + b * 6144;
                const Row xr = row_ld_f32(out + (size_t)row * DM, lane); Row yr;
                if (l == 0) yr = row_ld_bf16(Yb + (size_t)row * DM, lane);
                else { const int p1 = TPOS[row * 2], p2 = TPOS[row * 2 + 1]; const Row ya = row_ld_bf16(XG + (size_t)p1 * DM, lane), yb = row_ld_bf16(XG + (size_t)p2 * DM, lane);
#pragma unroll
                    for (int j = 0; j < 4; ++j) yr.v[j] = ya.v[j] + yb.v[j]; }
                const Row x2 = resid(xr, yr, INF(8) + l * DM, md + 5 * DM, out + (size_t)row * DM, lane);
                if (l == 0) { const float* md1 = MOD + 2 * 6144 + b * 6144; (void)adaln(x2, INF(5) + DM, md1 + 1 * DM, md1 + 0 * DM, XN + (size_t)row * DM, lane); } }
        }
        bool more = false; for (int q = ph + 1; q < args.ph_hi; ++q) more |= phase_active(q);
        if (more) xcd_barrier(bar);
        if (MK_REP_MASK != 0) { if ((((unsigned)MK_REP_MASK >> ph) & 1u) && repcnt + 1 < MK_REP_N) { ++repcnt; --ph; } else repcnt = 0; }
    }
#undef INF
#undef MOD
#undef Qb
#undef Vb
#undef Ob
#undef Yb
#undef out
#undef modl
}
}
#ifndef MK_PER_PHASE
#define MK_PER_PHASE 0
#endif
static int mk_setup() {
    static int grid = 0;
    if (grid == 0) {
        int dev = 0, cus = 0, per_cu = 0;
        if (hipGetDevice(&dev) != hipSuccess || hipDeviceGetAttribute(&cus, hipDeviceAttributeMultiprocessorCount, dev) != hipSuccess) { fprintf(stderr, "kernel_launch: device query failed\n"); grid = -1; return grid; }
        if (hipFuncSetAttribute((const void*)mk::mk_fwd, hipFuncAttributeMaxDynamicSharedMemorySize, mk::LDS_BYTES) != hipSuccess) { fprintf(stderr, "kernel_launch: hipFuncSetAttribute failed\n"); grid = -1; return grid; }
        if (hipOccupancyMaxActiveBlocksPerMultiprocessor(&per_cu, (const void*)mk::mk_fwd, mk::NWAVES * 64, mk::LDS_BYTES) != hipSuccess || per_cu < 1) fprintf(stderr, "kernel_launch: occupancy query reports %d blocks per CU\n", per_cu);
        (void)hipGetLastError();
        grid = cus;
        if (grid != 256) fprintf(stderr, "kernel_launch: this kernel is written for a 256-CU device (got %d)\n", grid);
    }
    return grid;
}
static void mk_launch(void* const* d_in, void* d_out, void* d_ws, hipStream_t stream, int lo, int hi, bool coop) {
    const int grid = mk_setup(); if (grid <= 0) return;
    mk::Args a{};
    for (int i = 0; i < 35; ++i) a.in[i] = d_in[i];
    a.out = (float*)d_out; a.ws = (unsigned char*)d_ws; a.ph_lo = lo; a.ph_hi = hi; a.never = 0; a.pad = 0;
    if (coop) { void* args[] = {&a}; hipError_t e = hipLaunchCooperativeKernel((const void*)mk::mk_fwd, dim3(grid), dim3(mk::NWAVES * 64), args, mk::LDS_BYTES, stream);
        if (e != hipSuccess) fprintf(stderr, "cooperative launch failed: %s (grid %d)\n", hipGetErrorString(e), grid); }
    else hipLaunchKernelGGL(mk::mk_fwd, dim3(grid), dim3(mk::NWAVES * 64), mk::LDS_BYTES, stream, a);
}
extern "C" void kernel_launch(void* const* d_in, const int* in_sizes, int n_in, void* d_out, int out_size, void* d_ws, size_t ws_size, hipStream_t stream) {
    (void)in_sizes; (void)n_in; (void)out_size;
    if (ws_size < mk::W_END) { fprintf(stderr, "kernel_launch: workspace too small (%zu < %zu)\n", ws_size, (size_t)mk::W_END); return; }
    (void)hipMemsetAsync((char*)d_ws + mk::W_CTL, 0, mk::CTL_ZERO_BYTES, stream);
#if MK_PER_PHASE
    for (int ph = 0; ph < mk::NPHASE; ++ph) mk_launch(d_in, d_out, d_ws, stream, ph, ph + 1, false);
#else
    mk_launch(d_in, d_out, d_ws, stream, 0, mk::NPHASE, true);
#endif
}
```

```cpp
#include <hip/hip_runtime.h>
#include <stdint.h>
#include <math.h>
#include <cstdio>
#include <hip/hip_cooperative_groups.h>
#define GAS __attribute__((address_space(1)))
#define LAS __attribute__((address_space(3)))
namespace mk {
typedef unsigned short bf16;
typedef short bf16x8 __attribute__((ext_vector_type(8)));
typedef short s16x4 __attribute__((ext_vector_type(4)));
typedef float f32x2 __attribute__((ext_vector_type(2)));
typedef float f32x4 __attribute__((ext_vector_type(4)));
typedef float f32x16 __attribute__((ext_vector_type(16)));
typedef unsigned u32x2 __attribute__((ext_vector_type(2)));
typedef unsigned u32x4 __attribute__((ext_vector_type(4)));
typedef __bf16 bf16x2_t __attribute__((ext_vector_type(2)));
typedef GAS unsigned gu32;
#define RLX_AGENT __ATOMIC_RELAXED, __HIP_MEMORY_SCOPE_AGENT
__device__ __forceinline__ unsigned cvtpk(float lo, float hi) { f32x2 v = {lo, hi}; bf16x2_t b = __builtin_convertvector(v, bf16x2_t); return __builtin_bit_cast(unsigned, b); }
__device__ __forceinline__ float bf2f(unsigned short b) { return __builtin_bit_cast(float, (unsigned)b << 16); }
__device__ __forceinline__ float bflo(unsigned w) { return __builtin_bit_cast(float, w << 16); }
__device__ __forceinline__ float bfhi(unsigned w) { return __builtin_bit_cast(float, w & 0xffff0000u); }
__device__ __forceinline__ float wave_sum(float v) {
#pragma unroll
    for (int o = 1; o < 64; o <<= 1) v += __shfl_xor(v, o);
    return v;
}
__device__ __forceinline__ float fast_sigmoid(float z) { return __builtin_amdgcn_rcpf(1.f + __builtin_amdgcn_exp2f(-1.4426950408889634f * z)); }
__device__ __forceinline__ float silu_fast(float v) { return v * fast_sigmoid(v); }
__device__ __forceinline__ float gelu_tanh_fast(float x) { const float a = 0.7978845608028654f * (x + 0.044715f * x * x * x); return x * fast_sigmoid(2.f * a); }

constexpr int NB = 2, SEQ = 8192, NTOK = 16384, DM = 1024, INC = 1728, INCP = 1792, DFF = 3584, NE = 8, NWAVES = 8;
constexpr float EPS = 1e-6f;
constexpr int SSM_C = 32, SSM_NCH = NTOK / SSM_C  , SSM_K = 640;
constexpr int RET_C = 64, RET_NCH = SEQ / RET_C  ;
constexpr int MOE_MAXT = 136;
constexpr float QSCALE = 0.07216878364870322f * 1.4426950408889634f;

#define XB_TMO      128
#define XB_XCNT(j)  (256  + 64 * (j))
#define XB_XSUB(j)  (1280 + 64 * (j))
#define XB_XGEN(j)  (2304 + 64 * (j))
#define XB_TOP      3328
#define XB_TOPGEN   3392
#define XCD_BAR_WORDS 3456
#define XB_SPIN_CAP (1u << 20)
__device__ __forceinline__ unsigned xb_ld(unsigned* p)              { return __hip_atomic_load(p, __ATOMIC_RELAXED, __HIP_MEMORY_SCOPE_AGENT); }
__device__ __forceinline__ unsigned xb_add(unsigned* p, unsigned v) { return __hip_atomic_fetch_add(p, v, __ATOMIC_RELAXED, __HIP_MEMORY_SCOPE_AGENT); }
__device__ __forceinline__ unsigned xb_xcc_id() { return (unsigned)__builtin_amdgcn_s_getreg((3 << 11) | 20) & 0xFu; }
#define XB_SPIN(cond, bar) do { unsigned _sp = 0; while (cond) { __builtin_amdgcn_s_sleep(1); \
    if ((++_sp & 255u) == 0u) { if (xb_ld(&(bar)[XB_TMO])) break; if (_sp > XB_SPIN_CAP) { atomicAdd(&(bar)[XB_TMO], 1u); break; } } } } while (0)
struct XcdBarrier { unsigned* bar; unsigned x; volatile LAS unsigned* st; };
__device__ __forceinline__ XcdBarrier xcd_barrier_post(unsigned* bar, volatile LAS unsigned* st) {
    XcdBarrier b; b.bar = bar; b.x = xb_xcc_id(); b.st = st;
    if (threadIdx.x == 0) (void)xb_add(&bar[XB_XCNT(b.x)], 1u);
    return b;
}
__device__ __forceinline__ void xcd_barrier_complete(unsigned* bar, unsigned x, unsigned& nloc, unsigned& nx) {
    const unsigned G = gridDim.x * gridDim.y * gridDim.z;
    unsigned sum, cnt, mine, sp = 0u;
    for (;;) {
        sum = 0u; cnt = 0u; mine = 0u;
#pragma unroll
        for (unsigned j = 0; j < 16; ++j) { const unsigned c = xb_ld(&bar[XB_XCNT(j)]); sum += c; cnt += (c > 0u) ? 1u : 0u; mine = (j == x) ? c : mine; }
        if (sum == G) break;
        __builtin_amdgcn_s_sleep(1);
        if ((++sp & 255u) == 0u) { if (xb_ld(&bar[XB_TMO])) break; if (sp > XB_SPIN_CAP) { atomicAdd(&bar[XB_TMO], 1u); break; } }
    }
    nloc = mine > 0u ? mine : 1u; nx = cnt > 0u ? cnt : 1u;
}
__device__ __forceinline__ void xcd_barrier(const XcdBarrier& b) {
    asm volatile("s_waitcnt vmcnt(0)" ::: "memory");
    __syncthreads();
    if (threadIdx.x == 0) {
        unsigned* bar = b.bar;
        __builtin_amdgcn_s_waitcnt(0);
        unsigned nloc = b.st[0], nx = b.st[1];
        if (nloc == 0u) { xcd_barrier_complete(bar, b.x, nloc, nx); b.st[0] = nloc; b.st[1] = nx; }
        const unsigned old = xb_add(&bar[XB_XSUB(b.x)], 1u);
        const unsigned gen = old / nloc;
        if (old + 1u == (gen + 1u) * nloc) {
            __builtin_amdgcn_fence(__ATOMIC_RELEASE, "agent");
            asm volatile("s_waitcnt vmcnt(0)" ::: "memory");
            const unsigned og = xb_add(&bar[XB_TOP], 1u);
            const unsigned tg = og / nx;
            if (og + 1u == (tg + 1u) * nx) xb_add(&bar[XB_TOPGEN], 1u);
            else XB_SPIN(xb_ld(&bar[XB_TOPGEN]) == tg, bar);
            __builtin_amdgcn_fence(__ATOMIC_ACQUIRE, "agent");
            xb_add(&bar[XB_XGEN(b.x)], 1u);
            asm volatile("s_waitcnt vmcnt(0)" ::: "memory");
        } else {
            XB_SPIN(xb_ld(&bar[XB_XGEN(b.x)]) == gen, bar);
            __builtin_amdgcn_fence(__ATOMIC_ACQUIRE, "agent");
            asm volatile("s_waitcnt vmcnt(0)" ::: "memory");
        }
    }
    __syncthreads();
}
}
namespace pg8 {
#define PG8_LAS __attribute__((address_space(3)))
typedef unsigned short bf16_t;
typedef short bf16x8 __attribute__((ext_vector_type(8)));
typedef float f32x4 __attribute__((ext_vector_type(4)));
typedef unsigned u32x4 __attribute__((ext_vector_type(4)));
constexpr int BM = 256, BK = 64, HALF = 128, HTB = HALF * BK * 2, STAGE_BYTES = 8 * HTB, NXCD = 8, WGM = 8;
__host__ __device__ __forceinline__ int lds_byte(int r, int c) { const int st = (r >> 4) * 2 + (c >> 5), rr = r & 15, cc = c & 31, ob = rr * 64 + cc * 2; return st * 1024 + (ob ^ (((ob >> 9) & 1) << 5)); }
__host__ __device__ __forceinline__ void stage_rc(int b, int& R, int& C) { const int st = b / 1024, sb = b % 1024, swz = sb ^ (((sb >> 9) & 1) << 5); R = (st >> 1) * 16 + swz / 64; C = (st & 1) * 32 + (swz % 64) / 2; }
__host__ __device__ __forceinline__ int perm32(int rho) { const int n = rho >> 4, i = rho & 15; return 8 * (i >> 2) + 4 * n + (i & 3); }
struct Unit { const char* pA; const char* pB; int pm, pn; };
struct Gemm { int lda, ldb, K; };
struct TileOrder {
    const char* A; const char* Bt; size_t a_t, b_t, b_e, k_off; const int* texp; int nM, nN, nN0, nwg, G, c;
    __device__ __forceinline__ void init(const void* A_, int lda, const void* Bt_, int ldb, int nM_, int nN_, int G_, int c_) {
        A = (const char*)A_; Bt = (const char*)Bt_; a_t = (size_t)BM * lda * 2; b_t = (size_t)BM * ldb * 2; b_e = 0; k_off = 0; texp = nullptr; nM = nM_; nN = nN_; nN0 = nN_; nwg = nM * nN; G = G_; c = c_; }
    __device__ __forceinline__ void split_k(int ks, size_t k_off_) { nN0 = nN; nN = nN * ks; nwg = nM * nN; k_off = k_off_; }
    __device__ __forceinline__ bool next(int i, Unit& u) const {
        const long L = (long)i * G + c; if (L >= nwg) return false;
        int wgid = (int)L; { const int q = nwg / NXCD, r = nwg % NXCD, xcd = wgid % NXCD, off = wgid / NXCD; wgid = (xcd < r ? xcd * (q + 1) : r * (q + 1) + (xcd - r) * q) + off; }
        const int nig = WGM * nN, gid = wgid / nig, fm = gid * WGM, gsz = (nM - fm) < WGM ? (nM - fm) : WGM;
        u.pm = fm + ((wgid % nig) % gsz); u.pn = (wgid % nig) / gsz;
        const int ks = u.pn / nN0, pn0 = u.pn - ks * nN0;
        u.pA = A + (size_t)u.pm * a_t + (size_t)ks * k_off; u.pB = Bt + (size_t)pn0 * b_t + (size_t)ks * k_off + (texp ? (size_t)texp[u.pm] * b_e : (size_t)0); return true;
    }
    __device__ __forceinline__ void a_ready(const Unit&) const {}
    __device__ __forceinline__ void done(const Unit&) const {}
};
struct GroupOrder {
    const char* A; const char* Bt; size_t a_t, b_t, a_g, b_g; int nM, nN, nwg, G, c;
    __device__ __forceinline__ void init(const void* A_, int lda, size_t a_g_, const void* Bt_, int ldb, size_t b_g_, int ng, int nM_, int nN_, int G_, int c_) {
        A = (const char*)A_; Bt = (const char*)Bt_; a_t = (size_t)BM * lda * 2; b_t = (size_t)BM * ldb * 2; a_g = a_g_; b_g = b_g_; nM = nM_; nN = nN_; nwg = ng * nM * nN; G = G_; c = c_; }
    __device__ __forceinline__ bool next(int i, Unit& u) const {
        const long L = (long)i * G + c; if (L >= nwg) return false;
        const int per = nM * nN, g = (int)L / per, r = (int)L % per, pm = r / nN, pn = r % nN;
        u.pm = g * nM + pm; u.pn = pn; u.pA = A + (size_t)g * a_g + (size_t)pm * a_t; u.pB = Bt + (size_t)g * b_g + (size_t)pn * b_t; return true;
    }
    __device__ __forceinline__ void a_ready(const Unit&) const {}
    __device__ __forceinline__ void done(const Unit&) const {}
};
template <class Epi, class Sched, bool ALIGN_EPI = false, bool SMALLK = false>
__device__ __forceinline__ void gemm_phase(PG8_LAS unsigned char* lds, const Gemm g, const Sched& S, const Epi& E) {
    int tid_ = threadIdx.x; asm volatile("" : "+v"(tid_));
    const int tid = tid_, wid = __builtin_amdgcn_readfirstlane(tid >> 6), lane = tid & 63, wr = wid >> 2, wc = wid & 3, fr = lane & 15, fq = lane >> 4;
    int K_ = g.K; if constexpr (SMALLK) asm volatile("" : "+s"(K_));
    const int K = K_, nt = K / BK, lda = g.lda, ldb = g.ldb;
    unsigned voffA[2], voffB[2];
#pragma unroll
    for (int i = 0; i < 2; ++i) { int R, C; stage_rc(tid * 16 + i * 8192, R, C); const int Rb = Epi::PERM ? ((R & ~31) + perm32(R & 31)) : R;
        voffA[i] = (unsigned)(R * lda + C) * 2u; voffB[i] = (unsigned)(Rb * ldb + C) * 2u; }
    const size_t kstep = (size_t)(BK * 2);
    const size_t hstepA = (size_t)HALF * lda * 2, hstepB = (size_t)HALF * ldb * 2;
    const unsigned ldsw = (unsigned)wid * 1024u;
    const int aoff = lds_byte(wr * 64 + fr, fq * 8), boff = lds_byte(wc * 32 + fr, fq * 8);
#define PG8_SA(b, h) (((b) * 2 + (h)) * HTB)
#define PG8_SB(b, h) ((4 + (b) * 2 + (h)) * HTB)
#define PG8_STAGE(bufoff, gbase, voff) do { _Pragma("unroll") for (int _i = 0; _i < 2; ++_i) \
        __builtin_amdgcn_global_load_lds((const unsigned*)((const char*)(gbase) + (voff)[_i]), (PG8_LAS unsigned*)(lds + (bufoff) + ldsw + _i * 8192), 16, 0, 0); } while (0)
#define PG8_LDA(dst, b, h) do { _Pragma("unroll") for (int m = 0; m < 4; ++m) _Pragma("unroll") for (int k = 0; k < 2; ++k) dst[m][k] = *(const PG8_LAS bf16x8*)(lds + PG8_SA(b, h) + aoff + m * 2048 + k * 1024); } while (0)
#define PG8_LDB(dst, b, h) do { _Pragma("unroll") for (int n = 0; n < 2; ++n) _Pragma("unroll") for (int k = 0; k < 2; ++k) dst[n][k] = *(const PG8_LAS bf16x8*)(lds + PG8_SB(b, h) + boff + n * 2048 + k * 1024); } while (0)
#define PG8_MMA(ai, bj, At, Bt) do { __builtin_amdgcn_s_setprio(1); _Pragma("unroll") for (int m = 0; m < 4; ++m) _Pragma("unroll") for (int n = 0; n < 2; ++n) _Pragma("unroll") for (int k = 0; k < 2; ++k) \
        acc[ai][bj][m][n] = __builtin_amdgcn_mfma_f32_16x16x32_bf16(Bt[n][k], At[m][k], acc[ai][bj][m][n], 0, 0, 0); __builtin_amdgcn_s_setprio(0); } while (0)
#define PG8_WAIT_V(n) asm volatile("s_waitcnt vmcnt(" #n ")" ::: "memory")
#define PG8_WAIT_L(n) asm volatile("s_waitcnt lgkmcnt(" #n ")" ::: "memory")
#define PG8_BAR __builtin_amdgcn_s_barrier()
#define PG8_SCHED __builtin_amdgcn_sched_barrier(0)
    Unit cur, nxt; int ui = 0;
    if (!S.next(0, cur)) return;
    f32x4 acc[2][2][4][2];
#pragma unroll
    for (int a = 0; a < 2; ++a)
#pragma unroll
        for (int b = 0; b < 2; ++b)
#pragma unroll
            for (int m = 0; m < 4; ++m)
#pragma unroll
                for (int n = 0; n < 2; ++n) acc[a][b][m][n] = (f32x4){0.f, 0.f, 0.f, 0.f};
    bf16x8 At[4][2], B0[2][2], B1[2][2];
    const char* cA = cur.pA; const char* cB = cur.pB;
    S.a_ready(cur);
    {
        PG8_STAGE(PG8_SB(0, 0), cB, voffB); PG8_STAGE(PG8_SB(0, 1), cB + hstepB, voffB); PG8_STAGE(PG8_SA(0, 0), cA, voffA); PG8_STAGE(PG8_SA(0, 1), cA + hstepA, voffA);
        if (wr == 1) PG8_BAR;
        PG8_WAIT_V(2); PG8_BAR;
        PG8_STAGE(PG8_SB(1, 0), cB + kstep, voffB); PG8_STAGE(PG8_SA(1, 0), cA + kstep, voffA); PG8_STAGE(PG8_SB(1, 1), cB + hstepB + kstep, voffB);
        PG8_WAIT_V(6); PG8_BAR;
    }
    for (;;) {
        const bool has_next = S.next(ui + 1, nxt);
        const char* nA = has_next ? nxt.pA : cA; const char* nB = has_next ? nxt.pB : cB;
        for (int t = 0; t < nt; t += 2) {
            const bool last = (t == nt - 2);
            const char* a1 = cA + (size_t)(t + 1) * kstep;
            const char* a2 = last ? nA : cA + (size_t)(t + 2) * kstep; const char* b2 = last ? nB : cB + (size_t)(t + 2) * kstep;
            const char* a3 = a2 + kstep; const char* b3 = b2 + kstep;
            if (last && has_next) S.a_ready(nxt);
            {
            PG8_LDB(B0, 0, 0); PG8_LDB(B1, 0, 1); PG8_SCHED; PG8_LDA(At, 0, 0); PG8_STAGE(PG8_SA(1, 1), a1 + hstepA, voffA);
            PG8_WAIT_V(8); PG8_WAIT_L(0); PG8_BAR; PG8_MMA(0, 0, At, B0); PG8_MMA(0, 1, At, B1); PG8_BAR; PG8_SCHED;
            PG8_LDA(At, 0, 1); PG8_STAGE(PG8_SB(0, 0), b2, voffB); PG8_STAGE(PG8_SB(0, 1), b2 + hstepB, voffB); PG8_STAGE(PG8_SA(0, 0), a2, voffA);
            PG8_WAIT_V(8); PG8_WAIT_L(0); PG8_BAR; PG8_MMA(1, 0, At, B0); PG8_MMA(1, 1, At, B1); PG8_BAR; PG8_SCHED;
            PG8_LDB(B0, 1, 0); PG8_LDB(B1, 1, 1); PG8_SCHED; PG8_LDA(At, 1, 0); PG8_STAGE(PG8_SA(0, 1), a2 + hstepA, voffA);
            PG8_WAIT_V(8); PG8_WAIT_L(0); PG8_BAR; PG8_MMA(0, 0, At, B0); PG8_MMA(0, 1, At, B1); PG8_BAR; PG8_SCHED;
            PG8_LDA(At, 1, 1); PG8_STAGE(PG8_SB(1, 0), b3, voffB); PG8_STAGE(PG8_SB(1, 1), b3 + hstepB, voffB); PG8_STAGE(PG8_SA(1, 0), a3, voffA);
            PG8_WAIT_V(8); PG8_WAIT_L(0); PG8_BAR; PG8_MMA(1, 0, At, B0); PG8_MMA(1, 1, At, B1); PG8_BAR; PG8_SCHED;
            }
        }
        if constexpr (ALIGN_EPI) { if (wr == 0) PG8_BAR; }
        if constexpr (!Epi::AFTER_DRAIN) { E(acc, cur, wr, wc, fr, fq); S.done(cur); }
        if (!has_next) break;
#pragma unroll
        for (int a = 0; a < 2; ++a)
#pragma unroll
            for (int b = 0; b < 2; ++b)
#pragma unroll
                for (int m = 0; m < 4; ++m)
#pragma unroll
                    for (int n = 0; n < 2; ++n) acc[a][b][m][n] = (f32x4){0.f, 0.f, 0.f, 0.f};
        cur = nxt; cA = nA; cB = nB; ++ui;
        if constexpr (ALIGN_EPI) { if (wr == 1) PG8_BAR; }
    }
    PG8_WAIT_V(0);
    if constexpr (!ALIGN_EPI) { if (wr == 0) PG8_BAR; }
    PG8_BAR;
    if constexpr (Epi::AFTER_DRAIN) { E.fused(acc, cur, wr, wc, fr, fq, lds, wid, lane); S.done(cur); }
#undef PG8_SA
#undef PG8_SB
#undef PG8_STAGE
#undef PG8_LDA
#undef PG8_LDB
#undef PG8_MMA
#undef PG8_WAIT_V
#undef PG8_WAIT_L
#undef PG8_BAR
#undef PG8_SCHED
}
}
namespace mk {
using pg8::Unit;
typedef f32x4 Acc[2][2][4][2];
__device__ __forceinline__ void st8(bf16* p, f32x4 v) { u32x2 w; w.x = cvtpk(v[0], v[1]); w.y = cvtpk(v[2], v[3]); *(u32x2*)p = w; }
__device__ __forceinline__ void st16(bf16* p, f32x4 a, f32x4 b) { u32x4 w; w.x = cvtpk(a[0], a[1]); w.y = cvtpk(a[2], a[3]); w.z = cvtpk(b[0], b[1]); w.w = cvtpk(b[2], b[3]); *(u32x4*)p = w; }
__device__ __forceinline__ f32x4 ld4bf(const bf16* p) { const u32x2 w = *(const u32x2*)p; return (f32x4){bflo(w.x), bfhi(w.x), bflo(w.y), bfhi(w.y)}; }
__device__ __forceinline__ f32x4 rope4(f32x4 v, f32x4 cs) { return (f32x4){v[0] * cs[0] - v[1] * cs[1], v[1] * cs[0] + v[0] * cs[1], v[2] * cs[2] - v[3] * cs[3], v[3] * cs[2] + v[2] * cs[3]}; }

__device__ __forceinline__ void st_tr_pairs(bf16* T, int col0, int row, f32x4 v, bool even) {
    const float s0 = even ? v[2] : v[0], s1 = even ? v[3] : v[1];
    const float r0 = __shfl_xor(s0, 1), r1 = __shfl_xor(s1, 1);
    const int c = col0 + (even ? 0 : 2), re = row & ~1;
    const unsigned w0 = even ? cvtpk(v[0], r0) : cvtpk(r0, v[2]), w1 = even ? cvtpk(v[1], r1) : cvtpk(r1, v[3]);
    *(unsigned*)(T + (size_t)c * NTOK + re) = w0; *(unsigned*)(T + (size_t)(c + 1) * NTOK + re) = w1;
}
struct EpiWin {
    static constexpr bool PERM = true, AFTER_DRAIN = false;
    bf16 *RQ, *RK, *RKT, *RVT, *RG, *UC, *CQ, *CKV, *KPE; float *SSQQ, *SSQKV; const f32x4* CS;
    __device__ __forceinline__ void operator()(const Acc& acc, const Unit& u, int wr, int wc, int fr, int fq) const { { int t_ = threadIdx.x; asm volatile("" : "+v"(t_)); fr = t_ & 15; fq = (t_ >> 4) & 3; }
        const int pn = u.pn, row0 = u.pm * 256 + wr * 64 + fr; const bool even = (fr & 1) == 0;
        if (pn <= 1) {
#pragma unroll
            for (int ai = 0; ai < 2; ++ai)
#pragma unroll
                for (int m = 0; m < 4; ++m) { const int row = row0 + ai * 128 + m * 16; const float pl = (float)(row & (RET_C - 1));
#pragma unroll
                    for (int bj = 0; bj < 2; ++bj) { const int head = 2 * bj + (wc >> 1);
                        const float lg2 = __builtin_amdgcn_logf(1.f - __builtin_amdgcn_exp2f(-5.f - (float)head));
                        const float dec = pn == 0 ? __builtin_amdgcn_exp2f(pl * lg2) : 0.125f * __builtin_amdgcn_exp2f(-pl * lg2);
                        const int i0 = 16 * (wc & 1) + 4 * fq, col = bj * 128 + wc * 32 + 8 * fq;
                        const f32x4 o0 = rope4(acc[ai][bj][m][0], CS[((row * 32 + i0) >> 1)]) * dec, o1 = rope4(acc[ai][bj][m][1], CS[((row * 32 + i0) >> 1) + 1]) * dec;
                        st16((pn == 0 ? RQ : RK) + (size_t)row * 256 + col, o0, o1);
                        if (pn == 1) { st_tr_pairs(RKT, col, row, o0, even); st_tr_pairs(RKT, col + 4, row, o1, even); } }
                    asm volatile("" ::: "memory"); }
        } else if (pn == 2) {
#pragma unroll
            for (int ai = 0; ai < 2; ++ai)
#pragma unroll
                for (int m = 0; m < 4; ++m) { const int row = row0 + ai * 128 + m * 16;
#pragma unroll
                    for (int bj = 0; bj < 2; ++bj) { const int col = bj * 128 + wc * 32 + 8 * fq; st_tr_pairs(RVT, col, row, acc[ai][bj][m][0], even); st_tr_pairs(RVT, col + 4, row, acc[ai][bj][m][1], even); } }
        } else if (pn == 3) {
#pragma unroll
            for (int ai = 0; ai < 2; ++ai)
#pragma unroll
                for (int m = 0; m < 4; ++m) { const int row = row0 + ai * 128 + m * 16;
#pragma unroll
                    for (int bj = 0; bj < 2; ++bj) { const f32x4 v = acc[ai][bj][m][0], w = acc[ai][bj][m][1];
                        st16(RG + (size_t)row * 256 + bj * 128 + wc * 32 + 8 * fq, (f32x4){silu_fast(v[0]), silu_fast(v[1]), silu_fast(v[2]), silu_fast(v[3])}, (f32x4){silu_fast(w[0]), silu_fast(w[1]), silu_fast(w[2]), silu_fast(w[3])}); } }
        } else if (pn == 4) {
#pragma unroll
            for (int ai = 0; ai < 2; ++ai)
#pragma unroll
                for (int m = 0; m < 4; ++m) { const int row = row0 + ai * 128 + m * 16, chunk = row / SSM_C, t = row % SSM_C;
#pragma unroll
                    for (int bj = 0; bj < 2; ++bj) { const int g = 8 * bj + 2 * wc + (fq >> 1);
                        st16(UC + ((size_t)g * SSM_NCH + chunk) * SSM_K + t * 16 + 8 * (fq & 1), acc[ai][bj][m][0], acc[ai][bj][m][1]); } }
        } else if (pn == 5) {
#pragma unroll
            for (int ai = 0; ai < 2; ++ai)
#pragma unroll
                for (int m = 0; m < 4; ++m) { const int row = row0 + ai * 128 + m * 16; float ss = 0.f;
#pragma unroll
                    for (int bj = 0; bj < 2; ++bj) { const f32x4 v = acc[ai][bj][m][0], w = acc[ai][bj][m][1];
                        ss += ((v[0] * v[0] + v[1] * v[1]) + (v[2] * v[2] + v[3] * v[3])) + ((w[0] * w[0] + w[1] * w[1]) + (w[2] * w[2] + w[3] * w[3]));
                        st16(CQ + (size_t)row * 256 + bj * 128 + wc * 32 + 8 * fq, v, w); }
                    ss += __shfl_xor(ss, 16); ss += __shfl_xor(ss, 32);
                    if (fq == 0) SSQQ[row * 4 + wc] = ss; }
        } else {
#pragma unroll
            for (int ai = 0; ai < 2; ++ai)
#pragma unroll
                for (int m = 0; m < 4; ++m) { const int row = row0 + ai * 128 + m * 16;
                    const f32x4 v = acc[ai][0][m][0], w = acc[ai][0][m][1];
                    float ss = ((v[0] * v[0] + v[1] * v[1]) + (v[2] * v[2] + v[3] * v[3])) + ((w[0] * w[0] + w[1] * w[1]) + (w[2] * w[2] + w[3] * w[3]));
                    st16(CKV + (size_t)row * 128 + wc * 32 + 8 * fq, v, w);
                    ss += __shfl_xor(ss, 16); ss += __shfl_xor(ss, 32);
                    if (fq == 0) SSQKV[row * 4 + wc] = ss;
                    if (wc < 2) { const int i0 = 16 * wc + 4 * fq;
                        st16(KPE + (size_t)row * 64 + wc * 32 + 8 * fq, rope4(acc[ai][1][m][0], CS[(row * 32 + i0) >> 1]), rope4(acc[ai][1][m][1], CS[((row * 32 + i0) >> 1) + 1])); } }
        }
    }
};
struct EpiQup {
    static constexpr bool PERM = false, AFTER_DRAIN = false;
    bf16* Q; const float* SSQ; const f32x4* CS;
    __device__ __forceinline__ void operator()(const Acc& acc, const Unit& u, int wr, int wc, int fr, int fq) const { { int t_ = threadIdx.x; asm volatile("" : "+v"(t_)); fr = t_ & 15; fq = (t_ >> 4) & 3; }
        const int row0 = u.pm * 256 + wr * 64 + fr;
#pragma unroll
        for (int ai = 0; ai < 2; ++ai)
#pragma unroll
            for (int m = 0; m < 4; ++m) { const int row = row0 + ai * 128 + m * 16; const f32x4 s4 = *(const f32x4*)(SSQ + row * 4);
                const float rstd = __builtin_amdgcn_rsqf(((s4[0] + s4[1]) + (s4[2] + s4[3])) * (1.f / 256.f) + EPS);
#pragma unroll
                for (int bj = 0; bj < 2; ++bj) { const bool rope = ((4 * u.pn + 2 * bj + (wc >> 1)) % 3) == 2;
#pragma unroll
                    for (int n = 0; n < 2; ++n) { f32x4 v = acc[ai][bj][m][n] * rstd;
                        if (rope) { const int i0 = 16 * (wc & 1) + 8 * n + 2 * fq; v = rope4(v, CS[(row * 32 + i0) >> 1]); }
                        st8(Q + (size_t)row * 768 + u.pn * 256 + bj * 128 + wc * 32 + n * 16 + fq * 4, v); } }
                asm volatile("" ::: "memory"); }
    }
};
struct EpiKVup {
    static constexpr bool PERM = false, AFTER_DRAIN = false;
    bf16 *KN, *V; const float* SSQ;
    __device__ __forceinline__ void operator()(const Acc& acc, const Unit& u, int wr, int wc, int fr, int fq) const { { int t_ = threadIdx.x; asm volatile("" : "+v"(t_)); fr = t_ & 15; fq = (t_ >> 4) & 3; }
        const int row0 = u.pm * 256 + wr * 64 + fr;
#pragma unroll
        for (int ai = 0; ai < 2; ++ai)
#pragma unroll
            for (int m = 0; m < 4; ++m) { const int row = row0 + ai * 128 + m * 16; const f32x4 s4 = *(const f32x4*)(SSQ + row * 4);
                const float rstd = __builtin_amdgcn_rsqf(((s4[0] + s4[1]) + (s4[2] + s4[3])) * (1.f / 128.f) + EPS);
#pragma unroll
                for (int bj = 0; bj < 2; ++bj)
#pragma unroll
                    for (int n = 0; n < 2; ++n) st8((bj == 0 ? KN : V) + (size_t)row * 512 + u.pn * 128 + wc * 32 + n * 16 + fq * 4, acc[ai][bj][m][n] * rstd);
                asm volatile("" ::: "memory"); }
    }
};
struct EpiSsmE {
    static constexpr bool PERM = false, AFTER_DRAIN = true;
    bf16* UC; const f32x2* LAMC;
    __device__ __forceinline__ void fused(Acc& acc, const Unit& u, int wr, int wc, int fr, int fq, PG8_LAS unsigned char* lds, int wid, int lane) const { { int t_ = threadIdx.x; asm volatile("" : "+v"(t_)); fr = t_ & 15; fq = (t_ >> 4) & 3; }
        PG8_LAS float* EL = (PG8_LAS float*)lds;
        const int g = u.pm >> 1, b = u.pm & 1;
#pragma unroll
        for (int ai = 0; ai < 2; ++ai)
#pragma unroll
            for (int m = 0; m < 4; ++m) { const int ch = ai * 128 + wr * 64 + m * 16 + fr;
#pragma unroll
                for (int n = 0; n < 2; ++n) *(PG8_LAS f32x4*)(EL + ch * 128 + wc * 32 + n * 16 + fq * 4) = acc[ai][0][m][n]; }
        asm volatile("s_waitcnt lgkmcnt(0)" ::: "memory"); __builtin_amdgcn_s_barrier(); asm volatile("" ::: "memory");
        {
            const f32x2 lc = LAMC[g * 64 + lane]; f32x2 c = {0.f, 0.f};
            f32x2 loc[32];
#pragma unroll
            for (int n = 0; n < 32; ++n) { const f32x2 e2 = *(const PG8_LAS f32x2*)(EL + (wid * 32 + n) * 128 + 2 * lane); loc[n] = c; c = (f32x2){lc.x * c.x - lc.y * c.y, lc.x * c.y + lc.y * c.x} + e2; }
            f32x2 pw = {1.f, 0.f};
#pragma unroll
            for (int n = 0; n < 32; ++n) pw = (f32x2){pw.x * lc.x - pw.y * lc.y, pw.x * lc.y + pw.y * lc.x};
            asm volatile("s_waitcnt lgkmcnt(0)" ::: "memory"); __builtin_amdgcn_s_barrier(); asm volatile("" ::: "memory");
            *(PG8_LAS f32x2*)(EL + wid * 128 + 2 * lane) = c;
            asm volatile("s_waitcnt lgkmcnt(0)" ::: "memory"); __builtin_amdgcn_s_barrier(); asm volatile("" ::: "memory");
            f32x2 cin = {0.f, 0.f};
            for (int s = 0; s < wid; ++s) { const f32x2 es = *(const PG8_LAS f32x2*)(EL + s * 128 + 2 * lane); cin = (f32x2){pw.x * cin.x - pw.y * cin.y, pw.x * cin.y + pw.y * cin.x} + es; }
            bf16* up = UC + ((size_t)g * SSM_NCH + b * 256 + wid * 32) * SSM_K + 512 + 2 * lane;
            f32x2 q = cin;
#pragma unroll
            for (int n = 0; n < 32; ++n) { const f32x2 v = loc[n] + q; *(unsigned*)(up + (size_t)n * SSM_K) = cvtpk(v.x, v.y); q = (f32x2){lc.x * q.x - lc.y * q.y, lc.x * q.y + lc.y * q.x}; }
        }
        asm volatile("s_waitcnt lgkmcnt(0)" ::: "memory"); __builtin_amdgcn_s_barrier(); asm volatile("" ::: "memory");
    }
};
struct EpiSsmZ {
    static constexpr bool PERM = false, AFTER_DRAIN = false;
    bf16* G; const bf16* UC; const float* dpar;
    __device__ __forceinline__ void operator()(const Acc& acc, const Unit& u, int wr, int wc, int fr, int fq) const { { int t_ = threadIdx.x; asm volatile("" : "+v"(t_)); fr = t_ & 15; fq = (t_ >> 4) & 3; }
        const int g = u.pm >> 1, ch0 = (u.pm & 1) * 256 + wr * 64 + fr;
        const f32x4 dd = *(const f32x4*)(dpar + g * 16 + 4 * fq);
#pragma unroll
        for (int ai = 0; ai < 2; ++ai)
#pragma unroll
            for (int m = 0; m < 4; ++m) { const int chunk = ch0 + ai * 128 + m * 16;
#pragma unroll
                for (int bj = 0; bj < 2; ++bj)
#pragma unroll
                    for (int n = 0; n < 2; ++n) { const int t = u.pn * 16 + bj * 8 + wc * 2 + n;
                        const f32x4 uv = ld4bf(UC + ((size_t)g * SSM_NCH + chunk) * SSM_K + t * 16 + 4 * fq);
                        const f32x4 y = acc[ai][bj][m][n] + dd * uv;
                        st8(G + (size_t)(chunk * SSM_C + t) * 256 + g * 16 + 4 * fq, (f32x4){gelu_tanh_fast(y[0]), gelu_tanh_fast(y[1]), gelu_tanh_fast(y[2]), gelu_tanh_fast(y[3])}); } }
    }
};
struct EpiGlu {
    static constexpr bool PERM = false, AFTER_DRAIN = true;
    const bf16* G; const float *bias, *gain; bf16* MIX;
    __device__ __forceinline__ void fused(Acc& acc, const Unit& u, int wr, int wc, int fr, int fq, PG8_LAS unsigned char* lds, int wid, int lane) const { { int t_ = threadIdx.x; asm volatile("" : "+v"(t_)); fr = t_ & 15; fq = (t_ >> 4) & 3; }
        PG8_LAS float* P = (PG8_LAS float*)lds;
        const int row0 = u.pm * 256 + wr * 64 + fr;
#pragma unroll
        for (int ai = 0; ai < 2; ++ai)
#pragma unroll
            for (int m = 0; m < 4; ++m) { const int row = row0 + ai * 128 + m * 16; float ss = 0.f;
#pragma unroll
                for (int bj = 0; bj < 2; ++bj)
#pragma unroll
                    for (int n = 0; n < 2; ++n) { const int col = bj * 128 + wc * 32 + n * 16 + fq * 4; const f32x4 b4 = *(const f32x4*)(bias + col), gl = ld4bf(G + (size_t)row * 256 + col);
                        f32x4 z = acc[ai][bj][m][n] + b4;
                        z = (f32x4){gl[0] * fast_sigmoid(z[0]), gl[1] * fast_sigmoid(z[1]), gl[2] * fast_sigmoid(z[2]), gl[3] * fast_sigmoid(z[3])};
                        acc[ai][bj][m][n] = z; ss += (z[0] * z[0] + z[1] * z[1]) + (z[2] * z[2] + z[3] * z[3]); }
                ss += __shfl_xor(ss, 16); ss += __shfl_xor(ss, 32);
                if (fq == 0) P[(ai * 128 + wr * 64 + m * 16 + fr) * 4 + wc] = ss; }
        asm volatile("s_waitcnt lgkmcnt(0)" ::: "memory"); __builtin_amdgcn_s_barrier(); asm volatile("" ::: "memory");
#pragma unroll
        for (int ai = 0; ai < 2; ++ai)
#pragma unroll
            for (int m = 0; m < 4; ++m) { const int lr = ai * 128 + wr * 64 + m * 16 + fr, row = u.pm * 256 + lr;
                const float rstd = __builtin_amdgcn_rsqf(((P[lr * 4 + 0] + P[lr * 4 + 1]) + (P[lr * 4 + 2] + P[lr * 4 + 3])) * (1.f / 256.f) + EPS);
#pragma unroll
                for (int bj = 0; bj < 2; ++bj)
#pragma unroll
                    for (int n = 0; n < 2; ++n) { const int col = bj * 128 + wc * 32 + n * 16 + fq * 4; const f32x4 g4 = *(const f32x4*)(gain + col);
                        st8(MIX + (size_t)row * DM + 256 + col, acc[ai][bj][m][n] * rstd * g4); } }
        asm volatile("s_waitcnt lgkmcnt(0)" ::: "memory"); __builtin_amdgcn_s_barrier(); asm volatile("" ::: "memory");
    }
};
struct EpiStore {
    static constexpr bool PERM = true, AFTER_DRAIN = false;
    bf16* O; int ldc; const float* rowscale; size_t split_stride;
    __device__ __forceinline__ void operator()(const Acc& acc, const Unit& u, int wr, int wc, int fr, int fq) const { { int t_ = threadIdx.x; asm volatile("" : "+v"(t_)); fr = t_ & 15; fq = (t_ >> 4) & 3; }
        const int ks = u.pn >> 2, pn0 = u.pn & 3; bf16* O = this->O + (size_t)ks * split_stride;
        const int row0 = u.pm * 256 + wr * 64 + fr, col0 = pn0 * 256 + wc * 32 + 8 * fq;
#pragma unroll
        for (int ai = 0; ai < 2; ++ai)
#pragma unroll
            for (int m = 0; m < 4; ++m) { const int row = row0 + ai * 128 + m * 16; const float s = rowscale ? rowscale[row] : 1.f;
#pragma unroll
                for (int bj = 0; bj < 2; ++bj) st16(O + (size_t)row * ldc + col0 + bj * 128, acc[ai][bj][m][0] * s, acc[ai][bj][m][1] * s); }
    }
};
struct EpiSwiglu {
    static constexpr bool PERM = true, AFTER_DRAIN = false;
    bf16* H;
    __device__ __forceinline__ void operator()(const Acc& acc, const Unit& u, int wr, int wc, int fr, int fq) const { { int t_ = threadIdx.x; asm volatile("" : "+v"(t_)); fr = t_ & 15; fq = (t_ >> 4) & 3; }
        const int row0 = u.pm * 256 + wr * 64 + fr, h0 = u.pn * 128 + wc * 32 + 8 * fq;
#pragma unroll
        for (int ai = 0; ai < 2; ++ai)
#pragma unroll
            for (int m = 0; m < 4; ++m) { const int row = row0 + ai * 128 + m * 16;
                const f32x4 g0 = acc[ai][0][m][0], g1 = acc[ai][0][m][1], u0 = acc[ai][1][m][0], u1 = acc[ai][1][m][1];
                st16(H + (size_t)row * DFF + h0, (f32x4){silu_fast(g0[0]) * u0[0], silu_fast(g0[1]) * u0[1], silu_fast(g0[2]) * u0[2], silu_fast(g0[3]) * u0[3]},
                                                 (f32x4){silu_fast(g1[0]) * u1[0], silu_fast(g1[1]) * u1[1], silu_fast(g1[2]) * u1[2], silu_fast(g1[3]) * u1[3]}); }
    }
};
}
namespace att {
using namespace mk;
constexpr int KVBLK = 64, SHM_V = 64 * 128 * 2, SHM_KN = 64 * 128 * 2, SHM_KP = 64 * 64 * 2, KBUF = SHM_KN + SHM_KP;
constexpr int OFF_V = 0  , OFF_K = 3 * SHM_V  , OFF_WS = 3 * SHM_V + 2 * KBUF, LDS_BYTES = OFF_WS + NWAVES * 64 * 4;
constexpr float THR = 8.f;
#define KSWZ(row, colB) ((row) * 256 + ((colB) ^ (((row) & 7) << 4)))
#define KPSWZ(row, colB) ((row) * 128 + ((colB) ^ (((row) & 7) << 4)))
#define SBAR() __builtin_amdgcn_sched_barrier(0)
__device__ __forceinline__ int v_st(int k, int c) { const int kk = (k & ~0xC) | ((k & 4) << 1) | ((k & 8) >> 1); return ((kk >> 3) * 4 + (c >> 5)) * 512 + ((kk & 7) * 32 + (c & 31)) * 2; }
__device__ __forceinline__ int v_rd_base(int lane) { return ((lane & 3) << 3) | (((lane >> 2) & 3) << 6) | (((lane >> 4) & 1) << 5) | (((lane >> 5) & 1) << 8); }
constexpr int v_rd_off(int d0, int ks, int half) { return d0 * 512 + ks * 4096 + half * 2048; }
__device__ __forceinline__ int crow(int r, int hi) { return (r & 3) + 8 * (r >> 2) + 4 * hi; }

struct Tensors { const bf16* Q; const bf16* KN; const bf16* KP; const bf16* V; bf16* O; };

#define KFR(i) ((i) < 8 ? *reinterpret_cast<const bf16x8*>(kb[(i) & 3] + ((i) >> 2) * 128) : *reinterpret_cast<const bf16x8*>(kp0 + KPSWZ(r32, (((i) - 8) * 16 + hi * 8) * 2)))
#define PK4(P_, B__, OUT) do { unsigned a0 = cvtpk(P_[B__ + 0], P_[B__ + 1]), a1 = cvtpk(P_[B__ + 2], P_[B__ + 3]), b0 = cvtpk(P_[B__ + 4], P_[B__ + 5]), b1 = cvtpk(P_[B__ + 6], P_[B__ + 7]); \
        auto r0 = __builtin_amdgcn_permlane32_swap(a0, b0, false, false); auto r1 = __builtin_amdgcn_permlane32_swap(a1, b1, false, false); \
        u32x4 w = {r0[0], r1[0], r0[1], r1[1]}; OUT = *reinterpret_cast<bf16x8*>(&w); } while (0)
__device__ __forceinline__ void glds16(const void* gsrc, unsigned lds_dst) { unsigned keep;
    asm volatile("s_mov_b32 %0, m0\n\ts_mov_b32 m0, %2\n\ts_nop 0\n\tglobal_load_lds_dwordx4 %1, off\n\ts_mov_b32 m0, %0" : "=&s"(keep) : "v"(gsrc), "s"(lds_dst) : "memory"); }
#define WAIT_BAR(N) asm volatile("s_waitcnt vmcnt(" #N ") lgkmcnt(0)\n\ts_barrier" ::: "memory")
template <int ABL>
__device__ __forceinline__ void attn_unit(int b, int h, int qb, const Tensors& T, char* lds) {
    int tid_ = threadIdx.x; asm volatile("" : "+v"(tid_));
    const int tid = tid_, wid = __builtin_amdgcn_readfirstlane(tid >> 6), lane = tid & 63, r32 = lane & 31, hi = lane >> 5;
    const int rg = wid & 3, kh = wid >> 2;
    const size_t tok0 = (size_t)b * SEQ; const int q0 = qb * 128, NT = 2 * qb + 2;
    float* ws = (float*)(lds + OFF_WS) + wid * 64;
    const unsigned lds0 = (unsigned)(uintptr_t)lds;
    const bf16 *gk0, *gk1, *gp, *gv0, *gv1;
    { const int ra = 4 * wid + (lane >> 4), rb = ra + 32, cc = lane & 15;
      gk0 = T.KN + (tok0 + ra) * 512 + h * 128 + ((cc ^ (ra & 7)) << 3); gk1 = T.KN + (tok0 + rb) * 512 + h * 128 + ((cc ^ (rb & 7)) << 3);
      const int rp = 8 * wid + (lane >> 3), cp = lane & 7; gp = T.KP + (tok0 + rp) * 64 + ((cp ^ (rp & 7)) << 3);
      const int r8 = (lane >> 2) & 7, c8 = (lane & 3) * 8;
      { const int sub = 2 * wid + (lane >> 5), kk = (sub >> 2) * 8 + r8, key = (kk & ~0xC) | ((kk & 4) << 1) | ((kk & 8) >> 1); gv0 = T.V + (tok0 + key) * 512 + h * 128 + (sub & 3) * 32 + c8; }
      { const int sub = 2 * (wid + 8) + (lane >> 5), kk = (sub >> 2) * 8 + r8, key = (kk & ~0xC) | ((kk & 4) << 1) | ((kk & 8) >> 1); gv1 = T.V + (tok0 + key) * 512 + h * 128 + (sub & 3) * 32 + c8; } }
#define DMA_K(t, kso) do { const size_t ko_ = ABL == 1 ? (size_t)0 : (size_t)(t) * KVBLK; const unsigned d_ = (unsigned)__builtin_amdgcn_readfirstlane((int)(lds0 + OFF_K + (kso) + wid * 1024)); \
        glds16(gk0 + ko_ * 512, d_); glds16(gk1 + ko_ * 512, d_ + 8192); glds16(gp + ko_ * 64, d_ + SHM_KN); } while (0)
#define DMA_V(t, vso) do { const size_t ko_ = ABL == 1 ? (size_t)0 : (size_t)(t) * KVBLK; const unsigned d_ = (unsigned)__builtin_amdgcn_readfirstlane((int)(lds0 + OFF_V + (vso) + wid * 1024)); \
        glds16(gv0 + ko_ * 512, d_); glds16(gv1 + ko_ * 512, d_ + 8192); } while (0)
    DMA_K(0, 0); DMA_V(0, 0); DMA_K(1, KBUF); DMA_V(1, SHM_V);
    bf16x8 qr[12];
    { const bf16* qp = T.Q + (tok0 + q0 + rg * 32 + r32) * 768 + h * 192 + hi * 8;
#pragma unroll
      for (int d0 = 0; d0 < 12; ++d0) qr[d0] = *(const bf16x8*)(qp + d0 * 16);
#pragma unroll
      for (int d0 = 0; d0 < 12; ++d0) asm volatile("" : "+v"(qr[d0])); }
    float m_reg = -1e30f, l_reg = 0.f; f32x16 o[4] = {};
    const int vb0 = (int)lds0 + v_rd_base(lane) + kh * 8192;
    const int qpos = q0 + rg * 32 + r32;
    WAIT_BAR(0);
#define RESC(a) do { if (__any((a) < 1.f)) { if (hi == 0) ws[r32] = (a); asm volatile("s_waitcnt lgkmcnt(0)" ::: "memory"); \
        _Pragma("unroll") for (int d_ = 0; d_ < 4; ++d_) _Pragma("unroll") for (int r = 0; r < 16; ++r) o[d_][r] *= ws[crow(r, hi)]; } } while (0)
#define KBASES(so) const char* k0_ = lds + OFF_K + (so) + kh * 8192; const char* kp0 = lds + OFF_K + (so) + SHM_KN + kh * 4096; const char* kb[4]; \
        _Pragma("unroll") for (int dd = 0; dd < 4; ++dd) kb[dd] = k0_ + KSWZ(r32, (dd * 16 + hi * 8) * 2);
#define MASKT(P_, t_) do { const int kb_ = (t_) * KVBLK + kh * 32 + 4 * hi; const float NEG = -__builtin_inff(); \
        _Pragma("unroll") for (int r = 0; r < 16; ++r) { const int key = kb_ + (r & 3) + 8 * (r >> 2); if (key > qpos) P_[r] = NEG; } } while (0)
#define DECIDE(P_, AL_) do { float pm_ = fmaxf(fmaxf(P_[0], P_[1]), fmaxf(P_[2], P_[3])); \
        _Pragma("unroll") for (int r = 4; r < 16; r += 4) pm_ = fmaxf(pm_, fmaxf(fmaxf(P_[r], P_[r + 1]), fmaxf(P_[r + 2], P_[r + 3]))); \
        { auto rr = __builtin_amdgcn_permlane32_swap(__float_as_uint(pm_), __float_as_uint(pm_), false, false); pm_ = fmaxf(__uint_as_float(rr[0]), __uint_as_float(rr[1])); } \
        const bool ok_ = __all((pm_ - m_reg) <= THR); const float mn_ = ok_ ? m_reg : fmaxf(m_reg, pm_); AL_ = ok_ ? 1.f : __builtin_amdgcn_exp2f(m_reg - mn_); m_reg = mn_; } while (0)
    f32x16 pc, pn; float alpha;
    { KBASES(0); pc = f32x16{}; bf16x8 f0 = KFR(0), f1 = KFR(1), f2 = KFR(2), f3 = KFR(3); SBAR();
#define QS0(i, F) do { pc = __builtin_amdgcn_mfma_f32_32x32x16_bf16(F, qr[i], pc, 0, 0, 0); if ((i) + 4 < 12) F = KFR((i) + 4); SBAR(); } while (0)
      QS0(0, f0); QS0(1, f1); QS0(2, f2); QS0(3, f3); QS0(4, f0); QS0(5, f1); QS0(6, f2); QS0(7, f3); QS0(8, f0); QS0(9, f1); QS0(10, f2); QS0(11, f3);
#undef QS0
      if (0 >= NT - 2) MASKT(pc, 0);
      DECIDE(pc, alpha); }
    WAIT_BAR(0);
    int kcur = 0  , v_cur = 0, v_nxt = SHM_V, v_nxt2 = 2 * SHM_V;
    for (int t = 0; t < NT; ++t) {
        const bool more = t + 1 < NT;
        if (t + 2 < NT) DMA_K(t + 2, kcur);
        bf16x8 pa0, pa1; float ps = 0.f; const float mn = m_reg;
#define EX2(i) do { pc[2 * (i)] = __builtin_amdgcn_exp2f(pc[2 * (i)] - mn); pc[2 * (i) + 1] = __builtin_amdgcn_exp2f(pc[2 * (i) + 1] - mn); ps += pc[2 * (i)] + pc[2 * (i) + 1]; } while (0)
#define SUMFIN() do { auto rr = __builtin_amdgcn_permlane32_swap(__float_as_uint(ps), __float_as_uint(ps), false, false); ps = __uint_as_float(rr[0]) + __uint_as_float(rr[1]); l_reg = l_reg * alpha + ps; } while (0)
        if (more) {
            KBASES(KBUF - kcur); pn = f32x16{}; bf16x8 f0 = KFR(0), f1 = KFR(1), f2 = KFR(2), f3 = KFR(3); SBAR();
#define QS(i, F, FILL) do { pn = __builtin_amdgcn_mfma_f32_32x32x16_bf16(F, qr[i], pn, 0, 0, 0); if ((i) + 4 < 12) F = KFR((i) + 4); FILL; SBAR(); } while (0)
            QS(0, f0, EX2(0)); QS(1, f1, EX2(1)); QS(2, f2, EX2(2)); QS(3, f3, EX2(3)); QS(4, f0, EX2(4)); QS(5, f1, EX2(5)); QS(6, f2, EX2(6)); QS(7, f3, EX2(7));
            QS(8, f0, SUMFIN()); QS(9, f1, PK4(pc, 0, pa0)); QS(10, f2, PK4(pc, 8, pa1)); QS(11, f3, (void)0);
#undef QS
            if (t + 1 >= NT - 2) MASKT(pn, t + 1);
        } else {
            EX2(0); EX2(1); EX2(2); EX2(3); EX2(4); EX2(5); EX2(6); EX2(7); SUMFIN(); PK4(pc, 0, pa0); PK4(pc, 8, pa1); SBAR();
        }
#undef EX2
#undef SUMFIN
        RESC(alpha); SBAR();
        { const int vb = vb0 + v_cur; float alpha_n = 1.f;
#define TRRD(dst, off) asm volatile("ds_read_b64_tr_b16 %0, %1 offset:%2" : "=&v"(dst) : "v"(vb), "i"(off) : "memory")
          s16x4 l0, l1, h0, h1, l2, l3, h2, h3;
          { constexpr int b_ = v_rd_off(0, 0, 0), c_ = v_rd_off(1, 0, 0);
            TRRD(l0, b_); TRRD(h0, b_ + 2048); TRRD(l1, b_ + 4096); TRRD(h1, b_ + 6144); TRRD(l2, c_); TRRD(h2, c_ + 2048); TRRD(l3, c_ + 4096); TRRD(h3, c_ + 6144); }
          if (t + 2 < NT) DMA_V(t + 2, v_nxt2);
          asm volatile("s_waitcnt lgkmcnt(0)" ::: "memory"); SBAR();
          o[0] = __builtin_amdgcn_mfma_f32_32x32x16_bf16(pa0, (bf16x8){l0[0], l0[1], l0[2], l0[3], h0[0], h0[1], h0[2], h0[3]}, o[0], 0, 0, 0);
          o[1] = __builtin_amdgcn_mfma_f32_32x32x16_bf16(pa0, (bf16x8){l2[0], l2[1], l2[2], l2[3], h2[0], h2[1], h2[2], h2[3]}, o[1], 0, 0, 0);
          SBAR();
          o[0] = __builtin_amdgcn_mfma_f32_32x32x16_bf16(pa1, (bf16x8){l1[0], l1[1], l1[2], l1[3], h1[0], h1[1], h1[2], h1[3]}, o[0], 0, 0, 0);
          o[1] = __builtin_amdgcn_mfma_f32_32x32x16_bf16(pa1, (bf16x8){l3[0], l3[1], l3[2], l3[3], h3[0], h3[1], h3[2], h3[3]}, o[1], 0, 0, 0);
          { constexpr int b_ = v_rd_off(2, 0, 0), c_ = v_rd_off(3, 0, 0);
            TRRD(l0, b_); TRRD(h0, b_ + 2048); TRRD(l1, b_ + 4096); TRRD(h1, b_ + 6144); TRRD(l2, c_); TRRD(h2, c_ + 2048); TRRD(l3, c_ + 4096); TRRD(h3, c_ + 6144); }
          SBAR();
          if (more) DECIDE(pn, alpha_n);
          asm volatile("s_waitcnt lgkmcnt(0)" ::: "memory"); SBAR();
          o[2] = __builtin_amdgcn_mfma_f32_32x32x16_bf16(pa0, (bf16x8){l0[0], l0[1], l0[2], l0[3], h0[0], h0[1], h0[2], h0[3]}, o[2], 0, 0, 0);
          o[3] = __builtin_amdgcn_mfma_f32_32x32x16_bf16(pa0, (bf16x8){l2[0], l2[1], l2[2], l2[3], h2[0], h2[1], h2[2], h2[3]}, o[3], 0, 0, 0);
          o[2] = __builtin_amdgcn_mfma_f32_32x32x16_bf16(pa1, (bf16x8){l1[0], l1[1], l1[2], l1[3], h1[0], h1[1], h1[2], h1[3]}, o[2], 0, 0, 0);
          o[3] = __builtin_amdgcn_mfma_f32_32x32x16_bf16(pa1, (bf16x8){l3[0], l3[1], l3[2], l3[3], h3[0], h3[1], h3[2], h3[3]}, o[3], 0, 0, 0);
#undef TRRD
          alpha = alpha_n; }
        if (t + 2 < NT) WAIT_BAR(2); else WAIT_BAR(0);
        pc = pn;
        kcur = KBUF - kcur; v_cur = v_nxt; v_nxt = v_nxt2; v_nxt2 = (v_nxt2 == 2 * SHM_V) ? 0 : v_nxt2 + SHM_V;
    }
#undef RESC
#undef DMA_K
#undef DMA_V
#undef KBASES
#undef MASKT
#undef DECIDE
    float* XO = (float*)lds;
    float* XM = (float*)(lds + 65536);
    if (kh == 1) {
#pragma unroll
        for (int d0 = 0; d0 < 4; ++d0)
#pragma unroll
            for (int r = 0; r < 16; ++r) XO[((rg * 64) + d0 * 16 + r) * 64 + lane] = o[d0][r];
        if (hi == 0) { XM[rg * 32 + r32] = m_reg; XM[128 + rg * 32 + r32] = l_reg; }
    }
    __syncthreads();
    if (kh == 0) {
        const float m1 = XM[rg * 32 + r32], l1 = XM[128 + rg * 32 + r32];
        const float mn = fmaxf(m_reg, m1), a0 = __builtin_amdgcn_exp2f(m_reg - mn), a1 = __builtin_amdgcn_exp2f(m1 - mn);
        const float inv = __builtin_amdgcn_rcpf(l_reg * a0 + l1 * a1);
        if (hi == 0) { ws[r32] = a0 * inv; ws[32 + r32] = a1 * inv; }
        asm volatile("s_waitcnt lgkmcnt(0)" ::: "memory");
        bf16* Ow = T.O + (tok0 + q0 + rg * 32) * 512 + h * 128;
#pragma unroll
        for (int r = 0; r < 16; ++r) { const int orow = crow(r, hi); const float f0 = ws[orow], f1 = ws[32 + orow];
#pragma unroll
            for (int d0 = 0; d0 < 4; ++d0) { const float v = o[d0][r] * f0 + XO[((rg * 64) + d0 * 16 + r) * 64 + lane] * f1; const float vn = __shfl_xor(v, 1);
                if ((r32 & 1) == 0) *(unsigned*)(Ow + (size_t)orow * 512 + d0 * 32 + r32) = cvtpk(v, vn); } }
    }
    __syncthreads();
}
#undef WAIT_BAR
#undef KSWZ
#undef KPSWZ
#undef SBAR
}
namespace ret {
using namespace mk;
__device__ __forceinline__ int crow(int r, int hi) { return (r & 3) + 8 * (r >> 2) + 4 * hi; }
struct Tensors { const bf16 *RQ, *RK, *RKT, *RVT, *RG; float* KVT; bf16* STATE; bf16* MIX; const float* gain; };
__device__ __forceinline__ void x_unit(int u, const Tensors& T, int lane) {
    asm volatile("" : "+v"(lane));
    const int n = u & 127, bh = u >> 7, h = bh & 3, b = bh >> 2, r32 = lane & 31, hi = lane >> 5;
    const size_t tok0 = (size_t)b * SEQ + (size_t)n * RET_C;
    f32x16 acc[2][2] = {};
#pragma unroll
    for (int s = 0; s < 4; ++s) {
        bf16x8 a[2], bb[2];
#pragma unroll
        for (int i = 0; i < 2; ++i) { a[i] = *(const bf16x8*)(T.RVT + (size_t)(h * 64 + i * 32 + r32) * NTOK + tok0 + s * 16 + hi * 8);
                                      bb[i] = *(const bf16x8*)(T.RKT + (size_t)(h * 64 + i * 32 + r32) * NTOK + tok0 + s * 16 + hi * 8); }
#pragma unroll
        for (int i = 0; i < 2; ++i)
#pragma unroll
            for (int j = 0; j < 2; ++j) acc[i][j] = __builtin_amdgcn_mfma_f32_32x32x16_bf16(a[i], bb[j], acc[i][j], 0, 0, 0);
    }
    float* out = T.KVT + (size_t)u * 4096;
#pragma unroll
    for (int i = 0; i < 2; ++i)
#pragma unroll
        for (int j = 0; j < 2; ++j)
#pragma unroll
            for (int r = 0; r < 16; ++r) out[(i * 32 + crow(r, hi)) * 64 + j * 32 + r32] = acc[i][j][r];
}
__device__ __forceinline__ void scan_elem(int e, const Tensors& T) {
    const int bh = e >> 12, el = e & 4095, h = bh & 3;
    const float gam = 1.f - __builtin_amdgcn_exp2f(-5.f - (float)h), lg2 = __builtin_amdgcn_logf(gam);
    const float g64 = __builtin_amdgcn_exp2f(64.f * lg2), g63 = __builtin_amdgcn_exp2f(63.f * lg2);
    const float* kv = T.KVT + (size_t)bh * 128 * 4096 + el; bf16* st = T.STATE + (size_t)bh * 128 * 4096 + el;
    float S = 0.f;
    for (int n0 = 0; n0 < 128; n0 += 16) {
        float v[16];
#pragma unroll
        for (int i = 0; i < 16; ++i) v[i] = kv[(size_t)(n0 + i) * 4096];
#pragma unroll
        for (int i = 0; i < 16; ++i) { st[(size_t)(n0 + i) * 4096] = (bf16)(cvtpk(gam * S, 0.f) & 0xffffu); S = g64 * S + g63 * v[i]; }
    }
}
__device__ __forceinline__ void z_unit(int u, const Tensors& T, int lane) {
    asm volatile("" : "+v"(lane));
    const int n = u & 127, bh = u >> 7, h = bh & 3, b = bh >> 2, r32 = lane & 31, hi = lane >> 5;
    const size_t tok0 = (size_t)b * SEQ + (size_t)n * RET_C;
    bf16x8 qf[2][4];
#pragma unroll
    for (int qb = 0; qb < 2; ++qb)
#pragma unroll
        for (int s = 0; s < 4; ++s) qf[qb][s] = *(const bf16x8*)(T.RQ + (tok0 + qb * 32 + r32) * 256 + h * 64 + s * 16 + hi * 8);
    f32x16 o[2][2] = {};
    const bf16* stp = T.STATE + (size_t)u * 4096;
#pragma unroll
    for (int s = 0; s < 4; ++s) {
        bf16x8 a[2];
#pragma unroll
        for (int i = 0; i < 2; ++i) a[i] = *(const bf16x8*)(stp + (i * 32 + r32) * 64 + s * 16 + hi * 8);
#pragma unroll
        for (int i = 0; i < 2; ++i)
#pragma unroll
            for (int qb = 0; qb < 2; ++qb) o[i][qb] = __builtin_amdgcn_mfma_f32_32x32x16_bf16(a[i], qf[qb][s], o[i][qb], 0, 0, 0);
    }
#pragma unroll
    for (int kb = 0; kb < 2; ++kb) {
        bf16x8 kf[4];
#pragma unroll
        for (int s = 0; s < 4; ++s) kf[s] = *(const bf16x8*)(T.RK + (tok0 + kb * 32 + r32) * 256 + h * 64 + s * 16 + hi * 8);
#pragma unroll
        for (int qb = kb; qb < 2; ++qb) {
            f32x16 st = {};
#pragma unroll
            for (int s = 0; s < 4; ++s) st = __builtin_amdgcn_mfma_f32_32x32x16_bf16(kf[s], qf[qb][s], st, 0, 0, 0);
            if (kb == qb) {
#pragma unroll
                for (int r = 0; r < 16; ++r) if (crow(r, hi) > r32) st[r] = 0.f;
            }
#pragma unroll
            for (int s2 = 0; s2 < 2; ++s2) {
                u32x4 w; w.x = cvtpk(st[8 * s2 + 0], st[8 * s2 + 1]); w.y = cvtpk(st[8 * s2 + 2], st[8 * s2 + 3]); w.z = cvtpk(st[8 * s2 + 4], st[8 * s2 + 5]); w.w = cvtpk(st[8 * s2 + 6], st[8 * s2 + 7]);
                const bf16x8 pb = __builtin_bit_cast(bf16x8, w);
#pragma unroll
                for (int i = 0; i < 2; ++i) {
                    const bf16* vp = T.RVT + (size_t)(h * 64 + i * 32 + r32) * NTOK + tok0 + kb * 32 + s2 * 16 + 4 * hi;
                    const u32x2 lo = *(const u32x2*)vp, hh = *(const u32x2*)(vp + 8);
                    const u32x4 av = {lo.x, lo.y, hh.x, hh.y};
                    o[i][qb] = __builtin_amdgcn_mfma_f32_32x32x16_bf16(__builtin_bit_cast(bf16x8, av), pb, o[i][qb], 0, 0, 0);
                }
            }
        }
    }
#pragma unroll
    for (int qb = 0; qb < 2; ++qb) {
        float ss = 0.f;
#pragma unroll
        for (int i = 0; i < 2; ++i)
#pragma unroll
            for (int r = 0; r < 16; ++r) ss += o[i][qb][r] * o[i][qb][r];
        { auto rr = __builtin_amdgcn_permlane32_swap(__float_as_uint(ss), __float_as_uint(ss), false, false); ss = __uint_as_float(rr[0]) + __uint_as_float(rr[1]); }
        const float rstd = __builtin_amdgcn_rsqf(ss * (1.f / 64.f) + EPS);
        const size_t row = tok0 + qb * 32 + r32;
#pragma unroll
        for (int i = 0; i < 2; ++i)
#pragma unroll
            for (int r4 = 0; r4 < 4; ++r4) { const int dv = i * 32 + 8 * r4 + 4 * hi;
                const f32x4 gt = ld4bf(T.RG + row * 256 + h * 64 + dv), gn = *(const f32x4*)(T.gain + h * 64 + dv);
                const f32x4 v = {o[i][qb][4 * r4 + 0], o[i][qb][4 * r4 + 1], o[i][qb][4 * r4 + 2], o[i][qb][4 * r4 + 3]};
                st8(T.MIX + row * DM + h * 64 + dv, v * rstd * gn * gt); }
    }
}
}
namespace mk {
constexpr size_t MiB = 1u << 20;
constexpr size_t W_CTL = 0, CTL_ZERO_BYTES = 64 * 1024;
constexpr size_t W_WGCNT = 128 * 1024;
constexpr size_t W_TILE = 192 * 1024;
constexpr size_t W_MOD = 1 * MiB;
constexpr size_t W_LAMC = 1 * MiB + 256 * 1024;
constexpr size_t W_TOP = 1 * MiB + 512 * 1024;
constexpr size_t W_CS = 2 * MiB;
constexpr size_t W_ROWW = 6 * MiB;
constexpr size_t W_MODP = 7 * MiB;
constexpr size_t W_SSQQ = 6 * MiB + 256 * 1024, W_SSQKV = 6 * MiB + 512 * 1024;
constexpr size_t W_MOEUP = 8 * MiB, W_MOEDN = 120 * MiB;
constexpr size_t W_WIN = 176 * MiB, W_WOUT = 183 * MiB, W_FFUP = 187 * MiB, W_FFDN = 201 * MiB, W_MW = 208 * MiB, W_WEND = 228 * MiB;
constexpr size_t W_WUQ = 233 * MiB, W_WUKV = 234 * MiB, W_GLUW = 235 * MiB;
constexpr size_t W_Y = 236 * MiB, W_MIX = 268 * MiB, W_T = 300 * MiB;
constexpr size_t W_RQ = W_T, W_RK = W_T + 8 * MiB, W_RKT = W_T + 16 * MiB, W_RVT = W_T + 24 * MiB, W_RG = W_T + 32 * MiB, W_UC = W_T + 40 * MiB, W_CQ = W_T + 50 * MiB,
                 W_CKV = W_T + 58 * MiB, W_KPE = W_T + 62 * MiB, W_Q = W_T + 64 * MiB, W_KN = W_T + 88 * MiB, W_V = W_T + 104 * MiB, W_O = W_T + 120 * MiB, W_G = W_T + 136 * MiB,
                 W_KVT = W_T + 144 * MiB, W_STATE = W_T + 160 * MiB, W_E = W_T + 168 * MiB;
constexpr size_t W_HB = W_T;
constexpr size_t W_XN = 480 * MiB;
constexpr size_t W_XG = 176 * MiB;
constexpr size_t W_Y2B = 8 * MiB;
constexpr size_t W_HBM = 244 * MiB;
constexpr size_t W_END = 512 * MiB;

struct Args { const void* in[35]; float* out; unsigned char* ws; int ph_lo, ph_hi, never, pad; };

template <class SrcF>
__device__ __forceinline__ void transpose_item(const SrcF src, int ld, int K, bf16* WT, const float* kscale, float cscale, LAS float* scr, int kb, int nb, int lane) {
    const int k0 = 64 * kb, n0 = 32 * nb;
    const float* sp = src(n0 + (lane & 31));
    float tv[32];
#pragma unroll
    for (int i = 0; i < 32; ++i) tv[i] = sp[(size_t)(k0 + 2 * i + (lane >> 5)) * ld];
#pragma unroll
    for (int i = 0; i < 32; ++i) { const int kk = 2 * i + (lane >> 5); float v = tv[i] * cscale; if (kscale) v *= kscale[k0 + kk]; scr[kk * 33 + (lane & 31)] = v; }
    asm volatile("s_waitcnt lgkmcnt(0)" ::: "memory");
    const int c = lane & 7;
#pragma unroll
    for (int j = 0; j < 4; ++j) { const int n = (lane >> 3) + 8 * j; const LAS float* s = scr + (8 * c) * 33 + n;
        u32x4 o; o.x = cvtpk(s[0 * 33], s[1 * 33]); o.y = cvtpk(s[2 * 33], s[3 * 33]); o.z = cvtpk(s[4 * 33], s[5 * 33]); o.w = cvtpk(s[6 * 33], s[7 * 33]);
        *(u32x4*)(WT + (size_t)(n0 + n) * K + k0 + 8 * c) = o; }
    asm volatile("s_waitcnt lgkmcnt(0)" ::: "memory");
}
struct SrcPlain { const float* W; __device__ __forceinline__ const float* operator()(int n) const { return W + n; } };
struct SrcWin { const float* W; __device__ __forceinline__ const float* operator()(int n) const {
        const bool rp = (n < 512) || (n >= 1664); const int g = n & ~63, cg = n & 63; return W + (rp ? g + (cg >> 1) + 32 * (cg & 1) : n); } };
struct SrcWuq { const float* W; __device__ __forceinline__ const float* operator()(int n) const { const int hh = n / 192, w = n % 192; const int cg = w - 128; return W + (w < 128 ? n : hh * 192 + 128 + (cg >> 1) + 32 * (cg & 1)); } };
struct SrcGU { const float* Wg; const float* Wu; __device__ __forceinline__ const float* operator()(int n) const { const int hid = (n >> 3) * 4 + (n & 3);
        const long long du = (const char*)Wu - (const char*)Wg; return (const float*)((const char*)Wg + (((n >> 2) & 1) ? du : 0ll)) + hid; } };

__device__ __forceinline__ f32x2 lam_pow(float a_re, float a_im, float dt, float e) {
    const float mag = __builtin_amdgcn_exp2f(1.4426950408889634f * a_re * dt * e);
    const double rev = (double)(a_im * dt) * (double)e * 0.15915494309189535;
    const float fr = (float)(rev - floor(rev));
    return (f32x2){mag * __builtin_amdgcn_cosf(fr), mag * __builtin_amdgcn_sinf(fr)};
}
__device__ __forceinline__ f32x2 cmul(f32x2 a, f32x2 b) { return (f32x2){a.x * b.x - a.y * b.y, a.x * b.y + a.y * b.x}; }

template <bool GU>
__device__ __forceinline__ void xp_issue(f32x4 (&v)[8], const float* W0, const float* W1, int ld, int k0, int n0, int tid) {
#pragma unroll
    for (int i = 0; i < 8; ++i) { const int idx = tid + 512 * i, row = idx >> 6, c4 = idx & 63;
        const float* src = GU ? ((c4 < 32 ? W0 : W1) + (size_t)(k0 + row) * ld + (n0 >> 1) + 4 * (c4 & 31)) : (W0 + (size_t)(k0 + row) * ld + n0 + 4 * c4);
        v[i] = *(const f32x4*)src; }
}
template <bool GU>
__device__ __forceinline__ void xp_finish(const f32x4 (&v)[8], bf16* WT, int K, int k0, int n0, LAS float* T, int tid) {
#pragma unroll
    for (int i = 0; i < 8; ++i) { const int idx = tid + 512 * i, row = idx >> 6, c4 = idx & 63; *(LAS f32x4*)(T + row * 256 + ((4 * c4) ^ (((row >> 3) & 7) << 2))) = v[i]; }
    __syncthreads();
#pragma unroll
    for (int j = 0; j < 4; ++j) { const int id = tid + 512 * j, c = id & 7, n = id >> 3; const int col = n;
        const LAS float* s = T + (8 * c) * 256 + (col ^ (c << 2));
        u32x4 o; o.x = cvtpk(s[0], s[256]); o.y = cvtpk(s[512], s[768]); o.z = cvtpk(s[1024], s[1280]); o.w = cvtpk(s[1536], s[1792]);
        *(u32x4*)(WT + (size_t)(n0 + n) * K + k0 + 8 * c) = o; }
    __syncthreads();
}
template <bool GU>
__device__ __forceinline__ void xp_matrix(const float* W0, const float* W1, int ld, int K, int N, bf16* WT, LAS float* T, int bx, int G, int tid) {
    const int nb_ = N / 256, ni_ = (K / 64) * nb_;
    f32x4 v[8];
    int it = bx; if (it >= ni_) return;
    xp_issue<GU>(v, W0, W1, ld, 64 * (it / nb_), 256 * (it % nb_), tid);
    for (; it < ni_; it += G) {
        f32x4 w[8];
#pragma unroll
        for (int i = 0; i < 8; ++i) w[i] = v[i];
        const int nx = it + G;
        if (nx < ni_) xp_issue<GU>(v, W0, W1, ld, 64 * (nx / nb_), 256 * (nx % nb_), tid);
        xp_finish<GU>(w, WT, K, 64 * (it / nb_), 256 * (it % nb_), T, tid);
    }
}
}
namespace mk {
struct SsmPar { const float *a_re, *a_im, *b_re, *b_im, *c_re, *c_im, *log_dt; };
__device__ __forceinline__ f32x2 ssm_fw(const SsmPar& P, int g, int p, float e, bool with_f) {
    const float dt = __builtin_amdgcn_exp2f(1.4426950408889634f * P.log_dt[g]);
    const float ar = P.a_re[g * 64 + p], ai = P.a_im[g * 64 + p];
    f32x2 w = lam_pow(ar, ai, dt, e);
    if (with_f) { const f32x2 lb = lam_pow(ar, ai, dt, 1.f); const float nr = lb.x - 1.f, ni = lb.y, den = ar * ar + ai * ai;
        const f32x2 f = {(nr * ar + ni * ai) / den, (ni * ar - nr * ai) / den}; w = cmul(w, f); }
    return w;
}
__device__ __forceinline__ void ssm_unit_toep(const SsmPar& P, bf16* MW, int g, int dd, LAS float* scr, int lane) {
    const int d = dd - 31, h = lane >> 2, hp0 = (lane & 3) * 4;
    f32x4 acc = {0.f, 0.f, 0.f, 0.f};
    if (d >= 0) {
#pragma unroll
        for (int i = 0; i < 4; ++i) { const int o = 4 * (lane + 64 * i);
            *(LAS f32x4*)(scr + o) = *(const f32x4*)(P.c_re + g * 1024 + o); *(LAS f32x4*)(scr + 1024 + o) = *(const f32x4*)(P.c_im + g * 1024 + o);
            *(LAS f32x4*)(scr + 2048 + o) = *(const f32x4*)(P.b_re + g * 1024 + o); *(LAS f32x4*)(scr + 3072 + o) = *(const f32x4*)(P.b_im + g * 1024 + o); }
        const f32x2 w = ssm_fw(P, g, lane, (float)d, true);
        asm volatile("s_waitcnt lgkmcnt(0)" ::: "memory");
#pragma unroll 8
        for (int p = 0; p < 64; ++p) {
            const f32x2 wp = {__shfl(w.x, p), __shfl(w.y, p)};
            const f32x2 cm = {scr[h * 64 + p], scr[1024 + h * 64 + p]};
            const f32x2 t = cmul(cm, wp);
            const f32x4 br = *(const LAS f32x4*)(scr + 2048 + p * 16 + hp0), bi = *(const LAS f32x4*)(scr + 3072 + p * 16 + hp0);
            acc += br * t.x - bi * t.y;
        }
        asm volatile("s_waitcnt lgkmcnt(0)" ::: "memory");
    }
    const int tlo = d >= 0 ? d : 0, thi = d >= 0 ? 32 : 32 + d;
    for (int t = tlo; t < thi; ++t) st8(MW + ((size_t)g * 512 + t * 16 + h) * SSM_K + (t - d) * 16 + hp0, acc);
}
__device__ __forceinline__ void ssm_unit_cross(const SsmPar& P, bf16* MW, f32x2* LAMC, int g, int t, int lane) {
    const f32x2 lp = ssm_fw(P, g, lane, (float)(t + 1), false);
    if (t == 31) LAMC[g * 64 + lane] = lp;
#pragma unroll 4
    for (int h = 0; h < 16; ++h) { const f32x2 cm = {P.c_re[(g * 16 + h) * 64 + lane], P.c_im[(g * 16 + h) * 64 + lane]}; const f32x2 v = cmul(cm, lp);
        *(unsigned*)(MW + ((size_t)g * 512 + t * 16 + h) * SSM_K + 512 + 2 * lane) = cvtpk(v.x, -v.y); }
}
__device__ __forceinline__ void ssm_unit_end(const SsmPar& P, bf16* WEND, int g, int j, int lane) {
    const f32x2 w = ssm_fw(P, g, lane, (float)(31 - j), true);
    float re[16], im[16];
#pragma unroll
    for (int q = 0; q < 4; ++q) { const f32x4 br = *(const f32x4*)(P.b_re + (g * 64 + lane) * 16 + 4 * q), bi = *(const f32x4*)(P.b_im + (g * 64 + lane) * 16 + 4 * q);
#pragma unroll
        for (int k = 0; k < 4; ++k) { re[4 * q + k] = w.x * br[k] - w.y * bi[k]; im[4 * q + k] = w.x * bi[k] + w.y * br[k]; } }
    bf16* r0 = WEND + ((size_t)g * 128 + 2 * lane) * 512 + j * 16;
    st16(r0, (f32x4){re[0], re[1], re[2], re[3]}, (f32x4){re[4], re[5], re[6], re[7]}); st16(r0 + 8, (f32x4){re[8], re[9], re[10], re[11]}, (f32x4){re[12], re[13], re[14], re[15]});
    st16(r0 + 512, (f32x4){im[0], im[1], im[2], im[3]}, (f32x4){im[4], im[5], im[6], im[7]}); st16(r0 + 520, (f32x4){im[8], im[9], im[10], im[11]}, (f32x4){im[12], im[13], im[14], im[15]});
}
__device__ __forceinline__ void ssm_scan(int bg, const float* E, const f32x2* LAMC, bf16* UC, int lane) {
    const int b = bg >> 4, g = bg & 15;
    const f32x2 lc = LAMC[g * 64 + lane];
    f32x2 c = {0.f, 0.f};
    for (int n0 = 0; n0 < 256; n0 += 16) {
        f32x2 e[16];
#pragma unroll
        for (int i = 0; i < 16; ++i) e[i] = *(const f32x2*)(E + ((size_t)g * SSM_NCH + b * 256 + n0 + i) * 128 + 2 * lane);
#pragma unroll
        for (int i = 0; i < 16; ++i) { *(unsigned*)(UC + ((size_t)g * SSM_NCH + b * 256 + n0 + i) * SSM_K + 512 + 2 * lane) = cvtpk(c.x, c.y); c = cmul(lc, c) + e[i]; }
    }
}
struct Row { f32x4 v[4]; };
__device__ __forceinline__ Row row_ld_f32(const float* p, int lane) { Row r;
#pragma unroll
    for (int j = 0; j < 4; ++j) r.v[j] = *(const f32x4*)(p + 4 * lane + 256 * j);
    return r; }
__device__ __forceinline__ Row row_ld_bf16(const bf16* p, int lane) { Row r;
#pragma unroll
    for (int j = 0; j < 4; ++j) r.v[j] = ld4bf(p + 4 * lane + 256 * j);
    return r; }
__device__ __forceinline__ float row_ssq(const Row& r) { float s = 0.f;
#pragma unroll
    for (int j = 0; j < 4; ++j) s += (r.v[j][0] * r.v[j][0] + r.v[j][1] * r.v[j][1]) + (r.v[j][2] * r.v[j][2] + r.v[j][3] * r.v[j][3]);
    return wave_sum(s); }
__device__ __forceinline__ Row adaln(const Row& x, const float* g, const float* sc, const float* sh, bf16* xn, int lane) {
    const float rstd = __builtin_amdgcn_rsqf(row_ssq(x) * (1.f / DM) + EPS); Row o;
#pragma unroll
    for (int j = 0; j < 4; ++j) { const int c = 4 * lane + 256 * j; const f32x4 g4 = *(const f32x4*)(g + c), s4 = *(const f32x4*)(sc + c), h4 = *(const f32x4*)(sh + c);
        o.v[j] = x.v[j] * rstd * g4 * (s4 + 1.f) + h4; st8(xn + c, o.v[j]); }
    return o; }
__device__ __forceinline__ Row resid(const Row& xin, const Row& y, const float* g, const float* gt, float* xout, int lane) {
    const float rstd = __builtin_amdgcn_rsqf(row_ssq(y) * (1.f / DM) + EPS); Row o;
#pragma unroll
    for (int j = 0; j < 4; ++j) { const int c = 4 * lane + 256 * j; const f32x4 g4 = *(const f32x4*)(g + c), t4 = *(const f32x4*)(gt + c);
        o.v[j] = xin.v[j] + t4 * y.v[j] * rstd * g4; *(f32x4*)(xout + c) = o.v[j]; }
    return o; }
__device__ __forceinline__ void route(const Row& h, const float* router, int lane, int& e1, int& e2, float& w1, float& w2) {
    float acc[8];
#pragma unroll
    for (int e = 0; e < 8; ++e) acc[e] = 0.f;
#pragma unroll
    for (int j = 0; j < 4; ++j)
#pragma unroll
        for (int k = 0; k < 4; ++k) { const int c = 4 * lane + 256 * j + k; const f32x4 r0 = *(const f32x4*)(router + c * 8), r1 = *(const f32x4*)(router + c * 8 + 4); const float hv = h.v[j][k];
            acc[0] += hv * r0[0]; acc[1] += hv * r0[1]; acc[2] += hv * r0[2]; acc[3] += hv * r0[3]; acc[4] += hv * r1[0]; acc[5] += hv * r1[1]; acc[6] += hv * r1[2]; acc[7] += hv * r1[3]; }
#pragma unroll
    for (int e = 0; e < 8; ++e) acc[e] = wave_sum(acc[e]);
    e1 = 0; float v1 = acc[0];
#pragma unroll
    for (int e = 1; e < 8; ++e) if (acc[e] > v1) { v1 = acc[e]; e1 = e; }
    e2 = -1; float v2 = -__builtin_inff();
#pragma unroll
    for (int e = 0; e < 8; ++e) if (e != e1 && acc[e] > v2) { v2 = acc[e]; e2 = e; }
    const float ex = __builtin_amdgcn_exp2f(1.4426950408889634f * (v2 - v1)); w1 = 1.f / (1.f + ex); w2 = ex / (1.f + ex);
}

__device__ __forceinline__ void glu_unit(int u, const bf16* G, const bf16* GLUW, const float* bias, const float* gain, bf16* MIX, int lane) {
    asm volatile("" : "+v"(lane));
    const int r32 = lane & 31, hi = lane >> 5; const size_t tok = (size_t)u * 32 + r32;
    f32x16 acc[8] = {};
#pragma unroll 2
    for (int s = 0; s < 16; ++s) {
        const bf16x8 bf = *(const bf16x8*)(G + tok * 256 + s * 16 + hi * 8);
#pragma unroll
        for (int j = 0; j < 8; ++j) { const bf16x8 a = *(const bf16x8*)(GLUW + (size_t)(j * 32 + r32) * 256 + s * 16 + hi * 8); acc[j] = __builtin_amdgcn_mfma_f32_32x32x16_bf16(a, bf, acc[j], 0, 0, 0); }
    }
    float ss = 0.f;
#pragma unroll
    for (int j = 0; j < 8; ++j)
#pragma unroll
        for (int r4 = 0; r4 < 4; ++r4) { const int ch = j * 32 + 8 * r4 + 4 * hi; const f32x4 b4 = *(const f32x4*)(bias + ch), gl = ld4bf(G + tok * 256 + ch);
#pragma unroll
            for (int k = 0; k < 4; ++k) { const float y = gl[k] * fast_sigmoid(acc[j][4 * r4 + k] + b4[k]); acc[j][4 * r4 + k] = y; ss += y * y; } }
    { auto rr = __builtin_amdgcn_permlane32_swap(__float_as_uint(ss), __float_as_uint(ss), false, false); ss = __uint_as_float(rr[0]) + __uint_as_float(rr[1]); }
    const float rstd = __builtin_amdgcn_rsqf(ss * (1.f / 256.f) + EPS);
#pragma unroll
    for (int j = 0; j < 8; ++j)
#pragma unroll
        for (int r4 = 0; r4 < 4; ++r4) { const int ch = j * 32 + 8 * r4 + 4 * hi; const f32x4 g4 = *(const f32x4*)(gain + ch);
            st8(MIX + tok * DM + 256 + ch, (f32x4){acc[j][4 * r4 + 0], acc[j][4 * r4 + 1], acc[j][4 * r4 + 2], acc[j][4 * r4 + 3]} * rstd * g4); }
}
}
#ifndef MK_MASK
#define MK_MASK 0x1fff
#endif
#define PH_ON(n) (((MK_MASK) >> (n)) & 1)
#ifndef MK_REP_MASK
#define MK_REP_MASK 0
#endif
#ifndef MK_REP_N
#define MK_REP_N 2
#endif
#ifndef MK_SUB
#define MK_SUB 0xff
#endif
#define SUB_ON(n) (((MK_SUB) >> (n)) & 1)
namespace mk {
constexpr int RING_BYTES = 131072, MISC_OFF = RING_BYTES + 320, LDS_BYTES = 147456;
constexpr int NPHASE = 25;
__device__ __forceinline__ bool phase_active(int ph) { if (ph == 0) return true; const int l = (ph - 1) / 12, k = (ph - 1) % 12; if (k == 0) return l == 0; if (k == 8) return l == 1; return true; }

__device__ __forceinline__ const float* inp(const Args& a, int i) { asm volatile("" : "+s"(i)); return (const float*)a.in[i]; }
__global__ void __launch_bounds__(NWAVES * 64, 2) mk_fwd(Args args) {
    extern __shared__ __attribute__((aligned(16))) unsigned char lds[];
    LAS unsigned char* L = (LAS unsigned char*)lds;
    volatile LAS unsigned* MISC = (volatile LAS unsigned*)(L + MISC_OFF);
    const int tid0 = threadIdx.x;
    const int G = gridDim.x, NGW = G * NWAVES;
    for (int u = tid0; u < (LDS_BYTES - RING_BYTES) / 4; u += NWAVES * 64) ((LAS unsigned*)(L + RING_BYTES))[u] = 0u;
    __syncthreads();
    unsigned char* ws = args.ws;
    XcdBarrier bar; bar.bar = (unsigned*)(ws + W_CTL) + 1024; bar.x = 0; bar.st = nullptr;
    if (args.ph_hi - args.ph_lo > 1) bar = xcd_barrier_post((unsigned*)(ws + W_CTL) + 1024, MISC + 8);
    if (args.never) cooperative_groups::this_grid().sync();
#define INF(i) (inp(args, (i)))
#define x_in INF(0)
#define out (args.out)
#define MOD ((float*)(ws + W_MOD))
#define CS4 ((const f32x4*)(ws + W_CS))
#define XN ((bf16*)(ws + W_XN))
#define Yb ((bf16*)(ws + W_Y))
#define MIX ((bf16*)(ws + W_MIX))
#define RQ ((bf16*)(ws + W_RQ))
#define RK ((bf16*)(ws + W_RK))
#define RKT ((bf16*)(ws + W_RKT))
#define RVT ((bf16*)(ws + W_RVT))
#define RG ((bf16*)(ws + W_RG))
#define UC ((bf16*)(ws + W_UC))
#define CQ ((bf16*)(ws + W_CQ))
#define CKV ((bf16*)(ws + W_CKV))
#define KPE ((bf16*)(ws + W_KPE))
#define Qb ((bf16*)(ws + W_Q))
#define KN ((bf16*)(ws + W_KN))
#define Vb ((bf16*)(ws + W_V))
#define Ob ((bf16*)(ws + W_O))
#define GB ((bf16*)(ws + W_G))
#define STATE ((bf16*)(ws + W_STATE))
#define HB ((bf16*)(ws + W_HB))
#define XG ((bf16*)(ws + W_XG))
#define HBM ((bf16*)(ws + W_HBM))
#define KVT ((float*)(ws + W_KVT))
#define EB ((float*)(ws + W_E))
#define SSQQ ((float*)(ws + W_SSQQ))
#define SSQKV ((float*)(ws + W_SSQKV))
#define ROWW ((float*)(ws + W_ROWW))
#define WGCNT ((int*)(ws + W_WGCNT))
#define TILE ((int*)(ws + W_TILE))
#define TOPI ((int*)(ws + W_TOP))
#define TOPW ((float*)(ws + W_TOP + 128 * 1024))
#define TPOS ((int*)(ws + W_TOP + 256 * 1024))
#define WIN ((bf16*)(ws + W_WIN + (size_t)l * (7 * MiB / 2)))
#define WOUT ((bf16*)(ws + W_WOUT + (size_t)l * 2 * MiB))
#define MW ((bf16*)(ws + W_MW + (size_t)l * 10 * MiB))
#define WEND ((bf16*)(ws + W_WEND + (size_t)l * 2 * MiB))
#define WUQ ((bf16*)(ws + W_WUQ + (size_t)l * 384 * 1024))
#define WUKV ((bf16*)(ws + W_WUKV + (size_t)l * 256 * 1024))
#define GLUW ((bf16*)(ws + W_GLUW + (size_t)l * 128 * 1024))
#define LAMC ((f32x2*)(ws + W_LAMC) + l * 1024)
#define modl (MOD + l * 2 * 6144)
    int repcnt = 0;
    for (int ph = args.ph_lo; ph < args.ph_hi; ++ph) {
        if (!phase_active(ph)) continue;
        int bx = blockIdx.x; asm volatile("" : "+s"(bx));
        const int vcu = (G % 8 == 0) ? (bx % 8) * (G / 8) + bx / 8 : bx;
#define LANEDEFS int tid = threadIdx.x; asm volatile("" : "+v"(tid)); const int lane = tid & 63, wave = __builtin_amdgcn_readfirstlane(tid >> 6), gw = bx * NWAVES + wave; (void)lane; (void)wave; (void)gw;
        const int l = ph == 0 ? 0 : (ph - 1) / 12, k = ph == 0 ? -1 : (ph - 1) % 12;
        if (ph == 0 && PH_ON(0)) { LANEDEFS
            LAS float* scr = (LAS float*)(L + wave * 16384);
            for (int u = gw; u < 1536; u += NGW) { const int ll = u / 768, r = u % 768, n0 = (r >> 3) * 64, ks = r & 7; const float* aw = INF(3) + (size_t)ll * DM * 6144 + n0 + lane; const float* c = INF(1);
                float a0 = 0.f, a1 = 0.f;
#pragma unroll 16
                for (int kk = 0; kk < 128; ++kk) { const int kq = ks * 128 + kk; const float w = aw[(size_t)kq * 6144]; a0 += silu_fast(c[kq]) * w; a1 += silu_fast(c[DM + kq]) * w; }
                float* mp = (float*)(ws + W_MODP) + (size_t)(ks * 2 + ll) * 2 * 6144 + n0 + lane; mp[0] = a0; mp[6144] = a1; }
#define CONV(SRC, LD, KK, NN, DST, KSC, CSC) do { const int nb_ = (NN) / 32, ni_ = ((KK) / 64) * nb_; for (int it = gw; it < ni_; it += NGW) transpose_item(SRC, LD, KK, DST, KSC, CSC, scr, it / nb_, it % nb_, lane); } while (0)
            for (int ll = 0; ll < 2; ++ll) {
                CONV((SrcWin{INF(9) + (size_t)ll * DM * INC}), INC, DM, INC, (bf16*)(ws + W_WIN + (size_t)ll * (7 * MiB / 2)), nullptr, 1.f);
                CONV((SrcWuq{INF(23) + (size_t)ll * 256 * 768}), 768, 256, 768, (bf16*)(ws + W_WUQ + (size_t)ll * 384 * 1024), INF(22) + ll * 256, QSCALE);
                CONV((SrcPlain{INF(25) + (size_t)ll * 128 * 1024}), 1024, 128, 1024, (bf16*)(ws + W_WUKV + (size_t)ll * 256 * 1024), INF(24) + ll * 128, 1.f);
                CONV((SrcPlain{INF(19) + (size_t)ll * 65536}), 256, 256, 256, (bf16*)(ws + W_GLUW + (size_t)ll * 128 * 1024), nullptr, 1.f);
            }
#undef CONV
            __syncthreads();
            { LAS float* T = (LAS float*)L; int rot = 0;
#define XPM(GU_, W0_, W1_, LD_, KK_, NN_, DST_) do { const int ni__ = ((KK_) / 64) * ((NN_) / 256); xp_matrix<GU_>(W0_, W1_, LD_, KK_, NN_, DST_, T, (bx + G - rot % G) % G, G, tid); rot += ni__; } while (0)
              for (int ll = 0; ll < 2; ++ll) XPM(false, INF(27) + (size_t)ll * DM * DM, nullptr, DM, DM, DM, (bf16*)(ws + W_WOUT + (size_t)ll * 2 * MiB));
              XPM(true, INF(28), INF(29), DFF, DM, 2 * DFF, (bf16*)(ws + W_FFUP));
              XPM(false, INF(30), nullptr, DM, DFF, DM, (bf16*)(ws + W_FFDN));
              for (int e = 0; e < NE; ++e) {
                  XPM(true, INF(32) + (size_t)e * DM * DFF, INF(33) + (size_t)e * DM * DFF, DFF, DM, 2 * DFF, (bf16*)(ws + W_MOEUP) + (size_t)e * 2 * DFF * DM);
                  XPM(false, INF(34) + (size_t)e * DFF * DM, nullptr, DM, DFF, DM, (bf16*)(ws + W_MOEDN) + (size_t)e * DM * DFF); }
#undef XPM
            }
            { const int* pos = (const int*)INF(2); f32x2* cs = (f32x2*)(ws + W_CS);
              for (int it = gw; it < NTOK * 32 / 64; it += NGW) { const int idx = it * 64 + lane, row = idx >> 5, i = idx & 31;
                  const float inv = __builtin_amdgcn_exp2f(-(float)i * (13.287712379549449f / 32.0f)); const float ang = (float)pos[row] * inv;
                  const double rev = (double)ang * 0.15915494309189535; const float fr = (float)(rev - floor(rev));
                  cs[idx] = (f32x2){__builtin_amdgcn_cosf(fr), __builtin_amdgcn_sinf(fr)}; } }
            for (int ll = 0; ll < 2; ++ll) {
                const SsmPar P{INF(11) + ll * 1024, INF(12) + ll * 1024, INF(13) + ll * 16384, INF(14) + ll * 16384, INF(15) + ll * 16384, INF(16) + ll * 16384, INF(18) + ll * 16};
                bf16* mw = (bf16*)(ws + W_MW + (size_t)ll * 10 * MiB); bf16* we = (bf16*)(ws + W_WEND + (size_t)ll * 2 * MiB); f32x2* lc = (f32x2*)(ws + W_LAMC) + ll * 1024;
                for (int it = gw; it < 2032; it += NGW) {
                    if (it < 1008) ssm_unit_toep(P, mw, it / 63, it % 63, scr, lane);
                    else if (it < 1520) ssm_unit_cross(P, mw, lc, (it - 1008) >> 5, (it - 1008) & 31, lane);
                    else ssm_unit_end(P, we, (it - 1520) >> 5, (it - 1520) & 31, lane);
                }
            }
        } else if (k == 0 && PH_ON(1)) { LANEDEFS
            { const float* mp = (const float*)(ws + W_MODP);
              if (tid < 96) { const int idx = bx * 96 + tid, ll = idx / 12288, n = idx % 6144; float s = INF(4)[ll * 6144 + n];
#pragma unroll
                  for (int ks = 0; ks < 8; ++ks) s += mp[(size_t)ks * 24576 + idx];
                  MOD[idx] = s; }
              LAS float* ml = (LAS float*)L; const int b = (bx * 64) / SEQ;
              for (int n = tid; n < 2048; n += NWAVES * 64) { float s = INF(4)[n];
#pragma unroll
                  for (int ks = 0; ks < 8; ++ks) s += mp[(size_t)ks * 24576 + b * 6144 + n];
                  ml[n] = s; }
              __syncthreads(); }
            for (int i = 0; i < 8; ++i) { const int row = bx * 64 + wave * 8 + i; const float* md = (const float*)lds;
                const Row xr = row_ld_f32(x_in + (size_t)row * DM, lane); (void)adaln(xr, INF(5) + l * DM, md + 1 * DM, md + 0 * DM, XN + (size_t)row * DM, lane); }
        } else if (k == 1 && PH_ON(2)) {
            pg8::Gemm g{DM, DM, DM}; pg8::TileOrder S; S.init(XN, DM, WIN, DM, 64, 7, G, bx);
            EpiWin E{RQ, RK, RKT, RVT, RG, UC, CQ, CKV, KPE, SSQQ, SSQKV, CS4};
            pg8::gemm_phase<EpiWin, pg8::TileOrder, true>(L, g, S, E);
        } else if (k == 2 && PH_ON(3)) {
            if (SUB_ON(0)) { pg8::Gemm g{256, 256, 256}; pg8::TileOrder S; S.init(CQ, 256, WUQ, 256, 64, 3, G, bx); EpiQup E{Qb, SSQQ, CS4}; pg8::gemm_phase<EpiQup, pg8::TileOrder, true, true>(L, g, S, E); }
            if (SUB_ON(1)) { pg8::Gemm g{128, 128, 128}; pg8::TileOrder S; S.init(CKV, 128, WUKV, 128, 64, 4, G, (bx + 64) % G); EpiKVup E{KN, Vb, SSQKV}; pg8::gemm_phase<EpiKVup, pg8::TileOrder, true, true>(L, g, S, E); }
            if (SUB_ON(2)) { pg8::Gemm g{SSM_K, 512, 512}; pg8::GroupOrder S; S.init(UC, SSM_K, (size_t)SSM_NCH * SSM_K * 2, WEND, 512, (size_t)128 * 512 * 2, 16, 2, 1, G, (bx + 64) % G);
              EpiSsmE E{UC, LAMC}; pg8::gemm_phase<EpiSsmE, pg8::GroupOrder, false, true>(L, g, S, E); }
            if (SUB_ON(3)) { LANEDEFS const ret::Tensors T{RQ, RK, RKT, RVT, RG, KVT, STATE, MIX, INF(10) + l * 256};
              for (int u = gw; u < 1024; u += NGW) ret::x_unit(u, T, lane); }
        } else if (k == 3 && PH_ON(4)) { LANEDEFS
            { const ret::Tensors T{RQ, RK, RKT, RVT, RG, KVT, STATE, MIX, INF(10) + l * 256}; if (tid < 128) ret::scan_elem(bx * 128 + tid, T); }
            __syncthreads();
            { const att::Tensors T{Qb, KN, KPE, Vb, Ob}; const int bh = vcu >> 5, xx = vcu & 31;
#if defined(MK_ABL)
              if (repcnt > 0) { const att::Tensors T2{Qb, KN, KPE, Vb, Yb}; att::attn_unit<MK_ABL>(bh >> 2, bh & 3, 63 - xx, T2, (char*)lds); att::attn_unit<MK_ABL>(bh >> 2, bh & 3, xx, T2, (char*)lds); } else
#endif
              { att::attn_unit<0>(bh >> 2, bh & 3, 63 - xx, T, (char*)lds); att::attn_unit<0>(bh >> 2, bh & 3, xx, T, (char*)lds); } }
        } else if (k == 4 && PH_ON(5)) {
            if (SUB_ON(4)) { pg8::Gemm g{SSM_K, SSM_K, SSM_K}; pg8::GroupOrder S; S.init(UC, SSM_K, (size_t)SSM_NCH * SSM_K * 2, MW, SSM_K, (size_t)512 * SSM_K * 2, 16, 2, 2, G, bx);
              EpiSsmZ E{GB, UC, INF(17) + l * 256}; pg8::gemm_phase<EpiSsmZ, pg8::GroupOrder, false, true>(L, g, S, E); }
            LANEDEFS
            if (SUB_ON(5) && bx >= 64) { const ret::Tensors T{RQ, RK, RKT, RVT, RG, KVT, STATE, MIX, INF(10) + l * 256}; for (int u = (bx - 64) * NWAVES + wave; u < 1024; u += (G - 64) * NWAVES) ret::z_unit(u, T, lane); }
            if (SUB_ON(6) && bx >= 64) for (int row = (bx - 64) * NWAVES + wave; row < NTOK; row += (G - 64) * NWAVES) { const u32x4 w = *(const u32x4*)(Ob + (size_t)row * 512 + 8 * lane);
                const f32x4 a = {bflo(w.x), bfhi(w.x), bflo(w.y), bfhi(w.y)}, c = {bflo(w.z), bfhi(w.z), bflo(w.w), bfhi(w.w)};
                float ss = (a[0] * a[0] + a[1] * a[1]) + (a[2] * a[2] + a[3] * a[3]) + (c[0] * c[0] + c[1] * c[1]) + (c[2] * c[2] + c[3] * c[3]); ss = wave_sum(ss);
                const float rstd = __builtin_amdgcn_rsqf(ss * (1.f / 512.f) + EPS); const float* gn = INF(26) + l * 512 + 8 * lane;
                st16(MIX + (size_t)row * DM + 512 + 8 * lane, a * rstd * *(const f32x4*)gn, c * rstd * *(const f32x4*)(gn + 4)); }
        } else if (k == 5 && PH_ON(6)) { LANEDEFS
            if (wave < 2) glu_unit(bx + 256 * wave, GB, GLUW, INF(20) + l * 256, INF(21) + l * 256, MIX, lane);
        } else if (k == 6 && PH_ON(7)) {
            pg8::Gemm g{DM, DM, DM}; pg8::TileOrder S; S.init(MIX, DM, WOUT, DM, 64, 4, G, bx); EpiStore E{Yb, DM, nullptr, 0};
            pg8::gemm_phase<EpiStore, pg8::TileOrder, false>(L, g, S, E);
        } else if (k == 7 && PH_ON(8)) { LANEDEFS
            LAS int* cnt = (LAS int*)L;
            if (l == 1) { if (tid < 8) cnt[tid] = 0; __syncthreads(); }
            const float* xsrc = l == 0 ? x_in : out;
            for (int i = 0; i < 8; ++i) { const int row = bx * 64 + wave * 8 + i, b = row / SEQ; const float* md = modl + b * 6144;
                const Row xr = row_ld_f32(xsrc + (size_t)row * DM, lane), yr = row_ld_bf16(Yb + (size_t)row * DM, lane);
                const Row x1 = resid(xr, yr, INF(6) + l * DM, md + 2 * DM, out + (size_t)row * DM, lane);
                const Row h = adaln(x1, INF(7) + l * DM, md + 4 * DM, md + 3 * DM, XN + (size_t)row * DM, lane);
                if (l == 1) { int e1, e2; float w1, w2; route(h, INF(31), lane, e1, e2, w1, w2);
                    if (lane == 0) { TOPI[row * 2] = e1; TOPI[row * 2 + 1] = e2; TOPW[row * 2] = w1; TOPW[row * 2 + 1] = w2; __hip_atomic_fetch_add(&cnt[e1], 1, __ATOMIC_RELAXED, __HIP_MEMORY_SCOPE_WORKGROUP); __hip_atomic_fetch_add(&cnt[e2], 1, __ATOMIC_RELAXED, __HIP_MEMORY_SCOPE_WORKGROUP); } } }
            if (l == 1) { __syncthreads(); if (tid < 8) WGCNT[bx * 8 + tid] = cnt[tid]; }
        } else if (k == 8 && PH_ON(9)) { LANEDEFS
            LAS int* sc = (LAS int*)L;
            for (int i = tid; i < 2048; i += NWAVES * 64) sc[i] = WGCNT[i];
            __syncthreads();
            { const int e = wave; int base = 0, tot = 0;
#pragma unroll
              for (int q = 0; q < 4; ++q) { const int w = q * 64 + lane; const int c = sc[w * 8 + e]; base += (w < bx) ? c : 0; tot += c; }
#pragma unroll
              for (int o = 1; o < 64; o <<= 1) { base += __shfl_xor(base, o); tot += __shfl_xor(tot, o); }
              if (lane == 0) { sc[2048 + e] = base; sc[2064 + e] = tot; } }
            __syncthreads();
            if (tid == 0) { int st = 0, nt = 0;
#pragma unroll 1
                for (int e = 0; e < 8; ++e) { sc[2056 + e] = st; const int t = (sc[2064 + e] + 255) >> 8; if (bx == 0) for (int q = 0; q < t; ++q) TILE[16 + nt + q] = e; nt += t; st += t << 8; } if (bx == 0) TILE[0] = nt; }
            __syncthreads();
            if (wave == 0) { const int row = bx * 64 + lane; const int e1 = TOPI[row * 2], e2 = TOPI[row * 2 + 1]; int p1 = 0, p2 = 0;
                const unsigned long long lt = (1ull << lane) - 1ull;
#pragma unroll
                for (int e = 0; e < 8; ++e) { const unsigned long long m1 = __ballot(e1 == e), m2 = __ballot(e2 == e); const int r = __popcll(m1 & lt) + __popcll(m2 & lt) + sc[2056 + e] + sc[2048 + e];
                    if (e1 == e) p1 = r; if (e2 == e) p2 = r; }
                sc[2080 + lane * 2] = p1; sc[2080 + lane * 2 + 1] = p2; TPOS[row * 2] = p1; TPOS[row * 2 + 1] = p2; ROWW[p1] = TOPW[row * 2]; ROWW[p2] = TOPW[row * 2 + 1]; }
            __syncthreads();
#pragma unroll
            for (int i0 = 0; i0 < 8; i0 += 4) { u32x4 a[4], c[4];
#pragma unroll
                for (int i = 0; i < 4; ++i) { const int row = bx * 64 + wave * 8 + i0 + i; a[i] = *(const u32x4*)(XN + (size_t)row * DM + 8 * lane); c[i] = *(const u32x4*)(XN + (size_t)row * DM + 512 + 8 * lane); }
#pragma unroll
                for (int i = 0; i < 4; ++i) { const int lr = wave * 8 + i0 + i; const int p1 = sc[2080 + lr * 2], p2 = sc[2080 + lr * 2 + 1];
                    *(u32x4*)(XG + (size_t)p1 * DM + 8 * lane) = a[i]; *(u32x4*)(XG + (size_t)p1 * DM + 512 + 8 * lane) = c[i];
                    *(u32x4*)(XG + (size_t)p2 * DM + 8 * lane) = a[i]; *(u32x4*)(XG + (size_t)p2 * DM + 512 + 8 * lane) = c[i]; } }
            if (bx < 8) { const int tot = sc[2064 + bx], st = sc[2056 + bx], pe = st + (((tot + 255) >> 8) << 8);
                for (int r = st + tot + wave; r < pe; r += NWAVES) { const u32x4 z = {0u, 0u, 0u, 0u}; *(u32x4*)(XG + (size_t)r * DM + 8 * lane) = z; *(u32x4*)(XG + (size_t)r * DM + 512 + 8 * lane) = z; if (lane == 0) ROWW[r] = 0.f; } }
        } else if (k == 9 && PH_ON(10)) {
            pg8::Gemm g{DM, DM, DM}; pg8::TileOrder S;
            if (l == 0) S.init(XN, DM, (bf16*)(ws + W_FFUP), DM, 64, 28, G, bx);
            else { S.init(XG, DM, (bf16*)(ws + W_MOEUP), DM, TILE[0], 28, G, bx); S.texp = TILE + 16; S.b_e = (size_t)2 * DFF * DM * 2; }
            EpiSwiglu E{l == 0 ? HB : HBM};
            pg8::gemm_phase<EpiSwiglu, pg8::TileOrder, true>(L, g, S, E);
        } else if (k == 10 && PH_ON(11)) {
            pg8::Gemm g{DFF, DFF, DFF}; pg8::TileOrder S; EpiStore E{Yb, DM, nullptr, 0};
            if (l == 0) S.init(HB, DFF, (bf16*)(ws + W_FFDN), DFF, 64, 4, G, bx);
            else { S.init(HBM, DFF, (bf16*)(ws + W_MOEDN), DFF, TILE[0], 4, G, bx); S.texp = TILE + 16; S.b_e = (size_t)DM * DFF * 2; S.split_k(2, (size_t)(DFF / 2) * 2); g.K = DFF / 2;
                   E.O = XG; E.rowscale = ROWW; E.split_stride = (size_t)(W_Y2B - W_XG) / 2; }
            pg8::gemm_phase<EpiStore, pg8::TileOrder, true>(L, g, S, E);
        } else if (k == 11 && PH_ON(12)) { LANEDEFS
            for (int i = 0; i < 8; ++i) { const int row = bx * 64 + wave * 8 + i, b = row / SEQ; const float* md = modl + b * 6144;
                const Row xr = row_ld_f32(out + (size_t)row * DM, lane); Row yr;
                if (l == 0) yr = row_ld_bf16(Yb + (size_t)row * DM, lane);
                else { const int p1 = TPOS[row * 2], p2 = TPOS[row * 2 + 1]; const bf16* Y2B = (const bf16*)(ws + W_Y2B);
                    const Row ya = row_ld_bf16(XG + (size_t)p1 * DM, lane), yb = row_ld_bf16(XG + (size_t)p2 * DM, lane), yc = row_ld_bf16(Y2B + (size_t)p1 * DM, lane), yd = row_ld_bf16(Y2B + (size_t)p2 * DM, lane);
#pragma unroll
                    for (int j = 0; j < 4; ++j) yr.v[j] = (ya.v[j] + yc.v[j]) + (yb.v[j] + yd.v[j]); }
                const Row x2 = resid(xr, yr, INF(8) + l * DM, md + 5 * DM, out + (size_t)row * DM, lane);
                if (l == 0) { const float* md1 = MOD + 2 * 6144 + b * 6144; (void)adaln(x2, INF(5) + DM, md1 + 1 * DM, md1 + 0 * DM, XN + (size_t)row * DM, lane); } }
        }
        bool more = false; for (int q = ph + 1; q < args.ph_hi; ++q) more |= phase_active(q);
        if (more) xcd_barrier(bar);
        if (MK_REP_MASK != 0) { if ((((unsigned)MK_REP_MASK >> ph) & 1u) && repcnt + 1 < MK_REP_N) { ++repcnt; --ph; } else repcnt = 0; }
    }
#undef INF
#undef LANEDEFS
#undef MOD
#undef Qb
#undef Vb
#undef Ob
#undef Yb
#undef out
#undef modl
}
}
#ifndef MK_PER_PHASE
#define MK_PER_PHASE 0
#endif
static int mk_setup() {
    static int grid = 0;
    if (grid == 0) {
        int dev = 0, cus = 0, per_cu = 0;
        if (hipGetDevice(&dev) != hipSuccess || hipDeviceGetAttribute(&cus, hipDeviceAttributeMultiprocessorCount, dev) != hipSuccess) { fprintf(stderr, "kernel_launch: device query failed\n"); grid = -1; return grid; }
        if (hipFuncSetAttribute((const void*)mk::mk_fwd, hipFuncAttributeMaxDynamicSharedMemorySize, mk::LDS_BYTES) != hipSuccess) { fprintf(stderr, "kernel_launch: hipFuncSetAttribute failed\n"); grid = -1; return grid; }
        if (hipOccupancyMaxActiveBlocksPerMultiprocessor(&per_cu, (const void*)mk::mk_fwd, mk::NWAVES * 64, mk::LDS_BYTES) != hipSuccess || per_cu < 1) fprintf(stderr, "kernel_launch: occupancy query reports %d blocks per CU\n", per_cu);
        (void)hipGetLastError();
        grid = cus;
        if (grid != 256) fprintf(stderr, "kernel_launch: this kernel is written for a 256-CU device (got %d)\n", grid);
    }
    return grid;
}
static void mk_launch(void* const* d_in, void* d_out, void* d_ws, hipStream_t stream, int lo, int hi, bool coop) {
    const int grid = mk_setup(); if (grid <= 0) return;
    mk::Args a{};
    for (int i = 0; i < 35; ++i) a.in[i] = d_in[i];
    a.out = (float*)d_out; a.ws = (unsigned char*)d_ws; a.ph_lo = lo; a.ph_hi = hi; a.never = 0; a.pad = 0;
    if (coop) { void* args[] = {&a}; hipError_t e = hipLaunchCooperativeKernel((const void*)mk::mk_fwd, dim3(grid), dim3(mk::NWAVES * 64), args, mk::LDS_BYTES, stream);
        if (e != hipSuccess) fprintf(stderr, "cooperative launch failed: %s (grid %d)\n", hipGetErrorString(e), grid); }
    else hipLaunchKernelGGL(mk::mk_fwd, dim3(grid), dim3(mk::NWAVES * 64), mk::LDS_BYTES, stream, a);
}
extern "C" void kernel_launch(void* const* d_in, const int* in_sizes, int n_in, void* d_out, int out_size, void* d_ws, size_t ws_size, hipStream_t stream) {
    (void)in_sizes; (void)n_in; (void)out_size;
    if (ws_size < mk::W_END) { fprintf(stderr, "kernel_launch: workspace too small (%zu < %zu)\n", ws_size, (size_t)mk::W_END); return; }
    (void)hipMemsetAsync((char*)d_ws + mk::W_CTL, 0, mk::CTL_ZERO_BYTES, stream);
#if MK_PER_PHASE
    for (int ph = 0; ph < mk::NPHASE; ++ph) mk_launch(d_in, d_out, d_ws, stream, ph, ph + 1, false);
#else
    mk_launch(d_in, d_out, d_ws, stream, 0, mk::NPHASE, true);
#endif
}
```

```cpp
#include <hip/hip_runtime.h>
#include <stdint.h>
#include <math.h>
#include <cstdio>
#define MK_Q2 10
#define MK_Q3 12
#include <hip/hip_cooperative_groups.h>
#define GAS __attribute__((address_space(1)))
#define LAS __attribute__((address_space(3)))
namespace mk {
typedef unsigned short bf16;
typedef short bf16x8 __attribute__((ext_vector_type(8)));
typedef short s16x4 __attribute__((ext_vector_type(4)));
typedef float f32x2 __attribute__((ext_vector_type(2)));
typedef float f32x4 __attribute__((ext_vector_type(4)));
typedef float f32x16 __attribute__((ext_vector_type(16)));
typedef unsigned u32x2 __attribute__((ext_vector_type(2)));
typedef unsigned u32x4 __attribute__((ext_vector_type(4)));
typedef __bf16 bf16x2_t __attribute__((ext_vector_type(2)));
typedef GAS unsigned gu32;
#define RLX_AGENT __ATOMIC_RELAXED, __HIP_MEMORY_SCOPE_AGENT
__device__ __forceinline__ unsigned cvtpk(float lo, float hi) { f32x2 v = {lo, hi}; bf16x2_t b = __builtin_convertvector(v, bf16x2_t); return __builtin_bit_cast(unsigned, b); }
__device__ __forceinline__ float bf2f(unsigned short b) { return __builtin_bit_cast(float, (unsigned)b << 16); }
__device__ __forceinline__ float bflo(unsigned w) { return __builtin_bit_cast(float, w << 16); }
__device__ __forceinline__ float bfhi(unsigned w) { return __builtin_bit_cast(float, w & 0xffff0000u); }
__device__ __forceinline__ float wave_sum(float v) {
#pragma unroll
    for (int o = 1; o < 64; o <<= 1) v += __shfl_xor(v, o);
    return v;
}
__device__ __forceinline__ float fast_sigmoid(float z) { return __builtin_amdgcn_rcpf(1.f + __builtin_amdgcn_exp2f(-1.4426950408889634f * z)); }
__device__ __forceinline__ float silu_fast(float v) { return v * fast_sigmoid(v); }
__device__ __forceinline__ float gelu_tanh_fast(float x) { const float a = 0.7978845608028654f * (x + 0.044715f * x * x * x); return x * fast_sigmoid(2.f * a); }

constexpr int NB = 2, SEQ = 8192, NTOK = 16384, DM = 1024, INC = 1728, INCP = 1792, DFF = 3584, NE = 8, NWAVES = 8;
constexpr float EPS = 1e-6f;
constexpr int SSM_C = 32, SSM_NCH = NTOK / SSM_C  , SSM_K = 640;
constexpr int RET_C = 64, RET_NCH = SEQ / RET_C  ;
constexpr int MOE_MAXT = 136;
constexpr float QSCALE = 0.07216878364870322f * 1.4426950408889634f;

#define XB_TMO      128
#define XB_XCNT(j)  (256  + 64 * (j))
#define XB_XSUB(j)  (1280 + 64 * (j))
#define XB_XGEN(j)  (2304 + 64 * (j))
#define XB_TOP      3328
#define XB_TOPGEN   3392
#define XCD_BAR_WORDS 3456
#define XB_SPIN_CAP (1u << 20)
__device__ __forceinline__ unsigned xb_ld(unsigned* p)              { return __hip_atomic_load(p, __ATOMIC_RELAXED, __HIP_MEMORY_SCOPE_AGENT); }
__device__ __forceinline__ unsigned xb_add(unsigned* p, unsigned v) { return __hip_atomic_fetch_add(p, v, __ATOMIC_RELAXED, __HIP_MEMORY_SCOPE_AGENT); }
__device__ __forceinline__ unsigned xb_xcc_id() { return (unsigned)__builtin_amdgcn_s_getreg((3 << 11) | 20) & 0xFu; }
#define XB_SPIN(cond, bar) do { unsigned _sp = 0; while (cond) { __builtin_amdgcn_s_sleep(1); \
    if ((++_sp & 255u) == 0u) { if (xb_ld(&(bar)[XB_TMO])) break; if (_sp > XB_SPIN_CAP) { atomicAdd(&(bar)[XB_TMO], 1u); break; } } } } while (0)
struct XcdBarrier { unsigned* bar; unsigned x; volatile LAS unsigned* st; };
__device__ __forceinline__ XcdBarrier xcd_barrier_post(unsigned* bar, volatile LAS unsigned* st) {
    XcdBarrier b; b.bar = bar; b.x = xb_xcc_id(); b.st = st;
    if (threadIdx.x == 0) (void)xb_add(&bar[XB_XCNT(b.x)], 1u);
    return b;
}
__device__ __forceinline__ void xcd_barrier_complete(unsigned* bar, unsigned x, unsigned& nloc, unsigned& nx) {
    const unsigned G = gridDim.x * gridDim.y * gridDim.z;
    unsigned sum, cnt, mine, sp = 0u;
    for (;;) {
        sum = 0u; cnt = 0u; mine = 0u;
#pragma unroll
        for (unsigned j = 0; j < 16; ++j) { const unsigned c = xb_ld(&bar[XB_XCNT(j)]); sum += c; cnt += (c > 0u) ? 1u : 0u; mine = (j == x) ? c : mine; }
        if (sum == G) break;
        __builtin_amdgcn_s_sleep(1);
        if ((++sp & 255u) == 0u) { if (xb_ld(&bar[XB_TMO])) break; if (sp > XB_SPIN_CAP) { atomicAdd(&bar[XB_TMO], 1u); break; } }
    }
    nloc = mine > 0u ? mine : 1u; nx = cnt > 0u ? cnt : 1u;
}
__device__ __forceinline__ void xcd_barrier(const XcdBarrier& b) {
    asm volatile("s_waitcnt vmcnt(0)" ::: "memory");
    __syncthreads();
    if (threadIdx.x == 0) {
        unsigned* bar = b.bar;
        __builtin_amdgcn_s_waitcnt(0);
        unsigned nloc = b.st[0], nx = b.st[1];
        if (nloc == 0u) { xcd_barrier_complete(bar, b.x, nloc, nx); b.st[0] = nloc; b.st[1] = nx; }
        const unsigned old = xb_add(&bar[XB_XSUB(b.x)], 1u);
        const unsigned gen = old / nloc;
        if (old + 1u == (gen + 1u) * nloc) {
            __builtin_amdgcn_fence(__ATOMIC_RELEASE, "agent");
            asm volatile("s_waitcnt vmcnt(0)" ::: "memory");
            const unsigned og = xb_add(&bar[XB_TOP], 1u);
            const unsigned tg = og / nx;
            if (og + 1u == (tg + 1u) * nx) xb_add(&bar[XB_TOPGEN], 1u);
            else XB_SPIN(xb_ld(&bar[XB_TOPGEN]) == tg, bar);
            __builtin_amdgcn_fence(__ATOMIC_ACQUIRE, "agent");
            xb_add(&bar[XB_XGEN(b.x)], 1u);
            asm volatile("s_waitcnt vmcnt(0)" ::: "memory");
        } else {
            XB_SPIN(xb_ld(&bar[XB_XGEN(b.x)]) == gen, bar);
            __builtin_amdgcn_fence(__ATOMIC_ACQUIRE, "agent");
            asm volatile("s_waitcnt vmcnt(0)" ::: "memory");
        }
    }
    __syncthreads();
}
}
namespace pg8 {
#define PG8_LAS __attribute__((address_space(3)))
typedef unsigned short bf16_t;
typedef short bf16x8 __attribute__((ext_vector_type(8)));
typedef float f32x4 __attribute__((ext_vector_type(4)));
typedef unsigned u32x4 __attribute__((ext_vector_type(4)));
constexpr int BM = 256, BK = 64, HALF = 128, HTB = HALF * BK * 2, STAGE_BYTES = 8 * HTB, NXCD = 8, WGM = 8;
__host__ __device__ __forceinline__ int lds_byte(int r, int c) { const int st = (r >> 4) * 2 + (c >> 5), rr = r & 15, cc = c & 31, ob = rr * 64 + cc * 2; return st * 1024 + (ob ^ (((ob >> 9) & 1) << 5)); }
__host__ __device__ __forceinline__ void stage_rc(int b, int& R, int& C) { const int st = b / 1024, sb = b % 1024, swz = sb ^ (((sb >> 9) & 1) << 5); R = (st >> 1) * 16 + swz / 64; C = (st & 1) * 32 + (swz % 64) / 2; }
__host__ __device__ __forceinline__ int perm32(int rho) { const int n = rho >> 4, i = rho & 15; return 8 * (i >> 2) + 4 * n + (i & 3); }
struct Unit { const char* pA; const char* pB; int pm, pn; };
struct Gemm { int lda, ldb, K; };
struct TileOrder {
    const char* A; const char* Bt; size_t a_t, b_t, b_e, k_off; const int* texp; int nM, nN, nN0, nwg, G, c;
    __device__ __forceinline__ void init(const void* A_, int lda, const void* Bt_, int ldb, int nM_, int nN_, int G_, int c_) {
        A = (const char*)A_; Bt = (const char*)Bt_; a_t = (size_t)BM * lda * 2; b_t = (size_t)BM * ldb * 2; b_e = 0; k_off = 0; texp = nullptr; nM = nM_; nN = nN_; nN0 = nN_; nwg = nM * nN; G = G_; c = c_; }
    __device__ __forceinline__ void split_k(int ks, size_t k_off_) { nN0 = nN; nN = nN * ks; nwg = nM * nN; k_off = k_off_; }
    __device__ __forceinline__ bool next(int i, Unit& u) const {
        const long L = (long)i * G + c; if (L >= nwg) return false;
        int wgid = (int)L; { const int q = nwg / NXCD, r = nwg % NXCD, xcd = wgid % NXCD, off = wgid / NXCD; wgid = (xcd < r ? xcd * (q + 1) : r * (q + 1) + (xcd - r) * q) + off; }
        const int nig = WGM * nN, gid = wgid / nig, fm = gid * WGM, gsz = (nM - fm) < WGM ? (nM - fm) : WGM;
        u.pm = fm + ((wgid % nig) % gsz); u.pn = (wgid % nig) / gsz;
        const int ks = u.pn / nN0, pn0 = u.pn - ks * nN0;
        u.pA = A + (size_t)u.pm * a_t + (size_t)ks * k_off; u.pB = Bt + (size_t)pn0 * b_t + (size_t)ks * k_off + (texp ? (size_t)texp[u.pm] * b_e : (size_t)0); return true;
    }
    __device__ __forceinline__ void a_ready(const Unit&) const {}
    __device__ __forceinline__ void done(const Unit&) const {}
};
struct GroupOrder {
    const char* A; const char* Bt; size_t a_t, b_t, a_g, b_g; int nM, nN, nwg, G, c;
    __device__ __forceinline__ void init(const void* A_, int lda, size_t a_g_, const void* Bt_, int ldb, size_t b_g_, int ng, int nM_, int nN_, int G_, int c_) {
        A = (const char*)A_; Bt = (const char*)Bt_; a_t = (size_t)BM * lda * 2; b_t = (size_t)BM * ldb * 2; a_g = a_g_; b_g = b_g_; nM = nM_; nN = nN_; nwg = ng * nM * nN; G = G_; c = c_; }
    __device__ __forceinline__ bool next(int i, Unit& u) const {
        const long L = (long)i * G + c; if (L >= nwg) return false;
        const int per = nM * nN, g = (int)L / per, r = (int)L % per, pm = r / nN, pn = r % nN;
        u.pm = g * nM + pm; u.pn = pn; u.pA = A + (size_t)g * a_g + (size_t)pm * a_t; u.pB = Bt + (size_t)g * b_g + (size_t)pn * b_t; return true;
    }
    __device__ __forceinline__ void a_ready(const Unit&) const {}
    __device__ __forceinline__ void done(const Unit&) const {}
};
struct OneUnit {
    Unit u; bool has;
    __device__ __forceinline__ bool next(int i, Unit& o) const { if (i > 0 || !has) return false; o = u; return true; }
    __device__ __forceinline__ void a_ready(const Unit&) const {}
    __device__ __forceinline__ void done(const Unit&) const {}
};
template <class Epi, class Sched, bool ALIGN_EPI = false, bool SMALLK = false>
__device__ __forceinline__ void gemm_phase(PG8_LAS unsigned char* lds, const Gemm g, const Sched& S, const Epi& E) {
    int tid_ = threadIdx.x; asm volatile("" : "+v"(tid_));
    const int tid = tid_, wid = __builtin_amdgcn_readfirstlane(tid >> 6), lane = tid & 63, wr = wid >> 2, wc = wid & 3, fr = lane & 15, fq = lane >> 4;
    int K_ = g.K; if constexpr (SMALLK) asm volatile("" : "+s"(K_));
    const int K = K_, nt = K / BK, lda = g.lda, ldb = g.ldb;
    unsigned voffA[2], voffB[2];
#pragma unroll
    for (int i = 0; i < 2; ++i) { int R, C; stage_rc(tid * 16 + i * 8192, R, C); const int Rb = Epi::PERM ? ((R & ~31) + perm32(R & 31)) : R;
        voffA[i] = (unsigned)(R * lda + C) * 2u; voffB[i] = (unsigned)(Rb * ldb + C) * 2u; }
    const size_t kstep = (size_t)(BK * 2);
    const size_t hstepA = (size_t)HALF * lda * 2, hstepB = (size_t)HALF * ldb * 2;
    const unsigned ldsw = (unsigned)wid * 1024u;
    const int aoff = lds_byte(wr * 64 + fr, fq * 8), boff = lds_byte(wc * 32 + fr, fq * 8);
#define PG8_SA(b, h) (((b) * 2 + (h)) * HTB)
#define PG8_SB(b, h) ((4 + (b) * 2 + (h)) * HTB)
#define PG8_STAGE(bufoff, gbase, voff) do { _Pragma("unroll") for (int _i = 0; _i < 2; ++_i) \
        __builtin_amdgcn_global_load_lds((const unsigned*)((const char*)(gbase) + (voff)[_i]), (PG8_LAS unsigned*)(lds + (bufoff) + ldsw + _i * 8192), 16, 0, 0); } while (0)
#define PG8_LDA(dst, b, h) do { _Pragma("unroll") for (int m = 0; m < 4; ++m) _Pragma("unroll") for (int k = 0; k < 2; ++k) dst[m][k] = *(const PG8_LAS bf16x8*)(lds + PG8_SA(b, h) + aoff + m * 2048 + k * 1024); } while (0)
#define PG8_LDB(dst, b, h) do { _Pragma("unroll") for (int n = 0; n < 2; ++n) _Pragma("unroll") for (int k = 0; k < 2; ++k) dst[n][k] = *(const PG8_LAS bf16x8*)(lds + PG8_SB(b, h) + boff + n * 2048 + k * 1024); } while (0)
#define PG8_MMA(ai, bj, At, Bt) do { __builtin_amdgcn_s_setprio(1); _Pragma("unroll") for (int m = 0; m < 4; ++m) _Pragma("unroll") for (int n = 0; n < 2; ++n) _Pragma("unroll") for (int k = 0; k < 2; ++k) \
        acc[ai][bj][m][n] = __builtin_amdgcn_mfma_f32_16x16x32_bf16(Bt[n][k], At[m][k], acc[ai][bj][m][n], 0, 0, 0); __builtin_amdgcn_s_setprio(0); } while (0)
#define PG8_WAIT_V(n) asm volatile("s_waitcnt vmcnt(" #n ")" ::: "memory")
#define PG8_WAIT_L(n) asm volatile("s_waitcnt lgkmcnt(" #n ")" ::: "memory")
#define PG8_BAR __builtin_amdgcn_s_barrier()
#define PG8_SCHED __builtin_amdgcn_sched_barrier(0)
    Unit cur, nxt; int ui = 0;
    if (!S.next(0, cur)) return;
    f32x4 acc[2][2][4][2];
#pragma unroll
    for (int a = 0; a < 2; ++a)
#pragma unroll
        for (int b = 0; b < 2; ++b)
#pragma unroll
            for (int m = 0; m < 4; ++m)
#pragma unroll
                for (int n = 0; n < 2; ++n) acc[a][b][m][n] = (f32x4){0.f, 0.f, 0.f, 0.f};
    bf16x8 At[4][2], B0[2][2], B1[2][2];
    const char* cA = cur.pA; const char* cB = cur.pB;
    S.a_ready(cur);
    {
        PG8_STAGE(PG8_SB(0, 0), cB, voffB); PG8_STAGE(PG8_SB(0, 1), cB + hstepB, voffB); PG8_STAGE(PG8_SA(0, 0), cA, voffA); PG8_STAGE(PG8_SA(0, 1), cA + hstepA, voffA);
        if (wr == 1) PG8_BAR;
        PG8_WAIT_V(2); PG8_BAR;
        PG8_STAGE(PG8_SB(1, 0), cB + kstep, voffB); PG8_STAGE(PG8_SA(1, 0), cA + kstep, voffA); PG8_STAGE(PG8_SB(1, 1), cB + hstepB + kstep, voffB);
        PG8_WAIT_V(6); PG8_BAR;
    }
    for (;;) {
        const bool has_next = S.next(ui + 1, nxt);
        const char* nA = has_next ? nxt.pA : cA; const char* nB = has_next ? nxt.pB : cB;
        for (int t = 0; t < nt; t += 2) {
            const bool last = (t == nt - 2);
            const char* a1 = cA + (size_t)(t + 1) * kstep;
            const char* a2 = last ? nA : cA + (size_t)(t + 2) * kstep; const char* b2 = last ? nB : cB + (size_t)(t + 2) * kstep;
            const char* a3 = a2 + kstep; const char* b3 = b2 + kstep;
            if (last && has_next) S.a_ready(nxt);
            {
            PG8_LDB(B0, 0, 0); PG8_LDB(B1, 0, 1); PG8_SCHED; PG8_LDA(At, 0, 0); PG8_STAGE(PG8_SA(1, 1), a1 + hstepA, voffA);
            PG8_WAIT_V(8); PG8_WAIT_L(0); PG8_BAR; PG8_MMA(0, 0, At, B0); PG8_MMA(0, 1, At, B1); PG8_BAR; PG8_SCHED;
            PG8_LDA(At, 0, 1); PG8_STAGE(PG8_SB(0, 0), b2, voffB); PG8_STAGE(PG8_SB(0, 1), b2 + hstepB, voffB); PG8_STAGE(PG8_SA(0, 0), a2, voffA);
            PG8_WAIT_V(8); PG8_WAIT_L(0); PG8_BAR; PG8_MMA(1, 0, At, B0); PG8_MMA(1, 1, At, B1); PG8_BAR; PG8_SCHED;
            PG8_LDB(B0, 1, 0); PG8_LDB(B1, 1, 1); PG8_SCHED; PG8_LDA(At, 1, 0); PG8_STAGE(PG8_SA(0, 1), a2 + hstepA, voffA);
            PG8_WAIT_V(8); PG8_WAIT_L(0); PG8_BAR; PG8_MMA(0, 0, At, B0); PG8_MMA(0, 1, At, B1); PG8_BAR; PG8_SCHED;
            PG8_LDA(At, 1, 1); PG8_STAGE(PG8_SB(1, 0), b3, voffB); PG8_STAGE(PG8_SB(1, 1), b3 + hstepB, voffB); PG8_STAGE(PG8_SA(1, 0), a3, voffA);
            PG8_WAIT_V(8); PG8_WAIT_L(0); PG8_BAR; PG8_MMA(1, 0, At, B0); PG8_MMA(1, 1, At, B1); PG8_BAR; PG8_SCHED;
            }
        }
        if constexpr (ALIGN_EPI) { if (wr == 0) PG8_BAR; }
        if constexpr (!Epi::AFTER_DRAIN) { E(acc, cur, wr, wc, fr, fq); S.done(cur); }
        if (!has_next) break;
#pragma unroll
        for (int a = 0; a < 2; ++a)
#pragma unroll
            for (int b = 0; b < 2; ++b)
#pragma unroll
                for (int m = 0; m < 4; ++m)
#pragma unroll
                    for (int n = 0; n < 2; ++n) acc[a][b][m][n] = (f32x4){0.f, 0.f, 0.f, 0.f};
        cur = nxt; cA = nA; cB = nB; ++ui;
        if constexpr (ALIGN_EPI) { if (wr == 1) PG8_BAR; }
    }
    PG8_WAIT_V(0);
    if constexpr (!ALIGN_EPI) { if (wr == 0) PG8_BAR; }
    PG8_BAR;
    if constexpr (Epi::AFTER_DRAIN) { E.fused(acc, cur, wr, wc, fr, fq, lds, wid, lane); S.done(cur); }
#undef PG8_SA
#undef PG8_SB
#undef PG8_STAGE
#undef PG8_LDA
#undef PG8_LDB
#undef PG8_MMA
#undef PG8_WAIT_V
#undef PG8_WAIT_L
#undef PG8_BAR
#undef PG8_SCHED
}
}
namespace mk {
using pg8::Unit;
typedef f32x4 Acc[2][2][4][2];
__device__ __forceinline__ void st8(bf16* p, f32x4 v) { u32x2 w; w.x = cvtpk(v[0], v[1]); w.y = cvtpk(v[2], v[3]); *(u32x2*)p = w; }
__device__ __forceinline__ void st16(bf16* p, f32x4 a, f32x4 b) { u32x4 w; w.x = cvtpk(a[0], a[1]); w.y = cvtpk(a[2], a[3]); w.z = cvtpk(b[0], b[1]); w.w = cvtpk(b[2], b[3]); *(u32x4*)p = w; }
__device__ __forceinline__ f32x4 ld4bf(const bf16* p) { const u32x2 w = *(const u32x2*)p; return (f32x4){bflo(w.x), bfhi(w.x), bflo(w.y), bfhi(w.y)}; }
__device__ __forceinline__ f32x4 rope4(f32x4 v, f32x4 cs) { return (f32x4){v[0] * cs[0] - v[1] * cs[1], v[1] * cs[0] + v[0] * cs[1], v[2] * cs[2] - v[3] * cs[3], v[3] * cs[2] + v[2] * cs[3]}; }

__device__ __forceinline__ void st_tr_pairs(bf16* T, int col0, int row, f32x4 v, bool even) {
    const float s0 = even ? v[2] : v[0], s1 = even ? v[3] : v[1];
    const float r0 = __shfl_xor(s0, 1), r1 = __shfl_xor(s1, 1);
    const int c = col0 + (even ? 0 : 2), re = row & ~1;
    const unsigned w0 = even ? cvtpk(v[0], r0) : cvtpk(r0, v[2]), w1 = even ? cvtpk(v[1], r1) : cvtpk(r1, v[3]);
    *(unsigned*)(T + (size_t)c * NTOK + re) = w0; *(unsigned*)(T + (size_t)(c + 1) * NTOK + re) = w1;
}
struct EpiWin {
    static constexpr bool PERM = true, AFTER_DRAIN = false;
    bf16 *RQ, *RK, *RKT, *RVT, *RG, *UC, *CQ, *CKV, *KPE; float *SSQQ, *SSQKV; const f32x4* CS;
    __device__ __forceinline__ void operator()(const Acc& acc, const Unit& u, int wr, int wc, int fr, int fq) const { { int t_ = threadIdx.x; asm volatile("" : "+v"(t_)); fr = t_ & 15; fq = (t_ >> 4) & 3; }
        const int pn = u.pn, row0 = u.pm * 256 + wr * 64 + fr; const bool even = (fr & 1) == 0;
        if (pn <= 1) {
#pragma unroll
            for (int ai = 0; ai < 2; ++ai)
#pragma unroll
                for (int m = 0; m < 4; ++m) { const int row = row0 + ai * 128 + m * 16; const float pl = (float)(row & (RET_C - 1));
#pragma unroll
                    for (int bj = 0; bj < 2; ++bj) { const int head = 2 * bj + (wc >> 1);
                        const float lg2 = __builtin_amdgcn_logf(1.f - __builtin_amdgcn_exp2f(-5.f - (float)head));
                        const float dec = pn == 0 ? __builtin_amdgcn_exp2f(pl * lg2) : 0.125f * __builtin_amdgcn_exp2f(-pl * lg2);
                        const int i0 = 16 * (wc & 1) + 4 * fq, col = bj * 128 + wc * 32 + 8 * fq;
                        const f32x4 o0 = rope4(acc[ai][bj][m][0], CS[((row * 32 + i0) >> 1)]) * dec, o1 = rope4(acc[ai][bj][m][1], CS[((row * 32 + i0) >> 1) + 1]) * dec;
                        st16((pn == 0 ? RQ : RK) + (size_t)row * 256 + col, o0, o1);
                        if (pn == 1) { st_tr_pairs(RKT, col, row, o0, even); st_tr_pairs(RKT, col + 4, row, o1, even); } }
                    asm volatile("" ::: "memory"); }
        } else if (pn == 2) {
#pragma unroll
            for (int ai = 0; ai < 2; ++ai)
#pragma unroll
                for (int m = 0; m < 4; ++m) { const int row = row0 + ai * 128 + m * 16;
#pragma unroll
                    for (int bj = 0; bj < 2; ++bj) { const int col = bj * 128 + wc * 32 + 8 * fq; st_tr_pairs(RVT, col, row, acc[ai][bj][m][0], even); st_tr_pairs(RVT, col + 4, row, acc[ai][bj][m][1], even); } }
        } else if (pn == 3) {
#pragma unroll
            for (int ai = 0; ai < 2; ++ai)
#pragma unroll
                for (int m = 0; m < 4; ++m) { const int row = row0 + ai * 128 + m * 16;
#pragma unroll
                    for (int bj = 0; bj < 2; ++bj) { const f32x4 v = acc[ai][bj][m][0], w = acc[ai][bj][m][1];
                        st16(RG + (size_t)row * 256 + bj * 128 + wc * 32 + 8 * fq, (f32x4){silu_fast(v[0]), silu_fast(v[1]), silu_fast(v[2]), silu_fast(v[3])}, (f32x4){silu_fast(w[0]), silu_fast(w[1]), silu_fast(w[2]), silu_fast(w[3])}); } }
        } else if (pn == 4) {
#pragma unroll
            for (int ai = 0; ai < 2; ++ai)
#pragma unroll
                for (int m = 0; m < 4; ++m) { const int row = row0 + ai * 128 + m * 16, chunk = row / SSM_C, t = row % SSM_C;
#pragma unroll
                    for (int bj = 0; bj < 2; ++bj) { const int g = 8 * bj + 2 * wc + (fq >> 1);
                        st16(UC + ((size_t)g * SSM_NCH + chunk) * SSM_K + t * 16 + 8 * (fq & 1), acc[ai][bj][m][0], acc[ai][bj][m][1]); } }
        } else if (pn == 5) {
#pragma unroll
            for (int ai = 0; ai < 2; ++ai)
#pragma unroll
                for (int m = 0; m < 4; ++m) { const int row = row0 + ai * 128 + m * 16; float ss = 0.f;
#pragma unroll
                    for (int bj = 0; bj < 2; ++bj) { const f32x4 v = acc[ai][bj][m][0], w = acc[ai][bj][m][1];
                        ss += ((v[0] * v[0] + v[1] * v[1]) + (v[2] * v[2] + v[3] * v[3])) + ((w[0] * w[0] + w[1] * w[1]) + (w[2] * w[2] + w[3] * w[3]));
                        st16(CQ + (size_t)row * 256 + bj * 128 + wc * 32 + 8 * fq, v, w); }
                    ss += __shfl_xor(ss, 16); ss += __shfl_xor(ss, 32);
                    if (fq == 0) SSQQ[row * 4 + wc] = ss; }
        } else {
#pragma unroll
            for (int ai = 0; ai < 2; ++ai)
#pragma unroll
                for (int m = 0; m < 4; ++m) { const int row = row0 + ai * 128 + m * 16;
                    const f32x4 v = acc[ai][0][m][0], w = acc[ai][0][m][1];
                    float ss = ((v[0] * v[0] + v[1] * v[1]) + (v[2] * v[2] + v[3] * v[3])) + ((w[0] * w[0] + w[1] * w[1]) + (w[2] * w[2] + w[3] * w[3]));
                    st16(CKV + (size_t)row * 128 + wc * 32 + 8 * fq, v, w);
                    ss += __shfl_xor(ss, 16); ss += __shfl_xor(ss, 32);
                    if (fq == 0) SSQKV[row * 4 + wc] = ss;
                    if (wc < 2) { const int i0 = 16 * wc + 4 * fq;
                        st16(KPE + (size_t)row * 64 + wc * 32 + 8 * fq, rope4(acc[ai][1][m][0], CS[(row * 32 + i0) >> 1]), rope4(acc[ai][1][m][1], CS[((row * 32 + i0) >> 1) + 1])); } }
        }
    }
};
struct EpiQup {
    static constexpr bool PERM = false, AFTER_DRAIN = false;
    bf16* Q; const float* SSQ; const f32x4* CS;
    __device__ __forceinline__ void operator()(const Acc& acc, const Unit& u, int wr, int wc, int fr, int fq) const { { int t_ = threadIdx.x; asm volatile("" : "+v"(t_)); fr = t_ & 15; fq = (t_ >> 4) & 3; }
        const int row0 = u.pm * 256 + wr * 64 + fr;
#pragma unroll
        for (int ai = 0; ai < 2; ++ai)
#pragma unroll
            for (int m = 0; m < 4; ++m) { const int row = row0 + ai * 128 + m * 16; const f32x4 s4 = *(const f32x4*)(SSQ + row * 4);
                const float rstd = __builtin_amdgcn_rsqf(((s4[0] + s4[1]) + (s4[2] + s4[3])) * (1.f / 256.f) + EPS);
#pragma unroll
                for (int bj = 0; bj < 2; ++bj) { const bool rope = ((4 * u.pn + 2 * bj + (wc >> 1)) % 3) == 2;
#pragma unroll
                    for (int n = 0; n < 2; ++n) { f32x4 v = acc[ai][bj][m][n] * rstd;
                        if (rope) { const int i0 = 16 * (wc & 1) + 8 * n + 2 * fq; v = rope4(v, CS[(row * 32 + i0) >> 1]); }
                        st8(Q + (size_t)row * 768 + u.pn * 256 + bj * 128 + wc * 32 + n * 16 + fq * 4, v); } }
                asm volatile("" ::: "memory"); }
    }
};
struct EpiKVup {
    static constexpr bool PERM = false, AFTER_DRAIN = false;
    bf16 *KN, *V; const float* SSQ;
    __device__ __forceinline__ void operator()(const Acc& acc, const Unit& u, int wr, int wc, int fr, int fq) const { { int t_ = threadIdx.x; asm volatile("" : "+v"(t_)); fr = t_ & 15; fq = (t_ >> 4) & 3; }
        const int row0 = u.pm * 256 + wr * 64 + fr;
#pragma unroll
        for (int ai = 0; ai < 2; ++ai)
#pragma unroll
            for (int m = 0; m < 4; ++m) { const int row = row0 + ai * 128 + m * 16; const f32x4 s4 = *(const f32x4*)(SSQ + row * 4);
                const float rstd = __builtin_amdgcn_rsqf(((s4[0] + s4[1]) + (s4[2] + s4[3])) * (1.f / 128.f) + EPS);
#pragma unroll
                for (int bj = 0; bj < 2; ++bj)
#pragma unroll
                    for (int n = 0; n < 2; ++n) st8((bj == 0 ? KN : V) + (size_t)row * 512 + u.pn * 128 + wc * 32 + n * 16 + fq * 4, acc[ai][bj][m][n] * rstd);
                asm volatile("" ::: "memory"); }
    }
};
struct EpiSsmE {
    static constexpr bool PERM = false, AFTER_DRAIN = true;
    bf16* UC; const f32x2* LAMC;
    __device__ __forceinline__ void fused(Acc& acc, const Unit& u, int wr, int wc, int fr, int fq, PG8_LAS unsigned char* lds, int wid, int lane) const { { int t_ = threadIdx.x; asm volatile("" : "+v"(t_)); fr = t_ & 15; fq = (t_ >> 4) & 3; }
        PG8_LAS float* EL = (PG8_LAS float*)lds;
        const int g = u.pm >> 1, b = u.pm & 1;
#pragma unroll
        for (int ai = 0; ai < 2; ++ai)
#pragma unroll
            for (int m = 0; m < 4; ++m) { const int ch = ai * 128 + wr * 64 + m * 16 + fr;
#pragma unroll
                for (int n = 0; n < 2; ++n) *(PG8_LAS f32x4*)(EL + ch * 128 + wc * 32 + n * 16 + fq * 4) = acc[ai][0][m][n]; }
        asm volatile("s_waitcnt lgkmcnt(0)" ::: "memory"); __builtin_amdgcn_s_barrier(); asm volatile("" ::: "memory");
        {
            const f32x2 lc = LAMC[g * 64 + lane]; f32x2 c = {0.f, 0.f};
            f32x2 loc[32];
#pragma unroll
            for (int n = 0; n < 32; ++n) { const f32x2 e2 = *(const PG8_LAS f32x2*)(EL + (wid * 32 + n) * 128 + 2 * lane); loc[n] = c; c = (f32x2){lc.x * c.x - lc.y * c.y, lc.x * c.y + lc.y * c.x} + e2; }
            f32x2 pw = {1.f, 0.f};
#pragma unroll
            for (int n = 0; n < 32; ++n) pw = (f32x2){pw.x * lc.x - pw.y * lc.y, pw.x * lc.y + pw.y * lc.x};
            asm volatile("s_waitcnt lgkmcnt(0)" ::: "memory"); __builtin_amdgcn_s_barrier(); asm volatile("" ::: "memory");
            *(PG8_LAS f32x2*)(EL + wid * 128 + 2 * lane) = c;
            asm volatile("s_waitcnt lgkmcnt(0)" ::: "memory"); __builtin_amdgcn_s_barrier(); asm volatile("" ::: "memory");
            f32x2 cin = {0.f, 0.f};
            for (int s = 0; s < wid; ++s) { const f32x2 es = *(const PG8_LAS f32x2*)(EL + s * 128 + 2 * lane); cin = (f32x2){pw.x * cin.x - pw.y * cin.y, pw.x * cin.y + pw.y * cin.x} + es; }
            bf16* up = UC + ((size_t)g * SSM_NCH + b * 256 + wid * 32) * SSM_K + 512 + 2 * lane;
            f32x2 q = cin;
#pragma unroll
            for (int n = 0; n < 32; ++n) { const f32x2 v = loc[n] + q; *(unsigned*)(up + (size_t)n * SSM_K) = cvtpk(v.x, v.y); q = (f32x2){lc.x * q.x - lc.y * q.y, lc.x * q.y + lc.y * q.x}; }
        }
        asm volatile("s_waitcnt vmcnt(0)" ::: "memory");
        asm volatile("s_waitcnt lgkmcnt(0)" ::: "memory"); __builtin_amdgcn_s_barrier(); asm volatile("" ::: "memory");
    }
};
struct EpiSsmZ {
    static constexpr bool PERM = false, AFTER_DRAIN = false;
    bf16* G; const bf16* UC; const float* dpar;
    __device__ __forceinline__ void operator()(const Acc& acc, const Unit& u, int wr, int wc, int fr, int fq) const { { int t_ = threadIdx.x; asm volatile("" : "+v"(t_)); fr = t_ & 15; fq = (t_ >> 4) & 3; }
        const int g = u.pm >> 1, ch0 = (u.pm & 1) * 256 + wr * 64 + fr;
        const f32x4 dd = *(const f32x4*)(dpar + g * 16 + 4 * fq);
#pragma unroll
        for (int ai = 0; ai < 2; ++ai)
#pragma unroll
            for (int m = 0; m < 4; ++m) { const int chunk = ch0 + ai * 128 + m * 16;
#pragma unroll
                for (int bj = 0; bj < 2; ++bj)
#pragma unroll
                    for (int n = 0; n < 2; ++n) { const int t = u.pn * 16 + bj * 8 + wc * 2 + n;
                        const f32x4 uv = ld4bf(UC + ((size_t)g * SSM_NCH + chunk) * SSM_K + t * 16 + 4 * fq);
                        const f32x4 y = acc[ai][bj][m][n] + dd * uv;
                        st8(G + (size_t)(chunk * SSM_C + t) * 256 + g * 16 + 4 * fq, (f32x4){gelu_tanh_fast(y[0]), gelu_tanh_fast(y[1]), gelu_tanh_fast(y[2]), gelu_tanh_fast(y[3])}); } }
    }
};
struct EpiGlu {
    static constexpr bool PERM = false, AFTER_DRAIN = true;
    const bf16* G; const float *bias, *gain; bf16* MIX;
    __device__ __forceinline__ void fused(Acc& acc, const Unit& u, int wr, int wc, int fr, int fq, PG8_LAS unsigned char* lds, int wid, int lane) const { { int t_ = threadIdx.x; asm volatile("" : "+v"(t_)); fr = t_ & 15; fq = (t_ >> 4) & 3; }
        PG8_LAS float* P = (PG8_LAS float*)lds;
        const int row0 = u.pm * 256 + wr * 64 + fr;
#pragma unroll
        for (int ai = 0; ai < 2; ++ai)
#pragma unroll
            for (int m = 0; m < 4; ++m) { const int row = row0 + ai * 128 + m * 16; float ss = 0.f;
#pragma unroll
                for (int bj = 0; bj < 2; ++bj)
#pragma unroll
                    for (int n = 0; n < 2; ++n) { const int col = bj * 128 + wc * 32 + n * 16 + fq * 4; const f32x4 b4 = *(const f32x4*)(bias + col), gl = ld4bf(G + (size_t)row * 256 + col);
                        f32x4 z = acc[ai][bj][m][n] + b4;
                        z = (f32x4){gl[0] * fast_sigmoid(z[0]), gl[1] * fast_sigmoid(z[1]), gl[2] * fast_sigmoid(z[2]), gl[3] * fast_sigmoid(z[3])};
                        acc[ai][bj][m][n] = z; ss += (z[0] * z[0] + z[1] * z[1]) + (z[2] * z[2] + z[3] * z[3]); }
                ss += __shfl_xor(ss, 16); ss += __shfl_xor(ss, 32);
                if (fq == 0) P[(ai * 128 + wr * 64 + m * 16 + fr) * 4 + wc] = ss; }
        asm volatile("s_waitcnt lgkmcnt(0)" ::: "memory"); __builtin_amdgcn_s_barrier(); asm volatile("" ::: "memory");
#pragma unroll
        for (int ai = 0; ai < 2; ++ai)
#pragma unroll
            for (int m = 0; m < 4; ++m) { const int lr = ai * 128 + wr * 64 + m * 16 + fr, row = u.pm * 256 + lr;
                const float rstd = __builtin_amdgcn_rsqf(((P[lr * 4 + 0] + P[lr * 4 + 1]) + (P[lr * 4 + 2] + P[lr * 4 + 3])) * (1.f / 256.f) + EPS);
#pragma unroll
                for (int bj = 0; bj < 2; ++bj)
#pragma unroll
                    for (int n = 0; n < 2; ++n) { const int col = bj * 128 + wc * 32 + n * 16 + fq * 4; const f32x4 g4 = *(const f32x4*)(gain + col);
                        st8(MIX + (size_t)row * DM + 256 + col, acc[ai][bj][m][n] * rstd * g4); } }
        asm volatile("s_waitcnt lgkmcnt(0)" ::: "memory"); __builtin_amdgcn_s_barrier(); asm volatile("" ::: "memory");
    }
};
struct EpiStore {
    static constexpr bool PERM = true, AFTER_DRAIN = false;
    bf16* O; int ldc; const float* rowscale; size_t split_stride;
    __device__ __forceinline__ void operator()(const Acc& acc, const Unit& u, int wr, int wc, int fr, int fq) const { { int t_ = threadIdx.x; asm volatile("" : "+v"(t_)); fr = t_ & 15; fq = (t_ >> 4) & 3; }
        const int ks = u.pn >> 2, pn0 = u.pn & 3; bf16* O = this->O + (size_t)ks * split_stride;
        const int row0 = u.pm * 256 + wr * 64 + fr, col0 = pn0 * 256 + wc * 32 + 8 * fq;
#pragma unroll
        for (int ai = 0; ai < 2; ++ai)
#pragma unroll
            for (int m = 0; m < 4; ++m) { const int row = row0 + ai * 128 + m * 16; const float s = rowscale ? rowscale[row] : 1.f;
#pragma unroll
                for (int bj = 0; bj < 2; ++bj) st16(O + (size_t)row * ldc + col0 + bj * 128, acc[ai][bj][m][0] * s, acc[ai][bj][m][1] * s); }
    }
};
struct EpiSwiglu {
    static constexpr bool PERM = true, AFTER_DRAIN = false;
    bf16* H;
    __device__ __forceinline__ void operator()(const Acc& acc, const Unit& u, int wr, int wc, int fr, int fq) const { { int t_ = threadIdx.x; asm volatile("" : "+v"(t_)); fr = t_ & 15; fq = (t_ >> 4) & 3; }
        const int row0 = u.pm * 256 + wr * 64 + fr, h0 = u.pn * 128 + wc * 32 + 8 * fq;
#pragma unroll
        for (int ai = 0; ai < 2; ++ai)
#pragma unroll
            for (int m = 0; m < 4; ++m) { const int row = row0 + ai * 128 + m * 16;
                const f32x4 g0 = acc[ai][0][m][0], g1 = acc[ai][0][m][1], u0 = acc[ai][1][m][0], u1 = acc[ai][1][m][1];
                st16(H + (size_t)row * DFF + h0, (f32x4){silu_fast(g0[0]) * u0[0], silu_fast(g0[1]) * u0[1], silu_fast(g0[2]) * u0[2], silu_fast(g0[3]) * u0[3]},
                                                 (f32x4){silu_fast(g1[0]) * u1[0], silu_fast(g1[1]) * u1[1], silu_fast(g1[2]) * u1[2], silu_fast(g1[3]) * u1[3]}); }
    }
};
}
namespace att {
using namespace mk;
constexpr int KVBLK = 64, SHM_V = 64 * 128 * 2, SHM_KN = 64 * 128 * 2, SHM_KP = 64 * 64 * 2, KBUF = SHM_KN + SHM_KP;
constexpr int OFF_V = 0  , OFF_K = 3 * SHM_V  , OFF_WS = 3 * SHM_V + 2 * KBUF, LDS_BYTES = OFF_WS + NWAVES * 64 * 4;
constexpr float THR = 8.f;
#define KSWZ(row, colB) ((row) * 256 + ((colB) ^ (((row) & 7) << 4)))
#define KPSWZ(row, colB) ((row) * 128 + ((colB) ^ (((row) & 7) << 4)))
#define SBAR() __builtin_amdgcn_sched_barrier(0)
__device__ __forceinline__ int v_st(int k, int c) { const int kk = (k & ~0xC) | ((k & 4) << 1) | ((k & 8) >> 1); return ((kk >> 3) * 4 + (c >> 5)) * 512 + ((kk & 7) * 32 + (c & 31)) * 2; }
__device__ __forceinline__ int v_rd_base(int lane) { return ((lane & 3) << 3) | (((lane >> 2) & 3) << 6) | (((lane >> 4) & 1) << 5) | (((lane >> 5) & 1) << 8); }
constexpr int v_rd_off(int d0, int ks, int half) { return d0 * 512 + ks * 4096 + half * 2048; }
__device__ __forceinline__ int crow(int r, int hi) { return (r & 3) + 8 * (r >> 2) + 4 * hi; }

struct Tensors { const bf16* Q; const bf16* KN; const bf16* KP; const bf16* V; bf16* O; };

#define KFR(i) ((i) < 8 ? *reinterpret_cast<const bf16x8*>(kb[(i) & 3] + ((i) >> 2) * 128) : *reinterpret_cast<const bf16x8*>(kp0 + KPSWZ(r32, (((i) - 8) * 16 + hi * 8) * 2)))
#define PK4(P_, B__, OUT) do { unsigned a0 = cvtpk(P_[B__ + 0], P_[B__ + 1]), a1 = cvtpk(P_[B__ + 2], P_[B__ + 3]), b0 = cvtpk(P_[B__ + 4], P_[B__ + 5]), b1 = cvtpk(P_[B__ + 6], P_[B__ + 7]); \
        auto r0 = __builtin_amdgcn_permlane32_swap(a0, b0, false, false); auto r1 = __builtin_amdgcn_permlane32_swap(a1, b1, false, false); \
        u32x4 w = {r0[0], r1[0], r0[1], r1[1]}; OUT = *reinterpret_cast<bf16x8*>(&w); } while (0)
__device__ __forceinline__ void glds16(const void* gsrc, unsigned lds_dst) { unsigned keep;
    asm volatile("s_mov_b32 %0, m0\n\ts_mov_b32 m0, %2\n\ts_nop 0\n\tglobal_load_lds_dwordx4 %1, off\n\ts_mov_b32 m0, %0" : "=&s"(keep) : "v"(gsrc), "s"(lds_dst) : "memory"); }
#define WAIT_BAR(N) asm volatile("s_waitcnt vmcnt(" #N ") lgkmcnt(0)\n\ts_barrier" ::: "memory")
template <int ABL>
__device__ __forceinline__ void attn_unit(int b, int h, int qb, const Tensors& T, char* lds) {
    int tid_ = threadIdx.x; asm volatile("" : "+v"(tid_));
    const int tid = tid_, wid = __builtin_amdgcn_readfirstlane(tid >> 6), lane = tid & 63, r32 = lane & 31, hi = lane >> 5;
    const int rg = wid & 3, kh = wid >> 2;
    const size_t tok0 = (size_t)b * SEQ; const int q0 = qb * 128, NT = 2 * qb + 2;
    float* ws = (float*)(lds + OFF_WS) + wid * 64;
    const unsigned lds0 = (unsigned)(uintptr_t)lds;
    const bf16 *gk0, *gk1, *gp, *gv0, *gv1;
    { const int ra = 4 * wid + (lane >> 4), rb = ra + 32, cc = lane & 15;
      gk0 = T.KN + (tok0 + ra) * 512 + h * 128 + ((cc ^ (ra & 7)) << 3); gk1 = T.KN + (tok0 + rb) * 512 + h * 128 + ((cc ^ (rb & 7)) << 3);
      const int rp = 8 * wid + (lane >> 3), cp = lane & 7; gp = T.KP + (tok0 + rp) * 64 + ((cp ^ (rp & 7)) << 3);
      const int r8 = (lane >> 2) & 7, c8 = (lane & 3) * 8;
      { const int sub = 2 * wid + (lane >> 5), kk = (sub >> 2) * 8 + r8, key = (kk & ~0xC) | ((kk & 4) << 1) | ((kk & 8) >> 1); gv0 = T.V + (tok0 + key) * 512 + h * 128 + (sub & 3) * 32 + c8; }
      { const int sub = 2 * (wid + 8) + (lane >> 5), kk = (sub >> 2) * 8 + r8, key = (kk & ~0xC) | ((kk & 4) << 1) | ((kk & 8) >> 1); gv1 = T.V + (tok0 + key) * 512 + h * 128 + (sub & 3) * 32 + c8; } }
#define DMA_K(t, kso) do { const size_t ko_ = ABL == 1 ? (size_t)0 : (size_t)(t) * KVBLK; const unsigned d_ = (unsigned)__builtin_amdgcn_readfirstlane((int)(lds0 + OFF_K + (kso) + wid * 1024)); \
        glds16(gk0 + ko_ * 512, d_); glds16(gk1 + ko_ * 512, d_ + 8192); glds16(gp + ko_ * 64, d_ + SHM_KN); } while (0)
#define DMA_V(t, vso) do { const size_t ko_ = ABL == 1 ? (size_t)0 : (size_t)(t) * KVBLK; const unsigned d_ = (unsigned)__builtin_amdgcn_readfirstlane((int)(lds0 + OFF_V + (vso) + wid * 1024)); \
        glds16(gv0 + ko_ * 512, d_); glds16(gv1 + ko_ * 512, d_ + 8192); } while (0)
    DMA_K(0, 0); DMA_V(0, 0); DMA_K(1, KBUF); DMA_V(1, SHM_V);
    bf16x8 qr[12];
    { const bf16* qp = T.Q + (tok0 + q0 + rg * 32 + r32) * 768 + h * 192 + hi * 8;
#pragma unroll
      for (int d0 = 0; d0 < 12; ++d0) qr[d0] = *(const bf16x8*)(qp + d0 * 16);
#pragma unroll
      for (int d0 = 0; d0 < 12; ++d0) asm volatile("" : "+v"(qr[d0])); }
    float m_reg = -1e30f, l_reg = 0.f; f32x16 o[4] = {};
    const int vb0 = (int)lds0 + v_rd_base(lane) + kh * 8192;
    const int qpos = q0 + rg * 32 + r32;
    WAIT_BAR(0);
#define RESC(a) do { if (__any((a) < 1.f)) { if (hi == 0) ws[r32] = (a); asm volatile("s_waitcnt lgkmcnt(0)" ::: "memory"); \
        _Pragma("unroll") for (int d_ = 0; d_ < 4; ++d_) _Pragma("unroll") for (int r = 0; r < 16; ++r) o[d_][r] *= ws[crow(r, hi)]; } } while (0)
#define KBASES(so) const char* k0_ = lds + OFF_K + (so) + kh * 8192; const char* kp0 = lds + OFF_K + (so) + SHM_KN + kh * 4096; const char* kb[4]; \
        _Pragma("unroll") for (int dd = 0; dd < 4; ++dd) kb[dd] = k0_ + KSWZ(r32, (dd * 16 + hi * 8) * 2);
#define MASKT(P_, t_) do { const int kb_ = (t_) * KVBLK + kh * 32 + 4 * hi; const float NEG = -__builtin_inff(); \
        _Pragma("unroll") for (int r = 0; r < 16; ++r) { const int key = kb_ + (r & 3) + 8 * (r >> 2); if (key > qpos) P_[r] = NEG; } } while (0)
#define DECIDE(P_, AL_) do { float pm_ = fmaxf(fmaxf(P_[0], P_[1]), fmaxf(P_[2], P_[3])); \
        _Pragma("unroll") for (int r = 4; r < 16; r += 4) pm_ = fmaxf(pm_, fmaxf(fmaxf(P_[r], P_[r + 1]), fmaxf(P_[r + 2], P_[r + 3]))); \
        { auto rr = __builtin_amdgcn_permlane32_swap(__float_as_uint(pm_), __float_as_uint(pm_), false, false); pm_ = fmaxf(__uint_as_float(rr[0]), __uint_as_float(rr[1])); } \
        const bool ok_ = __all((pm_ - m_reg) <= THR); const float mn_ = ok_ ? m_reg : fmaxf(m_reg, pm_); AL_ = ok_ ? 1.f : __builtin_amdgcn_exp2f(m_reg - mn_); m_reg = mn_; } while (0)
    f32x16 pc, pn; float alpha;
    { KBASES(0); pc = f32x16{}; bf16x8 f0 = KFR(0), f1 = KFR(1), f2 = KFR(2), f3 = KFR(3); SBAR();
#define QS0(i, F) do { pc = __builtin_amdgcn_mfma_f32_32x32x16_bf16(F, qr[i], pc, 0, 0, 0); if ((i) + 4 < 12) F = KFR((i) + 4); SBAR(); } while (0)
      QS0(0, f0); QS0(1, f1); QS0(2, f2); QS0(3, f3); QS0(4, f0); QS0(5, f1); QS0(6, f2); QS0(7, f3); QS0(8, f0); QS0(9, f1); QS0(10, f2); QS0(11, f3);
#undef QS0
      if (0 >= NT - 2) MASKT(pc, 0);
      DECIDE(pc, alpha); }
    WAIT_BAR(0);
    int kcur = 0  , v_cur = 0, v_nxt = SHM_V, v_nxt2 = 2 * SHM_V;
    for (int t = 0; t < NT; ++t) {
        const bool more = t + 1 < NT;
        if (t + 2 < NT) DMA_K(t + 2, kcur);
        bf16x8 pa0, pa1; float ps = 0.f; const float mn = m_reg;
#define EX2(i) do { pc[2 * (i)] = __builtin_amdgcn_exp2f(pc[2 * (i)] - mn); pc[2 * (i) + 1] = __builtin_amdgcn_exp2f(pc[2 * (i) + 1] - mn); ps += pc[2 * (i)] + pc[2 * (i) + 1]; } while (0)
#define SUMFIN() do { auto rr = __builtin_amdgcn_permlane32_swap(__float_as_uint(ps), __float_as_uint(ps), false, false); ps = __uint_as_float(rr[0]) + __uint_as_float(rr[1]); l_reg = l_reg * alpha + ps; } while (0)
        if (more) {
            KBASES(KBUF - kcur); pn = f32x16{}; bf16x8 f0 = KFR(0), f1 = KFR(1), f2 = KFR(2), f3 = KFR(3); SBAR();
#define QS(i, F, FILL) do { pn = __builtin_amdgcn_mfma_f32_32x32x16_bf16(F, qr[i], pn, 0, 0, 0); if ((i) + 4 < 12) F = KFR((i) + 4); FILL; SBAR(); } while (0)
            QS(0, f0, EX2(0)); QS(1, f1, EX2(1)); QS(2, f2, EX2(2)); QS(3, f3, EX2(3)); QS(4, f0, EX2(4)); QS(5, f1, EX2(5)); QS(6, f2, EX2(6)); QS(7, f3, EX2(7));
            QS(8, f0, SUMFIN()); QS(9, f1, PK4(pc, 0, pa0)); QS(10, f2, PK4(pc, 8, pa1)); QS(11, f3, (void)0);
#undef QS
            if (t + 1 >= NT - 2) MASKT(pn, t + 1);
        } else {
            EX2(0); EX2(1); EX2(2); EX2(3); EX2(4); EX2(5); EX2(6); EX2(7); SUMFIN(); PK4(pc, 0, pa0); PK4(pc, 8, pa1); SBAR();
        }
#undef EX2
#undef SUMFIN
        RESC(alpha); SBAR();
        { const int vb = vb0 + v_cur; float alpha_n = 1.f;
#define TRRD(dst, off) asm volatile("ds_read_b64_tr_b16 %0, %1 offset:%2" : "=&v"(dst) : "v"(vb), "i"(off) : "memory")
          s16x4 l0, l1, h0, h1, l2, l3, h2, h3;
          { constexpr int b_ = v_rd_off(0, 0, 0), c_ = v_rd_off(1, 0, 0);
            TRRD(l0, b_); TRRD(h0, b_ + 2048); TRRD(l1, b_ + 4096); TRRD(h1, b_ + 6144); TRRD(l2, c_); TRRD(h2, c_ + 2048); TRRD(l3, c_ + 4096); TRRD(h3, c_ + 6144); }
          if (t + 2 < NT) DMA_V(t + 2, v_nxt2);
          asm volatile("s_waitcnt lgkmcnt(0)" ::: "memory"); SBAR();
          o[0] = __builtin_amdgcn_mfma_f32_32x32x16_bf16(pa0, (bf16x8){l0[0], l0[1], l0[2], l0[3], h0[0], h0[1], h0[2], h0[3]}, o[0], 0, 0, 0);
          o[1] = __builtin_amdgcn_mfma_f32_32x32x16_bf16(pa0, (bf16x8){l2[0], l2[1], l2[2], l2[3], h2[0], h2[1], h2[2], h2[3]}, o[1], 0, 0, 0);
          SBAR();
          o[0] = __builtin_amdgcn_mfma_f32_32x32x16_bf16(pa1, (bf16x8){l1[0], l1[1], l1[2], l1[3], h1[0], h1[1], h1[2], h1[3]}, o[0], 0, 0, 0);
          o[1] = __builtin_amdgcn_mfma_f32_32x32x16_bf16(pa1, (bf16x8){l3[0], l3[1], l3[2], l3[3], h3[0], h3[1], h3[2], h3[3]}, o[1], 0, 0, 0);
          { constexpr int b_ = v_rd_off(2, 0, 0), c_ = v_rd_off(3, 0, 0);
            TRRD(l0, b_); TRRD(h0, b_ + 2048); TRRD(l1, b_ + 4096); TRRD(h1, b_ + 6144); TRRD(l2, c_); TRRD(h2, c_ + 2048); TRRD(l3, c_ + 4096); TRRD(h3, c_ + 6144); }
          SBAR();
          if (more) DECIDE(pn, alpha_n);
          asm volatile("s_waitcnt lgkmcnt(0)" ::: "memory"); SBAR();
          o[2] = __builtin_amdgcn_mfma_f32_32x32x16_bf16(pa0, (bf16x8){l0[0], l0[1], l0[2], l0[3], h0[0], h0[1], h0[2], h0[3]}, o[2], 0, 0, 0);
          o[3] = __builtin_amdgcn_mfma_f32_32x32x16_bf16(pa0, (bf16x8){l2[0], l2[1], l2[2], l2[3], h2[0], h2[1], h2[2], h2[3]}, o[3], 0, 0, 0);
          o[2] = __builtin_amdgcn_mfma_f32_32x32x16_bf16(pa1, (bf16x8){l1[0], l1[1], l1[2], l1[3], h1[0], h1[1], h1[2], h1[3]}, o[2], 0, 0, 0);
          o[3] = __builtin_amdgcn_mfma_f32_32x32x16_bf16(pa1, (bf16x8){l3[0], l3[1], l3[2], l3[3], h3[0], h3[1], h3[2], h3[3]}, o[3], 0, 0, 0);
#undef TRRD
          alpha = alpha_n; }
        if (t + 2 < NT) WAIT_BAR(2); else WAIT_BAR(0);
        pc = pn;
        kcur = KBUF - kcur; v_cur = v_nxt; v_nxt = v_nxt2; v_nxt2 = (v_nxt2 == 2 * SHM_V) ? 0 : v_nxt2 + SHM_V;
    }
#undef RESC
#undef DMA_K
#undef DMA_V
#undef KBASES
#undef MASKT
#undef DECIDE
    float* XO = (float*)lds;
    float* XM = (float*)(lds + 65536);
    if (kh == 1) {
#pragma unroll
        for (int d0 = 0; d0 < 4; ++d0)
#pragma unroll
            for (int r = 0; r < 16; ++r) XO[((rg * 64) + d0 * 16 + r) * 64 + lane] = o[d0][r];
        if (hi == 0) { XM[rg * 32 + r32] = m_reg; XM[128 + rg * 32 + r32] = l_reg; }
    }
    __syncthreads();
    if (kh == 0) {
        const float m1 = XM[rg * 32 + r32], l1 = XM[128 + rg * 32 + r32];
        const float mn = fmaxf(m_reg, m1), a0 = __builtin_amdgcn_exp2f(m_reg - mn), a1 = __builtin_amdgcn_exp2f(m1 - mn);
        const float inv = __builtin_amdgcn_rcpf(l_reg * a0 + l1 * a1);
        if (hi == 0) { ws[r32] = a0 * inv; ws[32 + r32] = a1 * inv; }
        asm volatile("s_waitcnt lgkmcnt(0)" ::: "memory");
        bf16* Ow = T.O + (tok0 + q0 + rg * 32) * 512 + h * 128;
#pragma unroll
        for (int r = 0; r < 16; ++r) { const int orow = crow(r, hi); const float f0 = ws[orow], f1 = ws[32 + orow];
#pragma unroll
            for (int d0 = 0; d0 < 4; ++d0) { const float v = o[d0][r] * f0 + XO[((rg * 64) + d0 * 16 + r) * 64 + lane] * f1; const float vn = __shfl_xor(v, 1);
                if ((r32 & 1) == 0) *(unsigned*)(Ow + (size_t)orow * 512 + d0 * 32 + r32) = cvtpk(v, vn); } }
    }
    __syncthreads();
}
#undef WAIT_BAR
#undef KSWZ
#undef KPSWZ
#undef SBAR
}
namespace ret {
using namespace mk;
__device__ __forceinline__ int crow(int r, int hi) { return (r & 3) + 8 * (r >> 2) + 4 * hi; }
struct Tensors { const bf16 *RQ, *RK, *RKT, *RVT, *RG; float* KVT; bf16* STATE; bf16* MIX; const float* gain; };
__device__ __forceinline__ void x_unit(int u, const Tensors& T, int lane) {
    asm volatile("" : "+v"(lane));
    const int n = u & 127, bh = u >> 7, h = bh & 3, b = bh >> 2, r32 = lane & 31, hi = lane >> 5;
    const size_t tok0 = (size_t)b * SEQ + (size_t)n * RET_C;
    f32x16 acc[2][2] = {};
#pragma unroll
    for (int s = 0; s < 4; ++s) {
        bf16x8 a[2], bb[2];
#pragma unroll
        for (int i = 0; i < 2; ++i) { a[i] = *(const bf16x8*)(T.RVT + (size_t)(h * 64 + i * 32 + r32) * NTOK + tok0 + s * 16 + hi * 8);
                                      bb[i] = *(const bf16x8*)(T.RKT + (size_t)(h * 64 + i * 32 + r32) * NTOK + tok0 + s * 16 + hi * 8); }
#pragma unroll
        for (int i = 0; i < 2; ++i)
#pragma unroll
            for (int j = 0; j < 2; ++j) acc[i][j] = __builtin_amdgcn_mfma_f32_32x32x16_bf16(a[i], bb[j], acc[i][j], 0, 0, 0);
    }
    float* out = T.KVT + (size_t)u * 4096;
#pragma unroll
    for (int i = 0; i < 2; ++i)
#pragma unroll
        for (int j = 0; j < 2; ++j)
#pragma unroll
            for (int r = 0; r < 16; ++r) out[(i * 32 + crow(r, hi)) * 64 + j * 32 + r32] = acc[i][j][r];
}
__device__ __forceinline__ void scan_elem(int e, const Tensors& T) {
    const int bh = e >> 12, el = e & 4095, h = bh & 3;
    const float gam = 1.f - __builtin_amdgcn_exp2f(-5.f - (float)h), lg2 = __builtin_amdgcn_logf(gam);
    const float g64 = __builtin_amdgcn_exp2f(64.f * lg2), g63 = __builtin_amdgcn_exp2f(63.f * lg2);
    const float* kv = T.KVT + (size_t)bh * 128 * 4096 + el; bf16* st = T.STATE + (size_t)bh * 128 * 4096 + el;
    float S = 0.f;
    for (int n0 = 0; n0 < 128; n0 += 16) {
        float v[16];
#pragma unroll
        for (int i = 0; i < 16; ++i) v[i] = kv[(size_t)(n0 + i) * 4096];
#pragma unroll
        for (int i = 0; i < 16; ++i) { st[(size_t)(n0 + i) * 4096] = (bf16)(cvtpk(gam * S, 0.f) & 0xffffu); S = g64 * S + g63 * v[i]; }
    }
}
__device__ __forceinline__ void z_unit(int u, const Tensors& T, int lane) {
    asm volatile("" : "+v"(lane));
    const int n = u & 127, bh = u >> 7, h = bh & 3, b = bh >> 2, r32 = lane & 31, hi = lane >> 5;
    const size_t tok0 = (size_t)b * SEQ + (size_t)n * RET_C;
    bf16x8 qf[2][4];
#pragma unroll
    for (int qb = 0; qb < 2; ++qb)
#pragma unroll
        for (int s = 0; s < 4; ++s) qf[qb][s] = *(const bf16x8*)(T.RQ + (tok0 + qb * 32 + r32) * 256 + h * 64 + s * 16 + hi * 8);
    f32x16 o[2][2] = {};
    const bf16* stp = T.STATE + (size_t)u * 4096;
#pragma unroll
    for (int s = 0; s < 4; ++s) {
        bf16x8 a[2];
#pragma unroll
        for (int i = 0; i < 2; ++i) a[i] = *(const bf16x8*)(stp + (i * 32 + r32) * 64 + s * 16 + hi * 8);
#pragma unroll
        for (int i = 0; i < 2; ++i)
#pragma unroll
            for (int qb = 0; qb < 2; ++qb) o[i][qb] = __builtin_amdgcn_mfma_f32_32x32x16_bf16(a[i], qf[qb][s], o[i][qb], 0, 0, 0);
    }
#pragma unroll
    for (int kb = 0; kb < 2; ++kb) {
        bf16x8 kf[4];
#pragma unroll
        for (int s = 0; s < 4; ++s) kf[s] = *(const bf16x8*)(T.RK + (tok0 + kb * 32 + r32) * 256 + h * 64 + s * 16 + hi * 8);
#pragma unroll
        for (int qb = kb; qb < 2; ++qb) {
            f32x16 st = {};
#pragma unroll
            for (int s = 0; s < 4; ++s) st = __builtin_amdgcn_mfma_f32_32x32x16_bf16(kf[s], qf[qb][s], st, 0, 0, 0);
            if (kb == qb) {
#pragma unroll
                for (int r = 0; r < 16; ++r) if (crow(r, hi) > r32) st[r] = 0.f;
            }
#pragma unroll
            for (int s2 = 0; s2 < 2; ++s2) {
                u32x4 w; w.x = cvtpk(st[8 * s2 + 0], st[8 * s2 + 1]); w.y = cvtpk(st[8 * s2 + 2], st[8 * s2 + 3]); w.z = cvtpk(st[8 * s2 + 4], st[8 * s2 + 5]); w.w = cvtpk(st[8 * s2 + 6], st[8 * s2 + 7]);
                const bf16x8 pb = __builtin_bit_cast(bf16x8, w);
#pragma unroll
                for (int i = 0; i < 2; ++i) {
                    const bf16* vp = T.RVT + (size_t)(h * 64 + i * 32 + r32) * NTOK + tok0 + kb * 32 + s2 * 16 + 4 * hi;
                    const u32x2 lo = *(const u32x2*)vp, hh = *(const u32x2*)(vp + 8);
                    const u32x4 av = {lo.x, lo.y, hh.x, hh.y};
                    o[i][qb] = __builtin_amdgcn_mfma_f32_32x32x16_bf16(__builtin_bit_cast(bf16x8, av), pb, o[i][qb], 0, 0, 0);
                }
            }
        }
    }
#pragma unroll
    for (int qb = 0; qb < 2; ++qb) {
        float ss = 0.f;
#pragma unroll
        for (int i = 0; i < 2; ++i)
#pragma unroll
            for (int r = 0; r < 16; ++r) ss += o[i][qb][r] * o[i][qb][r];
        { auto rr = __builtin_amdgcn_permlane32_swap(__float_as_uint(ss), __float_as_uint(ss), false, false); ss = __uint_as_float(rr[0]) + __uint_as_float(rr[1]); }
        const float rstd = __builtin_amdgcn_rsqf(ss * (1.f / 64.f) + EPS);
        const size_t row = tok0 + qb * 32 + r32;
#pragma unroll
        for (int i = 0; i < 2; ++i)
#pragma unroll
            for (int r4 = 0; r4 < 4; ++r4) { const int dv = i * 32 + 8 * r4 + 4 * hi;
                const f32x4 gt = ld4bf(T.RG + row * 256 + h * 64 + dv), gn = *(const f32x4*)(T.gain + h * 64 + dv);
                const f32x4 v = {o[i][qb][4 * r4 + 0], o[i][qb][4 * r4 + 1], o[i][qb][4 * r4 + 2], o[i][qb][4 * r4 + 3]};
                st8(T.MIX + row * DM + h * 64 + dv, v * rstd * gn * gt); }
    }
}
}
namespace mk {
constexpr size_t MiB = 1u << 20;
constexpr size_t W_CTL = 0, CTL_ZERO_BYTES = 64 * 1024;
constexpr size_t W_WGCNT = 128 * 1024;
constexpr size_t W_TILE = 192 * 1024;
constexpr size_t W_MOD = 1 * MiB;
constexpr size_t W_LAMC = 1 * MiB + 256 * 1024;
constexpr size_t W_TOP = 1 * MiB + 512 * 1024;
constexpr size_t W_CS = 2 * MiB;
constexpr size_t W_ROWW = 6 * MiB;
constexpr size_t W_MODP = 7 * MiB;
constexpr size_t W_SSQQ = 6 * MiB + 256 * 1024, W_SSQKV = 6 * MiB + 512 * 1024;
constexpr size_t W_MOEUP = 8 * MiB, W_MOEDN = 120 * MiB;
constexpr size_t W_WIN = 176 * MiB, W_WOUT = 183 * MiB, W_FFUP = 187 * MiB, W_FFDN = 201 * MiB, W_MW = 208 * MiB, W_WEND = 228 * MiB;
constexpr size_t W_WUQ = 233 * MiB, W_WUKV = 234 * MiB, W_GLUW = 235 * MiB;
constexpr size_t W_Y = 236 * MiB, W_MIX = 268 * MiB, W_T = 300 * MiB;
constexpr size_t W_RQ = W_T, W_RK = W_T + 8 * MiB, W_RKT = W_T + 16 * MiB, W_RVT = W_T + 24 * MiB, W_RG = W_T + 32 * MiB, W_UC = W_T + 40 * MiB, W_CQ = W_T + 50 * MiB,
                 W_CKV = W_T + 58 * MiB, W_KPE = W_T + 62 * MiB, W_Q = W_T + 64 * MiB, W_KN = W_T + 88 * MiB, W_V = W_T + 104 * MiB, W_O = W_T + 120 * MiB, W_G = W_T + 136 * MiB,
                 W_KVT = W_T + 144 * MiB, W_STATE = W_T + 160 * MiB, W_E = W_T + 168 * MiB;
constexpr size_t W_HB = W_T;
constexpr size_t W_XN = 480 * MiB;
constexpr size_t W_XG = 176 * MiB;
constexpr size_t W_Y2B = 8 * MiB;
constexpr size_t W_HBM = 244 * MiB;
constexpr size_t W_END = 512 * MiB;

struct Args { const void* in[35]; float* out; unsigned char* ws; int ph_lo, ph_hi, never, pad; };

template <class SrcF>
__device__ __forceinline__ void transpose_item(const SrcF src, int ld, int K, bf16* WT, const float* kscale, float cscale, LAS float* scr, int kb, int nb, int lane) {
    const int k0 = 64 * kb, n0 = 32 * nb;
    const float* sp = src(n0 + (lane & 31));
    float tv[32];
#pragma unroll
    for (int i = 0; i < 32; ++i) tv[i] = sp[(size_t)(k0 + 2 * i + (lane >> 5)) * ld];
#pragma unroll
    for (int i = 0; i < 32; ++i) { const int kk = 2 * i + (lane >> 5); float v = tv[i] * cscale; if (kscale) v *= kscale[k0 + kk]; scr[kk * 33 + (lane & 31)] = v; }
    asm volatile("s_waitcnt lgkmcnt(0)" ::: "memory");
    const int c = lane & 7;
#pragma unroll
    for (int j = 0; j < 4; ++j) { const int n = (lane >> 3) + 8 * j; const LAS float* s = scr + (8 * c) * 33 + n;
        u32x4 o; o.x = cvtpk(s[0 * 33], s[1 * 33]); o.y = cvtpk(s[2 * 33], s[3 * 33]); o.z = cvtpk(s[4 * 33], s[5 * 33]); o.w = cvtpk(s[6 * 33], s[7 * 33]);
        *(u32x4*)(WT + (size_t)(n0 + n) * K + k0 + 8 * c) = o; }
    asm volatile("s_waitcnt lgkmcnt(0)" ::: "memory");
}
struct SrcPlain { const float* W; __device__ __forceinline__ const float* operator()(int n) const { return W + n; } };
struct SrcWin { const float* W; __device__ __forceinline__ const float* operator()(int n) const {
        const bool rp = (n < 512) || (n >= 1664); const int g = n & ~63, cg = n & 63; return W + (rp ? g + (cg >> 1) + 32 * (cg & 1) : n); } };
struct SrcWuq { const float* W; __device__ __forceinline__ const float* operator()(int n) const { const int hh = n / 192, w = n % 192; const int cg = w - 128; return W + (w < 128 ? n : hh * 192 + 128 + (cg >> 1) + 32 * (cg & 1)); } };
struct SrcGU { const float* Wg; const float* Wu; __device__ __forceinline__ const float* operator()(int n) const { const int hid = (n >> 3) * 4 + (n & 3);
        const long long du = (const char*)Wu - (const char*)Wg; return (const float*)((const char*)Wg + (((n >> 2) & 1) ? du : 0ll)) + hid; } };

__device__ __forceinline__ f32x2 lam_pow(float a_re, float a_im, float dt, float e) {
    const float mag = __builtin_amdgcn_exp2f(1.4426950408889634f * a_re * dt * e);
    const double rev = (double)(a_im * dt) * (double)e * 0.15915494309189535;
    const float fr = (float)(rev - floor(rev));
    return (f32x2){mag * __builtin_amdgcn_cosf(fr), mag * __builtin_amdgcn_sinf(fr)};
}
__device__ __forceinline__ f32x2 cmul(f32x2 a, f32x2 b) { return (f32x2){a.x * b.x - a.y * b.y, a.x * b.y + a.y * b.x}; }

template <bool GU>
__device__ __forceinline__ void xp_issue(f32x4 (&v)[8], const float* W0, const float* W1, int ld, int k0, int n0, int tid) {
#pragma unroll
    for (int i = 0; i < 8; ++i) { const int idx = tid + 512 * i, row = idx >> 6, c4 = idx & 63;
        const float* src = GU ? ((c4 < 32 ? W0 : W1) + (size_t)(k0 + row) * ld + (n0 >> 1) + 4 * (c4 & 31)) : (W0 + (size_t)(k0 + row) * ld + n0 + 4 * c4);
        v[i] = *(const f32x4*)src; }
}
template <bool GU>
__device__ __forceinline__ void xp_finish(const f32x4 (&v)[8], bf16* WT, int K, int k0, int n0, LAS float* T, int tid) {
#pragma unroll
    for (int i = 0; i < 8; ++i) { const int idx = tid + 512 * i, row = idx >> 6, c4 = idx & 63; *(LAS f32x4*)(T + row * 256 + ((4 * c4) ^ (((row >> 3) & 7) << 2))) = v[i]; }
    __syncthreads();
#pragma unroll
    for (int j = 0; j < 4; ++j) { const int id = tid + 512 * j, c = id & 7, n = id >> 3; const int col = n;
        const LAS float* s = T + (8 * c) * 256 + (col ^ (c << 2));
        u32x4 o; o.x = cvtpk(s[0], s[256]); o.y = cvtpk(s[512], s[768]); o.z = cvtpk(s[1024], s[1280]); o.w = cvtpk(s[1536], s[1792]);
        *(u32x4*)(WT + (size_t)(n0 + n) * K + k0 + 8 * c) = o; }
    __syncthreads();
}
template <bool GU>
__device__ __forceinline__ void xp_matrix(const float* W0, const float* W1, int ld, int K, int N, bf16* WT, LAS float* T, int bx, int G, int tid) {
    const int nb_ = N / 256, ni_ = (K / 64) * nb_;
    f32x4 v[8];
    int it = bx; if (it >= ni_) return;
    xp_issue<GU>(v, W0, W1, ld, 64 * (it / nb_), 256 * (it % nb_), tid);
    for (; it < ni_; it += G) {
        f32x4 w[8];
#pragma unroll
        for (int i = 0; i < 8; ++i) w[i] = v[i];
        const int nx = it + G;
        if (nx < ni_) xp_issue<GU>(v, W0, W1, ld, 64 * (nx / nb_), 256 * (nx % nb_), tid);
        xp_finish<GU>(w, WT, K, 64 * (it / nb_), 256 * (it % nb_), T, tid);
    }
}

constexpr int MOE_ITEMS = NE * 672;
__device__ __forceinline__ void moe_item_issue(f32x4 (&v)[8], int id, const float* wg, const float* wu, const float* wd, int tid) {
    const int e = id / 672, r = id % 672;
    if (r < 448) xp_issue<true>(v, wg + (size_t)e * DM * DFF, wu + (size_t)e * DM * DFF, DFF, 64 * (r / 28), 256 * (r % 28), tid);
    else { const int q = r - 448; xp_issue<false>(v, wd + (size_t)e * DFF * DM, nullptr, DM, 64 * (q >> 2), 256 * (q & 3), tid); }
}
__device__ __forceinline__ void moe_item_finish(const f32x4 (&v)[8], int id, bf16* up, bf16* dn, LAS float* T, int tid) {
    const int e = id / 672, r = id % 672;
    if (r < 448) xp_finish<true>(v, up + (size_t)e * 2 * DFF * DM, DM, 64 * (r / 28), 256 * (r % 28), T, tid);
    else { const int q = r - 448; xp_finish<false>(v, dn + (size_t)e * DM * DFF, DFF, 64 * (q >> 2), 256 * (q & 3), T, tid); }
}
__device__ __forceinline__ void moe_convert(int quota, unsigned* counter, const float* wg, const float* wu, const float* wd, bf16* up, bf16* dn, LAS float* T, volatile LAS int* slot, int tid) {
    if (quota <= 0) return;
    __syncthreads();
    if (tid == 0) slot[0] = (int)__hip_atomic_fetch_add(counter, 1u, __ATOMIC_RELAXED, __HIP_MEMORY_SCOPE_AGENT);
    __syncthreads();
    int cur = slot[0]; if (cur >= MOE_ITEMS) return;
    f32x4 v[8]; moe_item_issue(v, cur, wg, wu, wd, tid);
    for (int n = 1;; ++n) {
        int nxt = MOE_ITEMS;
        if (n < quota) { __syncthreads(); if (tid == 0) slot[0] = (int)__hip_atomic_fetch_add(counter, 1u, __ATOMIC_RELAXED, __HIP_MEMORY_SCOPE_AGENT); __syncthreads(); nxt = slot[0]; }
        f32x4 w[8];
#pragma unroll
        for (int i = 0; i < 8; ++i) w[i] = v[i];
        if (nxt < MOE_ITEMS) moe_item_issue(v, nxt, wg, wu, wd, tid);
        moe_item_finish(w, cur, up, dn, T, tid);
        if (nxt >= MOE_ITEMS) break;
        cur = nxt;
    }
}
}
namespace mk {
struct SsmPar { const float *a_re, *a_im, *b_re, *b_im, *c_re, *c_im, *log_dt; };
__device__ __forceinline__ f32x2 ssm_fw(const SsmPar& P, int g, int p, float e, bool with_f) {
    const float dt = __builtin_amdgcn_exp2f(1.4426950408889634f * P.log_dt[g]);
    const float ar = P.a_re[g * 64 + p], ai = P.a_im[g * 64 + p];
    f32x2 w = lam_pow(ar, ai, dt, e);
    if (with_f) { const f32x2 lb = lam_pow(ar, ai, dt, 1.f); const float nr = lb.x - 1.f, ni = lb.y, den = ar * ar + ai * ai;
        const f32x2 f = {(nr * ar + ni * ai) / den, (ni * ar - nr * ai) / den}; w = cmul(w, f); }
    return w;
}
__device__ __forceinline__ void ssm_unit_toep(const SsmPar& P, bf16* MW, int g, int dd, LAS float* scr, int lane) {
    const int d = dd - 31, h = lane >> 2, hp0 = (lane & 3) * 4;
    f32x4 acc = {0.f, 0.f, 0.f, 0.f};
    if (d >= 0) {
#pragma unroll
        for (int i = 0; i < 4; ++i) { const int o = 4 * (lane + 64 * i);
            *(LAS f32x4*)(scr + o) = *(const f32x4*)(P.c_re + g * 1024 + o); *(LAS f32x4*)(scr + 1024 + o) = *(const f32x4*)(P.c_im + g * 1024 + o);
            *(LAS f32x4*)(scr + 2048 + o) = *(const f32x4*)(P.b_re + g * 1024 + o); *(LAS f32x4*)(scr + 3072 + o) = *(const f32x4*)(P.b_im + g * 1024 + o); }
        const f32x2 w = ssm_fw(P, g, lane, (float)d, true);
        asm volatile("s_waitcnt lgkmcnt(0)" ::: "memory");
#pragma unroll 8
        for (int p = 0; p < 64; ++p) {
            const f32x2 wp = {__shfl(w.x, p), __shfl(w.y, p)};
            const f32x2 cm = {scr[h * 64 + p], scr[1024 + h * 64 + p]};
            const f32x2 t = cmul(cm, wp);
            const f32x4 br = *(const LAS f32x4*)(scr + 2048 + p * 16 + hp0), bi = *(const LAS f32x4*)(scr + 3072 + p * 16 + hp0);
            acc += br * t.x - bi * t.y;
        }
        asm volatile("s_waitcnt lgkmcnt(0)" ::: "memory");
    }
    const int tlo = d >= 0 ? d : 0, thi = d >= 0 ? 32 : 32 + d;
    for (int t = tlo; t < thi; ++t) st8(MW + ((size_t)g * 512 + t * 16 + h) * SSM_K + (t - d) * 16 + hp0, acc);
}
__device__ __forceinline__ void ssm_unit_cross(const SsmPar& P, bf16* MW, f32x2* LAMC, int g, int t, int lane) {
    const f32x2 lp = ssm_fw(P, g, lane, (float)(t + 1), false);
    if (t == 31) LAMC[g * 64 + lane] = lp;
#pragma unroll 4
    for (int h = 0; h < 16; ++h) { const f32x2 cm = {P.c_re[(g * 16 + h) * 64 + lane], P.c_im[(g * 16 + h) * 64 + lane]}; const f32x2 v = cmul(cm, lp);
        *(unsigned*)(MW + ((size_t)g * 512 + t * 16 + h) * SSM_K + 512 + 2 * lane) = cvtpk(v.x, -v.y); }
}
__device__ __forceinline__ void ssm_unit_end(const SsmPar& P, bf16* WEND, int g, int j, int lane) {
    const f32x2 w = ssm_fw(P, g, lane, (float)(31 - j), true);
    float re[16], im[16];
#pragma unroll
    for (int q = 0; q < 4; ++q) { const f32x4 br = *(const f32x4*)(P.b_re + (g * 64 + lane) * 16 + 4 * q), bi = *(const f32x4*)(P.b_im + (g * 64 + lane) * 16 + 4 * q);
#pragma unroll
        for (int k = 0; k < 4; ++k) { re[4 * q + k] = w.x * br[k] - w.y * bi[k]; im[4 * q + k] = w.x * bi[k] + w.y * br[k]; } }
    bf16* r0 = WEND + ((size_t)g * 128 + 2 * lane) * 512 + j * 16;
    st16(r0, (f32x4){re[0], re[1], re[2], re[3]}, (f32x4){re[4], re[5], re[6], re[7]}); st16(r0 + 8, (f32x4){re[8], re[9], re[10], re[11]}, (f32x4){re[12], re[13], re[14], re[15]});
    st16(r0 + 512, (f32x4){im[0], im[1], im[2], im[3]}, (f32x4){im[4], im[5], im[6], im[7]}); st16(r0 + 520, (f32x4){im[8], im[9], im[10], im[11]}, (f32x4){im[12], im[13], im[14], im[15]});
}
__device__ __forceinline__ void ssm_scan(int bg, const float* E, const f32x2* LAMC, bf16* UC, int lane) {
    const int b = bg >> 4, g = bg & 15;
    const f32x2 lc = LAMC[g * 64 + lane];
    f32x2 c = {0.f, 0.f};
    for (int n0 = 0; n0 < 256; n0 += 16) {
        f32x2 e[16];
#pragma unroll
        for (int i = 0; i < 16; ++i) e[i] = *(const f32x2*)(E + ((size_t)g * SSM_NCH + b * 256 + n0 + i) * 128 + 2 * lane);
#pragma unroll
        for (int i = 0; i < 16; ++i) { *(unsigned*)(UC + ((size_t)g * SSM_NCH + b * 256 + n0 + i) * SSM_K + 512 + 2 * lane) = cvtpk(c.x, c.y); c = cmul(lc, c) + e[i]; }
    }
}
struct Row { f32x4 v[4]; };
__device__ __forceinline__ Row row_ld_f32(const float* p, int lane) { Row r;
#pragma unroll
    for (int j = 0; j < 4; ++j) r.v[j] = *(const f32x4*)(p + 4 * lane + 256 * j);
    return r; }
__device__ __forceinline__ Row row_ld_bf16(const bf16* p, int lane) { Row r;
#pragma unroll
    for (int j = 0; j < 4; ++j) r.v[j] = ld4bf(p + 4 * lane + 256 * j);
    return r; }
__device__ __forceinline__ float row_ssq(const Row& r) { float s = 0.f;
#pragma unroll
    for (int j = 0; j < 4; ++j) s += (r.v[j][0] * r.v[j][0] + r.v[j][1] * r.v[j][1]) + (r.v[j][2] * r.v[j][2] + r.v[j][3] * r.v[j][3]);
    return wave_sum(s); }
__device__ __forceinline__ Row adaln(const Row& x, const float* g, const float* sc, const float* sh, bf16* xn, int lane) {
    const float rstd = __builtin_amdgcn_rsqf(row_ssq(x) * (1.f / DM) + EPS); Row o;
#pragma unroll
    for (int j = 0; j < 4; ++j) { const int c = 4 * lane + 256 * j; const f32x4 g4 = *(const f32x4*)(g + c), s4 = *(const f32x4*)(sc + c), h4 = *(const f32x4*)(sh + c);
        o.v[j] = x.v[j] * rstd * g4 * (s4 + 1.f) + h4; st8(xn + c, o.v[j]); }
    return o; }
__device__ __forceinline__ Row resid(const Row& xin, const Row& y, const float* g, const float* gt, float* xout, int lane) {
    const float rstd = __builtin_amdgcn_rsqf(row_ssq(y) * (1.f / DM) + EPS); Row o;
#pragma unroll
    for (int j = 0; j < 4; ++j) { const int c = 4 * lane + 256 * j; const f32x4 g4 = *(const f32x4*)(g + c), t4 = *(const f32x4*)(gt + c);
        o.v[j] = xin.v[j] + t4 * y.v[j] * rstd * g4; *(f32x4*)(xout + c) = o.v[j]; }
    return o; }
__device__ __forceinline__ void route(const Row& h, const float* router, int lane, int& e1, int& e2, float& w1, float& w2) {
    float acc[8];
#pragma unroll
    for (int e = 0; e < 8; ++e) acc[e] = 0.f;
#pragma unroll
    for (int j = 0; j < 4; ++j)
#pragma unroll
        for (int k = 0; k < 4; ++k) { const int c = 4 * lane + 256 * j + k; const f32x4 r0 = *(const f32x4*)(router + c * 8), r1 = *(const f32x4*)(router + c * 8 + 4); const float hv = h.v[j][k];
            acc[0] += hv * r0[0]; acc[1] += hv * r0[1]; acc[2] += hv * r0[2]; acc[3] += hv * r0[3]; acc[4] += hv * r1[0]; acc[5] += hv * r1[1]; acc[6] += hv * r1[2]; acc[7] += hv * r1[3]; }
#pragma unroll
    for (int e = 0; e < 8; ++e) acc[e] = wave_sum(acc[e]);
    e1 = 0; float v1 = acc[0];
#pragma unroll
    for (int e = 1; e < 8; ++e) if (acc[e] > v1) { v1 = acc[e]; e1 = e; }
    e2 = -1; float v2 = -__builtin_inff();
#pragma unroll
    for (int e = 0; e < 8; ++e) if (e != e1 && acc[e] > v2) { v2 = acc[e]; e2 = e; }
    const float ex = __builtin_amdgcn_exp2f(1.4426950408889634f * (v2 - v1)); w1 = 1.f / (1.f + ex); w2 = ex / (1.f + ex);
}

__device__ __forceinline__ void glu_unit(int u, const bf16* G, const bf16* GLUW, const float* bias, const float* gain, bf16* MIX, int lane) {
    asm volatile("" : "+v"(lane));
    const int r32 = lane & 31, hi = lane >> 5; const size_t tok = (size_t)u * 32 + r32;
    f32x16 acc[8] = {};
#pragma unroll 2
    for (int s = 0; s < 16; ++s) {
        const bf16x8 bf = *(const bf16x8*)(G + tok * 256 + s * 16 + hi * 8);
#pragma unroll
        for (int j = 0; j < 8; ++j) { const bf16x8 a = *(const bf16x8*)(GLUW + (size_t)(j * 32 + r32) * 256 + s * 16 + hi * 8); acc[j] = __builtin_amdgcn_mfma_f32_32x32x16_bf16(a, bf, acc[j], 0, 0, 0); }
    }
    float ss = 0.f;
#pragma unroll
    for (int j = 0; j < 8; ++j)
#pragma unroll
        for (int r4 = 0; r4 < 4; ++r4) { const int ch = j * 32 + 8 * r4 + 4 * hi; const f32x4 b4 = *(const f32x4*)(bias + ch), gl = ld4bf(G + tok * 256 + ch);
#pragma unroll
            for (int k = 0; k < 4; ++k) { const float y = gl[k] * fast_sigmoid(acc[j][4 * r4 + k] + b4[k]); acc[j][4 * r4 + k] = y; ss += y * y; } }
    { auto rr = __builtin_amdgcn_permlane32_swap(__float_as_uint(ss), __float_as_uint(ss), false, false); ss = __uint_as_float(rr[0]) + __uint_as_float(rr[1]); }
    const float rstd = __builtin_amdgcn_rsqf(ss * (1.f / 256.f) + EPS);
#pragma unroll
    for (int j = 0; j < 8; ++j)
#pragma unroll
        for (int r4 = 0; r4 < 4; ++r4) { const int ch = j * 32 + 8 * r4 + 4 * hi; const f32x4 g4 = *(const f32x4*)(gain + ch);
            st8(MIX + tok * DM + 256 + ch, (f32x4){acc[j][4 * r4 + 0], acc[j][4 * r4 + 1], acc[j][4 * r4 + 2], acc[j][4 * r4 + 3]} * rstd * g4); }
}
}
#ifndef MK_MASK
#define MK_MASK 0x1fff
#endif
#define PH_ON(n) (((MK_MASK) >> (n)) & 1)
#ifndef MK_Q2
#define MK_Q2 6
#endif
#ifndef MK_Q3
#define MK_Q3 7
#endif
#ifndef MK_REP_MASK
#define MK_REP_MASK 0
#endif
#ifndef MK_REP_N
#define MK_REP_N 2
#endif
#ifndef MK_SUB
#define MK_SUB 0xff
#endif
#define SUB_ON(n) (((MK_SUB) >> (n)) & 1)
namespace mk {
constexpr int RING_BYTES = 131072, MISC_OFF = RING_BYTES + 320, LDS_BYTES = 147456;
constexpr int NPHASE = 25;
__device__ __forceinline__ bool phase_active(int ph) { if (ph == 0) return true; const int l = (ph - 1) / 12, k = (ph - 1) % 12; if (k == 0) return l == 0; if (k == 8) return l == 1; if (k == 5) return false; return true; }

__device__ __forceinline__ const float* inp(const Args& a, int i) { asm volatile("" : "+s"(i)); return (const float*)a.in[i]; }
__global__ void __launch_bounds__(NWAVES * 64, 2) mk_fwd(Args args) {
    extern __shared__ __attribute__((aligned(16))) unsigned char lds[];
    LAS unsigned char* L = (LAS unsigned char*)lds;
    volatile LAS unsigned* MISC = (volatile LAS unsigned*)(L + MISC_OFF);
    const int tid0 = threadIdx.x;
    const int G = gridDim.x, NGW = G * NWAVES;
    for (int u = tid0; u < (LDS_BYTES - RING_BYTES) / 4; u += NWAVES * 64) ((LAS unsigned*)(L + RING_BYTES))[u] = 0u;
    __syncthreads();
    unsigned char* ws = args.ws;
    XcdBarrier bar; bar.bar = (unsigned*)(ws + W_CTL) + 1024; bar.x = 0; bar.st = nullptr;
    if (args.ph_hi - args.ph_lo > 1) bar = xcd_barrier_post((unsigned*)(ws + W_CTL) + 1024, MISC + 8);
    if (args.never) cooperative_groups::this_grid().sync();
#define INF(i) (inp(args, (i)))
#define MOECONV(Q_) do { int tidq_ = threadIdx.x; asm volatile("" : "+v"(tidq_)); moe_convert((Q_), (unsigned*)(ws + W_CTL) + 8192, INF(32), INF(33), INF(34), (bf16*)(ws + W_MOEUP), (bf16*)(ws + W_MOEDN), (LAS float*)L, (volatile LAS int*)(L + RING_BYTES + 64), tidq_); } while (0)
#define x_in INF(0)
#define out (args.out)
#define MOD ((float*)(ws + W_MOD))
#define CS4 ((const f32x4*)(ws + W_CS))
#define XN ((bf16*)(ws + W_XN))
#define Yb ((bf16*)(ws + W_Y))
#define MIX ((bf16*)(ws + W_MIX))
#define RQ ((bf16*)(ws + W_RQ))
#define RK ((bf16*)(ws + W_RK))
#define RKT ((bf16*)(ws + W_RKT))
#define RVT ((bf16*)(ws + W_RVT))
#define RG ((bf16*)(ws + W_RG))
#define UC ((bf16*)(ws + W_UC))
#define CQ ((bf16*)(ws + W_CQ))
#define CKV ((bf16*)(ws + W_CKV))
#define KPE ((bf16*)(ws + W_KPE))
#define Qb ((bf16*)(ws + W_Q))
#define KN ((bf16*)(ws + W_KN))
#define Vb ((bf16*)(ws + W_V))
#define Ob ((bf16*)(ws + W_O))
#define GB ((bf16*)(ws + W_G))
#define STATE ((bf16*)(ws + W_STATE))
#define HB ((bf16*)(ws + W_HB))
#define XG ((bf16*)(ws + W_XG))
#define HBM ((bf16*)(ws + W_HBM))
#define KVT ((float*)(ws + W_KVT))
#define EB ((float*)(ws + W_E))
#define SSQQ ((float*)(ws + W_SSQQ))
#define SSQKV ((float*)(ws + W_SSQKV))
#define ROWW ((float*)(ws + W_ROWW))
#define WGCNT ((int*)(ws + W_WGCNT))
#define TILE ((int*)(ws + W_TILE))
#define TOPI ((int*)(ws + W_TOP))
#define TOPW ((float*)(ws + W_TOP + 128 * 1024))
#define TPOS ((int*)(ws + W_TOP + 256 * 1024))
#define WIN ((bf16*)(ws + W_WIN + (size_t)l * (7 * MiB / 2)))
#define WOUT ((bf16*)(ws + W_WOUT + (size_t)l * 2 * MiB))
#define MW ((bf16*)(ws + W_MW + (size_t)l * 10 * MiB))
#define WEND ((bf16*)(ws + W_WEND + (size_t)l * 2 * MiB))
#define WUQ ((bf16*)(ws + W_WUQ + (size_t)l * 384 * 1024))
#define WUKV ((bf16*)(ws + W_WUKV + (size_t)l * 256 * 1024))
#define GLUW ((bf16*)(ws + W_GLUW + (size_t)l * 128 * 1024))
#define LAMC ((f32x2*)(ws + W_LAMC) + l * 1024)
#define modl (MOD + l * 2 * 6144)
    int repcnt = 0;
    for (int ph = args.ph_lo; ph < args.ph_hi; ++ph) {
        if (!phase_active(ph)) continue;
        int bx = blockIdx.x; asm volatile("" : "+s"(bx));
        const int vcu = (G % 8 == 0) ? (bx % 8) * (G / 8) + bx / 8 : bx;
#define LANEDEFS int tid = threadIdx.x; asm volatile("" : "+v"(tid)); const int lane = tid & 63, wave = __builtin_amdgcn_readfirstlane(tid >> 6), gw = bx * NWAVES + wave; (void)lane; (void)wave; (void)gw;
        const int l = ph == 0 ? 0 : (ph - 1) / 12, k = ph == 0 ? -1 : (ph - 1) % 12;
        if (ph == 0 && PH_ON(0)) { LANEDEFS
            LAS float* scr = (LAS float*)(L + wave * 16384);
            for (int u = gw; u < 1536; u += NGW) { const int ll = u / 768, r = u % 768, n0 = (r >> 3) * 64, ks = r & 7; const float* aw = INF(3) + (size_t)ll * DM * 6144 + n0 + lane; const float* c = INF(1);
                float a0 = 0.f, a1 = 0.f;
#pragma unroll 16
                for (int kk = 0; kk < 128; ++kk) { const int kq = ks * 128 + kk; const float w = aw[(size_t)kq * 6144]; a0 += silu_fast(c[kq]) * w; a1 += silu_fast(c[DM + kq]) * w; }
                float* mp = (float*)(ws + W_MODP) + (size_t)(ks * 2 + ll) * 2 * 6144 + n0 + lane; mp[0] = a0; mp[6144] = a1; }
#define CONV(SRC, LD, KK, NN, DST, KSC, CSC) do { const int nb_ = (NN) / 32, ni_ = ((KK) / 64) * nb_; for (int it = gw; it < ni_; it += NGW) transpose_item(SRC, LD, KK, DST, KSC, CSC, scr, it / nb_, it % nb_, lane); } while (0)
            for (int ll = 0; ll < 2; ++ll) {
                CONV((SrcWin{INF(9) + (size_t)ll * DM * INC}), INC, DM, INC, (bf16*)(ws + W_WIN + (size_t)ll * (7 * MiB / 2)), nullptr, 1.f);
                CONV((SrcWuq{INF(23) + (size_t)ll * 256 * 768}), 768, 256, 768, (bf16*)(ws + W_WUQ + (size_t)ll * 384 * 1024), INF(22) + ll * 256, QSCALE);
                CONV((SrcPlain{INF(25) + (size_t)ll * 128 * 1024}), 1024, 128, 1024, (bf16*)(ws + W_WUKV + (size_t)ll * 256 * 1024), INF(24) + ll * 128, 1.f);
                CONV((SrcPlain{INF(19) + (size_t)ll * 65536}), 256, 256, 256, (bf16*)(ws + W_GLUW + (size_t)ll * 128 * 1024), nullptr, 1.f);
            }
#undef CONV
            __syncthreads();
            { LAS float* T = (LAS float*)L; int rot = 0;
#define XPM(GU_, W0_, W1_, LD_, KK_, NN_, DST_) do { const int ni__ = ((KK_) / 64) * ((NN_) / 256); xp_matrix<GU_>(W0_, W1_, LD_, KK_, NN_, DST_, T, (bx + G - rot % G) % G, G, tid); rot += ni__; } while (0)
              for (int ll = 0; ll < 2; ++ll) XPM(false, INF(27) + (size_t)ll * DM * DM, nullptr, DM, DM, DM, (bf16*)(ws + W_WOUT + (size_t)ll * 2 * MiB));
              XPM(true, INF(28), INF(29), DFF, DM, 2 * DFF, (bf16*)(ws + W_FFUP));
              XPM(false, INF(30), nullptr, DM, DFF, DM, (bf16*)(ws + W_FFDN));
#undef XPM
            }
            { const int* pos = (const int*)INF(2); f32x2* cs = (f32x2*)(ws + W_CS);
              for (int it = gw; it < NTOK * 32 / 64; it += NGW) { const int idx = it * 64 + lane, row = idx >> 5, i = idx & 31;
                  const float inv = __builtin_amdgcn_exp2f(-(float)i * (13.287712379549449f / 32.0f)); const float ang = (float)pos[row] * inv;
                  const double rev = (double)ang * 0.15915494309189535; const float fr = (float)(rev - floor(rev));
                  cs[idx] = (f32x2){__builtin_amdgcn_cosf(fr), __builtin_amdgcn_sinf(fr)}; } }
            for (int ll = 0; ll < 2; ++ll) {
                const SsmPar P{INF(11) + ll * 1024, INF(12) + ll * 1024, INF(13) + ll * 16384, INF(14) + ll * 16384, INF(15) + ll * 16384, INF(16) + ll * 16384, INF(18) + ll * 16};
                bf16* mw = (bf16*)(ws + W_MW + (size_t)ll * 10 * MiB); bf16* we = (bf16*)(ws + W_WEND + (size_t)ll * 2 * MiB); f32x2* lc = (f32x2*)(ws + W_LAMC) + ll * 1024;
                for (int it = gw; it < 2032; it += NGW) {
                    if (it < 1008) ssm_unit_toep(P, mw, it / 63, it % 63, scr, lane);
                    else if (it < 1520) ssm_unit_cross(P, mw, lc, (it - 1008) >> 5, (it - 1008) & 31, lane);
                    else ssm_unit_end(P, we, (it - 1520) >> 5, (it - 1520) & 31, lane);
                }
            }
        } else if (k == 0 && PH_ON(1)) { LANEDEFS
            { const float* mp = (const float*)(ws + W_MODP);
              if (tid < 96) { const int idx = bx * 96 + tid, ll = idx / 12288, n = idx % 6144; float s = INF(4)[ll * 6144 + n];
#pragma unroll
                  for (int ks = 0; ks < 8; ++ks) s += mp[(size_t)ks * 24576 + idx];
                  MOD[idx] = s; }
              LAS float* ml = (LAS float*)L; const int b = (bx * 64) / SEQ;
              for (int n = tid; n < 2048; n += NWAVES * 64) { float s = INF(4)[n];
#pragma unroll
                  for (int ks = 0; ks < 8; ++ks) s += mp[(size_t)ks * 24576 + b * 6144 + n];
                  ml[n] = s; }
              __syncthreads(); }
            Row xpf0 = row_ld_f32(x_in + (size_t)(bx * 64 + wave * 8) * DM, lane);
            for (int i = 0; i < 8; ++i) { const int row = bx * 64 + wave * 8 + i; const float* md = (const float*)lds;
                const Row xr = xpf0; if (i + 1 < 8) xpf0 = row_ld_f32(x_in + (size_t)(row + 1) * DM, lane); (void)adaln(xr, INF(5) + l * DM, md + 1 * DM, md + 0 * DM, XN + (size_t)row * DM, lane); }
        } else if (k == 1 && PH_ON(2)) {
            pg8::Gemm g{DM, DM, DM}; pg8::TileOrder S; S.init(XN, DM, WIN, DM, 64, 7, G, bx);
            EpiWin E{RQ, RK, RKT, RVT, RG, UC, CQ, CKV, KPE, SSQQ, SSQKV, CS4};
            pg8::gemm_phase<EpiWin, pg8::TileOrder, true>(L, g, S, E);
            { pg8::Unit u2; if (!S.next(1, u2)) MOECONV(MK_Q2); }
        } else if (k == 2 && PH_ON(3)) {
            if (SUB_ON(0)) { pg8::Gemm g{256, 256, 256}; pg8::TileOrder S; S.init(CQ, 256, WUQ, 256, 64, 3, G, bx); EpiQup E{Qb, SSQQ, CS4}; pg8::gemm_phase<EpiQup, pg8::TileOrder, true, true>(L, g, S, E); }
            if (SUB_ON(1)) { pg8::Gemm g{128, 128, 128}; pg8::TileOrder S; S.init(CKV, 128, WUKV, 128, 64, 4, 192, bx < 192 ? bx : 256); EpiKVup E{KN, Vb, SSQKV}; pg8::gemm_phase<EpiKVup, pg8::TileOrder, true, true>(L, g, S, E); }
            if (SUB_ON(2) && bx >= 192) {
                const int i = bx - 192, gI = i >> 2, bI = (i >> 1) & 1, pnI = i & 1;
                const char* Ap = (const char*)UC + ((size_t)gI * SSM_NCH + (size_t)bI * 256) * SSM_K * 2;
                { pg8::Gemm g{SSM_K, 512, 512}; pg8::OneUnit S; S.has = true; S.u.pA = Ap; S.u.pB = (const char*)WEND + (size_t)gI * 128 * 512 * 2; S.u.pm = gI * 2 + bI; S.u.pn = 0;
                  EpiSsmE E{UC, LAMC}; pg8::gemm_phase<EpiSsmE, pg8::OneUnit, false, true>(L, g, S, E); }
                { pg8::Gemm g{SSM_K, SSM_K, SSM_K}; pg8::OneUnit S; S.has = true; S.u.pA = Ap; S.u.pB = (const char*)MW + ((size_t)gI * 512 + (size_t)pnI * 256) * SSM_K * 2; S.u.pm = gI * 2 + bI; S.u.pn = pnI;
                  EpiSsmZ E{GB, UC, INF(17) + l * 256}; pg8::gemm_phase<EpiSsmZ, pg8::OneUnit, false, true>(L, g, S, E); } }
            if (SUB_ON(3)) { LANEDEFS const ret::Tensors T{RQ, RK, RKT, RVT, RG, KVT, STATE, MIX, INF(10) + l * 256};
              for (int u = gw; u < 1024; u += NGW) ret::x_unit(u, T, lane); }
            if (bx < 192) MOECONV(MK_Q3);
        } else if (k == 3 && PH_ON(4)) { LANEDEFS
            { const ret::Tensors T{RQ, RK, RKT, RVT, RG, KVT, STATE, MIX, INF(10) + l * 256}; if (tid < 128) ret::scan_elem(bx * 128 + tid, T); }
            __syncthreads();
            { const att::Tensors T{Qb, KN, KPE, Vb, Ob}; const int bh = vcu >> 5, xx = vcu & 31;
#if defined(MK_ABL)
              if (repcnt > 0) { const att::Tensors T2{Qb, KN, KPE, Vb, Yb}; att::attn_unit<MK_ABL>(bh >> 2, bh & 3, 63 - xx, T2, (char*)lds); att::attn_unit<MK_ABL>(bh >> 2, bh & 3, xx, T2, (char*)lds); } else
#endif
              { att::attn_unit<0>(bh >> 2, bh & 3, 63 - xx, T, (char*)lds); att::attn_unit<0>(bh >> 2, bh & 3, xx, T, (char*)lds); } }
        } else if (k == 4 && PH_ON(5)) {
            LANEDEFS
            if (SUB_ON(5) && wave < 4) { const ret::Tensors T{RQ, RK, RKT, RVT, RG, KVT, STATE, MIX, INF(10) + l * 256}; ret::z_unit(bx + 256 * wave, T, lane); }
            if (SUB_ON(4) && (wave == 4 || wave == 5)) glu_unit(bx + 256 * (wave - 4), GB, GLUW, INF(20) + l * 256, INF(21) + l * 256, MIX, lane);
            if (SUB_ON(6)) { const int nr = wave < 4 ? 5 : (wave < 6 ? 7 : 15), r0 = bx * 64 + (wave < 4 ? wave * 5 : (wave < 6 ? 20 + (wave - 4) * 7 : 34 + (wave - 6) * 15));
              u32x4 wpf = *(const u32x4*)(Ob + (size_t)r0 * 512 + 8 * lane);
              for (int i = 0; i < nr; ++i) { const int row = r0 + i; const u32x4 w = wpf; if (i + 1 < nr) wpf = *(const u32x4*)(Ob + (size_t)(row + 1) * 512 + 8 * lane);
                const f32x4 a = {bflo(w.x), bfhi(w.x), bflo(w.y), bfhi(w.y)}, c = {bflo(w.z), bfhi(w.z), bflo(w.w), bfhi(w.w)};
                float ss = (a[0] * a[0] + a[1] * a[1]) + (a[2] * a[2] + a[3] * a[3]) + (c[0] * c[0] + c[1] * c[1]) + (c[2] * c[2] + c[3] * c[3]); ss = wave_sum(ss);
                const float rstd = __builtin_amdgcn_rsqf(ss * (1.f / 512.f) + EPS); const float* gn = INF(26) + l * 512 + 8 * lane;
                st16(MIX + (size_t)row * DM + 512 + 8 * lane, a * rstd * *(const f32x4*)gn, c * rstd * *(const f32x4*)(gn + 4)); } }
        } else if (k == 5 && PH_ON(6)) { LANEDEFS
            if (wave < 2) glu_unit(bx + 256 * wave, GB, GLUW, INF(20) + l * 256, INF(21) + l * 256, MIX, lane);
        } else if (k == 6 && PH_ON(7)) {
            pg8::Gemm g{DM, DM, DM}; pg8::TileOrder S; S.init(MIX, DM, WOUT, DM, 64, 4, G, bx); EpiStore E{Yb, DM, nullptr, 0};
            pg8::gemm_phase<EpiStore, pg8::TileOrder, false>(L, g, S, E);
        } else if (k == 7 && PH_ON(8)) { LANEDEFS
            LAS int* cnt = (LAS int*)L;
            if (l == 1) { if (tid < 8) cnt[tid] = 0; __syncthreads(); }
            const float* xsrc = l == 0 ? x_in : out;
            Row xpf = row_ld_f32(xsrc + (size_t)(bx * 64 + wave * 8) * DM, lane), ypf = row_ld_bf16(Yb + (size_t)(bx * 64 + wave * 8) * DM, lane);
            for (int i = 0; i < 8; ++i) { const int row = bx * 64 + wave * 8 + i, b = row / SEQ; const float* md = modl + b * 6144;
                const Row xr = xpf, yr = ypf;
                if (i + 1 < 8) { xpf = row_ld_f32(xsrc + (size_t)(row + 1) * DM, lane); ypf = row_ld_bf16(Yb + (size_t)(row + 1) * DM, lane); }
                const Row x1 = resid(xr, yr, INF(6) + l * DM, md + 2 * DM, out + (size_t)row * DM, lane);
                const Row h = adaln(x1, INF(7) + l * DM, md + 4 * DM, md + 3 * DM, XN + (size_t)row * DM, lane);
                if (l == 1) { int e1, e2; float w1, w2; route(h, INF(31), lane, e1, e2, w1, w2);
                    if (lane == 0) { TOPI[row * 2] = e1; TOPI[row * 2 + 1] = e2; TOPW[row * 2] = w1; TOPW[row * 2 + 1] = w2; __hip_atomic_fetch_add(&cnt[e1], 1, __ATOMIC_RELAXED, __HIP_MEMORY_SCOPE_WORKGROUP); __hip_atomic_fetch_add(&cnt[e2], 1, __ATOMIC_RELAXED, __HIP_MEMORY_SCOPE_WORKGROUP); } } }
            if (l == 1) { __syncthreads(); if (tid < 8) WGCNT[bx * 8 + tid] = cnt[tid]; }
        } else if (k == 8 && PH_ON(9)) { LANEDEFS
            MOECONV(1 << 30);
            __syncthreads();
            LAS int* sc = (LAS int*)L;
            for (int i = tid; i < 2048; i += NWAVES * 64) sc[i] = WGCNT[i];
            __syncthreads();
            { const int e = wave; int base = 0, tot = 0;
#pragma unroll
              for (int q = 0; q < 4; ++q) { const int w = q * 64 + lane; const int c = sc[w * 8 + e]; base += (w < bx) ? c : 0; tot += c; }
#pragma unroll
              for (int o = 1; o < 64; o <<= 1) { base += __shfl_xor(base, o); tot += __shfl_xor(tot, o); }
              if (lane == 0) { sc[2048 + e] = base; sc[2064 + e] = tot; } }
            __syncthreads();
            if (tid == 0) { int st = 0, nt = 0;
#pragma unroll 1
                for (int e = 0; e < 8; ++e) { sc[2056 + e] = st; const int t = (sc[2064 + e] + 255) >> 8; if (bx == 0) for (int q = 0; q < t; ++q) TILE[16 + nt + q] = e; nt += t; st += t << 8; } if (bx == 0) TILE[0] = nt; }
            __syncthreads();
            if (wave == 0) { const int row = bx * 64 + lane; const int e1 = TOPI[row * 2], e2 = TOPI[row * 2 + 1]; int p1 = 0, p2 = 0;
                const unsigned long long lt = (1ull << lane) - 1ull;
#pragma unroll
                for (int e = 0; e < 8; ++e) { const unsigned long long m1 = __ballot(e1 == e), m2 = __ballot(e2 == e); const int r = __popcll(m1 & lt) + __popcll(m2 & lt) + sc[2056 + e] + sc[2048 + e];
                    if (e1 == e) p1 = r; if (e2 == e) p2 = r; }
                sc[2080 + lane * 2] = p1; sc[2080 + lane * 2 + 1] = p2; TPOS[row * 2] = p1; TPOS[row * 2 + 1] = p2; ROWW[p1] = TOPW[row * 2]; ROWW[p2] = TOPW[row * 2 + 1]; }
            __syncthreads();
#pragma unroll
            for (int i0 = 0; i0 < 8; i0 += 4) { u32x4 a[4], c[4];
#pragma unroll
                for (int i = 0; i < 4; ++i) { const int row = bx * 64 + wave * 8 + i0 + i; a[i] = *(const u32x4*)(XN + (size_t)row * DM + 8 * lane); c[i] = *(const u32x4*)(XN + (size_t)row * DM + 512 + 8 * lane); }
#pragma unroll
                for (int i = 0; i < 4; ++i) { const int lr = wave * 8 + i0 + i; const int p1 = sc[2080 + lr * 2], p2 = sc[2080 + lr * 2 + 1];
                    *(u32x4*)(XG + (size_t)p1 * DM + 8 * lane) = a[i]; *(u32x4*)(XG + (size_t)p1 * DM + 512 + 8 * lane) = c[i];
                    *(u32x4*)(XG + (size_t)p2 * DM + 8 * lane) = a[i]; *(u32x4*)(XG + (size_t)p2 * DM + 512 + 8 * lane) = c[i]; } }
            if (bx < 8) { const int tot = sc[2064 + bx], st = sc[2056 + bx], pe = st + (((tot + 255) >> 8) << 8);
                for (int r = st + tot + wave; r < pe; r += NWAVES) { const u32x4 z = {0u, 0u, 0u, 0u}; *(u32x4*)(XG + (size_t)r * DM + 8 * lane) = z; *(u32x4*)(XG + (size_t)r * DM + 512 + 8 * lane) = z; if (lane == 0) ROWW[r] = 0.f; } }
        } else if (k == 9 && PH_ON(10)) {
            pg8::Gemm g{DM, DM, DM}; pg8::TileOrder S;
            if (l == 0) S.init(XN, DM, (bf16*)(ws + W_FFUP), DM, 64, 28, G, bx);
            else { S.init(XG, DM, (bf16*)(ws + W_MOEUP), DM, TILE[0], 28, G, bx); S.texp = TILE + 16; S.b_e = (size_t)2 * DFF * DM * 2; }
            EpiSwiglu E{l == 0 ? HB : HBM};
            pg8::gemm_phase<EpiSwiglu, pg8::TileOrder, true>(L, g, S, E);
        } else if (k == 10 && PH_ON(11)) {
            pg8::Gemm g{DFF, DFF, DFF}; pg8::TileOrder S; EpiStore E{Yb, DM, nullptr, 0};
            if (l == 0) S.init(HB, DFF, (bf16*)(ws + W_FFDN), DFF, 64, 4, G, bx);
            else { S.init(HBM, DFF, (bf16*)(ws + W_MOEDN), DFF, TILE[0], 4, G, bx); S.texp = TILE + 16; S.b_e = (size_t)DM * DFF * 2; S.split_k(2, (size_t)(DFF / 2) * 2); g.K = DFF / 2;
                   E.O = XG; E.rowscale = ROWW; E.split_stride = (size_t)(W_Y2B - W_XG) / 2; }
            pg8::gemm_phase<EpiStore, pg8::TileOrder, true>(L, g, S, E);
        } else if (k == 11 && PH_ON(12)) { LANEDEFS
            const bf16* Y2B = (const bf16*)(ws + W_Y2B);
#define LDY(ROW_, DST_) do { if (l == 0) DST_ = row_ld_bf16(Yb + (size_t)(ROW_) * DM, lane); else { const int p1 = TPOS[(ROW_) * 2], p2 = TPOS[(ROW_) * 2 + 1]; \
                const Row ya = row_ld_bf16(XG + (size_t)p1 * DM, lane), yb = row_ld_bf16(XG + (size_t)p2 * DM, lane), yc = row_ld_bf16(Y2B + (size_t)p1 * DM, lane), yd = row_ld_bf16(Y2B + (size_t)p2 * DM, lane); \
                _Pragma("unroll") for (int j = 0; j < 4; ++j) DST_.v[j] = (ya.v[j] + yc.v[j]) + (yb.v[j] + yd.v[j]); } } while (0)
            Row xpf = row_ld_f32(out + (size_t)(bx * 64 + wave * 8) * DM, lane), ypf; LDY(bx * 64 + wave * 8, ypf);
            for (int i = 0; i < 8; ++i) { const int row = bx * 64 + wave * 8 + i, b = row / SEQ; const float* md = modl + b * 6144;
                const Row xr = xpf, yr = ypf;
                if (i + 1 < 8) { xpf = row_ld_f32(out + (size_t)(row + 1) * DM, lane); LDY(row + 1, ypf); }
                const Row x2 = resid(xr, yr, INF(8) + l * DM, md + 5 * DM, out + (size_t)row * DM, lane);
                if (l == 0) { const float* md1 = MOD + 2 * 6144 + b * 6144; (void)adaln(x2, INF(5) + DM, md1 + 1 * DM, md1 + 0 * DM, XN + (size_t)row * DM, lane); } }
#undef LDY
        }
        bool more = false; for (int q = ph + 1; q < args.ph_hi; ++q) more |= phase_active(q);
        if (more) xcd_barrier(bar);
#if defined(MK_XBAR)
        if (more && ph == MK_XBAR_PH) for (int q_ = 0; q_ < MK_XBAR; ++q_) xcd_barrier(bar);
#endif
        if (MK_REP_MASK != 0) { if ((((unsigned)MK_REP_MASK >> ph) & 1u) && repcnt + 1 < MK_REP_N) { ++repcnt; --ph; } else repcnt = 0; }
    }
#undef INF
#undef MOECONV
#undef LANEDEFS
#undef MOD
#undef Qb
#undef Vb
#undef Ob
#undef Yb
#undef out
#undef modl
}
}
#ifndef MK_PER_PHASE
#define MK_PER_PHASE 0
#endif
static int mk_setup() {
    static int grid = 0;
    if (grid == 0) {
        int dev = 0, cus = 0, per_cu = 0;
        if (hipGetDevice(&dev) != hipSuccess || hipDeviceGetAttribute(&cus, hipDeviceAttributeMultiprocessorCount, dev) != hipSuccess) { fprintf(stderr, "kernel_launch: device query failed\n"); grid = -1; return grid; }
        if (hipFuncSetAttribute((const void*)mk::mk_fwd, hipFuncAttributeMaxDynamicSharedMemorySize, mk::LDS_BYTES) != hipSuccess) { fprintf(stderr, "kernel_launch: hipFuncSetAttribute failed\n"); grid = -1; return grid; }
        if (hipOccupancyMaxActiveBlocksPerMultiprocessor(&per_cu, (const void*)mk::mk_fwd, mk::NWAVES * 64, mk::LDS_BYTES) != hipSuccess || per_cu < 1) fprintf(stderr, "kernel_launch: occupancy query reports %d blocks per CU\n", per_cu);
        (void)hipGetLastError();
        grid = cus;
        if (grid != 256) fprintf(stderr, "kernel_launch: this kernel is written for a 256-CU device (got %d)\n", grid);
    }
    return grid;
}
static void mk_launch(void* const* d_in, void* d_out, void* d_ws, hipStream_t stream, int lo, int hi, bool coop) {
    const int grid = mk_setup(); if (grid <= 0) return;
    mk::Args a{};
    for (int i = 0; i < 35; ++i) a.in[i] = d_in[i];
    a.out = (float*)d_out; a.ws = (unsigned char*)d_ws; a.ph_lo = lo; a.ph_hi = hi; a.never = 0; a.pad = 0;
    if (coop) { void* args[] = {&a}; hipError_t e = hipLaunchCooperativeKernel((const void*)mk::mk_fwd, dim3(grid), dim3(mk::NWAVES * 64), args, mk::LDS_BYTES, stream);
        if (e != hipSuccess) fprintf(stderr, "cooperative launch failed: %s (grid %d)\n", hipGetErrorString(e), grid); }
    else hipLaunchKernelGGL(mk::mk_fwd, dim3(grid), dim3(mk::NWAVES * 64), mk::LDS_BYTES, stream, a);
}
extern "C" void kernel_launch(void* const* d_in, const int* in_sizes, int n_in, void* d_out, int out_size, void* d_ws, size_t ws_size, hipStream_t stream) {
    (void)in_sizes; (void)n_in; (void)out_size;
    if (ws_size < mk::W_END) { fprintf(stderr, "kernel_launch: workspace too small (%zu < %zu)\n", ws_size, (size_t)mk::W_END); return; }
    (void)hipMemsetAsync((char*)d_ws + mk::W_CTL, 0, mk::CTL_ZERO_BYTES, stream);
#if MK_PER_PHASE
    for (int ph = 0; ph < mk::NPHASE; ++ph) mk_launch(d_in, d_out, d_ws, stream, ph, ph + 1, false);
#else
    mk_launch(d_in, d_out, d_ws, stream, 0, mk::NPHASE, true);
#endif
}
```

```cpp
#include <hip/hip_runtime.h>
#include <stdint.h>
#include <math.h>
#include <cstdio>
#define MK_Q2 10
#define MK_Q3 12
#include <hip/hip_cooperative_groups.h>
#define GAS __attribute__((address_space(1)))
#define LAS __attribute__((address_space(3)))
namespace mk {
typedef unsigned short bf16;
typedef short bf16x8 __attribute__((ext_vector_type(8)));
typedef short s16x4 __attribute__((ext_vector_type(4)));
typedef float f32x2 __attribute__((ext_vector_type(2)));
typedef float f32x4 __attribute__((ext_vector_type(4)));
typedef float f32x16 __attribute__((ext_vector_type(16)));
typedef unsigned u32x2 __attribute__((ext_vector_type(2)));
typedef unsigned u32x4 __attribute__((ext_vector_type(4)));
typedef __bf16 bf16x2_t __attribute__((ext_vector_type(2)));
typedef GAS unsigned gu32;
#define RLX_AGENT __ATOMIC_RELAXED, __HIP_MEMORY_SCOPE_AGENT
__device__ __forceinline__ unsigned cvtpk(float lo, float hi) { f32x2 v = {lo, hi}; bf16x2_t b = __builtin_convertvector(v, bf16x2_t); return __builtin_bit_cast(unsigned, b); }
__device__ __forceinline__ float bf2f(unsigned short b) { return __builtin_bit_cast(float, (unsigned)b << 16); }
__device__ __forceinline__ float bflo(unsigned w) { return __builtin_bit_cast(float, w << 16); }
__device__ __forceinline__ float bfhi(unsigned w) { return __builtin_bit_cast(float, w & 0xffff0000u); }
__device__ __forceinline__ float wave_sum(float v) {
#pragma unroll
    for (int o = 1; o < 64; o <<= 1) v += __shfl_xor(v, o);
    return v;
}
__device__ __forceinline__ float fast_sigmoid(float z) { return __builtin_amdgcn_rcpf(1.f + __builtin_amdgcn_exp2f(-1.4426950408889634f * z)); }
__device__ __forceinline__ float silu_fast(float v) { return v * fast_sigmoid(v); }
__device__ __forceinline__ float gelu_tanh_fast(float x) { const float a = 0.7978845608028654f * (x + 0.044715f * x * x * x); return x * fast_sigmoid(2.f * a); }

constexpr int NB = 2, SEQ = 8192, NTOK = 16384, DM = 1024, INC = 1728, INCP = 1792, DFF = 3584, NE = 8, NWAVES = 8;
constexpr float EPS = 1e-6f;
constexpr int SSM_C = 32, SSM_NCH = NTOK / SSM_C  , SSM_K = 640;
constexpr int RET_C = 64, RET_NCH = SEQ / RET_C  ;
constexpr int MOE_MAXT = 136;
constexpr float QSCALE = 0.07216878364870322f * 1.4426950408889634f;

#define XB_TMO      128
#define XB_XCNT(j)  (256  + 64 * (j))
#define XB_XSUB(j)  (1280 + 64 * (j))
#define XB_XGEN(j)  (2304 + 64 * (j))
#define XB_TOP      3328
#define XB_TOPGEN   3392
#define XCD_BAR_WORDS 3456
#define XB_SPIN_CAP (1u << 20)
__device__ __forceinline__ unsigned xb_ld(unsigned* p)              { return __hip_atomic_load(p, __ATOMIC_RELAXED, __HIP_MEMORY_SCOPE_AGENT); }
__device__ __forceinline__ unsigned xb_add(unsigned* p, unsigned v) { return __hip_atomic_fetch_add(p, v, __ATOMIC_RELAXED, __HIP_MEMORY_SCOPE_AGENT); }
__device__ __forceinline__ unsigned xb_xcc_id() { return (unsigned)__builtin_amdgcn_s_getreg((3 << 11) | 20) & 0xFu; }
#define XB_SPIN(cond, bar) do { unsigned _sp = 0; while (cond) { __builtin_amdgcn_s_sleep(1); \
    if ((++_sp & 255u) == 0u) { if (xb_ld(&(bar)[XB_TMO])) break; if (_sp > XB_SPIN_CAP) { atomicAdd(&(bar)[XB_TMO], 1u); break; } } } } while (0)
struct XcdBarrier { unsigned* bar; unsigned x; volatile LAS unsigned* st; };
__device__ __forceinline__ XcdBarrier xcd_barrier_post(unsigned* bar, volatile LAS unsigned* st) {
    XcdBarrier b; b.bar = bar; b.x = xb_xcc_id(); b.st = st;
    if (threadIdx.x == 0) (void)xb_add(&bar[XB_XCNT(b.x)], 1u);
    return b;
}
__device__ __forceinline__ void xcd_barrier_complete(unsigned* bar, unsigned x, unsigned& nloc, unsigned& nx) {
    const unsigned G = gridDim.x * gridDim.y * gridDim.z;
    unsigned sum, cnt, mine, sp = 0u;
    for (;;) {
        sum = 0u; cnt = 0u; mine = 0u;
#pragma unroll
        for (unsigned j = 0; j < 16; ++j) { const unsigned c = xb_ld(&bar[XB_XCNT(j)]); sum += c; cnt += (c > 0u) ? 1u : 0u; mine = (j == x) ? c : mine; }
        if (sum == G) break;
        __builtin_amdgcn_s_sleep(1);
        if ((++sp & 255u) == 0u) { if (xb_ld(&bar[XB_TMO])) break; if (sp > XB_SPIN_CAP) { atomicAdd(&bar[XB_TMO], 1u); break; } }
    }
    nloc = mine > 0u ? mine : 1u; nx = cnt > 0u ? cnt : 1u;
}
__device__ __forceinline__ void xcd_barrier(const XcdBarrier& b) {
    asm volatile("s_waitcnt vmcnt(0)" ::: "memory");
    __syncthreads();
    if (threadIdx.x == 0) {
        unsigned* bar = b.bar;
        __builtin_amdgcn_s_waitcnt(0);
        unsigned nloc = b.st[0], nx = b.st[1];
        if (nloc == 0u) { xcd_barrier_complete(bar, b.x, nloc, nx); b.st[0] = nloc; b.st[1] = nx; }
        const unsigned old = xb_add(&bar[XB_XSUB(b.x)], 1u);
        const unsigned gen = old / nloc;
        if (old + 1u == (gen + 1u) * nloc) {
            __builtin_amdgcn_fence(__ATOMIC_RELEASE, "agent");
            asm volatile("s_waitcnt vmcnt(0)" ::: "memory");
            const unsigned og = xb_add(&bar[XB_TOP], 1u);
            const unsigned tg = og / nx;
            if (og + 1u == (tg + 1u) * nx) xb_add(&bar[XB_TOPGEN], 1u);
            else XB_SPIN(xb_ld(&bar[XB_TOPGEN]) == tg, bar);
            __builtin_amdgcn_fence(__ATOMIC_ACQUIRE, "agent");
            xb_add(&bar[XB_XGEN(b.x)], 1u);
            asm volatile("s_waitcnt vmcnt(0)" ::: "memory");
        } else {
            XB_SPIN(xb_ld(&bar[XB_XGEN(b.x)]) == gen, bar);
            __builtin_amdgcn_fence(__ATOMIC_ACQUIRE, "agent");
            asm volatile("s_waitcnt vmcnt(0)" ::: "memory");
        }
    }
    __syncthreads();
}
}
namespace pg8 {
#define PG8_LAS __attribute__((address_space(3)))
typedef unsigned short bf16_t;
typedef short bf16x8 __attribute__((ext_vector_type(8)));
typedef float f32x4 __attribute__((ext_vector_type(4)));
typedef unsigned u32x4 __attribute__((ext_vector_type(4)));
constexpr int BM = 256, BK = 64, HALF = 128, HTB = HALF * BK * 2, STAGE_BYTES = 8 * HTB, NXCD = 8, WGM = 8;
__host__ __device__ __forceinline__ int lds_byte(int r, int c) { const int st = (r >> 4) * 2 + (c >> 5), rr = r & 15, cc = c & 31, ob = rr * 64 + cc * 2; return st * 1024 + (ob ^ (((ob >> 9) & 1) << 5)); }
__host__ __device__ __forceinline__ void stage_rc(int b, int& R, int& C) { const int st = b / 1024, sb = b % 1024, swz = sb ^ (((sb >> 9) & 1) << 5); R = (st >> 1) * 16 + swz / 64; C = (st & 1) * 32 + (swz % 64) / 2; }
__host__ __device__ __forceinline__ int perm32(int rho) { const int n = rho >> 4, i = rho & 15; return 8 * (i >> 2) + 4 * n + (i & 3); }
struct Unit { const char* pA; const char* pB; int pm, pn; };
struct Gemm { int lda, ldb, K; };
struct TileOrder {
    static constexpr bool KHOOK = false;
    const char* A; const char* Bt; size_t a_t, b_t, b_e, k_off; const int* texp; int nM, nN, nN0, nwg, G, c;
    __device__ __forceinline__ void init(const void* A_, int lda, const void* Bt_, int ldb, int nM_, int nN_, int G_, int c_) {
        A = (const char*)A_; Bt = (const char*)Bt_; a_t = (size_t)BM * lda * 2; b_t = (size_t)BM * ldb * 2; b_e = 0; k_off = 0; texp = nullptr; nM = nM_; nN = nN_; nN0 = nN_; nwg = nM * nN; G = G_; c = c_; }
    __device__ __forceinline__ void split_k(int ks, size_t k_off_) { nN0 = nN; nN = nN * ks; nwg = nM * nN; k_off = k_off_; }
    __device__ __forceinline__ bool next(int i, Unit& u) const {
        const long L = (long)i * G + c; if (L >= nwg) return false;
        int wgid = (int)L; { const int q = nwg / NXCD, r = nwg % NXCD, xcd = wgid % NXCD, off = wgid / NXCD; wgid = (xcd < r ? xcd * (q + 1) : r * (q + 1) + (xcd - r) * q) + off; }
        const int nig = WGM * nN, gid = wgid / nig, fm = gid * WGM, gsz = (nM - fm) < WGM ? (nM - fm) : WGM;
        u.pm = fm + ((wgid % nig) % gsz); u.pn = (wgid % nig) / gsz;
        const int ks = u.pn / nN0, pn0 = u.pn - ks * nN0;
        u.pA = A + (size_t)u.pm * a_t + (size_t)ks * k_off; u.pB = Bt + (size_t)pn0 * b_t + (size_t)ks * k_off + (texp ? (size_t)texp[u.pm] * b_e : (size_t)0); return true;
    }
    __device__ __forceinline__ void a_ready(const Unit&) const {}
    __device__ __forceinline__ void done(const Unit&) const {}
};
struct GroupOrder {
    static constexpr bool KHOOK = false;
    const char* A; const char* Bt; size_t a_t, b_t, a_g, b_g; int nM, nN, nwg, G, c;
    __device__ __forceinline__ void init(const void* A_, int lda, size_t a_g_, const void* Bt_, int ldb, size_t b_g_, int ng, int nM_, int nN_, int G_, int c_) {
        A = (const char*)A_; Bt = (const char*)Bt_; a_t = (size_t)BM * lda * 2; b_t = (size_t)BM * ldb * 2; a_g = a_g_; b_g = b_g_; nM = nM_; nN = nN_; nwg = ng * nM * nN; G = G_; c = c_; }
    __device__ __forceinline__ bool next(int i, Unit& u) const {
        const long L = (long)i * G + c; if (L >= nwg) return false;
        const int per = nM * nN, g = (int)L / per, r = (int)L % per, pm = r / nN, pn = r % nN;
        u.pm = g * nM + pm; u.pn = pn; u.pA = A + (size_t)g * a_g + (size_t)pm * a_t; u.pB = Bt + (size_t)g * b_g + (size_t)pn * b_t; return true;
    }
    __device__ __forceinline__ void a_ready(const Unit&) const {}
    __device__ __forceinline__ void done(const Unit&) const {}
};
struct OneUnit {
    static constexpr bool KHOOK = false;
    Unit u; bool has;
    __device__ __forceinline__ bool next(int i, Unit& o) const { if (i > 0 || !has) return false; o = u; return true; }
    __device__ __forceinline__ void a_ready(const Unit&) const {}
    __device__ __forceinline__ void done(const Unit&) const {}
};
struct OneUnitHook {
    static constexpr bool KHOOK = true;
    Unit u; bool has; int hook_t; unsigned* flag; unsigned need; unsigned* tmo;
    __device__ __forceinline__ bool next(int i, Unit& o) const { if (i > 0 || !has) return false; o = u; return true; }
    __device__ __forceinline__ void a_ready(const Unit&) const {}
    __device__ __forceinline__ void done(const Unit&) const {}
    __device__ __forceinline__ void khook() const {
        if (threadIdx.x < 64) {
            const unsigned long long t0 = __builtin_amdgcn_s_memrealtime();
            while ((unsigned)__builtin_amdgcn_readfirstlane(__hip_atomic_load(flag, __ATOMIC_RELAXED, __HIP_MEMORY_SCOPE_AGENT)) < need) {
                if (__builtin_amdgcn_s_memrealtime() - t0 > 2000000ull) { if (threadIdx.x == 0) __hip_atomic_store(tmo, 1u, __ATOMIC_RELAXED, __HIP_MEMORY_SCOPE_AGENT); break; }
                __builtin_amdgcn_s_sleep(2); }
            __builtin_amdgcn_fence(__ATOMIC_ACQUIRE, "agent");
            asm volatile("s_waitcnt vmcnt(0)" ::: "memory");
        }
        asm volatile("" ::: "memory"); __builtin_amdgcn_s_barrier(); asm volatile("" ::: "memory");
    }
};
template <class Epi, class Sched, bool ALIGN_EPI = false, bool SMALLK = false>
__device__ __forceinline__ void gemm_phase(PG8_LAS unsigned char* lds, const Gemm g, const Sched& S, const Epi& E) {
    int tid_ = threadIdx.x; asm volatile("" : "+v"(tid_));
    const int tid = tid_, wid = __builtin_amdgcn_readfirstlane(tid >> 6), lane = tid & 63, wr = wid >> 2, wc = wid & 3, fr = lane & 15, fq = lane >> 4;
    int K_ = g.K; if constexpr (SMALLK) asm volatile("" : "+s"(K_));
    const int K = K_, nt = K / BK, lda = g.lda, ldb = g.ldb;
    unsigned voffA[2], voffB[2];
#pragma unroll
    for (int i = 0; i < 2; ++i) { int R, C; stage_rc(tid * 16 + i * 8192, R, C); const int Rb = Epi::PERM ? ((R & ~31) + perm32(R & 31)) : R;
        voffA[i] = (unsigned)(R * lda + C) * 2u; voffB[i] = (unsigned)(Rb * ldb + C) * 2u; }
    const size_t kstep = (size_t)(BK * 2);
    const size_t hstepA = (size_t)HALF * lda * 2, hstepB = (size_t)HALF * ldb * 2;
    const unsigned ldsw = (unsigned)wid * 1024u;
    const int aoff = lds_byte(wr * 64 + fr, fq * 8), boff = lds_byte(wc * 32 + fr, fq * 8);
#define PG8_SA(b, h) (((b) * 2 + (h)) * HTB)
#define PG8_SB(b, h) ((4 + (b) * 2 + (h)) * HTB)
#define PG8_STAGE(bufoff, gbase, voff) do { _Pragma("unroll") for (int _i = 0; _i < 2; ++_i) \
        __builtin_amdgcn_global_load_lds((const unsigned*)((const char*)(gbase) + (voff)[_i]), (PG8_LAS unsigned*)(lds + (bufoff) + ldsw + _i * 8192), 16, 0, 0); } while (0)
#define PG8_LDA(dst, b, h) do { _Pragma("unroll") for (int m = 0; m < 4; ++m) _Pragma("unroll") for (int k = 0; k < 2; ++k) dst[m][k] = *(const PG8_LAS bf16x8*)(lds + PG8_SA(b, h) + aoff + m * 2048 + k * 1024); } while (0)
#define PG8_LDB(dst, b, h) do { _Pragma("unroll") for (int n = 0; n < 2; ++n) _Pragma("unroll") for (int k = 0; k < 2; ++k) dst[n][k] = *(const PG8_LAS bf16x8*)(lds + PG8_SB(b, h) + boff + n * 2048 + k * 1024); } while (0)
#define PG8_MMA(ai, bj, At, Bt) do { __builtin_amdgcn_s_setprio(1); _Pragma("unroll") for (int m = 0; m < 4; ++m) _Pragma("unroll") for (int n = 0; n < 2; ++n) _Pragma("unroll") for (int k = 0; k < 2; ++k) \
        acc[ai][bj][m][n] = __builtin_amdgcn_mfma_f32_16x16x32_bf16(Bt[n][k], At[m][k], acc[ai][bj][m][n], 0, 0, 0); __builtin_amdgcn_s_setprio(0); } while (0)
#define PG8_WAIT_V(n) asm volatile("s_waitcnt vmcnt(" #n ")" ::: "memory")
#define PG8_WAIT_L(n) asm volatile("s_waitcnt lgkmcnt(" #n ")" ::: "memory")
#define PG8_BAR __builtin_amdgcn_s_barrier()
#define PG8_SCHED __builtin_amdgcn_sched_barrier(0)
    Unit cur, nxt; int ui = 0;
    if (!S.next(0, cur)) return;
    f32x4 acc[2][2][4][2];
#pragma unroll
    for (int a = 0; a < 2; ++a)
#pragma unroll
        for (int b = 0; b < 2; ++b)
#pragma unroll
            for (int m = 0; m < 4; ++m)
#pragma unroll
                for (int n = 0; n < 2; ++n) acc[a][b][m][n] = (f32x4){0.f, 0.f, 0.f, 0.f};
    bf16x8 At[4][2], B0[2][2], B1[2][2];
    const char* cA = cur.pA; const char* cB = cur.pB;
    S.a_ready(cur);
    {
        PG8_STAGE(PG8_SB(0, 0), cB, voffB); PG8_STAGE(PG8_SB(0, 1), cB + hstepB, voffB); PG8_STAGE(PG8_SA(0, 0), cA, voffA); PG8_STAGE(PG8_SA(0, 1), cA + hstepA, voffA);
        if (wr == 1) PG8_BAR;
        PG8_WAIT_V(2); PG8_BAR;
        PG8_STAGE(PG8_SB(1, 0), cB + kstep, voffB); PG8_STAGE(PG8_SA(1, 0), cA + kstep, voffA); PG8_STAGE(PG8_SB(1, 1), cB + hstepB + kstep, voffB);
        PG8_WAIT_V(6); PG8_BAR;
    }
    for (;;) {
        const bool has_next = S.next(ui + 1, nxt);
        const char* nA = has_next ? nxt.pA : cA; const char* nB = has_next ? nxt.pB : cB;
        for (int t = 0; t < nt; t += 2) {
            const bool last = (t == nt - 2);
            const char* a1 = cA + (size_t)(t + 1) * kstep;
            const char* a2 = last ? nA : cA + (size_t)(t + 2) * kstep; const char* b2 = last ? nB : cB + (size_t)(t + 2) * kstep;
            const char* a3 = a2 + kstep; const char* b3 = b2 + kstep;
            if (last && has_next) S.a_ready(nxt);
            if constexpr (Sched::KHOOK) { if (t == S.hook_t) S.khook(); }
            {
            PG8_LDB(B0, 0, 0); PG8_LDB(B1, 0, 1); PG8_SCHED; PG8_LDA(At, 0, 0); PG8_STAGE(PG8_SA(1, 1), a1 + hstepA, voffA);
            PG8_WAIT_V(8); PG8_WAIT_L(0); PG8_BAR; PG8_MMA(0, 0, At, B0); PG8_MMA(0, 1, At, B1); PG8_BAR; PG8_SCHED;
            PG8_LDA(At, 0, 1); PG8_STAGE(PG8_SB(0, 0), b2, voffB); PG8_STAGE(PG8_SB(0, 1), b2 + hstepB, voffB); PG8_STAGE(PG8_SA(0, 0), a2, voffA);
            PG8_WAIT_V(8); PG8_WAIT_L(0); PG8_BAR; PG8_MMA(1, 0, At, B0); PG8_MMA(1, 1, At, B1); PG8_BAR; PG8_SCHED;
            PG8_LDB(B0, 1, 0); PG8_LDB(B1, 1, 1); PG8_SCHED; PG8_LDA(At, 1, 0); PG8_STAGE(PG8_SA(0, 1), a2 + hstepA, voffA);
            PG8_WAIT_V(8); PG8_WAIT_L(0); PG8_BAR; PG8_MMA(0, 0, At, B0); PG8_MMA(0, 1, At, B1); PG8_BAR; PG8_SCHED;
            PG8_LDA(At, 1, 1); PG8_STAGE(PG8_SB(1, 0), b3, voffB); PG8_STAGE(PG8_SB(1, 1), b3 + hstepB, voffB); PG8_STAGE(PG8_SA(1, 0), a3, voffA);
            PG8_WAIT_V(8); PG8_WAIT_L(0); PG8_BAR; PG8_MMA(1, 0, At, B0); PG8_MMA(1, 1, At, B1); PG8_BAR; PG8_SCHED;
            }
        }
        if constexpr (ALIGN_EPI) { if (wr == 0) PG8_BAR; }
        if constexpr (!Epi::AFTER_DRAIN) { E(acc, cur, wr, wc, fr, fq); S.done(cur); }
        if (!has_next) break;
#pragma unroll
        for (int a = 0; a < 2; ++a)
#pragma unroll
            for (int b = 0; b < 2; ++b)
#pragma unroll
                for (int m = 0; m < 4; ++m)
#pragma unroll
                    for (int n = 0; n < 2; ++n) acc[a][b][m][n] = (f32x4){0.f, 0.f, 0.f, 0.f};
        cur = nxt; cA = nA; cB = nB; ++ui;
        if constexpr (ALIGN_EPI) { if (wr == 1) PG8_BAR; }
    }
    PG8_WAIT_V(0);
    if constexpr (!ALIGN_EPI) { if (wr == 0) PG8_BAR; }
    PG8_BAR;
    if constexpr (Epi::AFTER_DRAIN) { E.fused(acc, cur, wr, wc, fr, fq, lds, wid, lane); S.done(cur); }
#undef PG8_SA
#undef PG8_SB
#undef PG8_STAGE
#undef PG8_LDA
#undef PG8_LDB
#undef PG8_MMA
#undef PG8_WAIT_V
#undef PG8_WAIT_L
#undef PG8_BAR
#undef PG8_SCHED
}
}
namespace mk {
using pg8::Unit;
typedef f32x4 Acc[2][2][4][2];
__device__ __forceinline__ void st8(bf16* p, f32x4 v) { u32x2 w; w.x = cvtpk(v[0], v[1]); w.y = cvtpk(v[2], v[3]); *(u32x2*)p = w; }
__device__ __forceinline__ void st16(bf16* p, f32x4 a, f32x4 b) { u32x4 w; w.x = cvtpk(a[0], a[1]); w.y = cvtpk(a[2], a[3]); w.z = cvtpk(b[0], b[1]); w.w = cvtpk(b[2], b[3]); *(u32x4*)p = w; }
__device__ __forceinline__ f32x4 ld4bf(const bf16* p) { const u32x2 w = *(const u32x2*)p; return (f32x4){bflo(w.x), bfhi(w.x), bflo(w.y), bfhi(w.y)}; }
__device__ __forceinline__ f32x4 rope4(f32x4 v, f32x4 cs) { return (f32x4){v[0] * cs[0] - v[1] * cs[1], v[1] * cs[0] + v[0] * cs[1], v[2] * cs[2] - v[3] * cs[3], v[3] * cs[2] + v[2] * cs[3]}; }

__device__ __forceinline__ void st_tr_pairs(bf16* T, int col0, int row, f32x4 v, bool even) {
    const float s0 = even ? v[2] : v[0], s1 = even ? v[3] : v[1];
    const float r0 = __shfl_xor(s0, 1), r1 = __shfl_xor(s1, 1);
    const int c = col0 + (even ? 0 : 2), re = row & ~1;
    const unsigned w0 = even ? cvtpk(v[0], r0) : cvtpk(r0, v[2]), w1 = even ? cvtpk(v[1], r1) : cvtpk(r1, v[3]);
    *(unsigned*)(T + (size_t)c * NTOK + re) = w0; *(unsigned*)(T + (size_t)(c + 1) * NTOK + re) = w1;
}
struct EpiWin {
    static constexpr bool PERM = true, AFTER_DRAIN = false;
    bf16 *RQ, *RK, *RKT, *RVT, *RG, *UC, *CQ, *CKV, *KPE; float *SSQQ, *SSQKV; const f32x4* CS;
    __device__ __forceinline__ void operator()(const Acc& acc, const Unit& u, int wr, int wc, int fr, int fq) const { { int t_ = threadIdx.x; asm volatile("" : "+v"(t_)); fr = t_ & 15; fq = (t_ >> 4) & 3; }
        const int pn = u.pn, row0 = u.pm * 256 + wr * 64 + fr; const bool even = (fr & 1) == 0;
        if (pn <= 1) {
#pragma unroll
            for (int ai = 0; ai < 2; ++ai)
#pragma unroll
                for (int m = 0; m < 4; ++m) { const int row = row0 + ai * 128 + m * 16; const float pl = (float)(row & (RET_C - 1));
#pragma unroll
                    for (int bj = 0; bj < 2; ++bj) { const int head = 2 * bj + (wc >> 1);
                        const float lg2 = __builtin_amdgcn_logf(1.f - __builtin_amdgcn_exp2f(-5.f - (float)head));
                        const float dec = pn == 0 ? __builtin_amdgcn_exp2f(pl * lg2) : 0.125f * __builtin_amdgcn_exp2f(-pl * lg2);
                        const int i0 = 16 * (wc & 1) + 4 * fq, col = bj * 128 + wc * 32 + 8 * fq;
                        const f32x4 o0 = rope4(acc[ai][bj][m][0], CS[((row * 32 + i0) >> 1)]) * dec, o1 = rope4(acc[ai][bj][m][1], CS[((row * 32 + i0) >> 1) + 1]) * dec;
                        st16((pn == 0 ? RQ : RK) + (size_t)row * 256 + col, o0, o1);
                        if (pn == 1) { st_tr_pairs(RKT, col, row, o0, even); st_tr_pairs(RKT, col + 4, row, o1, even); } }
                    asm volatile("" ::: "memory"); }
        } else if (pn == 2) {
#pragma unroll
            for (int ai = 0; ai < 2; ++ai)
#pragma unroll
                for (int m = 0; m < 4; ++m) { const int row = row0 + ai * 128 + m * 16;
#pragma unroll
                    for (int bj = 0; bj < 2; ++bj) { const int col = bj * 128 + wc * 32 + 8 * fq; st_tr_pairs(RVT, col, row, acc[ai][bj][m][0], even); st_tr_pairs(RVT, col + 4, row, acc[ai][bj][m][1], even); } }
        } else if (pn == 3) {
#pragma unroll
            for (int ai = 0; ai < 2; ++ai)
#pragma unroll
                for (int m = 0; m < 4; ++m) { const int row = row0 + ai * 128 + m * 16;
#pragma unroll
                    for (int bj = 0; bj < 2; ++bj) { const f32x4 v = acc[ai][bj][m][0], w = acc[ai][bj][m][1];
                        st16(RG + (size_t)row * 256 + bj * 128 + wc * 32 + 8 * fq, (f32x4){silu_fast(v[0]), silu_fast(v[1]), silu_fast(v[2]), silu_fast(v[3])}, (f32x4){silu_fast(w[0]), silu_fast(w[1]), silu_fast(w[2]), silu_fast(w[3])}); } }
        } else if (pn == 4) {
#pragma unroll
            for (int ai = 0; ai < 2; ++ai)
#pragma unroll
                for (int m = 0; m < 4; ++m) { const int row = row0 + ai * 128 + m * 16, chunk = row / SSM_C, t = row % SSM_C;
#pragma unroll
                    for (int bj = 0; bj < 2; ++bj) { const int g = 8 * bj + 2 * wc + (fq >> 1);
                        st16(UC + ((size_t)g * SSM_NCH + chunk) * SSM_K + t * 16 + 8 * (fq & 1), acc[ai][bj][m][0], acc[ai][bj][m][1]); } }
        } else if (pn == 5) {
#pragma unroll
            for (int ai = 0; ai < 2; ++ai)
#pragma unroll
                for (int m = 0; m < 4; ++m) { const int row = row0 + ai * 128 + m * 16; float ss = 0.f;
#pragma unroll
                    for (int bj = 0; bj < 2; ++bj) { const f32x4 v = acc[ai][bj][m][0], w = acc[ai][bj][m][1];
                        ss += ((v[0] * v[0] + v[1] * v[1]) + (v[2] * v[2] + v[3] * v[3])) + ((w[0] * w[0] + w[1] * w[1]) + (w[2] * w[2] + w[3] * w[3]));
                        st16(CQ + (size_t)row * 256 + bj * 128 + wc * 32 + 8 * fq, v, w); }
                    ss += __shfl_xor(ss, 16); ss += __shfl_xor(ss, 32);
                    if (fq == 0) SSQQ[row * 4 + wc] = ss; }
        } else {
#pragma unroll
            for (int ai = 0; ai < 2; ++ai)
#pragma unroll
                for (int m = 0; m < 4; ++m) { const int row = row0 + ai * 128 + m * 16;
                    const f32x4 v = acc[ai][0][m][0], w = acc[ai][0][m][1];
                    float ss = ((v[0] * v[0] + v[1] * v[1]) + (v[2] * v[2] + v[3] * v[3])) + ((w[0] * w[0] + w[1] * w[1]) + (w[2] * w[2] + w[3] * w[3]));
                    st16(CKV + (size_t)row * 128 + wc * 32 + 8 * fq, v, w);
                    ss += __shfl_xor(ss, 16); ss += __shfl_xor(ss, 32);
                    if (fq == 0) SSQKV[row * 4 + wc] = ss;
                    if (wc < 2) { const int i0 = 16 * wc + 4 * fq;
                        st16(KPE + (size_t)row * 64 + wc * 32 + 8 * fq, rope4(acc[ai][1][m][0], CS[(row * 32 + i0) >> 1]), rope4(acc[ai][1][m][1], CS[((row * 32 + i0) >> 1) + 1])); } }
        }
    }
};
struct EpiQup {
    static constexpr bool PERM = false, AFTER_DRAIN = false;
    bf16* Q; const float* SSQ; const f32x4* CS;
    __device__ __forceinline__ void operator()(const Acc& acc, const Unit& u, int wr, int wc, int fr, int fq) const { { int t_ = threadIdx.x; asm volatile("" : "+v"(t_)); fr = t_ & 15; fq = (t_ >> 4) & 3; }
        const int row0 = u.pm * 256 + wr * 64 + fr;
#pragma unroll
        for (int ai = 0; ai < 2; ++ai)
#pragma unroll
            for (int m = 0; m < 4; ++m) { const int row = row0 + ai * 128 + m * 16; const f32x4 s4 = *(const f32x4*)(SSQ + row * 4);
                const float rstd = __builtin_amdgcn_rsqf(((s4[0] + s4[1]) + (s4[2] + s4[3])) * (1.f / 256.f) + EPS);
#pragma unroll
                for (int bj = 0; bj < 2; ++bj) { const bool rope = ((4 * u.pn + 2 * bj + (wc >> 1)) % 3) == 2;
#pragma unroll
                    for (int n = 0; n < 2; ++n) { f32x4 v = acc[ai][bj][m][n] * rstd;
                        if (rope) { const int i0 = 16 * (wc & 1) + 8 * n + 2 * fq; v = rope4(v, CS[(row * 32 + i0) >> 1]); }
                        st8(Q + (size_t)row * 768 + u.pn * 256 + bj * 128 + wc * 32 + n * 16 + fq * 4, v); } }
                asm volatile("" ::: "memory"); }
    }
};
struct EpiKVup {
    static constexpr bool PERM = false, AFTER_DRAIN = false;
    bf16 *KN, *V; const float* SSQ;
    __device__ __forceinline__ void operator()(const Acc& acc, const Unit& u, int wr, int wc, int fr, int fq) const { { int t_ = threadIdx.x; asm volatile("" : "+v"(t_)); fr = t_ & 15; fq = (t_ >> 4) & 3; }
        const int row0 = u.pm * 256 + wr * 64 + fr;
#pragma unroll
        for (int ai = 0; ai < 2; ++ai)
#pragma unroll
            for (int m = 0; m < 4; ++m) { const int row = row0 + ai * 128 + m * 16; const f32x4 s4 = *(const f32x4*)(SSQ + row * 4);
                const float rstd = __builtin_amdgcn_rsqf(((s4[0] + s4[1]) + (s4[2] + s4[3])) * (1.f / 128.f) + EPS);
#pragma unroll
                for (int bj = 0; bj < 2; ++bj)
#pragma unroll
                    for (int n = 0; n < 2; ++n) st8((bj == 0 ? KN : V) + (size_t)row * 512 + u.pn * 128 + wc * 32 + n * 16 + fq * 4, acc[ai][bj][m][n] * rstd);
                asm volatile("" ::: "memory"); }
    }
};
struct EpiSsmE {
    static constexpr bool PERM = false, AFTER_DRAIN = true;
    bf16* UC; const f32x2* LAMC; unsigned* flag;
    __device__ __forceinline__ void fused(Acc& acc, const Unit& u, int wr, int wc, int fr, int fq, PG8_LAS unsigned char* lds, int wid, int lane) const { { int t_ = threadIdx.x; asm volatile("" : "+v"(t_)); fr = t_ & 15; fq = (t_ >> 4) & 3; }
        PG8_LAS float* EL = (PG8_LAS float*)lds;
        const int g = u.pm >> 1, b = u.pm & 1;
#pragma unroll
        for (int ai = 0; ai < 2; ++ai)
#pragma unroll
            for (int m = 0; m < 4; ++m) { const int ch = ai * 128 + wr * 64 + m * 16 + fr;
#pragma unroll
                for (int n = 0; n < 2; ++n) *(PG8_LAS f32x4*)(EL + ch * 128 + wc * 32 + n * 16 + fq * 4) = acc[ai][0][m][n]; }
        asm volatile("s_waitcnt lgkmcnt(0)" ::: "memory"); __builtin_amdgcn_s_barrier(); asm volatile("" ::: "memory");
        {
            const f32x2 lc = LAMC[g * 64 + lane]; f32x2 c = {0.f, 0.f};
            f32x2 loc[32];
#pragma unroll
            for (int n = 0; n < 32; ++n) { const f32x2 e2 = *(const PG8_LAS f32x2*)(EL + (wid * 32 + n) * 128 + 2 * lane); loc[n] = c; c = (f32x2){lc.x * c.x - lc.y * c.y, lc.x * c.y + lc.y * c.x} + e2; }
            f32x2 pw = {1.f, 0.f};
#pragma unroll
            for (int n = 0; n < 32; ++n) pw = (f32x2){pw.x * lc.x - pw.y * lc.y, pw.x * lc.y + pw.y * lc.x};
            asm volatile("s_waitcnt lgkmcnt(0)" ::: "memory"); __builtin_amdgcn_s_barrier(); asm volatile("" ::: "memory");
            *(PG8_LAS f32x2*)(EL + wid * 128 + 2 * lane) = c;
            asm volatile("s_waitcnt lgkmcnt(0)" ::: "memory"); __builtin_amdgcn_s_barrier(); asm volatile("" ::: "memory");
            f32x2 cin = {0.f, 0.f};
            for (int s = 0; s < wid; ++s) { const f32x2 es = *(const PG8_LAS f32x2*)(EL + s * 128 + 2 * lane); cin = (f32x2){pw.x * cin.x - pw.y * cin.y, pw.x * cin.y + pw.y * cin.x} + es; }
            bf16* up = UC + ((size_t)g * SSM_NCH + b * 256 + wid * 32) * SSM_K + 512 + 2 * lane;
            f32x2 q = cin;
#pragma unroll
            for (int n = 0; n < 32; ++n) { const f32x2 v = loc[n] + q; *(unsigned*)(up + (size_t)n * SSM_K) = cvtpk(v.x, v.y); q = (f32x2){lc.x * q.x - lc.y * q.y, lc.x * q.y + lc.y * q.x}; }
        }
        asm volatile("s_waitcnt vmcnt(0)" ::: "memory");
        asm volatile("s_waitcnt lgkmcnt(0)" ::: "memory"); __builtin_amdgcn_s_barrier(); asm volatile("" ::: "memory");
        if (threadIdx.x == 0) { __builtin_amdgcn_fence(__ATOMIC_RELEASE, "agent"); asm volatile("s_waitcnt vmcnt(0)" ::: "memory"); __hip_atomic_fetch_add(flag, 1u, __ATOMIC_RELAXED, __HIP_MEMORY_SCOPE_AGENT); }
    }
};
struct EpiSsmZ {
    static constexpr bool PERM = false, AFTER_DRAIN = false;
    bf16* G; const bf16* UC; const float* dpar;
    __device__ __forceinline__ void operator()(const Acc& acc, const Unit& u, int wr, int wc, int fr, int fq) const { { int t_ = threadIdx.x; asm volatile("" : "+v"(t_)); fr = t_ & 15; fq = (t_ >> 4) & 3; }
        const int g = u.pm >> 1, ch0 = (u.pm & 1) * 256 + wr * 64 + fr;
        const f32x4 dd = *(const f32x4*)(dpar + g * 16 + 4 * fq);
#pragma unroll
        for (int ai = 0; ai < 2; ++ai)
#pragma unroll
            for (int m = 0; m < 4; ++m) { const int chunk = ch0 + ai * 128 + m * 16;
#pragma unroll
                for (int bj = 0; bj < 2; ++bj)
#pragma unroll
                    for (int n = 0; n < 2; ++n) { const int t = u.pn * 16 + bj * 8 + wc * 2 + n;
                        const f32x4 uv = ld4bf(UC + ((size_t)g * SSM_NCH + chunk) * SSM_K + t * 16 + 4 * fq);
                        const f32x4 y = acc[ai][bj][m][n] + dd * uv;
                        st8(G + (size_t)(chunk * SSM_C + t) * 256 + g * 16 + 4 * fq, (f32x4){gelu_tanh_fast(y[0]), gelu_tanh_fast(y[1]), gelu_tanh_fast(y[2]), gelu_tanh_fast(y[3])}); } }
    }
};
struct EpiGlu {
    static constexpr bool PERM = false, AFTER_DRAIN = true;
    const bf16* G; const float *bias, *gain; bf16* MIX;
    __device__ __forceinline__ void fused(Acc& acc, const Unit& u, int wr, int wc, int fr, int fq, PG8_LAS unsigned char* lds, int wid, int lane) const { { int t_ = threadIdx.x; asm volatile("" : "+v"(t_)); fr = t_ & 15; fq = (t_ >> 4) & 3; }
        PG8_LAS float* P = (PG8_LAS float*)lds;
        const int row0 = u.pm * 256 + wr * 64 + fr;
#pragma unroll
        for (int ai = 0; ai < 2; ++ai)
#pragma unroll
            for (int m = 0; m < 4; ++m) { const int row = row0 + ai * 128 + m * 16; float ss = 0.f;
#pragma unroll
                for (int bj = 0; bj < 2; ++bj)
#pragma unroll
                    for (int n = 0; n < 2; ++n) { const int col = bj * 128 + wc * 32 + n * 16 + fq * 4; const f32x4 b4 = *(const f32x4*)(bias + col), gl = ld4bf(G + (size_t)row * 256 + col);
                        f32x4 z = acc[ai][bj][m][n] + b4;
                        z = (f32x4){gl[0] * fast_sigmoid(z[0]), gl[1] * fast_sigmoid(z[1]), gl[2] * fast_sigmoid(z[2]), gl[3] * fast_sigmoid(z[3])};
                        acc[ai][bj][m][n] = z; ss += (z[0] * z[0] + z[1] * z[1]) + (z[2] * z[2] + z[3] * z[3]); }
                ss += __shfl_xor(ss, 16); ss += __shfl_xor(ss, 32);
                if (fq == 0) P[(ai * 128 + wr * 64 + m * 16 + fr) * 4 + wc] = ss; }
        asm volatile("s_waitcnt lgkmcnt(0)" ::: "memory"); __builtin_amdgcn_s_barrier(); asm volatile("" ::: "memory");
#pragma unroll
        for (int ai = 0; ai < 2; ++ai)
#pragma unroll
            for (int m = 0; m < 4; ++m) { const int lr = ai * 128 + wr * 64 + m * 16 + fr, row = u.pm * 256 + lr;
                const float rstd = __builtin_amdgcn_rsqf(((P[lr * 4 + 0] + P[lr * 4 + 1]) + (P[lr * 4 + 2] + P[lr * 4 + 3])) * (1.f / 256.f) + EPS);
#pragma unroll
                for (int bj = 0; bj < 2; ++bj)
#pragma unroll
                    for (int n = 0; n < 2; ++n) { const int col = bj * 128 + wc * 32 + n * 16 + fq * 4; const f32x4 g4 = *(const f32x4*)(gain + col);
                        st8(MIX + (size_t)row * DM + 256 + col, acc[ai][bj][m][n] * rstd * g4); } }
        asm volatile("s_waitcnt lgkmcnt(0)" ::: "memory"); __builtin_amdgcn_s_barrier(); asm volatile("" ::: "memory");
    }
};
struct EpiStore {
    static constexpr bool PERM = true, AFTER_DRAIN = false;
    bf16* O; int ldc; const float* rowscale; size_t split_stride;
    __device__ __forceinline__ void operator()(const Acc& acc, const Unit& u, int wr, int wc, int fr, int fq) const { { int t_ = threadIdx.x; asm volatile("" : "+v"(t_)); fr = t_ & 15; fq = (t_ >> 4) & 3; }
        const int ks = u.pn >> 2, pn0 = u.pn & 3; bf16* O = this->O + (size_t)ks * split_stride;
        const int row0 = u.pm * 256 + wr * 64 + fr, col0 = pn0 * 256 + wc * 32 + 8 * fq;
#pragma unroll
        for (int ai = 0; ai < 2; ++ai)
#pragma unroll
            for (int m = 0; m < 4; ++m) { const int row = row0 + ai * 128 + m * 16; const float s = rowscale ? rowscale[row] : 1.f;
#pragma unroll
                for (int bj = 0; bj < 2; ++bj) st16(O + (size_t)row * ldc + col0 + bj * 128, acc[ai][bj][m][0] * s, acc[ai][bj][m][1] * s); }
    }
};
struct EpiSwiglu {
    static constexpr bool PERM = true, AFTER_DRAIN = false;
    bf16* H; int nostore;
    __device__ __forceinline__ void operator()(const Acc& acc, const Unit& u, int wr, int wc, int fr, int fq) const { { int t_ = threadIdx.x; asm volatile("" : "+v"(t_)); fr = t_ & 15; fq = (t_ >> 4) & 3; }
        const int row0 = u.pm * 256 + wr * 64 + fr, h0 = u.pn * 128 + wc * 32 + 8 * fq;
#pragma unroll
        for (int ai = 0; ai < 2; ++ai)
#pragma unroll
            for (int m = 0; m < 4; ++m) { const int row = row0 + ai * 128 + m * 16;
                const f32x4 g0 = acc[ai][0][m][0], g1 = acc[ai][0][m][1], u0 = acc[ai][1][m][0], u1 = acc[ai][1][m][1];
                if (nostore) { asm volatile("" :: "v"(g0), "v"(g1), "v"(u0), "v"(u1)); } else st16(H + (size_t)row * DFF + h0, (f32x4){silu_fast(g0[0]) * u0[0], silu_fast(g0[1]) * u0[1], silu_fast(g0[2]) * u0[2], silu_fast(g0[3]) * u0[3]},
                                                 (f32x4){silu_fast(g1[0]) * u1[0], silu_fast(g1[1]) * u1[1], silu_fast(g1[2]) * u1[2], silu_fast(g1[3]) * u1[3]}); }
    }
};
}
namespace att {
using namespace mk;
constexpr int KVBLK = 64, SHM_V = 64 * 128 * 2, SHM_KN = 64 * 128 * 2, SHM_KP = 64 * 64 * 2, KBUF = SHM_KN + SHM_KP;
constexpr int OFF_V = 0  , OFF_K = 3 * SHM_V  , OFF_WS = 3 * SHM_V + 2 * KBUF, LDS_BYTES = OFF_WS + NWAVES * 64 * 4;
constexpr float THR = 8.f;
#define KSWZ(row, colB) ((row) * 256 + ((colB) ^ (((row) & 7) << 4)))
#define KPSWZ(row, colB) ((row) * 128 + ((colB) ^ (((row) & 7) << 4)))
#define SBAR() __builtin_amdgcn_sched_barrier(0)
__device__ __forceinline__ int v_st(int k, int c) { const int kk = (k & ~0xC) | ((k & 4) << 1) | ((k & 8) >> 1); return ((kk >> 3) * 4 + (c >> 5)) * 512 + ((kk & 7) * 32 + (c & 31)) * 2; }
__device__ __forceinline__ int v_rd_base(int lane) { return ((lane & 3) << 3) | (((lane >> 2) & 3) << 6) | (((lane >> 4) & 1) << 5) | (((lane >> 5) & 1) << 8); }
constexpr int v_rd_off(int d0, int ks, int half) { return d0 * 512 + ks * 4096 + half * 2048; }
__device__ __forceinline__ int crow(int r, int hi) { return (r & 3) + 8 * (r >> 2) + 4 * hi; }

struct Tensors { const bf16* Q; const bf16* KN; const bf16* KP; const bf16* V; bf16* O; };

#define KFR(i) ((i) < 8 ? *reinterpret_cast<const bf16x8*>(kb[(i) & 3] + ((i) >> 2) * 128) : *reinterpret_cast<const bf16x8*>(kp0 + KPSWZ(r32, (((i) - 8) * 16 + hi * 8) * 2)))
#define PK4(P_, B__, OUT) do { unsigned a0 = cvtpk(P_[B__ + 0], P_[B__ + 1]), a1 = cvtpk(P_[B__ + 2], P_[B__ + 3]), b0 = cvtpk(P_[B__ + 4], P_[B__ + 5]), b1 = cvtpk(P_[B__ + 6], P_[B__ + 7]); \
        auto r0 = __builtin_amdgcn_permlane32_swap(a0, b0, false, false); auto r1 = __builtin_amdgcn_permlane32_swap(a1, b1, false, false); \
        u32x4 w = {r0[0], r1[0], r0[1], r1[1]}; OUT = *reinterpret_cast<bf16x8*>(&w); } while (0)
__device__ __forceinline__ void glds16(const void* gsrc, unsigned lds_dst) { unsigned keep;
    asm volatile("s_mov_b32 %0, m0\n\ts_mov_b32 m0, %2\n\ts_nop 0\n\tglobal_load_lds_dwordx4 %1, off\n\ts_mov_b32 m0, %0" : "=&s"(keep) : "v"(gsrc), "s"(lds_dst) : "memory"); }
#define WAIT_BAR(N) asm volatile("s_waitcnt vmcnt(" #N ") lgkmcnt(0)\n\ts_barrier" ::: "memory")
template <int ABL>
__device__ __forceinline__ void attn_unit(int b, int h, int qb, const Tensors& T, char* lds) {
    int tid_ = threadIdx.x; asm volatile("" : "+v"(tid_));
    const int tid = tid_, wid = __builtin_amdgcn_readfirstlane(tid >> 6), lane = tid & 63, r32 = lane & 31, hi = lane >> 5;
    const int rg = wid & 3, kh = wid >> 2;
    const size_t tok0 = (size_t)b * SEQ; const int q0 = qb * 128, NT = 2 * qb + 2;
    float* ws = (float*)(lds + OFF_WS) + wid * 64;
    const unsigned lds0 = (unsigned)(uintptr_t)lds;
    const bf16 *gk0, *gk1, *gp, *gv0, *gv1;
    { const int ra = 4 * wid + (lane >> 4), rb = ra + 32, cc = lane & 15;
      gk0 = T.KN + (tok0 + ra) * 512 + h * 128 + ((cc ^ (ra & 7)) << 3); gk1 = T.KN + (tok0 + rb) * 512 + h * 128 + ((cc ^ (rb & 7)) << 3);
      const int rp = 8 * wid + (lane >> 3), cp = lane & 7; gp = T.KP + (tok0 + rp) * 64 + ((cp ^ (rp & 7)) << 3);
      const int r8 = (lane >> 2) & 7, c8 = (lane & 3) * 8;
      { const int sub = 2 * wid + (lane >> 5), kk = (sub >> 2) * 8 + r8, key = (kk & ~0xC) | ((kk & 4) << 1) | ((kk & 8) >> 1); gv0 = T.V + (tok0 + key) * 512 + h * 128 + (sub & 3) * 32 + c8; }
      { const int sub = 2 * (wid + 8) + (lane >> 5), kk = (sub >> 2) * 8 + r8, key = (kk & ~0xC) | ((kk & 4) << 1) | ((kk & 8) >> 1); gv1 = T.V + (tok0 + key) * 512 + h * 128 + (sub & 3) * 32 + c8; } }
#define DMA_K(t, kso) do { const size_t ko_ = ABL == 1 ? (size_t)0 : (size_t)(t) * KVBLK; const unsigned d_ = (unsigned)__builtin_amdgcn_readfirstlane((int)(lds0 + OFF_K + (kso) + wid * 1024)); \
        glds16(gk0 + ko_ * 512, d_); glds16(gk1 + ko_ * 512, d_ + 8192); glds16(gp + ko_ * 64, d_ + SHM_KN); } while (0)
#define DMA_V(t, vso) do { const size_t ko_ = ABL == 1 ? (size_t)0 : (size_t)(t) * KVBLK; const unsigned d_ = (unsigned)__builtin_amdgcn_readfirstlane((int)(lds0 + OFF_V + (vso) + wid * 1024)); \
        glds16(gv0 + ko_ * 512, d_); glds16(gv1 + ko_ * 512, d_ + 8192); } while (0)
    DMA_K(0, 0); DMA_V(0, 0); DMA_K(1, KBUF); DMA_V(1, SHM_V);
    bf16x8 qr[12];
    { const bf16* qp = T.Q + (tok0 + q0 + rg * 32 + r32) * 768 + h * 192 + hi * 8;
#pragma unroll
      for (int d0 = 0; d0 < 12; ++d0) qr[d0] = *(const bf16x8*)(qp + d0 * 16);
#pragma unroll
      for (int d0 = 0; d0 < 12; ++d0) asm volatile("" : "+v"(qr[d0])); }
    float m_reg = -1e30f, l_reg = 0.f; f32x16 o[4] = {};
    const int vb0 = (int)lds0 + v_rd_base(lane) + kh * 8192;
    const int qpos = q0 + rg * 32 + r32;
    WAIT_BAR(0);
#define RESC(a) do { if (__any((a) < 1.f)) { if (hi == 0) ws[r32] = (a); asm volatile("s_waitcnt lgkmcnt(0)" ::: "memory"); \
        _Pragma("unroll") for (int d_ = 0; d_ < 4; ++d_) _Pragma("unroll") for (int r = 0; r < 16; ++r) o[d_][r] *= ws[crow(r, hi)]; } } while (0)
#define KBASES(so) const char* k0_ = lds + OFF_K + (so) + kh * 8192; const char* kp0 = lds + OFF_K + (so) + SHM_KN + kh * 4096; const char* kb[4]; \
        _Pragma("unroll") for (int dd = 0; dd < 4; ++dd) kb[dd] = k0_ + KSWZ(r32, (dd * 16 + hi * 8) * 2);
#define MASKT(P_, t_) do { const int kb_ = (t_) * KVBLK + kh * 32 + 4 * hi; const float NEG = -__builtin_inff(); \
        _Pragma("unroll") for (int r = 0; r < 16; ++r) { const int key = kb_ + (r & 3) + 8 * (r >> 2); if (key > qpos) P_[r] = NEG; } } while (0)
#define DECIDE(P_, AL_) do { float pm_ = fmaxf(fmaxf(P_[0], P_[1]), fmaxf(P_[2], P_[3])); \
        _Pragma("unroll") for (int r = 4; r < 16; r += 4) pm_ = fmaxf(pm_, fmaxf(fmaxf(P_[r], P_[r + 1]), fmaxf(P_[r + 2], P_[r + 3]))); \
        { auto rr = __builtin_amdgcn_permlane32_swap(__float_as_uint(pm_), __float_as_uint(pm_), false, false); pm_ = fmaxf(__uint_as_float(rr[0]), __uint_as_float(rr[1])); } \
        const bool ok_ = __all((pm_ - m_reg) <= THR); const float mn_ = ok_ ? m_reg : fmaxf(m_reg, pm_); AL_ = ok_ ? 1.f : __builtin_amdgcn_exp2f(m_reg - mn_); m_reg = mn_; } while (0)
    f32x16 pc, pn; float alpha;
    { KBASES(0); pc = f32x16{}; bf16x8 f0 = KFR(0), f1 = KFR(1), f2 = KFR(2), f3 = KFR(3); SBAR();
#define QS0(i, F) do { pc = __builtin_amdgcn_mfma_f32_32x32x16_bf16(F, qr[i], pc, 0, 0, 0); if ((i) + 4 < 12) F = KFR((i) + 4); SBAR(); } while (0)
      QS0(0, f0); QS0(1, f1); QS0(2, f2); QS0(3, f3); QS0(4, f0); QS0(5, f1); QS0(6, f2); QS0(7, f3); QS0(8, f0); QS0(9, f1); QS0(10, f2); QS0(11, f3);
#undef QS0
      if (0 >= NT - 2) MASKT(pc, 0);
      DECIDE(pc, alpha); }
    WAIT_BAR(0);
    int kcur = 0  , v_cur = 0, v_nxt = SHM_V, v_nxt2 = 2 * SHM_V;
    for (int t = 0; t < NT; ++t) {
        const bool more = t + 1 < NT;
        if (t + 2 < NT) DMA_K(t + 2, kcur);
        bf16x8 pa0, pa1; float ps = 0.f; const float mn = m_reg;
#define EX2(i) do { pc[2 * (i)] = __builtin_amdgcn_exp2f(pc[2 * (i)] - mn); pc[2 * (i) + 1] = __builtin_amdgcn_exp2f(pc[2 * (i) + 1] - mn); ps += pc[2 * (i)] + pc[2 * (i) + 1]; } while (0)
#define SUMFIN() do { auto rr = __builtin_amdgcn_permlane32_swap(__float_as_uint(ps), __float_as_uint(ps), false, false); ps = __uint_as_float(rr[0]) + __uint_as_float(rr[1]); l_reg = l_reg * alpha + ps; } while (0)
        if (more) {
            KBASES(KBUF - kcur); pn = f32x16{}; bf16x8 f0 = KFR(0), f1 = KFR(1), f2 = KFR(2), f3 = KFR(3); SBAR();
            __builtin_amdgcn_s_setprio(1);
#define QS(i, F, FILL) do { pn = __builtin_amdgcn_mfma_f32_32x32x16_bf16(F, qr[i], pn, 0, 0, 0); if ((i) + 4 < 12) F = KFR((i) + 4); FILL; SBAR(); } while (0)
            QS(0, f0, EX2(0)); QS(1, f1, EX2(1)); QS(2, f2, EX2(2)); QS(3, f3, EX2(3)); QS(4, f0, EX2(4)); QS(5, f1, EX2(5)); QS(6, f2, EX2(6)); QS(7, f3, EX2(7));
            QS(8, f0, SUMFIN()); QS(9, f1, PK4(pc, 0, pa0)); QS(10, f2, PK4(pc, 8, pa1)); QS(11, f3, (void)0);
            __builtin_amdgcn_s_setprio(0);
#undef QS
            if (t + 1 >= NT - 2) MASKT(pn, t + 1);
        } else {
            EX2(0); EX2(1); EX2(2); EX2(3); EX2(4); EX2(5); EX2(6); EX2(7); SUMFIN(); PK4(pc, 0, pa0); PK4(pc, 8, pa1); SBAR();
        }
#undef EX2
#undef SUMFIN
        RESC(alpha); SBAR();
        { const int vb = vb0 + v_cur; float alpha_n = 1.f;
#define TRRD(dst, off) asm volatile("ds_read_b64_tr_b16 %0, %1 offset:%2" : "=&v"(dst) : "v"(vb), "i"(off) : "memory")
          s16x4 l0, l1, h0, h1, l2, l3, h2, h3;
          { constexpr int b_ = v_rd_off(0, 0, 0), c_ = v_rd_off(1, 0, 0);
            TRRD(l0, b_); TRRD(h0, b_ + 2048); TRRD(l1, b_ + 4096); TRRD(h1, b_ + 6144); TRRD(l2, c_); TRRD(h2, c_ + 2048); TRRD(l3, c_ + 4096); TRRD(h3, c_ + 6144); }
          if (t + 2 < NT) DMA_V(t + 2, v_nxt2);
          asm volatile("s_waitcnt lgkmcnt(0)" ::: "memory"); SBAR();
          o[0] = __builtin_amdgcn_mfma_f32_32x32x16_bf16(pa0, (bf16x8){l0[0], l0[1], l0[2], l0[3], h0[0], h0[1], h0[2], h0[3]}, o[0], 0, 0, 0);
          o[1] = __builtin_amdgcn_mfma_f32_32x32x16_bf16(pa0, (bf16x8){l2[0], l2[1], l2[2], l2[3], h2[0], h2[1], h2[2], h2[3]}, o[1], 0, 0, 0);
          SBAR();
          o[0] = __builtin_amdgcn_mfma_f32_32x32x16_bf16(pa1, (bf16x8){l1[0], l1[1], l1[2], l1[3], h1[0], h1[1], h1[2], h1[3]}, o[0], 0, 0, 0);
          o[1] = __builtin_amdgcn_mfma_f32_32x32x16_bf16(pa1, (bf16x8){l3[0], l3[1], l3[2], l3[3], h3[0], h3[1], h3[2], h3[3]}, o[1], 0, 0, 0);
          { constexpr int b_ = v_rd_off(2, 0, 0), c_ = v_rd_off(3, 0, 0);
            TRRD(l0, b_); TRRD(h0, b_ + 2048); TRRD(l1, b_ + 4096); TRRD(h1, b_ + 6144); TRRD(l2, c_); TRRD(h2, c_ + 2048); TRRD(l3, c_ + 4096); TRRD(h3, c_ + 6144); }
          SBAR();
          if (more) DECIDE(pn, alpha_n);
          asm volatile("s_waitcnt lgkmcnt(0)" ::: "memory"); SBAR();
          o[2] = __builtin_amdgcn_mfma_f32_32x32x16_bf16(pa0, (bf16x8){l0[0], l0[1], l0[2], l0[3], h0[0], h0[1], h0[2], h0[3]}, o[2], 0, 0, 0);
          o[3] = __builtin_amdgcn_mfma_f32_32x32x16_bf16(pa0, (bf16x8){l2[0], l2[1], l2[2], l2[3], h2[0], h2[1], h2[2], h2[3]}, o[3], 0, 0, 0);
          o[2] = __builtin_amdgcn_mfma_f32_32x32x16_bf16(pa1, (bf16x8){l1[0], l1[1], l1[2], l1[3], h1[0], h1[1], h1[2], h1[3]}, o[2], 0, 0, 0);
          o[3] = __builtin_amdgcn_mfma_f32_32x32x16_bf16(pa1, (bf16x8){l3[0], l3[1], l3[2], l3[3], h3[0], h3[1], h3[2], h3[3]}, o[3], 0, 0, 0);
#undef TRRD
          alpha = alpha_n; }
        if (t + 2 < NT) WAIT_BAR(2); else WAIT_BAR(0);
        pc = pn;
        kcur = KBUF - kcur; v_cur = v_nxt; v_nxt = v_nxt2; v_nxt2 = (v_nxt2 == 2 * SHM_V) ? 0 : v_nxt2 + SHM_V;
    }
#undef RESC
#undef DMA_K
#undef DMA_V
#undef KBASES
#undef MASKT
#undef DECIDE
    float* XO = (float*)lds;
    float* XM = (float*)(lds + 65536);
    if (kh == 1) {
#pragma unroll
        for (int d0 = 0; d0 < 4; ++d0)
#pragma unroll
            for (int r = 0; r < 16; ++r) XO[((rg * 64) + d0 * 16 + r) * 64 + lane] = o[d0][r];
        if (hi == 0) { XM[rg * 32 + r32] = m_reg; XM[128 + rg * 32 + r32] = l_reg; }
    }
    __syncthreads();
    if (kh == 0) {
        const float m1 = XM[rg * 32 + r32], l1 = XM[128 + rg * 32 + r32];
        const float mn = fmaxf(m_reg, m1), a0 = __builtin_amdgcn_exp2f(m_reg - mn), a1 = __builtin_amdgcn_exp2f(m1 - mn);
        const float inv = __builtin_amdgcn_rcpf(l_reg * a0 + l1 * a1);
        if (hi == 0) { ws[r32] = a0 * inv; ws[32 + r32] = a1 * inv; }
        asm volatile("s_waitcnt lgkmcnt(0)" ::: "memory");
        bf16* Ow = T.O + (tok0 + q0 + rg * 32) * 512 + h * 128;
#pragma unroll
        for (int r = 0; r < 16; ++r) { const int orow = crow(r, hi); const float f0 = ws[orow], f1 = ws[32 + orow];
#pragma unroll
            for (int d0 = 0; d0 < 4; ++d0) { const float v = o[d0][r] * f0 + XO[((rg * 64) + d0 * 16 + r) * 64 + lane] * f1; const float vn = __shfl_xor(v, 1);
                if ((r32 & 1) == 0) *(unsigned*)(Ow + (size_t)orow * 512 + d0 * 32 + r32) = cvtpk(v, vn); } }
    }
    __syncthreads();
}
#undef WAIT_BAR
#undef KSWZ
#undef KPSWZ
#undef SBAR
}
namespace ret {
using namespace mk;
__device__ __forceinline__ int crow(int r, int hi) { return (r & 3) + 8 * (r >> 2) + 4 * hi; }
struct Tensors { const bf16 *RQ, *RK, *RKT, *RVT, *RG; float* KVT; bf16* STATE; bf16* MIX; const float* gain; };
__device__ __forceinline__ void x_unit(int u, const Tensors& T, int lane) {
    asm volatile("" : "+v"(lane));
    const int n = u & 127, bh = u >> 7, h = bh & 3, b = bh >> 2, r32 = lane & 31, hi = lane >> 5;
    const size_t tok0 = (size_t)b * SEQ + (size_t)n * RET_C;
    f32x16 acc[2][2] = {};
#pragma unroll
    for (int s = 0; s < 4; ++s) {
        bf16x8 a[2], bb[2];
#pragma unroll
        for (int i = 0; i < 2; ++i) { a[i] = *(const bf16x8*)(T.RVT + (size_t)(h * 64 + i * 32 + r32) * NTOK + tok0 + s * 16 + hi * 8);
                                      bb[i] = *(const bf16x8*)(T.RKT + (size_t)(h * 64 + i * 32 + r32) * NTOK + tok0 + s * 16 + hi * 8); }
#pragma unroll
        for (int i = 0; i < 2; ++i)
#pragma unroll
            for (int j = 0; j < 2; ++j) acc[i][j] = __builtin_amdgcn_mfma_f32_32x32x16_bf16(a[i], bb[j], acc[i][j], 0, 0, 0);
    }
    float* out = T.KVT + (size_t)u * 4096;
#pragma unroll
    for (int i = 0; i < 2; ++i)
#pragma unroll
        for (int j = 0; j < 2; ++j)
#pragma unroll
            for (int r = 0; r < 16; ++r) out[(i * 32 + crow(r, hi)) * 64 + j * 32 + r32] = acc[i][j][r];
}
__device__ __forceinline__ void scan_elem(int e, const Tensors& T) {
    const int bh = e >> 12, el = e & 4095, h = bh & 3;
    const float gam = 1.f - __builtin_amdgcn_exp2f(-5.f - (float)h), lg2 = __builtin_amdgcn_logf(gam);
    const float g64 = __builtin_amdgcn_exp2f(64.f * lg2), g63 = __builtin_amdgcn_exp2f(63.f * lg2);
    const float* kv = T.KVT + (size_t)bh * 128 * 4096 + el; bf16* st = T.STATE + (size_t)bh * 128 * 4096 + el;
    float S = 0.f;
    for (int n0 = 0; n0 < 128; n0 += 16) {
        float v[16];
#pragma unroll
        for (int i = 0; i < 16; ++i) v[i] = kv[(size_t)(n0 + i) * 4096];
#pragma unroll
        for (int i = 0; i < 16; ++i) { st[(size_t)(n0 + i) * 4096] = (bf16)(cvtpk(gam * S, 0.f) & 0xffffu); S = g64 * S + g63 * v[i]; }
    }
}
__device__ __forceinline__ void z_unit(int u, const Tensors& T, int lane) {
    asm volatile("" : "+v"(lane));
    const int n = u & 127, bh = u >> 7, h = bh & 3, b = bh >> 2, r32 = lane & 31, hi = lane >> 5;
    const size_t tok0 = (size_t)b * SEQ + (size_t)n * RET_C;
    bf16x8 qf[2][4], kf[2][4], sa[4][2]; u32x4 vt[2][2][2];
#pragma unroll
    for (int qb = 0; qb < 2; ++qb)
#pragma unroll
        for (int s = 0; s < 4; ++s) { qf[qb][s] = *(const bf16x8*)(T.RQ + (tok0 + qb * 32 + r32) * 256 + h * 64 + s * 16 + hi * 8); kf[qb][s] = *(const bf16x8*)(T.RK + (tok0 + qb * 32 + r32) * 256 + h * 64 + s * 16 + hi * 8); }
    const bf16* stp = T.STATE + (size_t)u * 4096;
#pragma unroll
    for (int s = 0; s < 4; ++s)
#pragma unroll
        for (int i = 0; i < 2; ++i) sa[s][i] = *(const bf16x8*)(stp + (i * 32 + r32) * 64 + s * 16 + hi * 8);
#pragma unroll
    for (int kb = 0; kb < 2; ++kb)
#pragma unroll
        for (int s2 = 0; s2 < 2; ++s2)
#pragma unroll
            for (int i = 0; i < 2; ++i) { const bf16* vp = T.RVT + (size_t)(h * 64 + i * 32 + r32) * NTOK + tok0 + kb * 32 + s2 * 16 + 4 * hi;
                const u32x2 lo = *(const u32x2*)vp, hh = *(const u32x2*)(vp + 8); vt[kb][s2][i] = (u32x4){lo.x, lo.y, hh.x, hh.y}; }
    __builtin_amdgcn_sched_barrier(0);
    f32x16 o[2][2] = {};
#pragma unroll
    for (int s = 0; s < 4; ++s)
#pragma unroll
        for (int i = 0; i < 2; ++i)
#pragma unroll
            for (int qb = 0; qb < 2; ++qb) o[i][qb] = __builtin_amdgcn_mfma_f32_32x32x16_bf16(sa[s][i], qf[qb][s], o[i][qb], 0, 0, 0);
#pragma unroll
    for (int kb = 0; kb < 2; ++kb) {
#pragma unroll
        for (int qb = kb; qb < 2; ++qb) {
            f32x16 st = {};
#pragma unroll
            for (int s = 0; s < 4; ++s) st = __builtin_amdgcn_mfma_f32_32x32x16_bf16(kf[kb][s], qf[qb][s], st, 0, 0, 0);
            if (kb == qb) {
#pragma unroll
                for (int r = 0; r < 16; ++r) if (crow(r, hi) > r32) st[r] = 0.f;
            }
#pragma unroll
            for (int s2 = 0; s2 < 2; ++s2) {
                u32x4 w; w.x = cvtpk(st[8 * s2 + 0], st[8 * s2 + 1]); w.y = cvtpk(st[8 * s2 + 2], st[8 * s2 + 3]); w.z = cvtpk(st[8 * s2 + 4], st[8 * s2 + 5]); w.w = cvtpk(st[8 * s2 + 6], st[8 * s2 + 7]);
                const bf16x8 pb = __builtin_bit_cast(bf16x8, w);
#pragma unroll
                for (int i = 0; i < 2; ++i) o[i][qb] = __builtin_amdgcn_mfma_f32_32x32x16_bf16(__builtin_bit_cast(bf16x8, vt[kb][s2][i]), pb, o[i][qb], 0, 0, 0);
            }
        }
    }
#pragma unroll
    for (int qb = 0; qb < 2; ++qb) {
        float ss = 0.f;
#pragma unroll
        for (int i = 0; i < 2; ++i)
#pragma unroll
            for (int r = 0; r < 16; ++r) ss += o[i][qb][r] * o[i][qb][r];
        { auto rr = __builtin_amdgcn_permlane32_swap(__float_as_uint(ss), __float_as_uint(ss), false, false); ss = __uint_as_float(rr[0]) + __uint_as_float(rr[1]); }
        const float rstd = __builtin_amdgcn_rsqf(ss * (1.f / 64.f) + EPS);
        const size_t row = tok0 + qb * 32 + r32;
#pragma unroll
        for (int i = 0; i < 2; ++i)
#pragma unroll
            for (int r4 = 0; r4 < 4; ++r4) { const int dv = i * 32 + 8 * r4 + 4 * hi;
                const f32x4 gt = ld4bf(T.RG + row * 256 + h * 64 + dv), gn = *(const f32x4*)(T.gain + h * 64 + dv);
                const f32x4 v = {o[i][qb][4 * r4 + 0], o[i][qb][4 * r4 + 1], o[i][qb][4 * r4 + 2], o[i][qb][4 * r4 + 3]};
                st8(T.MIX + row * DM + h * 64 + dv, v * rstd * gn * gt); }
    }
}
}
namespace mk {
constexpr size_t MiB = 1u << 20;
constexpr size_t W_CTL = 0, CTL_ZERO_BYTES = 64 * 1024;
constexpr size_t W_WGCNT = 128 * 1024;
constexpr size_t W_TILE = 192 * 1024;
constexpr size_t W_MOD = 1 * MiB;
constexpr size_t W_LAMC = 1 * MiB + 256 * 1024;
constexpr size_t W_TOP = 1 * MiB + 512 * 1024;
constexpr size_t W_CS = 2 * MiB;
constexpr size_t W_ROWW = 6 * MiB;
constexpr size_t W_MODP = 7 * MiB;
constexpr size_t W_SSQQ = 6 * MiB + 256 * 1024, W_SSQKV = 6 * MiB + 512 * 1024;
constexpr size_t W_MOEUP = 8 * MiB, W_MOEDN = 120 * MiB;
constexpr size_t W_WIN = 176 * MiB, W_WOUT = 183 * MiB, W_FFUP = 187 * MiB, W_FFDN = 201 * MiB, W_MW = 208 * MiB, W_WEND = 228 * MiB;
constexpr size_t W_WUQ = 233 * MiB, W_WUKV = 234 * MiB, W_GLUW = 235 * MiB;
constexpr size_t W_Y = 236 * MiB, W_MIX = 268 * MiB, W_T = 300 * MiB;
constexpr size_t W_RQ = W_T, W_RK = W_T + 8 * MiB, W_RKT = W_T + 16 * MiB, W_RVT = W_T + 24 * MiB, W_RG = W_T + 32 * MiB, W_UC = W_T + 40 * MiB, W_CQ = W_T + 50 * MiB,
                 W_CKV = W_T + 58 * MiB, W_KPE = W_T + 62 * MiB, W_Q = W_T + 64 * MiB, W_KN = W_T + 88 * MiB, W_V = W_T + 104 * MiB, W_O = W_T + 120 * MiB, W_G = W_T + 136 * MiB,
                 W_KVT = W_T + 144 * MiB, W_STATE = W_T + 160 * MiB, W_E = W_T + 168 * MiB;
constexpr size_t W_HB = W_T;
constexpr size_t W_XN = 480 * MiB;
constexpr size_t W_XG = 176 * MiB;
constexpr size_t W_Y2B = 8 * MiB;
constexpr size_t W_HBM = 244 * MiB;
constexpr size_t W_END = 512 * MiB;

struct Args { const void* in[35]; float* out; unsigned char* ws; int ph_lo, ph_hi, never, pad; };

template <class SrcF>
__device__ __forceinline__ void transpose_item(const SrcF src, int ld, int K, bf16* WT, const float* kscale, float cscale, LAS float* scr, int kb, int nb, int lane) {
    const int k0 = 64 * kb, n0 = 32 * nb;
    const float* sp = src(n0 + (lane & 31));
    float tv[32];
#pragma unroll
    for (int i = 0; i < 32; ++i) tv[i] = sp[(size_t)(k0 + 2 * i + (lane >> 5)) * ld];
#pragma unroll
    for (int i = 0; i < 32; ++i) { const int kk = 2 * i + (lane >> 5); float v = tv[i] * cscale; if (kscale) v *= kscale[k0 + kk]; scr[kk * 33 + (lane & 31)] = v; }
    asm volatile("s_waitcnt lgkmcnt(0)" ::: "memory");
    const int c = lane & 7;
#pragma unroll
    for (int j = 0; j < 4; ++j) { const int n = (lane >> 3) + 8 * j; const LAS float* s = scr + (8 * c) * 33 + n;
        u32x4 o; o.x = cvtpk(s[0 * 33], s[1 * 33]); o.y = cvtpk(s[2 * 33], s[3 * 33]); o.z = cvtpk(s[4 * 33], s[5 * 33]); o.w = cvtpk(s[6 * 33], s[7 * 33]);
        *(u32x4*)(WT + (size_t)(n0 + n) * K + k0 + 8 * c) = o; }
    asm volatile("s_waitcnt lgkmcnt(0)" ::: "memory");
}
struct SrcPlain { const float* W; __device__ __forceinline__ const float* operator()(int n) const { return W + n; } };
struct SrcWin { const float* W; __device__ __forceinline__ const float* operator()(int n) const {
        const bool rp = (n < 512) || (n >= 1664); const int g = n & ~63, cg = n & 63; return W + (rp ? g + (cg >> 1) + 32 * (cg & 1) : n); } };
struct SrcWuq { const float* W; __device__ __forceinline__ const float* operator()(int n) const { const int hh = n / 192, w = n % 192; const int cg = w - 128; return W + (w < 128 ? n : hh * 192 + 128 + (cg >> 1) + 32 * (cg & 1)); } };
struct SrcGU { const float* Wg; const float* Wu; __device__ __forceinline__ const float* operator()(int n) const { const int hid = (n >> 3) * 4 + (n & 3);
        const long long du = (const char*)Wu - (const char*)Wg; return (const float*)((const char*)Wg + (((n >> 2) & 1) ? du : 0ll)) + hid; } };

__device__ __forceinline__ f32x2 lam_pow(float a_re, float a_im, float dt, float e) {
    const float mag = __builtin_amdgcn_exp2f(1.4426950408889634f * a_re * dt * e);
    const double rev = (double)(a_im * dt) * (double)e * 0.15915494309189535;
    const float fr = (float)(rev - floor(rev));
    return (f32x2){mag * __builtin_amdgcn_cosf(fr), mag * __builtin_amdgcn_sinf(fr)};
}
__device__ __forceinline__ f32x2 cmul(f32x2 a, f32x2 b) { return (f32x2){a.x * b.x - a.y * b.y, a.x * b.y + a.y * b.x}; }

template <bool GU>
__device__ __forceinline__ void xp_issue(f32x4 (&v)[8], const float* W0, const float* W1, int ld, int k0, int n0, int tid) {
#pragma unroll
    for (int i = 0; i < 8; ++i) { const int idx = tid + 512 * i, row = idx >> 6, c4 = idx & 63;
        const float* src = GU ? ((c4 < 32 ? W0 : W1) + (size_t)(k0 + row) * ld + (n0 >> 1) + 4 * (c4 & 31)) : (W0 + (size_t)(k0 + row) * ld + n0 + 4 * c4);
        v[i] = *(const f32x4*)src; }
}
template <bool GU>
__device__ __forceinline__ void xp_finish(const f32x4 (&v)[8], bf16* WT, int K, int k0, int n0, LAS float* T, int tid) {
#pragma unroll
    for (int i = 0; i < 8; ++i) { const int idx = tid + 512 * i, row = idx >> 6, c4 = idx & 63; *(LAS f32x4*)(T + row * 256 + ((4 * c4) ^ (((row >> 3) & 7) << 2))) = v[i]; }
    __syncthreads();
#pragma unroll
    for (int j = 0; j < 4; ++j) { const int id = tid + 512 * j, c = id & 7, n = id >> 3; const int col = n;
        const LAS float* s = T + (8 * c) * 256 + (col ^ (c << 2));
        u32x4 o; o.x = cvtpk(s[0], s[256]); o.y = cvtpk(s[512], s[768]); o.z = cvtpk(s[1024], s[1280]); o.w = cvtpk(s[1536], s[1792]);
        *(u32x4*)(WT + (size_t)(n0 + n) * K + k0 + 8 * c) = o; }
    __syncthreads();
}
template <bool GU>
__device__ __forceinline__ void xp_matrix(const float* W0, const float* W1, int ld, int K, int N, bf16* WT, LAS float* T, int bx, int G, int tid) {
    const int nb_ = N / 256, ni_ = (K / 64) * nb_;
    f32x4 v[8];
    int it = bx; if (it >= ni_) return;
    xp_issue<GU>(v, W0, W1, ld, 64 * (it / nb_), 256 * (it % nb_), tid);
    for (; it < ni_; it += G) {
        f32x4 w[8];
#pragma unroll
        for (int i = 0; i < 8; ++i) w[i] = v[i];
        const int nx = it + G;
        if (nx < ni_) xp_issue<GU>(v, W0, W1, ld, 64 * (nx / nb_), 256 * (nx % nb_), tid);
        xp_finish<GU>(w, WT, K, 64 * (it / nb_), 256 * (it % nb_), T, tid);
    }
}

constexpr int MOE_ITEMS = NE * 672;
__device__ __forceinline__ void moe_item_issue(f32x4 (&v)[8], int id, const float* wg, const float* wu, const float* wd, int tid) {
    const int e = id / 672, r = id % 672;
    if (r < 448) xp_issue<true>(v, wg + (size_t)e * DM * DFF, wu + (size_t)e * DM * DFF, DFF, 64 * (r / 28), 256 * (r % 28), tid);
    else { const int q = r - 448; xp_issue<false>(v, wd + (size_t)e * DFF * DM, nullptr, DM, 64 * (q >> 2), 256 * (q & 3), tid); }
}
__device__ __forceinline__ void moe_item_finish(const f32x4 (&v)[8], int id, bf16* up, bf16* dn, LAS float* T, int tid) {
    const int e = id / 672, r = id % 672;
    if (r < 448) xp_finish<true>(v, up + (size_t)e * 2 * DFF * DM, DM, 64 * (r / 28), 256 * (r % 28), T, tid);
    else { const int q = r - 448; xp_finish<false>(v, dn + (size_t)e * DM * DFF, DFF, 64 * (q >> 2), 256 * (q & 3), T, tid); }
}
__device__ __forceinline__ void moe_convert(int quota, unsigned* counter, const float* wg, const float* wu, const float* wd, bf16* up, bf16* dn, LAS float* T, volatile LAS int* slot, int tid) {
    if (quota <= 0) return;
    __syncthreads();
    if (tid == 0) slot[0] = (int)__hip_atomic_fetch_add(counter, 1u, __ATOMIC_RELAXED, __HIP_MEMORY_SCOPE_AGENT);
    __syncthreads();
    int cur = slot[0]; if (cur >= MOE_ITEMS) return;
    f32x4 v[8]; moe_item_issue(v, cur, wg, wu, wd, tid);
    for (int n = 1;; ++n) {
        int nxt = MOE_ITEMS;
        if (n < quota) { __syncthreads(); if (tid == 0) slot[0] = (int)__hip_atomic_fetch_add(counter, 1u, __ATOMIC_RELAXED, __HIP_MEMORY_SCOPE_AGENT); __syncthreads(); nxt = slot[0]; }
        f32x4 w[8];
#pragma unroll
        for (int i = 0; i < 8; ++i) w[i] = v[i];
        if (nxt < MOE_ITEMS) moe_item_issue(v, nxt, wg, wu, wd, tid);
        moe_item_finish(w, cur, up, dn, T, tid);
        if (nxt >= MOE_ITEMS) break;
        cur = nxt;
    }
}
}
namespace mk {
struct SsmPar { const float *a_re, *a_im, *b_re, *b_im, *c_re, *c_im, *log_dt; };
__device__ __forceinline__ f32x2 ssm_fw(const SsmPar& P, int g, int p, float e, bool with_f) {
    const float dt = __builtin_amdgcn_exp2f(1.4426950408889634f * P.log_dt[g]);
    const float ar = P.a_re[g * 64 + p], ai = P.a_im[g * 64 + p];
    f32x2 w = lam_pow(ar, ai, dt, e);
    if (with_f) { const f32x2 lb = lam_pow(ar, ai, dt, 1.f); const float nr = lb.x - 1.f, ni = lb.y, den = ar * ar + ai * ai;
        const f32x2 f = {(nr * ar + ni * ai) / den, (ni * ar - nr * ai) / den}; w = cmul(w, f); }
    return w;
}
__device__ __forceinline__ void ssm_unit_toep(const SsmPar& P, bf16* MW, int g, int dd, LAS float* scr, int lane) {
    const int d = dd - 31, h = lane >> 2, hp0 = (lane & 3) * 4;
    f32x4 acc = {0.f, 0.f, 0.f, 0.f};
    if (d >= 0) {
#pragma unroll
        for (int i = 0; i < 4; ++i) { const int o = 4 * (lane + 64 * i);
            *(LAS f32x4*)(scr + o) = *(const f32x4*)(P.c_re + g * 1024 + o); *(LAS f32x4*)(scr + 1024 + o) = *(const f32x4*)(P.c_im + g * 1024 + o);
            *(LAS f32x4*)(scr + 2048 + o) = *(const f32x4*)(P.b_re + g * 1024 + o); *(LAS f32x4*)(scr + 3072 + o) = *(const f32x4*)(P.b_im + g * 1024 + o); }
        const f32x2 w = ssm_fw(P, g, lane, (float)d, true);
        asm volatile("s_waitcnt lgkmcnt(0)" ::: "memory");
#pragma unroll 8
        for (int p = 0; p < 64; ++p) {
            const f32x2 wp = {__shfl(w.x, p), __shfl(w.y, p)};
            const f32x2 cm = {scr[h * 64 + p], scr[1024 + h * 64 + p]};
            const f32x2 t = cmul(cm, wp);
            const f32x4 br = *(const LAS f32x4*)(scr + 2048 + p * 16 + hp0), bi = *(const LAS f32x4*)(scr + 3072 + p * 16 + hp0);
            acc += br * t.x - bi * t.y;
        }
        asm volatile("s_waitcnt lgkmcnt(0)" ::: "memory");
    }
    const int tlo = d >= 0 ? d : 0, thi = d >= 0 ? 32 : 32 + d;
    for (int t = tlo; t < thi; ++t) st8(MW + ((size_t)g * 512 + t * 16 + h) * SSM_K + (t - d) * 16 + hp0, acc);
}
__device__ __forceinline__ void ssm_unit_cross(const SsmPar& P, bf16* MW, f32x2* LAMC, int g, int t, int lane) {
    const f32x2 lp = ssm_fw(P, g, lane, (float)(t + 1), false);
    if (t == 31) LAMC[g * 64 + lane] = lp;
#pragma unroll 4
    for (int h = 0; h < 16; ++h) { const f32x2 cm = {P.c_re[(g * 16 + h) * 64 + lane], P.c_im[(g * 16 + h) * 64 + lane]}; const f32x2 v = cmul(cm, lp);
        *(unsigned*)(MW + ((size_t)g * 512 + t * 16 + h) * SSM_K + 512 + 2 * lane) = cvtpk(v.x, -v.y); }
}
__device__ __forceinline__ void ssm_unit_end(const SsmPar& P, bf16* WEND, int g, int j, int lane) {
    const f32x2 w = ssm_fw(P, g, lane, (float)(31 - j), true);
    float re[16], im[16];
#pragma unroll
    for (int q = 0; q < 4; ++q) { const f32x4 br = *(const f32x4*)(P.b_re + (g * 64 + lane) * 16 + 4 * q), bi = *(const f32x4*)(P.b_im + (g * 64 + lane) * 16 + 4 * q);
#pragma unroll
        for (int k = 0; k < 4; ++k) { re[4 * q + k] = w.x * br[k] - w.y * bi[k]; im[4 * q + k] = w.x * bi[k] + w.y * br[k]; } }
    bf16* r0 = WEND + ((size_t)g * 128 + 2 * lane) * 512 + j * 16;
    st16(r0, (f32x4){re[0], re[1], re[2], re[3]}, (f32x4){re[4], re[5], re[6], re[7]}); st16(r0 + 8, (f32x4){re[8], re[9], re[10], re[11]}, (f32x4){re[12], re[13], re[14], re[15]});
    st16(r0 + 512, (f32x4){im[0], im[1], im[2], im[3]}, (f32x4){im[4], im[5], im[6], im[7]}); st16(r0 + 520, (f32x4){im[8], im[9], im[10], im[11]}, (f32x4){im[12], im[13], im[14], im[15]});
}
__device__ __forceinline__ void ssm_scan(int bg, const float* E, const f32x2* LAMC, bf16* UC, int lane) {
    const int b = bg >> 4, g = bg & 15;
    const f32x2 lc = LAMC[g * 64 + lane];
    f32x2 c = {0.f, 0.f};
    for (int n0 = 0; n0 < 256; n0 += 16) {
        f32x2 e[16];
#pragma unroll
        for (int i = 0; i < 16; ++i) e[i] = *(const f32x2*)(E + ((size_t)g * SSM_NCH + b * 256 + n0 + i) * 128 + 2 * lane);
#pragma unroll
        for (int i = 0; i < 16; ++i) { *(unsigned*)(UC + ((size_t)g * SSM_NCH + b * 256 + n0 + i) * SSM_K + 512 + 2 * lane) = cvtpk(c.x, c.y); c = cmul(lc, c) + e[i]; }
    }
}
struct Row { f32x4 v[4]; };
__device__ __forceinline__ Row row_ld_f32(const float* p, int lane) { Row r;
#pragma unroll
    for (int j = 0; j < 4; ++j) r.v[j] = *(const f32x4*)(p + 4 * lane + 256 * j);
    return r; }
__device__ __forceinline__ Row row_ld_bf16(const bf16* p, int lane) { Row r;
#pragma unroll
    for (int j = 0; j < 4; ++j) r.v[j] = ld4bf(p + 4 * lane + 256 * j);
    return r; }
__device__ __forceinline__ float row_ssq(const Row& r) { float s = 0.f;
#pragma unroll
    for (int j = 0; j < 4; ++j) s += (r.v[j][0] * r.v[j][0] + r.v[j][1] * r.v[j][1]) + (r.v[j][2] * r.v[j][2] + r.v[j][3] * r.v[j][3]);
    return wave_sum(s); }
__device__ __forceinline__ Row adaln(const Row& x, const float* g, const float* sc, const float* sh, bf16* xn, int lane) {
    const float rstd = __builtin_amdgcn_rsqf(row_ssq(x) * (1.f / DM) + EPS); Row o;
#pragma unroll
    for (int j = 0; j < 4; ++j) { const int c = 4 * lane + 256 * j; const f32x4 g4 = *(const f32x4*)(g + c), s4 = *(const f32x4*)(sc + c), h4 = *(const f32x4*)(sh + c);
        o.v[j] = x.v[j] * rstd * g4 * (s4 + 1.f) + h4; st8(xn + c, o.v[j]); }
    return o; }
__device__ __forceinline__ Row resid(const Row& xin, const Row& y, const float* g, const float* gt, float* xout, int lane) {
    const float rstd = __builtin_amdgcn_rsqf(row_ssq(y) * (1.f / DM) + EPS); Row o;
#pragma unroll
    for (int j = 0; j < 4; ++j) { const int c = 4 * lane + 256 * j; const f32x4 g4 = *(const f32x4*)(g + c), t4 = *(const f32x4*)(gt + c);
        o.v[j] = xin.v[j] + t4 * y.v[j] * rstd * g4; *(f32x4*)(xout + c) = o.v[j]; }
    return o; }
__device__ __forceinline__ void route(const Row& h, const float* router, int lane, int& e1, int& e2, float& w1, float& w2) {
    float acc[8];
#pragma unroll
    for (int e = 0; e < 8; ++e) acc[e] = 0.f;
#pragma unroll
    for (int j = 0; j < 4; ++j)
#pragma unroll
        for (int k = 0; k < 4; ++k) { const int c = 4 * lane + 256 * j + k; const f32x4 r0 = *(const f32x4*)(router + c * 8), r1 = *(const f32x4*)(router + c * 8 + 4); const float hv = h.v[j][k];
            acc[0] += hv * r0[0]; acc[1] += hv * r0[1]; acc[2] += hv * r0[2]; acc[3] += hv * r0[3]; acc[4] += hv * r1[0]; acc[5] += hv * r1[1]; acc[6] += hv * r1[2]; acc[7] += hv * r1[3]; }
#pragma unroll
    for (int e = 0; e < 8; ++e) acc[e] = wave_sum(acc[e]);
    e1 = 0; float v1 = acc[0];
#pragma unroll
    for (int e = 1; e < 8; ++e) if (acc[e] > v1) { v1 = acc[e]; e1 = e; }
    e2 = -1; float v2 = -__builtin_inff();
#pragma unroll
    for (int e = 0; e < 8; ++e) if (e != e1 && acc[e] > v2) { v2 = acc[e]; e2 = e; }
    const float ex = __builtin_amdgcn_exp2f(1.4426950408889634f * (v2 - v1)); w1 = 1.f / (1.f + ex); w2 = ex / (1.f + ex);
}

__device__ __forceinline__ void glu_unit(int u, const bf16* G, const bf16* GLUW, const float* bias, const float* gain, bf16* MIX, int lane) {
    asm volatile("" : "+v"(lane));
    const int r32 = lane & 31, hi = lane >> 5; const size_t tok = (size_t)u * 32 + r32;
    f32x16 acc[8] = {};
#pragma unroll 2
    for (int s = 0; s < 16; ++s) {
        const bf16x8 bf = *(const bf16x8*)(G + tok * 256 + s * 16 + hi * 8);
#pragma unroll
        for (int j = 0; j < 8; ++j) { const bf16x8 a = *(const bf16x8*)(GLUW + (size_t)(j * 32 + r32) * 256 + s * 16 + hi * 8); acc[j] = __builtin_amdgcn_mfma_f32_32x32x16_bf16(a, bf, acc[j], 0, 0, 0); }
    }
    float ss = 0.f;
#pragma unroll
    for (int j = 0; j < 8; ++j)
#pragma unroll
        for (int r4 = 0; r4 < 4; ++r4) { const int ch = j * 32 + 8 * r4 + 4 * hi; const f32x4 b4 = *(const f32x4*)(bias + ch), gl = ld4bf(G + tok * 256 + ch);
#pragma unroll
            for (int k = 0; k < 4; ++k) { const float y = gl[k] * fast_sigmoid(acc[j][4 * r4 + k] + b4[k]); acc[j][4 * r4 + k] = y; ss += y * y; } }
    { auto rr = __builtin_amdgcn_permlane32_swap(__float_as_uint(ss), __float_as_uint(ss), false, false); ss = __uint_as_float(rr[0]) + __uint_as_float(rr[1]); }
    const float rstd = __builtin_amdgcn_rsqf(ss * (1.f / 256.f) + EPS);
#pragma unroll
    for (int j = 0; j < 8; ++j)
#pragma unroll
        for (int r4 = 0; r4 < 4; ++r4) { const int ch = j * 32 + 8 * r4 + 4 * hi; const f32x4 g4 = *(const f32x4*)(gain + ch);
            st8(MIX + tok * DM + 256 + ch, (f32x4){acc[j][4 * r4 + 0], acc[j][4 * r4 + 1], acc[j][4 * r4 + 2], acc[j][4 * r4 + 3]} * rstd * g4); }
}
}
#ifndef MK_MASK
#define MK_MASK 0x1fff
#endif
#define PH_ON(n) (((MK_MASK) >> (n)) & 1)
#ifndef MK_BG
#define MK_BG 1
#endif
#ifndef MK_Q2
#define MK_Q2 6
#endif
#ifndef MK_Q3
#define MK_Q3 7
#endif
#ifndef MK_REP_MASK
#define MK_REP_MASK 0
#endif
#ifndef MK_REP_N
#define MK_REP_N 2
#endif
#ifndef MK_SUB
#define MK_SUB 0xff
#endif
#define SUB_ON(n) (((MK_SUB) >> (n)) & 1)
namespace mk {
constexpr int RING_BYTES = 131072, MISC_OFF = RING_BYTES + 320, LDS_BYTES = 147456;
constexpr int NPHASE = 25;
__device__ __forceinline__ bool phase_active(int ph) { if (ph == 0) return true; const int l = (ph - 1) / 12, k = (ph - 1) % 12; if (k == 0) return l == 0; if (k == 8) return l == 1; if (k == 5) return false; return true; }

__device__ __forceinline__ const float* inp(const Args& a, int i) { asm volatile("" : "+s"(i)); return (const float*)a.in[i]; }
__global__ void __launch_bounds__(NWAVES * 64, 2) mk_fwd(Args args) {
    extern __shared__ __attribute__((aligned(16))) unsigned char lds[];
    LAS unsigned char* L = (LAS unsigned char*)lds;
    volatile LAS unsigned* MISC = (volatile LAS unsigned*)(L + MISC_OFF);
    const int tid0 = threadIdx.x;
    const int G = gridDim.x, NGW = G * NWAVES;
    for (int u = tid0; u < (LDS_BYTES - RING_BYTES) / 4; u += NWAVES * 64) ((LAS unsigned*)(L + RING_BYTES))[u] = 0u;
    __syncthreads();
    unsigned char* ws = args.ws;
    XcdBarrier bar; bar.bar = (unsigned*)(ws + W_CTL) + 1024; bar.x = 0; bar.st = nullptr;
    if (args.ph_hi - args.ph_lo > 1) bar = xcd_barrier_post((unsigned*)(ws + W_CTL) + 1024, MISC + 8);
    if (args.never) cooperative_groups::this_grid().sync();
#define INF(i) (inp(args, (i)))
#define MOECONV(Q_) do { if (!MK_BG) break; int tidq_ = threadIdx.x; asm volatile("" : "+v"(tidq_)); moe_convert((Q_), (unsigned*)(ws + W_CTL) + 8192, INF(32), INF(33), INF(34), (bf16*)(ws + W_MOEUP), (bf16*)(ws + W_MOEDN), (LAS float*)L, (volatile LAS int*)(L + RING_BYTES + 64), tidq_); } while (0)
#define x_in INF(0)
#define out (args.out)
#define MOD ((float*)(ws + W_MOD))
#define CS4 ((const f32x4*)(ws + W_CS))
#define XN ((bf16*)(ws + W_XN))
#define Yb ((bf16*)(ws + W_Y))
#define MIX ((bf16*)(ws + W_MIX))
#define RQ ((bf16*)(ws + W_RQ))
#define RK ((bf16*)(ws + W_RK))
#define RKT ((bf16*)(ws + W_RKT))
#define RVT ((bf16*)(ws + W_RVT))
#define RG ((bf16*)(ws + W_RG))
#define UC ((bf16*)(ws + W_UC))
#define CQ ((bf16*)(ws + W_CQ))
#define CKV ((bf16*)(ws + W_CKV))
#define KPE ((bf16*)(ws + W_KPE))
#define Qb ((bf16*)(ws + W_Q))
#define KN ((bf16*)(ws + W_KN))
#define Vb ((bf16*)(ws + W_V))
#define Ob ((bf16*)(ws + W_O))
#define GB ((bf16*)(ws + W_G))
#define STATE ((bf16*)(ws + W_STATE))
#define HB ((bf16*)(ws + W_HB))
#define XG ((bf16*)(ws + W_XG))
#define HBM ((bf16*)(ws + W_HBM))
#define KVT ((float*)(ws + W_KVT))
#define EB ((float*)(ws + W_E))
#define SSQQ ((float*)(ws + W_SSQQ))
#define SSQKV ((float*)(ws + W_SSQKV))
#define ROWW ((float*)(ws + W_ROWW))
#define WGCNT ((int*)(ws + W_WGCNT))
#define TILE ((int*)(ws + W_TILE))
#define TOPI ((int*)(ws + W_TOP))
#define TOPW ((float*)(ws + W_TOP + 128 * 1024))
#define TPOS ((int*)(ws + W_TOP + 256 * 1024))
#define WIN ((bf16*)(ws + W_WIN + (size_t)l * (7 * MiB / 2)))
#define WOUT ((bf16*)(ws + W_WOUT + (size_t)l * 2 * MiB))
#define MW ((bf16*)(ws + W_MW + (size_t)l * 10 * MiB))
#define WEND ((bf16*)(ws + W_WEND + (size_t)l * 2 * MiB))
#define WUQ ((bf16*)(ws + W_WUQ + (size_t)l * 384 * 1024))
#define WUKV ((bf16*)(ws + W_WUKV + (size_t)l * 256 * 1024))
#define GLUW ((bf16*)(ws + W_GLUW + (size_t)l * 128 * 1024))
#define LAMC ((f32x2*)(ws + W_LAMC) + l * 1024)
#define modl (MOD + l * 2 * 6144)
    int repcnt = 0;
    for (int ph = args.ph_lo; ph < args.ph_hi; ++ph) {
        if (!phase_active(ph)) continue;
        int bx = blockIdx.x; asm volatile("" : "+s"(bx));
        const int vcu = (G % 8 == 0) ? (bx % 8) * (G / 8) + bx / 8 : bx;
#define LANEDEFS int tid = threadIdx.x; asm volatile("" : "+v"(tid)); const int lane = tid & 63, wave = __builtin_amdgcn_readfirstlane(tid >> 6), gw = bx * NWAVES + wave; (void)lane; (void)wave; (void)gw;
        const int l = ph == 0 ? 0 : (ph - 1) / 12, k = ph == 0 ? -1 : (ph - 1) % 12;
        if (ph == 0 && PH_ON(0)) { LANEDEFS
            LAS float* scr = (LAS float*)(L + wave * 16384);
            for (int u = gw; u < 1536; u += NGW) { const int ll = u / 768, r = u % 768, n0 = (r >> 3) * 64, ks = r & 7; const float* aw = INF(3) + (size_t)ll * DM * 6144 + n0 + lane; const float* c = INF(1);
                float a0 = 0.f, a1 = 0.f;
#pragma unroll 16
                for (int kk = 0; kk < 128; ++kk) { const int kq = ks * 128 + kk; const float w = aw[(size_t)kq * 6144]; a0 += silu_fast(c[kq]) * w; a1 += silu_fast(c[DM + kq]) * w; }
                float* mp = (float*)(ws + W_MODP) + (size_t)(ks * 2 + ll) * 2 * 6144 + n0 + lane; mp[0] = a0; mp[6144] = a1; }
#define CONV(SRC, LD, KK, NN, DST, KSC, CSC) do { const int nb_ = (NN) / 32, ni_ = ((KK) / 64) * nb_; for (int it = gw; it < ni_; it += NGW) transpose_item(SRC, LD, KK, DST, KSC, CSC, scr, it / nb_, it % nb_, lane); } while (0)
            for (int ll = 0; ll < 2; ++ll) {
                CONV((SrcWin{INF(9) + (size_t)ll * DM * INC}), INC, DM, INC, (bf16*)(ws + W_WIN + (size_t)ll * (7 * MiB / 2)), nullptr, 1.f);
                CONV((SrcWuq{INF(23) + (size_t)ll * 256 * 768}), 768, 256, 768, (bf16*)(ws + W_WUQ + (size_t)ll * 384 * 1024), INF(22) + ll * 256, QSCALE);
                CONV((SrcPlain{INF(25) + (size_t)ll * 128 * 1024}), 1024, 128, 1024, (bf16*)(ws + W_WUKV + (size_t)ll * 256 * 1024), INF(24) + ll * 128, 1.f);
                CONV((SrcPlain{INF(19) + (size_t)ll * 65536}), 256, 256, 256, (bf16*)(ws + W_GLUW + (size_t)ll * 128 * 1024), nullptr, 1.f);
            }
#undef CONV
            __syncthreads();
            { LAS float* T = (LAS float*)L; int rot = 0;
#define XPM(GU_, W0_, W1_, LD_, KK_, NN_, DST_) do { const int ni__ = ((KK_) / 64) * ((NN_) / 256); xp_matrix<GU_>(W0_, W1_, LD_, KK_, NN_, DST_, T, (bx + G - rot % G) % G, G, tid); rot += ni__; } while (0)
              for (int ll = 0; ll < 2; ++ll) XPM(false, INF(27) + (size_t)ll * DM * DM, nullptr, DM, DM, DM, (bf16*)(ws + W_WOUT + (size_t)ll * 2 * MiB));
              XPM(true, INF(28), INF(29), DFF, DM, 2 * DFF, (bf16*)(ws + W_FFUP));
              XPM(false, INF(30), nullptr, DM, DFF, DM, (bf16*)(ws + W_FFDN));
#if !MK_BG
              for (int e = 0; e < NE; ++e) {
                  XPM(true, INF(32) + (size_t)e * DM * DFF, INF(33) + (size_t)e * DM * DFF, DFF, DM, 2 * DFF, (bf16*)(ws + W_MOEUP) + (size_t)e * 2 * DFF * DM);
                  XPM(false, INF(34) + (size_t)e * DFF * DM, nullptr, DM, DFF, DM, (bf16*)(ws + W_MOEDN) + (size_t)e * DM * DFF); }
#endif
#undef XPM
            }
            { const int* pos = (const int*)INF(2); f32x2* cs = (f32x2*)(ws + W_CS);
              for (int it = gw; it < NTOK * 32 / 64; it += NGW) { const int idx = it * 64 + lane, row = idx >> 5, i = idx & 31;
                  const float inv = __builtin_amdgcn_exp2f(-(float)i * (13.287712379549449f / 32.0f)); const float ang = (float)pos[row] * inv;
                  const double rev = (double)ang * 0.15915494309189535; const float fr = (float)(rev - floor(rev));
                  cs[idx] = (f32x2){__builtin_amdgcn_cosf(fr), __builtin_amdgcn_sinf(fr)}; } }
            for (int ll = 0; ll < 2; ++ll) {
                const SsmPar P{INF(11) + ll * 1024, INF(12) + ll * 1024, INF(13) + ll * 16384, INF(14) + ll * 16384, INF(15) + ll * 16384, INF(16) + ll * 16384, INF(18) + ll * 16};
                bf16* mw = (bf16*)(ws + W_MW + (size_t)ll * 10 * MiB); bf16* we = (bf16*)(ws + W_WEND + (size_t)ll * 2 * MiB); f32x2* lc = (f32x2*)(ws + W_LAMC) + ll * 1024;
                for (int it = gw; it < 2032; it += NGW) {
                    if (it < 1008) ssm_unit_toep(P, mw, it / 63, it % 63, scr, lane);
                    else if (it < 1520) ssm_unit_cross(P, mw, lc, (it - 1008) >> 5, (it - 1008) & 31, lane);
                    else ssm_unit_end(P, we, (it - 1520) >> 5, (it - 1520) & 31, lane);
                }
            }
        } else if (k == 0 && PH_ON(1)) { LANEDEFS
            { const float* mp = (const float*)(ws + W_MODP);
              if (tid < 96) { const int idx = bx * 96 + tid, ll = idx / 12288, n = idx % 6144; float s = INF(4)[ll * 6144 + n];
#pragma unroll
                  for (int ks = 0; ks < 8; ++ks) s += mp[(size_t)ks * 24576 + idx];
                  MOD[idx] = s; }
              LAS float* ml = (LAS float*)L; const int b = (bx * 64) / SEQ;
              for (int n = tid; n < 2048; n += NWAVES * 64) { float s = INF(4)[n];
#pragma unroll
                  for (int ks = 0; ks < 8; ++ks) s += mp[(size_t)ks * 24576 + b * 6144 + n];
                  ml[n] = s; }
              __syncthreads(); }
            Row xpf0 = row_ld_f32(x_in + (size_t)(bx * 64 + wave * 8) * DM, lane);
            for (int i = 0; i < 8; ++i) { const int row = bx * 64 + wave * 8 + i; const float* md = (const float*)lds;
                const Row xr = xpf0; if (i + 1 < 8) xpf0 = row_ld_f32(x_in + (size_t)(row + 1) * DM, lane); (void)adaln(xr, INF(5) + l * DM, md + 1 * DM, md + 0 * DM, XN + (size_t)row * DM, lane); }
        } else if (k == 1 && PH_ON(2)) {
            pg8::Gemm g{DM, DM, DM}; pg8::TileOrder S; S.init(XN, DM, WIN, DM, 64, 7, G, bx);
            EpiWin E{RQ, RK, RKT, RVT, RG, UC, CQ, CKV, KPE, SSQQ, SSQKV, CS4};
            pg8::gemm_phase<EpiWin, pg8::TileOrder, true>(L, g, S, E);
            { pg8::Unit u2; if (!S.next(1, u2)) MOECONV(MK_Q2); }
        } else if (k == 2 && PH_ON(3)) {
            unsigned* ssmflag = (unsigned*)(ws + W_CTL) + 9216 + 64 * (l * 32);
            if (SUB_ON(0)) { pg8::Gemm g{256, 256, 256}; pg8::TileOrder S; S.init(CQ, 256, WUQ, 256, 64, 3, G, bx); EpiQup E{Qb, SSQQ, CS4}; pg8::gemm_phase<EpiQup, pg8::TileOrder, true, true>(L, g, S, E); }
            if (SUB_ON(1)) { pg8::Gemm g{128, 128, 128}; pg8::TileOrder S; S.init(CKV, 128, WUKV, 128, 64, 4, 192, bx < 192 ? bx : 256); EpiKVup E{KN, Vb, SSQKV}; pg8::gemm_phase<EpiKVup, pg8::TileOrder, true, true>(L, g, S, E); }
            if (SUB_ON(2) && bx >= 192) {
                const int i = bx - 192, gI = i >> 2, bI = (i >> 1) & 1, pnI = i & 1;
                const char* Ap = (const char*)UC + ((size_t)gI * SSM_NCH + (size_t)bI * 256) * SSM_K * 2;
                { pg8::Gemm g{SSM_K, 512, 512}; pg8::OneUnit S; S.has = true; S.u.pA = Ap; S.u.pB = (const char*)WEND + (size_t)gI * 128 * 512 * 2; S.u.pm = gI * 2 + bI; S.u.pn = 0;
                  EpiSsmE E{UC, LAMC, ssmflag + 64 * i}; pg8::gemm_phase<EpiSsmE, pg8::OneUnit, false, true>(L, g, S, E); }
                { pg8::Gemm g{SSM_K, SSM_K, SSM_K}; pg8::OneUnit S; S.has = true; S.u.pA = Ap; S.u.pB = (const char*)MW + ((size_t)gI * 512 + (size_t)pnI * 256) * SSM_K * 2; S.u.pm = gI * 2 + bI; S.u.pn = pnI;
                  EpiSsmZ E{GB, UC, INF(17) + l * 256}; pg8::gemm_phase<EpiSsmZ, pg8::OneUnit, false, true>(L, g, S, E); } }
            if (SUB_ON(3)) { LANEDEFS const ret::Tensors T{RQ, RK, RKT, RVT, RG, KVT, STATE, MIX, INF(10) + l * 256};
              for (int u = gw; u < 1024; u += NGW) ret::x_unit(u, T, lane); }
            if (bx < 192) MOECONV(MK_Q3);
        } else if (k == 3 && PH_ON(4)) { LANEDEFS
            { const ret::Tensors T{RQ, RK, RKT, RVT, RG, KVT, STATE, MIX, INF(10) + l * 256}; if (tid < 128) ret::scan_elem(bx * 128 + tid, T); }
            __syncthreads();
            { const att::Tensors T{Qb, KN, KPE, Vb, Ob}; const int bh = vcu >> 5, xx = vcu & 31;
#if defined(MK_ABL)
              if (repcnt > 0) { const att::Tensors T2{Qb, KN, KPE, Vb, Yb}; att::attn_unit<MK_ABL>(bh >> 2, bh & 3, 63 - xx, T2, (char*)lds); att::attn_unit<MK_ABL>(bh >> 2, bh & 3, xx, T2, (char*)lds); } else
#endif
              { att::attn_unit<0>(bh >> 2, bh & 3, 63 - xx, T, (char*)lds); att::attn_unit<0>(bh >> 2, bh & 3, xx, T, (char*)lds); } }
        } else if (k == 4 && PH_ON(5)) {
            LANEDEFS
            if (SUB_ON(5) && wave < 4) { const ret::Tensors T{RQ, RK, RKT, RVT, RG, KVT, STATE, MIX, INF(10) + l * 256}; ret::z_unit(bx + 256 * wave, T, lane); }
            if (SUB_ON(4) && (wave == 4 || wave == 5)) glu_unit(bx + 256 * (wave - 4), GB, GLUW, INF(20) + l * 256, INF(21) + l * 256, MIX, lane);
            if (SUB_ON(6)) { const int nr = wave < 4 ? 5 : (wave < 6 ? 7 : 15), r0 = bx * 64 + (wave < 4 ? wave * 5 : (wave < 6 ? 20 + (wave - 4) * 7 : 34 + (wave - 6) * 15));
              u32x4 wpf = *(const u32x4*)(Ob + (size_t)r0 * 512 + 8 * lane);
              for (int i = 0; i < nr; ++i) { const int row = r0 + i; const u32x4 w = wpf; if (i + 1 < nr) wpf = *(const u32x4*)(Ob + (size_t)(row + 1) * 512 + 8 * lane);
                const f32x4 a = {bflo(w.x), bfhi(w.x), bflo(w.y), bfhi(w.y)}, c = {bflo(w.z), bfhi(w.z), bflo(w.w), bfhi(w.w)};
                float ss = (a[0] * a[0] + a[1] * a[1]) + (a[2] * a[2] + a[3] * a[3]) + (c[0] * c[0] + c[1] * c[1]) + (c[2] * c[2] + c[3] * c[3]); ss = wave_sum(ss);
                const float rstd = __builtin_amdgcn_rsqf(ss * (1.f / 512.f) + EPS); const float* gn = INF(26) + l * 512 + 8 * lane;
                st16(MIX + (size_t)row * DM + 512 + 8 * lane, a * rstd * *(const f32x4*)gn, c * rstd * *(const f32x4*)(gn + 4)); } }
        } else if (k == 5 && PH_ON(6)) { LANEDEFS
            if (wave < 2) glu_unit(bx + 256 * wave, GB, GLUW, INF(20) + l * 256, INF(21) + l * 256, MIX, lane);
        } else if (k == 6 && PH_ON(7)) {
            pg8::Gemm g{DM, DM, DM}; pg8::TileOrder S; S.init(MIX, DM, WOUT, DM, 64, 4, G, bx); EpiStore E{Yb, DM, nullptr, 0};
            pg8::gemm_phase<EpiStore, pg8::TileOrder, false>(L, g, S, E);
        } else if (k == 7 && PH_ON(8)) { LANEDEFS
            LAS int* cnt = (LAS int*)L;
            if (l == 1) { if (tid < 8) cnt[tid] = 0; __syncthreads(); }
            const float* xsrc = l == 0 ? x_in : out;
            Row xpf = row_ld_f32(xsrc + (size_t)(bx * 64 + wave * 8) * DM, lane), ypf = row_ld_bf16(Yb + (size_t)(bx * 64 + wave * 8) * DM, lane);
            for (int i = 0; i < 8; ++i) { const int row = bx * 64 + wave * 8 + i, b = row / SEQ; const float* md = modl + b * 6144;
                const Row xr = xpf, yr = ypf;
                if (i + 1 < 8) { xpf = row_ld_f32(xsrc + (size_t)(row + 1) * DM, lane); ypf = row_ld_bf16(Yb + (size_t)(row + 1) * DM, lane); }
                const Row x1 = resid(xr, yr, INF(6) + l * DM, md + 2 * DM, out + (size_t)row * DM, lane);
                const Row h = adaln(x1, INF(7) + l * DM, md + 4 * DM, md + 3 * DM, XN + (size_t)row * DM, lane);
                if (l == 1) { int e1, e2; float w1, w2; route(h, INF(31), lane, e1, e2, w1, w2);
                    if (lane == 0) { TOPI[row * 2] = e1; TOPI[row * 2 + 1] = e2; TOPW[row * 2] = w1; TOPW[row * 2 + 1] = w2; __hip_atomic_fetch_add(&cnt[e1], 1, __ATOMIC_RELAXED, __HIP_MEMORY_SCOPE_WORKGROUP); __hip_atomic_fetch_add(&cnt[e2], 1, __ATOMIC_RELAXED, __HIP_MEMORY_SCOPE_WORKGROUP); } } }
            if (l == 1) { __syncthreads(); if (tid < 8) WGCNT[bx * 8 + tid] = cnt[tid]; }
        } else if (k == 8 && PH_ON(9)) { LANEDEFS
            MOECONV(1 << 30);
            __syncthreads();
            LAS int* sc = (LAS int*)L;
            for (int i = tid; i < 2048; i += NWAVES * 64) sc[i] = WGCNT[i];
            __syncthreads();
            { const int e = wave; int base = 0, tot = 0;
#pragma unroll
              for (int q = 0; q < 4; ++q) { const int w = q * 64 + lane; const int c = sc[w * 8 + e]; base += (w < bx) ? c : 0; tot += c; }
#pragma unroll
              for (int o = 1; o < 64; o <<= 1) { base += __shfl_xor(base, o); tot += __shfl_xor(tot, o); }
              if (lane == 0) { sc[2048 + e] = base; sc[2064 + e] = tot; } }
            __syncthreads();
            if (tid == 0) { int st = 0, nt = 0;
#pragma unroll 1
                for (int e = 0; e < 8; ++e) { sc[2056 + e] = st; const int t = (sc[2064 + e] + 255) >> 8; if (bx == 0) for (int q = 0; q < t; ++q) TILE[16 + nt + q] = e; nt += t; st += t << 8; } if (bx == 0) TILE[0] = nt; }
            __syncthreads();
            if (wave == 0) { const int row = bx * 64 + lane; const int e1 = TOPI[row * 2], e2 = TOPI[row * 2 + 1]; int p1 = 0, p2 = 0;
                const unsigned long long lt = (1ull << lane) - 1ull;
#pragma unroll
                for (int e = 0; e < 8; ++e) { const unsigned long long m1 = __ballot(e1 == e), m2 = __ballot(e2 == e); const int r = __popcll(m1 & lt) + __popcll(m2 & lt) + sc[2056 + e] + sc[2048 + e];
                    if (e1 == e) p1 = r; if (e2 == e) p2 = r; }
                sc[2080 + lane * 2] = p1; sc[2080 + lane * 2 + 1] = p2; TPOS[row * 2] = p1; TPOS[row * 2 + 1] = p2; ROWW[p1] = TOPW[row * 2]; ROWW[p2] = TOPW[row * 2 + 1]; }
            __syncthreads();
#pragma unroll
            for (int i0 = 0; i0 < 8; i0 += 4) { u32x4 a[4], c[4];
#pragma unroll
                for (int i = 0; i < 4; ++i) { const int row = bx * 64 + wave * 8 + i0 + i; a[i] = *(const u32x4*)(XN + (size_t)row * DM + 8 * lane); c[i] = *(const u32x4*)(XN + (size_t)row * DM + 512 + 8 * lane); }
#pragma unroll
                for (int i = 0; i < 4; ++i) { const int lr = wave * 8 + i0 + i; const int p1 = sc[2080 + lr * 2], p2 = sc[2080 + lr * 2 + 1];
                    *(u32x4*)(XG + (size_t)p1 * DM + 8 * lane) = a[i]; *(u32x4*)(XG + (size_t)p1 * DM + 512 + 8 * lane) = c[i];
                    *(u32x4*)(XG + (size_t)p2 * DM + 8 * lane) = a[i]; *(u32x4*)(XG + (size_t)p2 * DM + 512 + 8 * lane) = c[i]; } }
            if (bx < 8) { const int tot = sc[2064 + bx], st = sc[2056 + bx], pe = st + (((tot + 255) >> 8) << 8);
                for (int r = st + tot + wave; r < pe; r += NWAVES) { const u32x4 z = {0u, 0u, 0u, 0u}; *(u32x4*)(XG + (size_t)r * DM + 8 * lane) = z; *(u32x4*)(XG + (size_t)r * DM + 512 + 8 * lane) = z; if (lane == 0) ROWW[r] = 0.f; } }
        } else if (k == 9 && PH_ON(10)) {
            pg8::Gemm g{DM, DM, DM}; pg8::TileOrder S;
            if (l == 0) S.init(XN, DM, (bf16*)(ws + W_FFUP), DM, 64, 28, G, bx);
            else { S.init(XG, DM, (bf16*)(ws + W_MOEUP), DM, TILE[0], 28, G, bx); S.texp = TILE + 16; S.b_e = (size_t)2 * DFF * DM * 2; }
            EpiSwiglu E{l == 0 ? HB : HBM, 0};
#if defined(MK_NOSTORE)
            if (repcnt > 0) E.nostore = 1;
#endif
            pg8::gemm_phase<EpiSwiglu, pg8::TileOrder, true>(L, g, S, E);
        } else if (k == 10 && PH_ON(11)) {
            pg8::Gemm g{DFF, DFF, DFF}; pg8::TileOrder S; EpiStore E{Yb, DM, nullptr, 0};
            if (l == 0) S.init(HB, DFF, (bf16*)(ws + W_FFDN), DFF, 64, 4, G, bx);
            else { S.init(HBM, DFF, (bf16*)(ws + W_MOEDN), DFF, 128, 4, G, bx); S.texp = TILE + 16; S.b_e = (size_t)DM * DFF * 2; E.O = XG; E.rowscale = ROWW; }
            pg8::gemm_phase<EpiStore, pg8::TileOrder, true>(L, g, S, E);
            if (l == 1) {
                const int ntail = TILE[0] - 128;
                if (ntail > 0) { pg8::Gemm g2{DFF, DFF, DFF / 4}; pg8::TileOrder S2; S2.init(HBM + (size_t)32768 * DFF, DFF, (bf16*)(ws + W_MOEDN), DFF, ntail, 4, G, bx); S2.texp = TILE + 16 + 128; S2.b_e = (size_t)DM * DFF * 2;
                    S2.split_k(4, (size_t)(DFF / 4) * 2); EpiStore E2{(bf16*)(ws + W_Y2B), DM, ROWW + 32768, (size_t)7 * 256 * DM};
                    pg8::gemm_phase<EpiStore, pg8::TileOrder, true>(L, g2, S2, E2); } }
        } else if (k == 11 && PH_ON(12)) { LANEDEFS
            const bf16* Y2B = (const bf16*)(ws + W_Y2B);
#define LDP(P_, DST_) do { const int p_ = __builtin_amdgcn_readfirstlane(P_); if (p_ < 32768) DST_ = row_ld_bf16(XG + (size_t)p_ * DM, lane); else { const bf16* t_ = Y2B + (size_t)(p_ - 32768) * DM; \
                const Row a_ = row_ld_bf16(t_, lane), b_ = row_ld_bf16(t_ + (size_t)7 * 256 * DM, lane), c_ = row_ld_bf16(t_ + (size_t)14 * 256 * DM, lane), d_ = row_ld_bf16(t_ + (size_t)21 * 256 * DM, lane); \
                _Pragma("unroll") for (int j = 0; j < 4; ++j) DST_.v[j] = (a_.v[j] + b_.v[j]) + (c_.v[j] + d_.v[j]); } } while (0)
#define LDY(ROW_, DST_) do { if (l == 0) DST_ = row_ld_bf16(Yb + (size_t)(ROW_) * DM, lane); else { Row ya, yb; LDP(TPOS[(ROW_) * 2], ya); LDP(TPOS[(ROW_) * 2 + 1], yb); \
                _Pragma("unroll") for (int j = 0; j < 4; ++j) DST_.v[j] = ya.v[j] + yb.v[j]; } } while (0)
            Row xpf = row_ld_f32(out + (size_t)(bx * 64 + wave * 8) * DM, lane), ypf; LDY(bx * 64 + wave * 8, ypf);
            for (int i = 0; i < 8; ++i) { const int row = bx * 64 + wave * 8 + i, b = row / SEQ; const float* md = modl + b * 6144;
                const Row xr = xpf, yr = ypf;
                if (i + 1 < 8) { xpf = row_ld_f32(out + (size_t)(row + 1) * DM, lane); LDY(row + 1, ypf); }
                const Row x2 = resid(xr, yr, INF(8) + l * DM, md + 5 * DM, out + (size_t)row * DM, lane);
                if (l == 0) { const float* md1 = MOD + 2 * 6144 + b * 6144; (void)adaln(x2, INF(5) + DM, md1 + 1 * DM, md1 + 0 * DM, XN + (size_t)row * DM, lane); } }
#undef LDY
#undef LDP
        }
        bool more = false; for (int q = ph + 1; q < args.ph_hi; ++q) more |= phase_active(q);
        if (more) xcd_barrier(bar);
#if defined(MK_XBAR)
        if (more && ph == MK_XBAR_PH) for (int q_ = 0; q_ < MK_XBAR; ++q_) xcd_barrier(bar);
#endif
        if (MK_REP_MASK != 0) { if ((((unsigned)MK_REP_MASK >> ph) & 1u) && repcnt + 1 < MK_REP_N) { ++repcnt; --ph; } else repcnt = 0; }
    }
#undef INF
#undef MOECONV
#undef LANEDEFS
#undef MOD
#undef Qb
#undef Vb
#undef Ob
#undef Yb
#undef out
#undef modl
}
}
#ifndef MK_PER_PHASE
#define MK_PER_PHASE 0
#endif
static int mk_setup() {
    static int grid = 0;
    if (grid == 0) {
        int dev = 0, cus = 0, per_cu = 0;
        if (hipGetDevice(&dev) != hipSuccess || hipDeviceGetAttribute(&cus, hipDeviceAttributeMultiprocessorCount, dev) != hipSuccess) { fprintf(stderr, "kernel_launch: device query failed\n"); grid = -1; return grid; }
        if (hipFuncSetAttribute((const void*)mk::mk_fwd, hipFuncAttributeMaxDynamicSharedMemorySize, mk::LDS_BYTES) != hipSuccess) { fprintf(stderr, "kernel_launch: hipFuncSetAttribute failed\n"); grid = -1; return grid; }
        if (hipOccupancyMaxActiveBlocksPerMultiprocessor(&per_cu, (const void*)mk::mk_fwd, mk::NWAVES * 64, mk::LDS_BYTES) != hipSuccess || per_cu < 1) fprintf(stderr, "kernel_launch: occupancy query reports %d blocks per CU\n", per_cu);
        (void)hipGetLastError();
        grid = cus;
        if (grid != 256) fprintf(stderr, "kernel_launch: this kernel is written for a 256-CU device (got %d)\n", grid);
    }
    return grid;
}
static void mk_launch(void* const* d_in, void* d_out, void* d_ws, hipStream_t stream, int lo, int hi, bool coop) {
    const int grid = mk_setup(); if (grid <= 0) return;
    mk::Args a{};
    for (int i = 0; i < 35; ++i) a.in[i] = d_in[i];
    a.out = (float*)d_out; a.ws = (unsigned char*)d_ws; a.ph_lo = lo; a.ph_hi = hi; a.never = 0; a.pad = 0;
    if (coop) { void* args[] = {&a}; hipError_t e = hipLaunchCooperativeKernel((const void*)mk::mk_fwd, dim3(grid), dim3(mk::NWAVES * 64), args, mk::LDS_BYTES, stream);
        if (e != hipSuccess) fprintf(stderr, "cooperative launch failed: %s (grid %d)\n", hipGetErrorString(e), grid); }
    else hipLaunchKernelGGL(mk::mk_fwd, dim3(grid), dim3(mk::NWAVES * 64), mk::LDS_BYTES, stream, a);
}
extern "C" void kernel_launch(void* const* d_in, const int* in_sizes, int n_in, void* d_out, int out_size, void* d_ws, size_t ws_size, hipStream_t stream) {
    (void)in_sizes; (void)n_in; (void)out_size;
    if (ws_size < mk::W_END) { fprintf(stderr, "kernel_launch: workspace too small (%zu < %zu)\n", ws_size, (size_t)mk::W_END); return; }
    (void)hipMemsetAsync((char*)d_ws + mk::W_CTL, 0, mk::CTL_ZERO_BYTES, stream);
#if MK_PER_PHASE
    for (int ph = 0; ph < mk::NPHASE; ++ph) mk_launch(d_in, d_out, d_ws, stream, ph, ph + 1, false);
#else
    mk_launch(d_in, d_out, d_ws, stream, 0, mk::NPHASE, true);
#endif
}
```

```cpp
#include <hip/hip_runtime.h>
#include <stdint.h>
#include <math.h>
#include <cstdio>
#include <hip/hip_cooperative_groups.h>
#define GAS __attribute__((address_space(1)))
#define LAS __attribute__((address_space(3)))
namespace mk {
typedef unsigned short bf16;
typedef short bf16x8 __attribute__((ext_vector_type(8)));
typedef short s16x4 __attribute__((ext_vector_type(4)));
typedef float f32x2 __attribute__((ext_vector_type(2)));
typedef float f32x4 __attribute__((ext_vector_type(4)));
typedef float f32x16 __attribute__((ext_vector_type(16)));
typedef unsigned u32x2 __attribute__((ext_vector_type(2)));
typedef unsigned u32x4 __attribute__((ext_vector_type(4)));
typedef __bf16 bf16x2_t __attribute__((ext_vector_type(2)));
typedef GAS unsigned gu32;
#define RLX_AGENT __ATOMIC_RELAXED, __HIP_MEMORY_SCOPE_AGENT
__device__ __forceinline__ unsigned cvtpk(float lo, float hi) { f32x2 v = {lo, hi}; bf16x2_t b = __builtin_convertvector(v, bf16x2_t); return __builtin_bit_cast(unsigned, b); }
__device__ __forceinline__ float bf2f(unsigned short b) { return __builtin_bit_cast(float, (unsigned)b << 16); }
__device__ __forceinline__ float bflo(unsigned w) { return __builtin_bit_cast(float, w << 16); }
__device__ __forceinline__ float bfhi(unsigned w) { return __builtin_bit_cast(float, w & 0xffff0000u); }
__device__ __forceinline__ float wave_sum(float v) {
#pragma unroll
    for (int o = 1; o < 64; o <<= 1) v += __shfl_xor(v, o);
    return v;
}
__device__ __forceinline__ float fast_sigmoid(float z) { return __builtin_amdgcn_rcpf(1.f + __builtin_amdgcn_exp2f(-1.4426950408889634f * z)); }
__device__ __forceinline__ float silu_fast(float v) { return v * fast_sigmoid(v); }
__device__ __forceinline__ float gelu_tanh_fast(float x) { const float a = 0.7978845608028654f * (x + 0.044715f * x * x * x); return x * fast_sigmoid(2.f * a); }

constexpr int NB = 2, SEQ = 8192, NTOK = 16384, DM = 1024, INC = 1728, INCP = 1792, DFF = 3584, NE = 8, NWAVES = 8;
constexpr float EPS = 1e-6f;
constexpr int SSM_C = 32, SSM_NCH = NTOK / SSM_C  , SSM_K = 640;
constexpr int RET_C = 64, RET_NCH = SEQ / RET_C  ;
constexpr int MOE_MAXT = 136;
constexpr float QSCALE = 0.07216878364870322f * 1.4426950408889634f;

#define XB_TMO      128
#define XB_XCNT(j)  (256  + 64 * (j))
#define XB_XSUB(j)  (1280 + 64 * (j))
#define XB_XGEN(j)  (2304 + 64 * (j))
#define XB_TOP      3328
#define XB_TOPGEN   3392
#define XCD_BAR_WORDS 3456
#define XB_SPIN_CAP (1u << 20)
__device__ __forceinline__ unsigned xb_ld(unsigned* p)              { return __hip_atomic_load(p, __ATOMIC_RELAXED, __HIP_MEMORY_SCOPE_AGENT); }
__device__ __forceinline__ unsigned xb_add(unsigned* p, unsigned v) { return __hip_atomic_fetch_add(p, v, __ATOMIC_RELAXED, __HIP_MEMORY_SCOPE_AGENT); }
__device__ __forceinline__ unsigned xb_xcc_id() { return (unsigned)__builtin_amdgcn_s_getreg((3 << 11) | 20) & 0xFu; }
#define XB_SPIN(cond, bar) do { unsigned _sp = 0; while (cond) { __builtin_amdgcn_s_sleep(1); \
    if ((++_sp & 255u) == 0u) { if (xb_ld(&(bar)[XB_TMO])) break; if (_sp > XB_SPIN_CAP) { atomicAdd(&(bar)[XB_TMO], 1u); break; } } } } while (0)
struct XcdBarrier { unsigned* bar; unsigned x; volatile LAS unsigned* st; };
__device__ __forceinline__ XcdBarrier xcd_barrier_post(unsigned* bar, volatile LAS unsigned* st) {
    XcdBarrier b; b.bar = bar; b.x = xb_xcc_id(); b.st = st;
    if (threadIdx.x == 0) (void)xb_add(&bar[XB_XCNT(b.x)], 1u);
    return b;
}
__device__ __forceinline__ void xcd_barrier_complete(unsigned* bar, unsigned x, unsigned& nloc, unsigned& nx) {
    const unsigned G = gridDim.x * gridDim.y * gridDim.z;
    unsigned sum, cnt, mine, sp = 0u;
    for (;;) {
        sum = 0u; cnt = 0u; mine = 0u;
#pragma unroll
        for (unsigned j = 0; j < 16; ++j) { const unsigned c = xb_ld(&bar[XB_XCNT(j)]); sum += c; cnt += (c > 0u) ? 1u : 0u; mine = (j == x) ? c : mine; }
        if (sum == G) break;
        __builtin_amdgcn_s_sleep(1);
        if ((++sp & 255u) == 0u) { if (xb_ld(&bar[XB_TMO])) break; if (sp > XB_SPIN_CAP) { atomicAdd(&bar[XB_TMO], 1u); break; } }
    }
    nloc = mine > 0u ? mine : 1u; nx = cnt > 0u ? cnt : 1u;
}
__device__ __forceinline__ void xcd_barrier(const XcdBarrier& b) {
    asm volatile("s_waitcnt vmcnt(0)" ::: "memory");
    __syncthreads();
    if (threadIdx.x == 0) {
        unsigned* bar = b.bar;
        __builtin_amdgcn_s_waitcnt(0);
        unsigned nloc = b.st[0], nx = b.st[1];
        if (nloc == 0u) { xcd_barrier_complete(bar, b.x, nloc, nx); b.st[0] = nloc; b.st[1] = nx; }
        const unsigned old = xb_add(&bar[XB_XSUB(b.x)], 1u);
        const unsigned gen = old / nloc;
        if (old + 1u == (gen + 1u) * nloc) {
            __builtin_amdgcn_fence(__ATOMIC_RELEASE, "agent");
            asm volatile("s_waitcnt vmcnt(0)" ::: "memory");
            const unsigned og = xb_add(&bar[XB_TOP], 1u);
            const unsigned tg = og / nx;
            if (og + 1u == (tg + 1u) * nx) xb_add(&bar[XB_TOPGEN], 1u);
            else XB_SPIN(xb_ld(&bar[XB_TOPGEN]) == tg, bar);
            __builtin_amdgcn_fence(__ATOMIC_ACQUIRE, "agent");
            xb_add(&bar[XB_XGEN(b.x)], 1u);
            asm volatile("s_waitcnt vmcnt(0)" ::: "memory");
        } else {
            XB_SPIN(xb_ld(&bar[XB_XGEN(b.x)]) == gen, bar);
            __builtin_amdgcn_fence(__ATOMIC_ACQUIRE, "agent");
            asm volatile("s_waitcnt vmcnt(0)" ::: "memory");
        }
    }
    __syncthreads();
}
}
#ifndef MK_WGM
#define MK_WGM 8
#endif
namespace pg8 {
#define PG8_LAS __attribute__((address_space(3)))
typedef unsigned short bf16_t;
typedef short bf16x8 __attribute__((ext_vector_type(8)));
typedef float f32x4 __attribute__((ext_vector_type(4)));
typedef unsigned u32x4 __attribute__((ext_vector_type(4)));
constexpr int BM = 256, BK = 64, HALF = 128, HTB = HALF * BK * 2, STAGE_BYTES = 8 * HTB, NXCD = 8, WGM = MK_WGM;
__host__ __device__ __forceinline__ int lds_byte(int r, int c) { const int st = (r >> 4) * 2 + (c >> 5), rr = r & 15, cc = c & 31, ob = rr * 64 + cc * 2; return st * 1024 + (ob ^ (((ob >> 9) & 1) << 5)); }
__host__ __device__ __forceinline__ void stage_rc(int b, int& R, int& C) { const int st = b / 1024, sb = b % 1024, swz = sb ^ (((sb >> 9) & 1) << 5); R = (st >> 1) * 16 + swz / 64; C = (st & 1) * 32 + (swz % 64) / 2; }
__host__ __device__ __forceinline__ int perm32(int rho) { const int n = rho >> 4, i = rho & 15; return 8 * (i >> 2) + 4 * n + (i & 3); }
struct Unit { const char* pA; const char* pB; int pm, pn; };
struct Gemm { int lda, ldb, K; };
struct TileOrder {
    static constexpr bool KHOOK = false;
    const char* A; const char* Bt; size_t a_t, b_t, b_e, k_off; const int* texp; int nM, nN, nN0, nwg, G, c;
    __device__ __forceinline__ void init(const void* A_, int lda, const void* Bt_, int ldb, int nM_, int nN_, int G_, int c_) {
        A = (const char*)A_; Bt = (const char*)Bt_; a_t = (size_t)BM * lda * 2; b_t = (size_t)BM * ldb * 2; b_e = 0; k_off = 0; texp = nullptr; nM = nM_; nN = nN_; nN0 = nN_; nwg = nM * nN; G = G_; c = c_; }
    __device__ __forceinline__ void split_k(int ks, size_t k_off_) { nN0 = nN; nN = nN * ks; nwg = nM * nN; k_off = k_off_; }
    __device__ __forceinline__ bool next(int i, Unit& u) const {
        const long L = (long)i * G + c; if (L >= nwg) return false;
        int wgid = (int)L; { const int q = nwg / NXCD, r = nwg % NXCD, xcd = wgid % NXCD, off = wgid / NXCD; wgid = (xcd < r ? xcd * (q + 1) : r * (q + 1) + (xcd - r) * q) + off; }
        const int nig = WGM * nN, gid = wgid / nig, fm = gid * WGM, gsz = (nM - fm) < WGM ? (nM - fm) : WGM;
        u.pm = fm + ((wgid % nig) % gsz); u.pn = (wgid % nig) / gsz;
        const int ks = u.pn / nN0, pn0 = u.pn - ks * nN0;
        u.pA = A + (size_t)u.pm * a_t + (size_t)ks * k_off; u.pB = Bt + (size_t)pn0 * b_t + (size_t)ks * k_off + (texp ? (size_t)texp[u.pm] * b_e : (size_t)0); return true;
    }
    __device__ __forceinline__ void a_ready(const Unit&) const {}
    __device__ __forceinline__ void done(const Unit&) const {}
};
struct GroupOrder {
    static constexpr bool KHOOK = false;
    const char* A; const char* Bt; size_t a_t, b_t, a_g, b_g; int nM, nN, nwg, G, c;
    __device__ __forceinline__ void init(const void* A_, int lda, size_t a_g_, const void* Bt_, int ldb, size_t b_g_, int ng, int nM_, int nN_, int G_, int c_) {
        A = (const char*)A_; Bt = (const char*)Bt_; a_t = (size_t)BM * lda * 2; b_t = (size_t)BM * ldb * 2; a_g = a_g_; b_g = b_g_; nM = nM_; nN = nN_; nwg = ng * nM * nN; G = G_; c = c_; }
    __device__ __forceinline__ bool next(int i, Unit& u) const {
        const long L = (long)i * G + c; if (L >= nwg) return false;
        const int per = nM * nN, g = (int)L / per, r = (int)L % per, pm = r / nN, pn = r % nN;
        u.pm = g * nM + pm; u.pn = pn; u.pA = A + (size_t)g * a_g + (size_t)pm * a_t; u.pB = Bt + (size_t)g * b_g + (size_t)pn * b_t; return true;
    }
    __device__ __forceinline__ void a_ready(const Unit&) const {}
    __device__ __forceinline__ void done(const Unit&) const {}
};
struct OneUnit {
    static constexpr bool KHOOK = false;
    Unit u; bool has;
    __device__ __forceinline__ bool next(int i, Unit& o) const { if (i > 0 || !has) return false; o = u; return true; }
    __device__ __forceinline__ void a_ready(const Unit&) const {}
    __device__ __forceinline__ void done(const Unit&) const {}
};
struct OneUnitHook {
    static constexpr bool KHOOK = true;
    Unit u; bool has; int hook_t; unsigned* flag; unsigned need; unsigned* tmo;
    __device__ __forceinline__ bool next(int i, Unit& o) const { if (i > 0 || !has) return false; o = u; return true; }
    __device__ __forceinline__ void a_ready(const Unit&) const {}
    __device__ __forceinline__ void done(const Unit&) const {}
    __device__ __forceinline__ void khook() const {
        if (threadIdx.x < 64) {
            const unsigned long long t0 = __builtin_amdgcn_s_memrealtime();
            while ((unsigned)__builtin_amdgcn_readfirstlane(__hip_atomic_load(flag, __ATOMIC_RELAXED, __HIP_MEMORY_SCOPE_AGENT)) < need) {
                if (__builtin_amdgcn_s_memrealtime() - t0 > 2000000ull) { if (threadIdx.x == 0) __hip_atomic_store(tmo, 1u, __ATOMIC_RELAXED, __HIP_MEMORY_SCOPE_AGENT); break; }
                __builtin_amdgcn_s_sleep(2); }
            __builtin_amdgcn_fence(__ATOMIC_ACQUIRE, "agent");
            asm volatile("s_waitcnt vmcnt(0)" ::: "memory");
        }
        asm volatile("" ::: "memory"); __builtin_amdgcn_s_barrier(); asm volatile("" ::: "memory");
    }
};
template <class Epi, class Sched, bool ALIGN_EPI = false, bool SMALLK = false>
__device__ __forceinline__ void gemm_phase(PG8_LAS unsigned char* lds, const Gemm g, const Sched& S, const Epi& E) {
    int tid_ = threadIdx.x; asm volatile("" : "+v"(tid_));
    const int tid = tid_, wid = __builtin_amdgcn_readfirstlane(tid >> 6), lane = tid & 63, wr = wid >> 2, wc = wid & 3, fr = lane & 15, fq = lane >> 4;
    int K_ = g.K; if constexpr (SMALLK) asm volatile("" : "+s"(K_));
    const int K = K_, nt = K / BK, lda = g.lda, ldb = g.ldb;
    unsigned voffA[2], voffB[2];
#pragma unroll
    for (int i = 0; i < 2; ++i) { int R, C; stage_rc(tid * 16 + i * 8192, R, C); const int Rb = Epi::PERM ? ((R & ~31) + perm32(R & 31)) : R;
        voffA[i] = (unsigned)(R * lda + C) * 2u; voffB[i] = (unsigned)(Rb * ldb + C) * 2u; }
    const size_t kstep = (size_t)(BK * 2);
    const size_t hstepA = (size_t)HALF * lda * 2, hstepB = (size_t)HALF * ldb * 2;
    const unsigned ldsw = (unsigned)wid * 1024u;
    const int aoff = lds_byte(wr * 64 + fr, fq * 8), boff = lds_byte(wc * 32 + fr, fq * 8);
#define PG8_SA(b, h) (((b) * 2 + (h)) * HTB)
#define PG8_SB(b, h) ((4 + (b) * 2 + (h)) * HTB)
#define PG8_STAGE(bufoff, gbase, voff) do { _Pragma("unroll") for (int _i = 0; _i < 2; ++_i) \
        __builtin_amdgcn_global_load_lds((const unsigned*)((const char*)(gbase) + (voff)[_i]), (PG8_LAS unsigned*)(lds + (bufoff) + ldsw + _i * 8192), 16, 0, 0); } while (0)
#define PG8_LDA(dst, b, h) do { _Pragma("unroll") for (int m = 0; m < 4; ++m) _Pragma("unroll") for (int k = 0; k < 2; ++k) dst[m][k] = *(const PG8_LAS bf16x8*)(lds + PG8_SA(b, h) + aoff + m * 2048 + k * 1024); } while (0)
#define PG8_LDB(dst, b, h) do { _Pragma("unroll") for (int n = 0; n < 2; ++n) _Pragma("unroll") for (int k = 0; k < 2; ++k) dst[n][k] = *(const PG8_LAS bf16x8*)(lds + PG8_SB(b, h) + boff + n * 2048 + k * 1024); } while (0)
#define PG8_MMA(ai, bj, At, Bt) do { __builtin_amdgcn_s_setprio(1); _Pragma("unroll") for (int m = 0; m < 4; ++m) _Pragma("unroll") for (int n = 0; n < 2; ++n) _Pragma("unroll") for (int k = 0; k < 2; ++k) \
        acc[ai][bj][m][n] = __builtin_amdgcn_mfma_f32_16x16x32_bf16(Bt[n][k], At[m][k], acc[ai][bj][m][n], 0, 0, 0); __builtin_amdgcn_s_setprio(0); } while (0)
#define PG8_WAIT_V(n) asm volatile("s_waitcnt vmcnt(" #n ")" ::: "memory")
#define PG8_WAIT_L(n) asm volatile("s_waitcnt lgkmcnt(" #n ")" ::: "memory")
#define PG8_BAR __builtin_amdgcn_s_barrier()
#define PG8_SCHED __builtin_amdgcn_sched_barrier(0)
    Unit cur, nxt; int ui = 0;
    if (!S.next(0, cur)) return;
    f32x4 acc[2][2][4][2];
#pragma unroll
    for (int a = 0; a < 2; ++a)
#pragma unroll
        for (int b = 0; b < 2; ++b)
#pragma unroll
            for (int m = 0; m < 4; ++m)
#pragma unroll
                for (int n = 0; n < 2; ++n) acc[a][b][m][n] = (f32x4){0.f, 0.f, 0.f, 0.f};
    bf16x8 At[4][2], B0[2][2], B1[2][2];
    const char* cA = cur.pA; const char* cB = cur.pB;
    S.a_ready(cur);
    {
        PG8_STAGE(PG8_SB(0, 0), cB, voffB); PG8_STAGE(PG8_SB(0, 1), cB + hstepB, voffB); PG8_STAGE(PG8_SA(0, 0), cA, voffA); PG8_STAGE(PG8_SA(0, 1), cA + hstepA, voffA);
        if (wr == 1) PG8_BAR;
        PG8_WAIT_V(2); PG8_BAR;
        PG8_STAGE(PG8_SB(1, 0), cB + kstep, voffB); PG8_STAGE(PG8_SA(1, 0), cA + kstep, voffA); PG8_STAGE(PG8_SB(1, 1), cB + hstepB + kstep, voffB);
        PG8_WAIT_V(6); PG8_BAR;
    }
    for (;;) {
        const bool has_next = S.next(ui + 1, nxt);
        const char* nA = has_next ? nxt.pA : cA; const char* nB = has_next ? nxt.pB : cB;
        for (int t = 0; t < nt; t += 2) {
            const bool last = (t == nt - 2);
            const char* a1 = cA + (size_t)(t + 1) * kstep;
            const char* a2 = last ? nA : cA + (size_t)(t + 2) * kstep; const char* b2 = last ? nB : cB + (size_t)(t + 2) * kstep;
            const char* a3 = a2 + kstep; const char* b3 = b2 + kstep;
            if (last && has_next) S.a_ready(nxt);
            if constexpr (Sched::KHOOK) { if (t == S.hook_t) S.khook(); }
            {
            PG8_LDB(B0, 0, 0); PG8_LDB(B1, 0, 1); PG8_SCHED; PG8_LDA(At, 0, 0); PG8_STAGE(PG8_SA(1, 1), a1 + hstepA, voffA);
            PG8_WAIT_V(8); PG8_WAIT_L(0); PG8_BAR; PG8_MMA(0, 0, At, B0); PG8_MMA(0, 1, At, B1); PG8_BAR; PG8_SCHED;
            PG8_LDA(At, 0, 1); PG8_STAGE(PG8_SB(0, 0), b2, voffB); PG8_STAGE(PG8_SB(0, 1), b2 + hstepB, voffB); PG8_STAGE(PG8_SA(0, 0), a2, voffA);
            PG8_WAIT_V(8); PG8_WAIT_L(0); PG8_BAR; PG8_MMA(1, 0, At, B0); PG8_MMA(1, 1, At, B1); PG8_BAR; PG8_SCHED;
            PG8_LDB(B0, 1, 0); PG8_LDB(B1, 1, 1); PG8_SCHED; PG8_LDA(At, 1, 0); PG8_STAGE(PG8_SA(0, 1), a2 + hstepA, voffA);
            PG8_WAIT_V(8); PG8_WAIT_L(0); PG8_BAR; PG8_MMA(0, 0, At, B0); PG8_MMA(0, 1, At, B1); PG8_BAR; PG8_SCHED;
            PG8_LDA(At, 1, 1); PG8_STAGE(PG8_SB(1, 0), b3, voffB); PG8_STAGE(PG8_SB(1, 1), b3 + hstepB, voffB); PG8_STAGE(PG8_SA(1, 0), a3, voffA);
            PG8_WAIT_V(8); PG8_WAIT_L(0); PG8_BAR; PG8_MMA(1, 0, At, B0); PG8_MMA(1, 1, At, B1); PG8_BAR; PG8_SCHED;
            }
        }
        if constexpr (ALIGN_EPI) { if (wr == 0) PG8_BAR; }
        if constexpr (!Epi::AFTER_DRAIN) { E(acc, cur, wr, wc, fr, fq); S.done(cur); }
        if (!has_next) break;
#pragma unroll
        for (int a = 0; a < 2; ++a)
#pragma unroll
            for (int b = 0; b < 2; ++b)
#pragma unroll
                for (int m = 0; m < 4; ++m)
#pragma unroll
                    for (int n = 0; n < 2; ++n) acc[a][b][m][n] = (f32x4){0.f, 0.f, 0.f, 0.f};
        cur = nxt; cA = nA; cB = nB; ++ui;
        if constexpr (ALIGN_EPI) { if (wr == 1) PG8_BAR; }
    }
    PG8_WAIT_V(0);
    if constexpr (!ALIGN_EPI) { if (wr == 0) PG8_BAR; }
    PG8_BAR;
    if constexpr (Epi::AFTER_DRAIN) { E.fused(acc, cur, wr, wc, fr, fq, lds, wid, lane); S.done(cur); }
#undef PG8_SA
#undef PG8_SB
#undef PG8_STAGE
#undef PG8_LDA
#undef PG8_LDB
#undef PG8_MMA
#undef PG8_WAIT_V
#undef PG8_WAIT_L
#undef PG8_BAR
#undef PG8_SCHED
}
}
namespace mk {
using pg8::Unit;
typedef f32x4 Acc[2][2][4][2];
__device__ __forceinline__ void st8(bf16* p, f32x4 v) { u32x2 w; w.x = cvtpk(v[0], v[1]); w.y = cvtpk(v[2], v[3]); *(u32x2*)p = w; }
__device__ __forceinline__ void st16(bf16* p, f32x4 a, f32x4 b) { u32x4 w; w.x = cvtpk(a[0], a[1]); w.y = cvtpk(a[2], a[3]); w.z = cvtpk(b[0], b[1]); w.w = cvtpk(b[2], b[3]); *(u32x4*)p = w; }
__device__ __forceinline__ f32x4 ld4bf(const bf16* p) { const u32x2 w = *(const u32x2*)p; return (f32x4){bflo(w.x), bfhi(w.x), bflo(w.y), bfhi(w.y)}; }
__device__ __forceinline__ f32x4 rope4(f32x4 v, f32x4 cs) { return (f32x4){v[0] * cs[0] - v[1] * cs[1], v[1] * cs[0] + v[0] * cs[1], v[2] * cs[2] - v[3] * cs[3], v[3] * cs[2] + v[2] * cs[3]}; }

__device__ __forceinline__ void st_tr_pairs(bf16* T, int col0, int row, f32x4 v, bool even) {
    const float s0 = even ? v[2] : v[0], s1 = even ? v[3] : v[1];
    const float r0 = __shfl_xor(s0, 1), r1 = __shfl_xor(s1, 1);
    const int c = col0 + (even ? 0 : 2), re = row & ~1;
    const unsigned w0 = even ? cvtpk(v[0], r0) : cvtpk(r0, v[2]), w1 = even ? cvtpk(v[1], r1) : cvtpk(r1, v[3]);
    *(unsigned*)(T + (size_t)c * NTOK + re) = w0; *(unsigned*)(T + (size_t)(c + 1) * NTOK + re) = w1;
}
struct EpiWin {
    static constexpr bool PERM = true, AFTER_DRAIN = false;
    bf16 *RQ, *RK, *RKT, *RVT, *RG, *UC, *CQ, *CKV, *KPE; float *SSQQ, *SSQKV; const f32x4* CS;
    __device__ __forceinline__ void operator()(const Acc& acc, const Unit& u, int wr, int wc, int fr, int fq) const { { int t_ = threadIdx.x; asm volatile("" : "+v"(t_)); fr = t_ & 15; fq = (t_ >> 4) & 3; }
        const int pn = u.pn, row0 = u.pm * 256 + wr * 64 + fr; const bool even = (fr & 1) == 0;
        if (pn <= 1) {
#pragma unroll
            for (int ai = 0; ai < 2; ++ai)
#pragma unroll
                for (int m = 0; m < 4; ++m) { const int row = row0 + ai * 128 + m * 16; const float pl = (float)(row & (RET_C - 1));
#pragma unroll
                    for (int bj = 0; bj < 2; ++bj) { const int head = 2 * bj + (wc >> 1);
                        const float lg2 = __builtin_amdgcn_logf(1.f - __builtin_amdgcn_exp2f(-5.f - (float)head));
                        const float dec = pn == 0 ? __builtin_amdgcn_exp2f(pl * lg2) : 0.125f * __builtin_amdgcn_exp2f(-pl * lg2);
                        const int i0 = 16 * (wc & 1) + 4 * fq, col = bj * 128 + wc * 32 + 8 * fq;
                        const f32x4 o0 = rope4(acc[ai][bj][m][0], CS[((row * 32 + i0) >> 1)]) * dec, o1 = rope4(acc[ai][bj][m][1], CS[((row * 32 + i0) >> 1) + 1]) * dec;
                        st16((pn == 0 ? RQ : RK) + (size_t)row * 256 + col, o0, o1);
                        if (pn == 1) { st_tr_pairs(RKT, col, row, o0, even); st_tr_pairs(RKT, col + 4, row, o1, even); } }
                    asm volatile("" ::: "memory"); }
        } else if (pn == 2) {
#pragma unroll
            for (int ai = 0; ai < 2; ++ai)
#pragma unroll
                for (int m = 0; m < 4; ++m) { const int row = row0 + ai * 128 + m * 16;
#pragma unroll
                    for (int bj = 0; bj < 2; ++bj) { const int col = bj * 128 + wc * 32 + 8 * fq; st_tr_pairs(RVT, col, row, acc[ai][bj][m][0], even); st_tr_pairs(RVT, col + 4, row, acc[ai][bj][m][1], even); } }
        } else if (pn == 3) {
#pragma unroll
            for (int ai = 0; ai < 2; ++ai)
#pragma unroll
                for (int m = 0; m < 4; ++m) { const int row = row0 + ai * 128 + m * 16;
#pragma unroll
                    for (int bj = 0; bj < 2; ++bj) { const f32x4 v = acc[ai][bj][m][0], w = acc[ai][bj][m][1];
                        st16(RG + (size_t)row * 256 + bj * 128 + wc * 32 + 8 * fq, (f32x4){silu_fast(v[0]), silu_fast(v[1]), silu_fast(v[2]), silu_fast(v[3])}, (f32x4){silu_fast(w[0]), silu_fast(w[1]), silu_fast(w[2]), silu_fast(w[3])}); } }
        } else if (pn == 4) {
#pragma unroll
            for (int ai = 0; ai < 2; ++ai)
#pragma unroll
                for (int m = 0; m < 4; ++m) { const int row = row0 + ai * 128 + m * 16, chunk = row / SSM_C, t = row % SSM_C;
#pragma unroll
                    for (int bj = 0; bj < 2; ++bj) { const int g = 8 * bj + 2 * wc + (fq >> 1);
                        st16(UC + ((size_t)g * SSM_NCH + chunk) * SSM_K + t * 16 + 8 * (fq & 1), acc[ai][bj][m][0], acc[ai][bj][m][1]); } }
        } else if (pn == 5) {
#pragma unroll
            for (int ai = 0; ai < 2; ++ai)
#pragma unroll
                for (int m = 0; m < 4; ++m) { const int row = row0 + ai * 128 + m * 16; float ss = 0.f;
#pragma unroll
                    for (int bj = 0; bj < 2; ++bj) { const f32x4 v = acc[ai][bj][m][0], w = acc[ai][bj][m][1];
                        ss += ((v[0] * v[0] + v[1] * v[1]) + (v[2] * v[2] + v[3] * v[3])) + ((w[0] * w[0] + w[1] * w[1]) + (w[2] * w[2] + w[3] * w[3]));
                        st16(CQ + (size_t)row * 256 + bj * 128 + wc * 32 + 8 * fq, v, w); }
                    ss += __shfl_xor(ss, 16); ss += __shfl_xor(ss, 32);
                    if (fq == 0) SSQQ[row * 4 + wc] = ss; }
        } else {
#pragma unroll
            for (int ai = 0; ai < 2; ++ai)
#pragma unroll
                for (int m = 0; m < 4; ++m) { const int row = row0 + ai * 128 + m * 16;
                    const f32x4 v = acc[ai][0][m][0], w = acc[ai][0][m][1];
                    float ss = ((v[0] * v[0] + v[1] * v[1]) + (v[2] * v[2] + v[3] * v[3])) + ((w[0] * w[0] + w[1] * w[1]) + (w[2] * w[2] + w[3] * w[3]));
                    st16(CKV + (size_t)row * 128 + wc * 32 + 8 * fq, v, w);
                    ss += __shfl_xor(ss, 16); ss += __shfl_xor(ss, 32);
                    if (fq == 0) SSQKV[row * 4 + wc] = ss;
                    if (wc < 2) { const int i0 = 16 * wc + 4 * fq;
                        st16(KPE + (size_t)row * 64 + wc * 32 + 8 * fq, rope4(acc[ai][1][m][0], CS[(row * 32 + i0) >> 1]), rope4(acc[ai][1][m][1], CS[((row * 32 + i0) >> 1) + 1])); } }
        }
    }
};
struct EpiQup {
    static constexpr bool PERM = false, AFTER_DRAIN = false;
    bf16* Q; const float* SSQ; const f32x4* CS;
    __device__ __forceinline__ void operator()(const Acc& acc, const Unit& u, int wr, int wc, int fr, int fq) const { { int t_ = threadIdx.x; asm volatile("" : "+v"(t_)); fr = t_ & 15; fq = (t_ >> 4) & 3; }
        const int row0 = u.pm * 256 + wr * 64 + fr;
#pragma unroll
        for (int ai = 0; ai < 2; ++ai)
#pragma unroll
            for (int m = 0; m < 4; ++m) { const int row = row0 + ai * 128 + m * 16; const f32x4 s4 = *(const f32x4*)(SSQ + row * 4);
                const float rstd = __builtin_amdgcn_rsqf(((s4[0] + s4[1]) + (s4[2] + s4[3])) * (1.f / 256.f) + EPS);
#pragma unroll
                for (int bj = 0; bj < 2; ++bj) { const bool rope = ((4 * u.pn + 2 * bj + (wc >> 1)) % 3) == 2;
#pragma unroll
                    for (int n = 0; n < 2; ++n) { f32x4 v = acc[ai][bj][m][n] * rstd;
                        if (rope) { const int i0 = 16 * (wc & 1) + 8 * n + 2 * fq; v = rope4(v, CS[(row * 32 + i0) >> 1]); }
                        st8(Q + (size_t)row * 768 + u.pn * 256 + bj * 128 + wc * 32 + n * 16 + fq * 4, v); } }
                asm volatile("" ::: "memory"); }
    }
};
struct EpiKVup {
    static constexpr bool PERM = false, AFTER_DRAIN = false;
    bf16 *KN, *V; const float* SSQ;
    __device__ __forceinline__ void operator()(const Acc& acc, const Unit& u, int wr, int wc, int fr, int fq) const { { int t_ = threadIdx.x; asm volatile("" : "+v"(t_)); fr = t_ & 15; fq = (t_ >> 4) & 3; }
        const int row0 = u.pm * 256 + wr * 64 + fr;
#pragma unroll
        for (int ai = 0; ai < 2; ++ai)
#pragma unroll
            for (int m = 0; m < 4; ++m) { const int row = row0 + ai * 128 + m * 16; const f32x4 s4 = *(const f32x4*)(SSQ + row * 4);
                const float rstd = __builtin_amdgcn_rsqf(((s4[0] + s4[1]) + (s4[2] + s4[3])) * (1.f / 128.f) + EPS);
#pragma unroll
                for (int bj = 0; bj < 2; ++bj)
#pragma unroll
                    for (int n = 0; n < 2; ++n) st8((bj == 0 ? KN : V) + (size_t)row * 512 + u.pn * 128 + wc * 32 + n * 16 + fq * 4, acc[ai][bj][m][n] * rstd);
                asm volatile("" ::: "memory"); }
    }
};
struct EpiSsmE {
    static constexpr bool PERM = false, AFTER_DRAIN = true;
    bf16* UC; const f32x2* LAMC; unsigned* flag;
    __device__ __forceinline__ void fused(Acc& acc, const Unit& u, int wr, int wc, int fr, int fq, PG8_LAS unsigned char* lds, int wid, int lane) const { { int t_ = threadIdx.x; asm volatile("" : "+v"(t_)); fr = t_ & 15; fq = (t_ >> 4) & 3; }
        PG8_LAS float* EL = (PG8_LAS float*)lds;
        const int g = u.pm >> 1, b = u.pm & 1;
#pragma unroll
        for (int ai = 0; ai < 2; ++ai)
#pragma unroll
            for (int m = 0; m < 4; ++m) { const int ch = ai * 128 + wr * 64 + m * 16 + fr;
#pragma unroll
                for (int n = 0; n < 2; ++n) *(PG8_LAS f32x4*)(EL + ch * 128 + wc * 32 + n * 16 + fq * 4) = acc[ai][0][m][n]; }
        asm volatile("s_waitcnt lgkmcnt(0)" ::: "memory"); __builtin_amdgcn_s_barrier(); asm volatile("" ::: "memory");
        {
            const f32x2 lc = LAMC[g * 64 + lane]; f32x2 c = {0.f, 0.f};
            f32x2 loc[32];
#pragma unroll
            for (int n = 0; n < 32; ++n) { const f32x2 e2 = *(const PG8_LAS f32x2*)(EL + (wid * 32 + n) * 128 + 2 * lane); loc[n] = c; c = (f32x2){lc.x * c.x - lc.y * c.y, lc.x * c.y + lc.y * c.x} + e2; }
            f32x2 pw = {1.f, 0.f};
#pragma unroll
            for (int n = 0; n < 32; ++n) pw = (f32x2){pw.x * lc.x - pw.y * lc.y, pw.x * lc.y + pw.y * lc.x};
            asm volatile("s_waitcnt lgkmcnt(0)" ::: "memory"); __builtin_amdgcn_s_barrier(); asm volatile("" ::: "memory");
            *(PG8_LAS f32x2*)(EL + wid * 128 + 2 * lane) = c;
            asm volatile("s_waitcnt lgkmcnt(0)" ::: "memory"); __builtin_amdgcn_s_barrier(); asm volatile("" ::: "memory");
            f32x2 cin = {0.f, 0.f};
            for (int s = 0; s < wid; ++s) { const f32x2 es = *(const PG8_LAS f32x2*)(EL + s * 128 + 2 * lane); cin = (f32x2){pw.x * cin.x - pw.y * cin.y, pw.x * cin.y + pw.y * cin.x} + es; }
            bf16* up = UC + ((size_t)g * SSM_NCH + b * 256 + wid * 32) * SSM_K + 512 + 2 * lane;
            f32x2 q = cin;
#pragma unroll
            for (int n = 0; n < 32; ++n) { const f32x2 v = loc[n] + q; *(unsigned*)(up + (size_t)n * SSM_K) = cvtpk(v.x, v.y); q = (f32x2){lc.x * q.x - lc.y * q.y, lc.x * q.y + lc.y * q.x}; }
        }
        asm volatile("s_waitcnt vmcnt(0)" ::: "memory");
        asm volatile("s_waitcnt lgkmcnt(0)" ::: "memory"); __builtin_amdgcn_s_barrier(); asm volatile("" ::: "memory");
        if (threadIdx.x == 0) { __builtin_amdgcn_fence(__ATOMIC_RELEASE, "agent"); asm volatile("s_waitcnt vmcnt(0)" ::: "memory"); __hip_atomic_fetch_add(flag, 1u, __ATOMIC_RELAXED, __HIP_MEMORY_SCOPE_AGENT); }
    }
};
struct EpiSsmZ {
    static constexpr bool PERM = false, AFTER_DRAIN = false;
    bf16* G; const bf16* UC; const float* dpar;
    __device__ __forceinline__ void operator()(const Acc& acc, const Unit& u, int wr, int wc, int fr, int fq) const { { int t_ = threadIdx.x; asm volatile("" : "+v"(t_)); fr = t_ & 15; fq = (t_ >> 4) & 3; }
        const int g = u.pm >> 1, ch0 = (u.pm & 1) * 256 + wr * 64 + fr;
        const f32x4 dd = *(const f32x4*)(dpar + g * 16 + 4 * fq);
#pragma unroll
        for (int ai = 0; ai < 2; ++ai)
#pragma unroll
            for (int m = 0; m < 4; ++m) { const int chunk = ch0 + ai * 128 + m * 16;
#pragma unroll
                for (int bj = 0; bj < 2; ++bj)
#pragma unroll
                    for (int n = 0; n < 2; ++n) { const int t = u.pn * 16 + bj * 8 + wc * 2 + n;
                        const f32x4 uv = ld4bf(UC + ((size_t)g * SSM_NCH + chunk) * SSM_K + t * 16 + 4 * fq);
                        const f32x4 y = acc[ai][bj][m][n] + dd * uv;
                        st8(G + (size_t)(chunk * SSM_C + t) * 256 + g * 16 + 4 * fq, (f32x4){gelu_tanh_fast(y[0]), gelu_tanh_fast(y[1]), gelu_tanh_fast(y[2]), gelu_tanh_fast(y[3])}); } }
    }
};
struct EpiStore {
    static constexpr bool PERM = true, AFTER_DRAIN = false;
    bf16* O; int ldc; const float* rowscale; size_t split_stride;
    __device__ __forceinline__ void operator()(const Acc& acc, const Unit& u, int wr, int wc, int fr, int fq) const { { int t_ = threadIdx.x; asm volatile("" : "+v"(t_)); fr = t_ & 15; fq = (t_ >> 4) & 3; }
        const int ks = u.pn >> 2, pn0 = u.pn & 3; bf16* O = this->O + (size_t)ks * split_stride;
        const int row0 = u.pm * 256 + wr * 64 + fr, col0 = pn0 * 256 + wc * 32 + 8 * fq;
#pragma unroll
        for (int ai = 0; ai < 2; ++ai)
#pragma unroll
            for (int m = 0; m < 4; ++m) { const int row = row0 + ai * 128 + m * 16; const float s = rowscale ? rowscale[row] : 1.f;
#pragma unroll
                for (int bj = 0; bj < 2; ++bj) st16(O + (size_t)row * ldc + col0 + bj * 128, acc[ai][bj][m][0] * s, acc[ai][bj][m][1] * s); }
    }
};
struct EpiSwiglu {
    static constexpr bool PERM = true, AFTER_DRAIN = false;
    bf16* H;
    __device__ __forceinline__ void operator()(const Acc& acc, const Unit& u, int wr, int wc, int fr, int fq) const { { int t_ = threadIdx.x; asm volatile("" : "+v"(t_)); fr = t_ & 15; fq = (t_ >> 4) & 3; }
        const int row0 = u.pm * 256 + wr * 64 + fr, h0 = u.pn * 128 + wc * 32 + 8 * fq;
#pragma unroll
        for (int ai = 0; ai < 2; ++ai)
#pragma unroll
            for (int m = 0; m < 4; ++m) { const int row = row0 + ai * 128 + m * 16;
                const f32x4 g0 = acc[ai][0][m][0], g1 = acc[ai][0][m][1], u0 = acc[ai][1][m][0], u1 = acc[ai][1][m][1];
                st16(H + (size_t)row * DFF + h0, (f32x4){silu_fast(g0[0]) * u0[0], silu_fast(g0[1]) * u0[1], silu_fast(g0[2]) * u0[2], silu_fast(g0[3]) * u0[3]},
                                                 (f32x4){silu_fast(g1[0]) * u1[0], silu_fast(g1[1]) * u1[1], silu_fast(g1[2]) * u1[2], silu_fast(g1[3]) * u1[3]}); }
    }
};
}
namespace att {
using namespace mk;
constexpr int KVBLK = 64, SHM_V = 64 * 128 * 2, SHM_KN = 64 * 128 * 2, SHM_KP = 64 * 64 * 2, KBUF = SHM_KN + SHM_KP;
constexpr int OFF_V = 0  , OFF_K = 3 * SHM_V  , OFF_WS = 3 * SHM_V + 2 * KBUF, LDS_BYTES = OFF_WS + NWAVES * 64 * 4;
constexpr float THR = 8.f;
#define KSWZ(row, colB) ((row) * 256 + ((colB) ^ (((row) & 7) << 4)))
#define KPSWZ(row, colB) ((row) * 128 + ((colB) ^ (((row) & 7) << 4)))
#define SBAR() __builtin_amdgcn_sched_barrier(0)
__device__ __forceinline__ int v_st(int k, int c) { const int kk = (k & ~0xC) | ((k & 4) << 1) | ((k & 8) >> 1); return ((kk >> 3) * 4 + (c >> 5)) * 512 + ((kk & 7) * 32 + (c & 31)) * 2; }
__device__ __forceinline__ int v_rd_base(int lane) { return ((lane & 3) << 3) | (((lane >> 2) & 3) << 6) | (((lane >> 4) & 1) << 5) | (((lane >> 5) & 1) << 8); }
constexpr int v_rd_off(int d0, int ks, int half) { return d0 * 512 + ks * 4096 + half * 2048; }
__device__ __forceinline__ int crow(int r, int hi) { return (r & 3) + 8 * (r >> 2) + 4 * hi; }

struct Tensors { const bf16* Q; const bf16* KN; const bf16* KP; const bf16* V; bf16* O; };

#define KFR(i) ((i) < 8 ? *reinterpret_cast<const bf16x8*>(kb[(i) & 3] + ((i) >> 2) * 128) : *reinterpret_cast<const bf16x8*>(kp0 + KPSWZ(r32, (((i) - 8) * 16 + hi * 8) * 2)))
#define PK4(P_, B__, OUT) do { unsigned a0 = cvtpk(P_[B__ + 0], P_[B__ + 1]), a1 = cvtpk(P_[B__ + 2], P_[B__ + 3]), b0 = cvtpk(P_[B__ + 4], P_[B__ + 5]), b1 = cvtpk(P_[B__ + 6], P_[B__ + 7]); \
        auto r0 = __builtin_amdgcn_permlane32_swap(a0, b0, false, false); auto r1 = __builtin_amdgcn_permlane32_swap(a1, b1, false, false); \
        u32x4 w = {r0[0], r1[0], r0[1], r1[1]}; OUT = *reinterpret_cast<bf16x8*>(&w); } while (0)
__device__ __forceinline__ void glds16(const void* gsrc, unsigned lds_dst) { unsigned keep;
    asm volatile("s_mov_b32 %0, m0\n\ts_mov_b32 m0, %2\n\ts_nop 0\n\tglobal_load_lds_dwordx4 %1, off\n\ts_mov_b32 m0, %0" : "=&s"(keep) : "v"(gsrc), "s"(lds_dst) : "memory"); }
#define WAIT_BAR(N) asm volatile("s_waitcnt vmcnt(" #N ") lgkmcnt(0)\n\ts_barrier" ::: "memory")
__device__ __forceinline__ void attn_unit(int b, int h, int qb, const Tensors& T, char* lds) {
    int tid_ = threadIdx.x; asm volatile("" : "+v"(tid_));
    const int tid = tid_, wid = __builtin_amdgcn_readfirstlane(tid >> 6), lane = tid & 63, r32 = lane & 31, hi = lane >> 5;
    const int rg = wid & 3, kh = wid >> 2;
    const size_t tok0 = (size_t)b * SEQ; const int q0 = qb * 128, NT = 2 * qb + 2;
    float* ws = (float*)(lds + OFF_WS) + wid * 64;
    const unsigned lds0 = (unsigned)(uintptr_t)lds;
    const bf16 *gk0, *gk1, *gp, *gv0, *gv1;
    { const int ra = 4 * wid + (lane >> 4), rb = ra + 32, cc = lane & 15;
      gk0 = T.KN + (tok0 + ra) * 512 + h * 128 + ((cc ^ (ra & 7)) << 3); gk1 = T.KN + (tok0 + rb) * 512 + h * 128 + ((cc ^ (rb & 7)) << 3);
      const int rp = 8 * wid + (lane >> 3), cp = lane & 7; gp = T.KP + (tok0 + rp) * 64 + ((cp ^ (rp & 7)) << 3);
      const int r8 = (lane >> 2) & 7, c8 = (lane & 3) * 8;
      { const int sub = 2 * wid + (lane >> 5), kk = (sub >> 2) * 8 + r8, key = (kk & ~0xC) | ((kk & 4) << 1) | ((kk & 8) >> 1); gv0 = T.V + (tok0 + key) * 512 + h * 128 + (sub & 3) * 32 + c8; }
      { const int sub = 2 * (wid + 8) + (lane >> 5), kk = (sub >> 2) * 8 + r8, key = (kk & ~0xC) | ((kk & 4) << 1) | ((kk & 8) >> 1); gv1 = T.V + (tok0 + key) * 512 + h * 128 + (sub & 3) * 32 + c8; } }
#define DMA_K(t, kso) do { const size_t ko_ = (size_t)(t) * KVBLK; const unsigned d_ = (unsigned)__builtin_amdgcn_readfirstlane((int)(lds0 + OFF_K + (kso) + wid * 1024)); \
        glds16(gk0 + ko_ * 512, d_); glds16(gk1 + ko_ * 512, d_ + 8192); glds16(gp + ko_ * 64, d_ + SHM_KN); } while (0)
#define DMA_V(t, vso) do { const size_t ko_ = (size_t)(t) * KVBLK; const unsigned d_ = (unsigned)__builtin_amdgcn_readfirstlane((int)(lds0 + OFF_V + (vso) + wid * 1024)); \
        glds16(gv0 + ko_ * 512, d_); glds16(gv1 + ko_ * 512, d_ + 8192); } while (0)
    DMA_K(0, 0); DMA_V(0, 0); DMA_K(1, KBUF); DMA_V(1, SHM_V);
    bf16x8 qr[12];
    { const bf16* qp = T.Q + (tok0 + q0 + rg * 32 + r32) * 768 + h * 192 + hi * 8;
#pragma unroll
      for (int d0 = 0; d0 < 12; ++d0) qr[d0] = *(const bf16x8*)(qp + d0 * 16);
#pragma unroll
      for (int d0 = 0; d0 < 12; ++d0) asm volatile("" : "+v"(qr[d0])); }
    float m_reg = -1e30f, l_reg = 0.f; f32x16 o[4] = {};
    const int vb0 = (int)lds0 + v_rd_base(lane) + kh * 8192;
    const int qpos = q0 + rg * 32 + r32;
    WAIT_BAR(0);
#define RESC(a) do { if (__any((a) < 1.f)) { if (hi == 0) ws[r32] = (a); asm volatile("s_waitcnt lgkmcnt(0)" ::: "memory"); \
        _Pragma("unroll") for (int d_ = 0; d_ < 4; ++d_) _Pragma("unroll") for (int r = 0; r < 16; ++r) o[d_][r] *= ws[crow(r, hi)]; } } while (0)
#define KBASES(so) const char* k0_ = lds + OFF_K + (so) + kh * 8192; const char* kp0 = lds + OFF_K + (so) + SHM_KN + kh * 4096; const char* kb[4]; \
        _Pragma("unroll") for (int dd = 0; dd < 4; ++dd) kb[dd] = k0_ + KSWZ(r32, (dd * 16 + hi * 8) * 2);
#define MASKT(P_, t_) do { const int kb_ = (t_) * KVBLK + kh * 32 + 4 * hi; const float NEG = -__builtin_inff(); \
        _Pragma("unroll") for (int r = 0; r < 16; ++r) { const int key = kb_ + (r & 3) + 8 * (r >> 2); if (key > qpos) P_[r] = NEG; } } while (0)
#define DECIDE(P_, AL_) do { float pm_ = fmaxf(fmaxf(P_[0], P_[1]), fmaxf(P_[2], P_[3])); \
        _Pragma("unroll") for (int r = 4; r < 16; r += 4) pm_ = fmaxf(pm_, fmaxf(fmaxf(P_[r], P_[r + 1]), fmaxf(P_[r + 2], P_[r + 3]))); \
        { auto rr = __builtin_amdgcn_permlane32_swap(__float_as_uint(pm_), __float_as_uint(pm_), false, false); pm_ = fmaxf(__uint_as_float(rr[0]), __uint_as_float(rr[1])); } \
        const bool ok_ = __all((pm_ - m_reg) <= THR); const float mn_ = ok_ ? m_reg : fmaxf(m_reg, pm_); AL_ = ok_ ? 1.f : __builtin_amdgcn_exp2f(m_reg - mn_); m_reg = mn_; } while (0)
    f32x16 pc, pn; float alpha;
    { KBASES(0); pc = f32x16{}; bf16x8 f0 = KFR(0), f1 = KFR(1), f2 = KFR(2), f3 = KFR(3); SBAR();
#define QS0(i, F) do { pc = __builtin_amdgcn_mfma_f32_32x32x16_bf16(F, qr[i], pc, 0, 0, 0); if ((i) + 4 < 12) F = KFR((i) + 4); SBAR(); } while (0)
      QS0(0, f0); QS0(1, f1); QS0(2, f2); QS0(3, f3); QS0(4, f0); QS0(5, f1); QS0(6, f2); QS0(7, f3); QS0(8, f0); QS0(9, f1); QS0(10, f2); QS0(11, f3);
#undef QS0
      if (0 >= NT - 2) MASKT(pc, 0);
      DECIDE(pc, alpha); }
    WAIT_BAR(0);
    int kcur = 0  , v_cur = 0, v_nxt = SHM_V, v_nxt2 = 2 * SHM_V;
    for (int t = 0; t < NT; ++t) {
        const bool more = t + 1 < NT;
        if (t + 2 < NT) DMA_K(t + 2, kcur);
        bf16x8 pa0, pa1; float ps = 0.f; const float mn = m_reg;
#define EX2(i) do { pc[2 * (i)] = __builtin_amdgcn_exp2f(pc[2 * (i)] - mn); pc[2 * (i) + 1] = __builtin_amdgcn_exp2f(pc[2 * (i) + 1] - mn); ps += pc[2 * (i)] + pc[2 * (i) + 1]; } while (0)
#define SUMFIN() do { auto rr = __builtin_amdgcn_permlane32_swap(__float_as_uint(ps), __float_as_uint(ps), false, false); ps = __uint_as_float(rr[0]) + __uint_as_float(rr[1]); l_reg = l_reg * alpha + ps; } while (0)
        if (more) {
            KBASES(KBUF - kcur); pn = f32x16{}; bf16x8 f0 = KFR(0), f1 = KFR(1), f2 = KFR(2), f3 = KFR(3); SBAR();
            __builtin_amdgcn_s_setprio(1);
#define QS(i, F, FILL) do { pn = __builtin_amdgcn_mfma_f32_32x32x16_bf16(F, qr[i], pn, 0, 0, 0); if ((i) + 4 < 12) F = KFR((i) + 4); FILL; SBAR(); } while (0)
            QS(0, f0, EX2(0)); QS(1, f1, EX2(1)); QS(2, f2, EX2(2)); QS(3, f3, EX2(3)); QS(4, f0, EX2(4)); QS(5, f1, EX2(5)); QS(6, f2, EX2(6)); QS(7, f3, EX2(7));
            QS(8, f0, SUMFIN()); QS(9, f1, PK4(pc, 0, pa0)); QS(10, f2, PK4(pc, 8, pa1)); QS(11, f3, (void)0);
            __builtin_amdgcn_s_setprio(0);
#undef QS
            if (t + 1 >= NT - 2) MASKT(pn, t + 1);
        } else {
            EX2(0); EX2(1); EX2(2); EX2(3); EX2(4); EX2(5); EX2(6); EX2(7); SUMFIN(); PK4(pc, 0, pa0); PK4(pc, 8, pa1); SBAR();
        }
#undef EX2
#undef SUMFIN
        RESC(alpha); SBAR();
        { const int vb = vb0 + v_cur; float alpha_n = 1.f;
#define TRRD(dst, off) asm volatile("ds_read_b64_tr_b16 %0, %1 offset:%2" : "=&v"(dst) : "v"(vb), "i"(off) : "memory")
          s16x4 l0, l1, h0, h1, l2, l3, h2, h3;
          { constexpr int b_ = v_rd_off(0, 0, 0), c_ = v_rd_off(1, 0, 0);
            TRRD(l0, b_); TRRD(h0, b_ + 2048); TRRD(l1, b_ + 4096); TRRD(h1, b_ + 6144); TRRD(l2, c_); TRRD(h2, c_ + 2048); TRRD(l3, c_ + 4096); TRRD(h3, c_ + 6144); }
          if (t + 2 < NT) DMA_V(t + 2, v_nxt2);
          asm volatile("s_waitcnt lgkmcnt(0)" ::: "memory"); SBAR();
          o[0] = __builtin_amdgcn_mfma_f32_32x32x16_bf16(pa0, (bf16x8){l0[0], l0[1], l0[2], l0[3], h0[0], h0[1], h0[2], h0[3]}, o[0], 0, 0, 0);
          o[1] = __builtin_amdgcn_mfma_f32_32x32x16_bf16(pa0, (bf16x8){l2[0], l2[1], l2[2], l2[3], h2[0], h2[1], h2[2], h2[3]}, o[1], 0, 0, 0);
          SBAR();
          o[0] = __builtin_amdgcn_mfma_f32_32x32x16_bf16(pa1, (bf16x8){l1[0], l1[1], l1[2], l1[3], h1[0], h1[1], h1[2], h1[3]}, o[0], 0, 0, 0);
          o[1] = __builtin_amdgcn_mfma_f32_32x32x16_bf16(pa1, (bf16x8){l3[0], l3[1], l3[2], l3[3], h3[0], h3[1], h3[2], h3[3]}, o[1], 0, 0, 0);
          { constexpr int b_ = v_rd_off(2, 0, 0), c_ = v_rd_off(3, 0, 0);
            TRRD(l0, b_); TRRD(h0, b_ + 2048); TRRD(l1, b_ + 4096); TRRD(h1, b_ + 6144); TRRD(l2, c_); TRRD(h2, c_ + 2048); TRRD(l3, c_ + 4096); TRRD(h3, c_ + 6144); }
          SBAR();
          if (more) DECIDE(pn, alpha_n);
          asm volatile("s_waitcnt lgkmcnt(0)" ::: "memory"); SBAR();
          o[2] = __builtin_amdgcn_mfma_f32_32x32x16_bf16(pa0, (bf16x8){l0[0], l0[1], l0[2], l0[3], h0[0], h0[1], h0[2], h0[3]}, o[2], 0, 0, 0);
          o[3] = __builtin_amdgcn_mfma_f32_32x32x16_bf16(pa0, (bf16x8){l2[0], l2[1], l2[2], l2[3], h2[0], h2[1], h2[2], h2[3]}, o[3], 0, 0, 0);
          o[2] = __builtin_amdgcn_mfma_f32_32x32x16_bf16(pa1, (bf16x8){l1[0], l1[1], l1[2], l1[3], h1[0], h1[1], h1[2], h1[3]}, o[2], 0, 0, 0);
          o[3] = __builtin_amdgcn_mfma_f32_32x32x16_bf16(pa1, (bf16x8){l3[0], l3[1], l3[2], l3[3], h3[0], h3[1], h3[2], h3[3]}, o[3], 0, 0, 0);
#undef TRRD
          alpha = alpha_n; }
        if (t + 2 < NT) WAIT_BAR(2); else WAIT_BAR(0);
        pc = pn;
        kcur = KBUF - kcur; v_cur = v_nxt; v_nxt = v_nxt2; v_nxt2 = (v_nxt2 == 2 * SHM_V) ? 0 : v_nxt2 + SHM_V;
    }
#undef RESC
#undef DMA_K
#undef DMA_V
#undef KBASES
#undef MASKT
#undef DECIDE
    float* XO = (float*)lds;
    float* XM = (float*)(lds + 65536);
    if (kh == 1) {
#pragma unroll
        for (int d0 = 0; d0 < 4; ++d0)
#pragma unroll
            for (int r = 0; r < 16; ++r) XO[((rg * 64) + d0 * 16 + r) * 64 + lane] = o[d0][r];
        if (hi == 0) { XM[rg * 32 + r32] = m_reg; XM[128 + rg * 32 + r32] = l_reg; }
    }
    __syncthreads();
    if (kh == 0) {
        const float m1 = XM[rg * 32 + r32], l1 = XM[128 + rg * 32 + r32];
        const float mn = fmaxf(m_reg, m1), a0 = __builtin_amdgcn_exp2f(m_reg - mn), a1 = __builtin_amdgcn_exp2f(m1 - mn);
        const float inv = __builtin_amdgcn_rcpf(l_reg * a0 + l1 * a1);
        if (hi == 0) { ws[r32] = a0 * inv; ws[32 + r32] = a1 * inv; }
        asm volatile("s_waitcnt lgkmcnt(0)" ::: "memory");
        bf16* Ow = T.O + (tok0 + q0 + rg * 32) * 512 + h * 128;
#pragma unroll
        for (int r = 0; r < 16; ++r) { const int orow = crow(r, hi); const float f0 = ws[orow], f1 = ws[32 + orow];
#pragma unroll
            for (int d0 = 0; d0 < 4; ++d0) { const float v = o[d0][r] * f0 + XO[((rg * 64) + d0 * 16 + r) * 64 + lane] * f1; const float vn = __shfl_xor(v, 1);
                if ((r32 & 1) == 0) *(unsigned*)(Ow + (size_t)orow * 512 + d0 * 32 + r32) = cvtpk(v, vn); } }
    }
    __syncthreads();
}
#undef WAIT_BAR
#undef KSWZ
#undef KPSWZ
#undef SBAR
}
namespace ret {
using namespace mk;
__device__ __forceinline__ int crow(int r, int hi) { return (r & 3) + 8 * (r >> 2) + 4 * hi; }
struct Tensors { const bf16 *RQ, *RK, *RKT, *RVT, *RG; float* KVT; bf16* STATE; bf16* MIX; const float* gain; };
__device__ __forceinline__ void x_unit(int u, const Tensors& T, int lane) {
    asm volatile("" : "+v"(lane));
    const int n = u & 127, bh = u >> 7, h = bh & 3, b = bh >> 2, r32 = lane & 31, hi = lane >> 5;
    const size_t tok0 = (size_t)b * SEQ + (size_t)n * RET_C;
    f32x16 acc[2][2] = {};
#pragma unroll
    for (int s = 0; s < 4; ++s) {
        bf16x8 a[2], bb[2];
#pragma unroll
        for (int i = 0; i < 2; ++i) { a[i] = *(const bf16x8*)(T.RVT + (size_t)(h * 64 + i * 32 + r32) * NTOK + tok0 + s * 16 + hi * 8);
                                      bb[i] = *(const bf16x8*)(T.RKT + (size_t)(h * 64 + i * 32 + r32) * NTOK + tok0 + s * 16 + hi * 8); }
#pragma unroll
        for (int i = 0; i < 2; ++i)
#pragma unroll
            for (int j = 0; j < 2; ++j) acc[i][j] = __builtin_amdgcn_mfma_f32_32x32x16_bf16(a[i], bb[j], acc[i][j], 0, 0, 0);
    }
    float* out = T.KVT + (size_t)u * 4096;
#pragma unroll
    for (int i = 0; i < 2; ++i)
#pragma unroll
        for (int j = 0; j < 2; ++j)
#pragma unroll
            for (int r = 0; r < 16; ++r) out[(i * 32 + crow(r, hi)) * 64 + j * 32 + r32] = acc[i][j][r];
}
__device__ __forceinline__ void scan_wg(int e0, const Tensors& T, float* xs, int tid) {
    const int q = tid >> 7, e = e0 + (tid & 127);
    const int bh = e >> 12, el = e & 4095, h = bh & 3;
    const float gam = 1.f - __builtin_amdgcn_exp2f(-5.f - (float)h), lg2 = __builtin_amdgcn_logf(gam);
    const float g64 = __builtin_amdgcn_exp2f(64.f * lg2), g63 = __builtin_amdgcn_exp2f(63.f * lg2);
    const float* kv = T.KVT + ((size_t)bh * 128 + q * 32) * 4096 + el; bf16* st = T.STATE + ((size_t)bh * 128 + q * 32) * 4096 + el;
    float v[32];
#pragma unroll
    for (int i = 0; i < 32; ++i) v[i] = kv[(size_t)i * 4096];
    float S = 0.f;
#pragma unroll
    for (int i = 0; i < 32; ++i) { const float x = v[i]; v[i] = S; S = g64 * S + g63 * x; }
    xs[q * 128 + (tid & 127)] = S;
    __syncthreads();
    const float g64_32 = __builtin_amdgcn_exp2f(64.f * 32.f * lg2);
    float cin = 0.f;
    for (int s = 0; s < q; ++s) cin = g64_32 * cin + xs[s * 128 + (tid & 127)];
    float pw = cin;
#pragma unroll
    for (int i = 0; i < 32; ++i) { st[(size_t)i * 4096] = (bf16)(cvtpk(gam * (v[i] + pw), 0.f) & 0xffffu); pw *= g64; }
    __syncthreads();
}
__device__ __forceinline__ void z_unit(int u, const Tensors& T, int lane) {
    asm volatile("" : "+v"(lane));
    const int n = u & 127, bh = u >> 7, h = bh & 3, b = bh >> 2, r32 = lane & 31, hi = lane >> 5;
    const size_t tok0 = (size_t)b * SEQ + (size_t)n * RET_C;
    bf16x8 qf[2][4], kf[2][4], sa[4][2]; u32x4 vt[2][2][2];
#pragma unroll
    for (int qb = 0; qb < 2; ++qb)
#pragma unroll
        for (int s = 0; s < 4; ++s) { qf[qb][s] = *(const bf16x8*)(T.RQ + (tok0 + qb * 32 + r32) * 256 + h * 64 + s * 16 + hi * 8); kf[qb][s] = *(const bf16x8*)(T.RK + (tok0 + qb * 32 + r32) * 256 + h * 64 + s * 16 + hi * 8); }
    const bf16* stp = T.STATE + (size_t)u * 4096;
#pragma unroll
    for (int s = 0; s < 4; ++s)
#pragma unroll
        for (int i = 0; i < 2; ++i) sa[s][i] = *(const bf16x8*)(stp + (i * 32 + r32) * 64 + s * 16 + hi * 8);
#pragma unroll
    for (int kb = 0; kb < 2; ++kb)
#pragma unroll
        for (int s2 = 0; s2 < 2; ++s2)
#pragma unroll
            for (int i = 0; i < 2; ++i) { const bf16* vp = T.RVT + (size_t)(h * 64 + i * 32 + r32) * NTOK + tok0 + kb * 32 + s2 * 16 + 4 * hi;
                const u32x2 lo = *(const u32x2*)vp, hh = *(const u32x2*)(vp + 8); vt[kb][s2][i] = (u32x4){lo.x, lo.y, hh.x, hh.y}; }
    __builtin_amdgcn_sched_barrier(0);
    f32x16 o[2][2] = {};
#pragma unroll
    for (int s = 0; s < 4; ++s)
#pragma unroll
        for (int i = 0; i < 2; ++i)
#pragma unroll
            for (int qb = 0; qb < 2; ++qb) o[i][qb] = __builtin_amdgcn_mfma_f32_32x32x16_bf16(sa[s][i], qf[qb][s], o[i][qb], 0, 0, 0);
#pragma unroll
    for (int kb = 0; kb < 2; ++kb) {
#pragma unroll
        for (int qb = kb; qb < 2; ++qb) {
            f32x16 st = {};
#pragma unroll
            for (int s = 0; s < 4; ++s) st = __builtin_amdgcn_mfma_f32_32x32x16_bf16(kf[kb][s], qf[qb][s], st, 0, 0, 0);
            if (kb == qb) {
#pragma unroll
                for (int r = 0; r < 16; ++r) if (crow(r, hi) > r32) st[r] = 0.f;
            }
#pragma unroll
            for (int s2 = 0; s2 < 2; ++s2) {
                u32x4 w; w.x = cvtpk(st[8 * s2 + 0], st[8 * s2 + 1]); w.y = cvtpk(st[8 * s2 + 2], st[8 * s2 + 3]); w.z = cvtpk(st[8 * s2 + 4], st[8 * s2 + 5]); w.w = cvtpk(st[8 * s2 + 6], st[8 * s2 + 7]);
                const bf16x8 pb = __builtin_bit_cast(bf16x8, w);
#pragma unroll
                for (int i = 0; i < 2; ++i) o[i][qb] = __builtin_amdgcn_mfma_f32_32x32x16_bf16(__builtin_bit_cast(bf16x8, vt[kb][s2][i]), pb, o[i][qb], 0, 0, 0);
            }
        }
    }
#pragma unroll
    for (int qb = 0; qb < 2; ++qb) {
        float ss = 0.f;
#pragma unroll
        for (int i = 0; i < 2; ++i)
#pragma unroll
            for (int r = 0; r < 16; ++r) ss += o[i][qb][r] * o[i][qb][r];
        { auto rr = __builtin_amdgcn_permlane32_swap(__float_as_uint(ss), __float_as_uint(ss), false, false); ss = __uint_as_float(rr[0]) + __uint_as_float(rr[1]); }
        const float rstd = __builtin_amdgcn_rsqf(ss * (1.f / 64.f) + EPS);
        const size_t row = tok0 + qb * 32 + r32;
#pragma unroll
        for (int i = 0; i < 2; ++i)
#pragma unroll
            for (int r4 = 0; r4 < 4; ++r4) { const int dv = i * 32 + 8 * r4 + 4 * hi;
                const f32x4 gt = ld4bf(T.RG + row * 256 + h * 64 + dv), gn = *(const f32x4*)(T.gain + h * 64 + dv);
                const f32x4 v = {o[i][qb][4 * r4 + 0], o[i][qb][4 * r4 + 1], o[i][qb][4 * r4 + 2], o[i][qb][4 * r4 + 3]};
                st8(T.MIX + row * DM + h * 64 + dv, v * rstd * gn * gt); }
    }
}
}
namespace mk {
constexpr size_t MiB = 1u << 20;
constexpr size_t W_CTL = 0, CTL_ZERO_BYTES = 64 * 1024;
constexpr size_t W_WGCNT = 128 * 1024;
constexpr size_t W_TILE = 192 * 1024;
constexpr size_t W_MOD = 1 * MiB;
constexpr size_t W_LAMC = 1 * MiB + 256 * 1024;
constexpr size_t W_TOP = 1 * MiB + 512 * 1024;
constexpr size_t W_CS = 2 * MiB;
constexpr size_t W_ROWW = 6 * MiB;
constexpr size_t W_MODP = 7 * MiB;
constexpr size_t W_SSQQ = 6 * MiB + 256 * 1024, W_SSQKV = 6 * MiB + 512 * 1024;
constexpr size_t W_MOEUP = 8 * MiB, W_MOEDN = 120 * MiB;
constexpr size_t W_WIN = 176 * MiB, W_WOUT = 183 * MiB, W_FFUP = 187 * MiB, W_FFDN = 201 * MiB, W_MW = 208 * MiB, W_WEND = 228 * MiB;
constexpr size_t W_WUQ = 233 * MiB, W_WUKV = 234 * MiB, W_GLUW = 235 * MiB;
constexpr size_t W_Y = 236 * MiB, W_MIX = 268 * MiB, W_T = 300 * MiB;
constexpr size_t W_RQ = W_T, W_RK = W_T + 8 * MiB, W_RKT = W_T + 16 * MiB, W_RVT = W_T + 24 * MiB, W_RG = W_T + 32 * MiB, W_UC = W_T + 40 * MiB, W_CQ = W_T + 50 * MiB,
                 W_CKV = W_T + 58 * MiB, W_KPE = W_T + 62 * MiB, W_Q = W_T + 64 * MiB, W_KN = W_T + 88 * MiB, W_V = W_T + 104 * MiB, W_O = W_T + 120 * MiB, W_G = W_T + 136 * MiB,
                 W_KVT = W_T + 144 * MiB, W_STATE = W_T + 160 * MiB, W_E = W_T + 168 * MiB;
constexpr size_t W_HB = W_T;
constexpr size_t W_XN = 480 * MiB;
constexpr size_t W_XG = 176 * MiB;
constexpr size_t W_Y2B = 8 * MiB;
constexpr size_t W_HBM = 244 * MiB;
constexpr size_t W_END = 512 * MiB;

struct Args { const void* in[35]; float* out; unsigned char* ws; int ph_lo, ph_hi, never, pad; };

template <class SrcF>
__device__ __forceinline__ void transpose_item(const SrcF src, int ld, int K, bf16* WT, const float* kscale, float cscale, LAS float* scr, int kb, int nb, int lane) {
    const int k0 = 64 * kb, n0 = 32 * nb;
    const float* sp = src(n0 + (lane & 31));
    float tv[32];
#pragma unroll
    for (int i = 0; i < 32; ++i) tv[i] = sp[(size_t)(k0 + 2 * i + (lane >> 5)) * ld];
#pragma unroll
    for (int i = 0; i < 32; ++i) { const int kk = 2 * i + (lane >> 5); float v = tv[i] * cscale; if (kscale) v *= kscale[k0 + kk]; scr[kk * 33 + (lane & 31)] = v; }
    asm volatile("s_waitcnt lgkmcnt(0)" ::: "memory");
    const int c = lane & 7;
#pragma unroll
    for (int j = 0; j < 4; ++j) { const int n = (lane >> 3) + 8 * j; const LAS float* s = scr + (8 * c) * 33 + n;
        u32x4 o; o.x = cvtpk(s[0 * 33], s[1 * 33]); o.y = cvtpk(s[2 * 33], s[3 * 33]); o.z = cvtpk(s[4 * 33], s[5 * 33]); o.w = cvtpk(s[6 * 33], s[7 * 33]);
        *(u32x4*)(WT + (size_t)(n0 + n) * K + k0 + 8 * c) = o; }
    asm volatile("s_waitcnt lgkmcnt(0)" ::: "memory");
}
struct SrcPlain { const float* W; __device__ __forceinline__ const float* operator()(int n) const { return W + n; } };
struct SrcWin { const float* W; __device__ __forceinline__ const float* operator()(int n) const {
        const bool rp = (n < 512) || (n >= 1664); const int g = n & ~63, cg = n & 63; return W + (rp ? g + (cg >> 1) + 32 * (cg & 1) : n); } };
struct SrcWuq { const float* W; __device__ __forceinline__ const float* operator()(int n) const { const int hh = n / 192, w = n % 192; const int cg = w - 128; return W + (w < 128 ? n : hh * 192 + 128 + (cg >> 1) + 32 * (cg & 1)); } };
struct SrcGU { const float* Wg; const float* Wu; __device__ __forceinline__ const float* operator()(int n) const { const int hid = (n >> 3) * 4 + (n & 3);
        const long long du = (const char*)Wu - (const char*)Wg; return (const float*)((const char*)Wg + (((n >> 2) & 1) ? du : 0ll)) + hid; } };

__device__ __forceinline__ f32x2 lam_pow(float a_re, float a_im, float dt, float e) {
    const float mag = __builtin_amdgcn_exp2f(1.4426950408889634f * a_re * dt * e);
    const double rev = (double)(a_im * dt) * (double)e * 0.15915494309189535;
    const float fr = (float)(rev - floor(rev));
    return (f32x2){mag * __builtin_amdgcn_cosf(fr), mag * __builtin_amdgcn_sinf(fr)};
}
__device__ __forceinline__ f32x2 cmul(f32x2 a, f32x2 b) { return (f32x2){a.x * b.x - a.y * b.y, a.x * b.y + a.y * b.x}; }

template <bool GU>
__device__ __forceinline__ void xp_issue(f32x4 (&v)[8], const float* W0, const float* W1, int ld, int k0, int n0, int tid) {
#pragma unroll
    for (int i = 0; i < 8; ++i) { const int idx = tid + 512 * i, row = idx >> 6, c4 = idx & 63;
        const float* src = GU ? ((c4 < 32 ? W0 : W1) + (size_t)(k0 + row) * ld + (n0 >> 1) + 4 * (c4 & 31)) : (W0 + (size_t)(k0 + row) * ld + n0 + 4 * c4);
        v[i] = *(const f32x4*)src; }
}
template <bool GU>
__device__ __forceinline__ void xp_finish(const f32x4 (&v)[8], bf16* WT, int K, int k0, int n0, LAS float* T, int tid) {
#pragma unroll
    for (int i = 0; i < 8; ++i) { const int idx = tid + 512 * i, row = idx >> 6, c4 = idx & 63; *(LAS f32x4*)(T + row * 256 + ((4 * c4) ^ (((row >> 3) & 7) << 2))) = v[i]; }
    __syncthreads();
#pragma unroll
    for (int j = 0; j < 4; ++j) { const int id = tid + 512 * j, c = id & 7, n = id >> 3; const int col = n;
        const LAS float* s = T + (8 * c) * 256 + (col ^ (c << 2));
        u32x4 o; o.x = cvtpk(s[0], s[256]); o.y = cvtpk(s[512], s[768]); o.z = cvtpk(s[1024], s[1280]); o.w = cvtpk(s[1536], s[1792]);
        *(u32x4*)(WT + (size_t)(n0 + n) * K + k0 + 8 * c) = o; }
    __syncthreads();
}
template <bool GU>
__device__ __forceinline__ void xp_matrix(const float* W0, const float* W1, int ld, int K, int N, bf16* WT, LAS float* T, int bx, int G, int tid) {
    const int nb_ = N / 256, ni_ = (K / 64) * nb_;
    f32x4 v[8];
    int it = bx; if (it >= ni_) return;
    xp_issue<GU>(v, W0, W1, ld, 64 * (it / nb_), 256 * (it % nb_), tid);
    for (; it < ni_; it += G) {
        f32x4 w[8];
#pragma unroll
        for (int i = 0; i < 8; ++i) w[i] = v[i];
        const int nx = it + G;
        if (nx < ni_) xp_issue<GU>(v, W0, W1, ld, 64 * (nx / nb_), 256 * (nx % nb_), tid);
        xp_finish<GU>(w, WT, K, 64 * (it / nb_), 256 * (it % nb_), T, tid);
    }
}

constexpr int MOE_ITEMS = NE * 672;
__device__ __forceinline__ void moe_item_issue(f32x4 (&v)[8], int id, const float* wg, const float* wu, const float* wd, int tid) {
    const int e = id / 672, r = id % 672;
    if (r < 448) xp_issue<true>(v, wg + (size_t)e * DM * DFF, wu + (size_t)e * DM * DFF, DFF, 64 * (r / 28), 256 * (r % 28), tid);
    else { const int q = r - 448; xp_issue<false>(v, wd + (size_t)e * DFF * DM, nullptr, DM, 64 * (q >> 2), 256 * (q & 3), tid); }
}
__device__ __forceinline__ void moe_item_finish(const f32x4 (&v)[8], int id, bf16* up, bf16* dn, LAS float* T, int tid) {
    const int e = id / 672, r = id % 672;
    if (r < 448) xp_finish<true>(v, up + (size_t)e * 2 * DFF * DM, DM, 64 * (r / 28), 256 * (r % 28), T, tid);
    else { const int q = r - 448; xp_finish<false>(v, dn + (size_t)e * DM * DFF, DFF, 64 * (q >> 2), 256 * (q & 3), T, tid); }
}
__device__ __forceinline__ void moe_convert(int quota, unsigned* counter, const float* wg, const float* wu, const float* wd, bf16* up, bf16* dn, LAS float* T, volatile LAS int* slot, int tid) {
    if (quota <= 0) return;
    __syncthreads();
    if (tid == 0) slot[0] = (int)__hip_atomic_fetch_add(counter, 1u, __ATOMIC_RELAXED, __HIP_MEMORY_SCOPE_AGENT);
    __syncthreads();
    int cur = slot[0]; if (cur >= MOE_ITEMS) return;
    f32x4 v[8]; moe_item_issue(v, cur, wg, wu, wd, tid);
    for (int n = 1;; ++n) {
        int nxt = MOE_ITEMS;
        if (n < quota) { __syncthreads(); if (tid == 0) slot[0] = (int)__hip_atomic_fetch_add(counter, 1u, __ATOMIC_RELAXED, __HIP_MEMORY_SCOPE_AGENT); __syncthreads(); nxt = slot[0]; }
        f32x4 w[8];
#pragma unroll
        for (int i = 0; i < 8; ++i) w[i] = v[i];
        if (nxt < MOE_ITEMS) moe_item_issue(v, nxt, wg, wu, wd, tid);
        moe_item_finish(w, cur, up, dn, T, tid);
        if (nxt >= MOE_ITEMS) break;
        cur = nxt;
    }
}
}
namespace mk {
struct SsmPar { const float *a_re, *a_im, *b_re, *b_im, *c_re, *c_im, *log_dt; };
__device__ __forceinline__ f32x2 ssm_fw(const SsmPar& P, int g, int p, float e, bool with_f) {
    const float dt = __builtin_amdgcn_exp2f(1.4426950408889634f * P.log_dt[g]);
    const float ar = P.a_re[g * 64 + p], ai = P.a_im[g * 64 + p];
    f32x2 w = lam_pow(ar, ai, dt, e);
    if (with_f) { const f32x2 lb = lam_pow(ar, ai, dt, 1.f); const float nr = lb.x - 1.f, ni = lb.y, den = ar * ar + ai * ai;
        const f32x2 f = {(nr * ar + ni * ai) / den, (ni * ar - nr * ai) / den}; w = cmul(w, f); }
    return w;
}
__device__ __forceinline__ void ssm_unit_toep(const SsmPar& P, bf16* MW, int g, int dd, LAS float* scr, int lane) {
    const int d = dd - 31, h = lane >> 2, hp0 = (lane & 3) * 4;
    f32x4 acc = {0.f, 0.f, 0.f, 0.f};
    if (d >= 0) {
#pragma unroll
        for (int i = 0; i < 4; ++i) { const int o = 4 * (lane + 64 * i);
            *(LAS f32x4*)(scr + o) = *(const f32x4*)(P.c_re + g * 1024 + o); *(LAS f32x4*)(scr + 1024 + o) = *(const f32x4*)(P.c_im + g * 1024 + o);
            *(LAS f32x4*)(scr + 2048 + o) = *(const f32x4*)(P.b_re + g * 1024 + o); *(LAS f32x4*)(scr + 3072 + o) = *(const f32x4*)(P.b_im + g * 1024 + o); }
        const f32x2 w = ssm_fw(P, g, lane, (float)d, true);
        asm volatile("s_waitcnt lgkmcnt(0)" ::: "memory");
#pragma unroll 8
        for (int p = 0; p < 64; ++p) {
            const f32x2 wp = {__shfl(w.x, p), __shfl(w.y, p)};
            const f32x2 cm = {scr[h * 64 + p], scr[1024 + h * 64 + p]};
            const f32x2 t = cmul(cm, wp);
            const f32x4 br = *(const LAS f32x4*)(scr + 2048 + p * 16 + hp0), bi = *(const LAS f32x4*)(scr + 3072 + p * 16 + hp0);
            acc += br * t.x - bi * t.y;
        }
        asm volatile("s_waitcnt lgkmcnt(0)" ::: "memory");
    }
    const int tlo = d >= 0 ? d : 0, thi = d >= 0 ? 32 : 32 + d;
    for (int t = tlo; t < thi; ++t) st8(MW + ((size_t)g * 512 + t * 16 + h) * SSM_K + (t - d) * 16 + hp0, acc);
}
__device__ __forceinline__ void ssm_unit_cross(const SsmPar& P, bf16* MW, f32x2* LAMC, int g, int t, int lane) {
    const f32x2 lp = ssm_fw(P, g, lane, (float)(t + 1), false);
    if (t == 31) LAMC[g * 64 + lane] = lp;
#pragma unroll 4
    for (int h = 0; h < 16; ++h) { const f32x2 cm = {P.c_re[(g * 16 + h) * 64 + lane], P.c_im[(g * 16 + h) * 64 + lane]}; const f32x2 v = cmul(cm, lp);
        *(unsigned*)(MW + ((size_t)g * 512 + t * 16 + h) * SSM_K + 512 + 2 * lane) = cvtpk(v.x, -v.y); }
}
__device__ __forceinline__ void ssm_unit_end(const SsmPar& P, bf16* WEND, int g, int j, int lane) {
    const f32x2 w = ssm_fw(P, g, lane, (float)(31 - j), true);
    float re[16], im[16];
#pragma unroll
    for (int q = 0; q < 4; ++q) { const f32x4 br = *(const f32x4*)(P.b_re + (g * 64 + lane) * 16 + 4 * q), bi = *(const f32x4*)(P.b_im + (g * 64 + lane) * 16 + 4 * q);
#pragma unroll
        for (int k = 0; k < 4; ++k) { re[4 * q + k] = w.x * br[k] - w.y * bi[k]; im[4 * q + k] = w.x * bi[k] + w.y * br[k]; } }
    bf16* r0 = WEND + ((size_t)g * 128 + 2 * lane) * 512 + j * 16;
    st16(r0, (f32x4){re[0], re[1], re[2], re[3]}, (f32x4){re[4], re[5], re[6], re[7]}); st16(r0 + 8, (f32x4){re[8], re[9], re[10], re[11]}, (f32x4){re[12], re[13], re[14], re[15]});
    st16(r0 + 512, (f32x4){im[0], im[1], im[2], im[3]}, (f32x4){im[4], im[5], im[6], im[7]}); st16(r0 + 520, (f32x4){im[8], im[9], im[10], im[11]}, (f32x4){im[12], im[13], im[14], im[15]});
}
struct Row { f32x4 v[4]; };
__device__ __forceinline__ Row row_ld_f32(const float* p, int lane) { Row r;
#pragma unroll
    for (int j = 0; j < 4; ++j) r.v[j] = *(const f32x4*)(p + 4 * lane + 256 * j);
    return r; }
__device__ __forceinline__ Row row_ld_bf16(const bf16* p, int lane) { Row r;
#pragma unroll
    for (int j = 0; j < 4; ++j) r.v[j] = ld4bf(p + 4 * lane + 256 * j);
    return r; }
__device__ __forceinline__ float row_ssq(const Row& r) { float s = 0.f;
#pragma unroll
    for (int j = 0; j < 4; ++j) s += (r.v[j][0] * r.v[j][0] + r.v[j][1] * r.v[j][1]) + (r.v[j][2] * r.v[j][2] + r.v[j][3] * r.v[j][3]);
    return wave_sum(s); }
__device__ __forceinline__ Row adaln(const Row& x, const float* g, const float* sc, const float* sh, bf16* xn, int lane) {
    const float rstd = __builtin_amdgcn_rsqf(row_ssq(x) * (1.f / DM) + EPS); Row o;
#pragma unroll
    for (int j = 0; j < 4; ++j) { const int c = 4 * lane + 256 * j; const f32x4 g4 = *(const f32x4*)(g + c), s4 = *(const f32x4*)(sc + c), h4 = *(const f32x4*)(sh + c);
        o.v[j] = x.v[j] * rstd * g4 * (s4 + 1.f) + h4; st8(xn + c, o.v[j]); }
    return o; }
__device__ __forceinline__ Row resid(const Row& xin, const Row& y, const float* g, const float* gt, float* xout, int lane) {
    const float rstd = __builtin_amdgcn_rsqf(row_ssq(y) * (1.f / DM) + EPS); Row o;
#pragma unroll
    for (int j = 0; j < 4; ++j) { const int c = 4 * lane + 256 * j; const f32x4 g4 = *(const f32x4*)(g + c), t4 = *(const f32x4*)(gt + c);
        o.v[j] = xin.v[j] + t4 * y.v[j] * rstd * g4; *(f32x4*)(xout + c) = o.v[j]; }
    return o; }
__device__ __forceinline__ void route(const Row& h, const float* router, int lane, int& e1, int& e2, float& w1, float& w2) {
    float acc[8];
#pragma unroll
    for (int e = 0; e < 8; ++e) acc[e] = 0.f;
#pragma unroll
    for (int j = 0; j < 4; ++j)
#pragma unroll
        for (int k = 0; k < 4; ++k) { const int c = 4 * lane + 256 * j + k; const f32x4 r0 = *(const f32x4*)(router + c * 8), r1 = *(const f32x4*)(router + c * 8 + 4); const float hv = h.v[j][k];
            acc[0] += hv * r0[0]; acc[1] += hv * r0[1]; acc[2] += hv * r0[2]; acc[3] += hv * r0[3]; acc[4] += hv * r1[0]; acc[5] += hv * r1[1]; acc[6] += hv * r1[2]; acc[7] += hv * r1[3]; }
#pragma unroll
    for (int e = 0; e < 8; ++e) acc[e] = wave_sum(acc[e]);
    e1 = 0; float v1 = acc[0];
#pragma unroll
    for (int e = 1; e < 8; ++e) if (acc[e] > v1) { v1 = acc[e]; e1 = e; }
    e2 = -1; float v2 = -__builtin_inff();
#pragma unroll
    for (int e = 0; e < 8; ++e) if (e != e1 && acc[e] > v2) { v2 = acc[e]; e2 = e; }
    const float ex = __builtin_amdgcn_exp2f(1.4426950408889634f * (v2 - v1)); w1 = 1.f / (1.f + ex); w2 = ex / (1.f + ex);
}

__device__ __forceinline__ void glu_unit(int u, const bf16* G, const bf16* GLUW, const float* bias, const float* gain, bf16* MIX, int lane) {
    asm volatile("" : "+v"(lane));
    const int r32 = lane & 31, hi = lane >> 5; const size_t tok = (size_t)u * 32 + r32;
    f32x16 acc[8] = {};
#pragma unroll 2
    for (int s = 0; s < 16; ++s) {
        const bf16x8 bf = *(const bf16x8*)(G + tok * 256 + s * 16 + hi * 8);
#pragma unroll
        for (int j = 0; j < 8; ++j) { const bf16x8 a = *(const bf16x8*)(GLUW + (size_t)(j * 32 + r32) * 256 + s * 16 + hi * 8); acc[j] = __builtin_amdgcn_mfma_f32_32x32x16_bf16(a, bf, acc[j], 0, 0, 0); }
    }
    float ss = 0.f;
#pragma unroll
    for (int j = 0; j < 8; ++j)
#pragma unroll
        for (int r4 = 0; r4 < 4; ++r4) { const int ch = j * 32 + 8 * r4 + 4 * hi; const f32x4 b4 = *(const f32x4*)(bias + ch), gl = ld4bf(G + tok * 256 + ch);
#pragma unroll
            for (int k = 0; k < 4; ++k) { const float y = gl[k] * fast_sigmoid(acc[j][4 * r4 + k] + b4[k]); acc[j][4 * r4 + k] = y; ss += y * y; } }
    { auto rr = __builtin_amdgcn_permlane32_swap(__float_as_uint(ss), __float_as_uint(ss), false, false); ss = __uint_as_float(rr[0]) + __uint_as_float(rr[1]); }
    const float rstd = __builtin_amdgcn_rsqf(ss * (1.f / 256.f) + EPS);
#pragma unroll
    for (int j = 0; j < 8; ++j)
#pragma unroll
        for (int r4 = 0; r4 < 4; ++r4) { const int ch = j * 32 + 8 * r4 + 4 * hi; const f32x4 g4 = *(const f32x4*)(gain + ch);
            st8(MIX + tok * DM + 256 + ch, (f32x4){acc[j][4 * r4 + 0], acc[j][4 * r4 + 1], acc[j][4 * r4 + 2], acc[j][4 * r4 + 3]} * rstd * g4); }
}
}
#ifndef MK_MASK
#define MK_MASK 0x1fff
#endif
#define PH_ON(n) (((MK_MASK) >> (n)) & 1)
#ifndef MK_BG
#define MK_BG 1
#endif
#ifndef MK_Q2
#define MK_Q2 10
#endif
#ifndef MK_Q3
#define MK_Q3 12
#endif
#ifndef MK_REP_MASK
#define MK_REP_MASK 0
#endif
#ifndef MK_REP_N
#define MK_REP_N 2
#endif
#ifndef MK_SUB
#define MK_SUB 0xff
#endif
#define SUB_ON(n) (((MK_SUB) >> (n)) & 1)
namespace mk {
constexpr int RING_BYTES = 131072, MISC_OFF = RING_BYTES + 320, LDS_BYTES = 147456;
constexpr int NPHASE = 25;
__device__ __forceinline__ bool phase_active(int ph) { if (ph == 0) return true; const int l = (ph - 1) / 12, k = (ph - 1) % 12; if (k == 0) return l == 0; if (k == 8) return l == 1; if (k == 5) return false; return true; }

__device__ __forceinline__ const float* inp(const Args& a, int i) { asm volatile("" : "+s"(i)); return (const float*)a.in[i]; }
__global__ void __launch_bounds__(NWAVES * 64, 2) mk_fwd(Args args) {
    extern __shared__ __attribute__((aligned(16))) unsigned char lds[];
    LAS unsigned char* L = (LAS unsigned char*)lds;
    volatile LAS unsigned* MISC = (volatile LAS unsigned*)(L + MISC_OFF);
    const int tid0 = threadIdx.x;
    const int G = gridDim.x, NGW = G * NWAVES;
    for (int u = tid0; u < (LDS_BYTES - RING_BYTES) / 4; u += NWAVES * 64) ((LAS unsigned*)(L + RING_BYTES))[u] = 0u;
    __syncthreads();
    unsigned char* ws = args.ws;
    XcdBarrier bar; bar.bar = (unsigned*)(ws + W_CTL) + 1024; bar.x = 0; bar.st = nullptr;
    if (args.ph_hi - args.ph_lo > 1) bar = xcd_barrier_post((unsigned*)(ws + W_CTL) + 1024, MISC + 8);
    if (args.never) cooperative_groups::this_grid().sync();
#define INF(i) (inp(args, (i)))
#define MOECONV(Q_) do { if (!MK_BG) break; int tidq_ = threadIdx.x; asm volatile("" : "+v"(tidq_)); moe_convert((Q_), (unsigned*)(ws + W_CTL) + 8192, INF(32), INF(33), INF(34), (bf16*)(ws + W_MOEUP), (bf16*)(ws + W_MOEDN), (LAS float*)L, (volatile LAS int*)(L + RING_BYTES + 64), tidq_); } while (0)
#define x_in INF(0)
#define out (args.out)
#define MOD ((float*)(ws + W_MOD))
#define CS4 ((const f32x4*)(ws + W_CS))
#define XN ((bf16*)(ws + W_XN))
#define Yb ((bf16*)(ws + W_Y))
#define MIX ((bf16*)(ws + W_MIX))
#define RQ ((bf16*)(ws + W_RQ))
#define RK ((bf16*)(ws + W_RK))
#define RKT ((bf16*)(ws + W_RKT))
#define RVT ((bf16*)(ws + W_RVT))
#define RG ((bf16*)(ws + W_RG))
#define UC ((bf16*)(ws + W_UC))
#define CQ ((bf16*)(ws + W_CQ))
#define CKV ((bf16*)(ws + W_CKV))
#define KPE ((bf16*)(ws + W_KPE))
#define Qb ((bf16*)(ws + W_Q))
#define KN ((bf16*)(ws + W_KN))
#define Vb ((bf16*)(ws + W_V))
#define Ob ((bf16*)(ws + W_O))
#define GB ((bf16*)(ws + W_G))
#define STATE ((bf16*)(ws + W_STATE))
#define HB ((bf16*)(ws + W_HB))
#define XG ((bf16*)(ws + W_XG))
#define HBM ((bf16*)(ws + W_HBM))
#define KVT ((float*)(ws + W_KVT))
#define EB ((float*)(ws + W_E))
#define SSQQ ((float*)(ws + W_SSQQ))
#define SSQKV ((float*)(ws + W_SSQKV))
#define ROWW ((float*)(ws + W_ROWW))
#define WGCNT ((int*)(ws + W_WGCNT))
#define TILE ((int*)(ws + W_TILE))
#define TOPI ((int*)(ws + W_TOP))
#define TOPW ((float*)(ws + W_TOP + 128 * 1024))
#define TPOS ((int*)(ws + W_TOP + 256 * 1024))
#define WIN ((bf16*)(ws + W_WIN + (size_t)l * (7 * MiB / 2)))
#define WOUT ((bf16*)(ws + W_WOUT + (size_t)l * 2 * MiB))
#define MW ((bf16*)(ws + W_MW + (size_t)l * 10 * MiB))
#define WEND ((bf16*)(ws + W_WEND + (size_t)l * 2 * MiB))
#define WUQ ((bf16*)(ws + W_WUQ + (size_t)l * 384 * 1024))
#define WUKV ((bf16*)(ws + W_WUKV + (size_t)l * 256 * 1024))
#define GLUW ((bf16*)(ws + W_GLUW + (size_t)l * 128 * 1024))
#define LAMC ((f32x2*)(ws + W_LAMC) + l * 1024)
#define modl (MOD + l * 2 * 6144)
    int repcnt = 0;
    for (int ph = args.ph_lo; ph < args.ph_hi; ++ph) {
        if (!phase_active(ph)) continue;
        int bx = blockIdx.x; asm volatile("" : "+s"(bx));
        const int vcu = (G % 8 == 0) ? (bx % 8) * (G / 8) + bx / 8 : bx;
#define LANEDEFS int tid = threadIdx.x; asm volatile("" : "+v"(tid)); const int lane = tid & 63, wave = __builtin_amdgcn_readfirstlane(tid >> 6), gw = bx * NWAVES + wave; (void)lane; (void)wave; (void)gw;
        const int l = ph == 0 ? 0 : (ph - 1) / 12, k = ph == 0 ? -1 : (ph - 1) % 12;
        if (ph == 0 && PH_ON(0)) { LANEDEFS
            LAS float* scr = (LAS float*)(L + wave * 16384);
            for (int u = gw; u < 1536; u += NGW) { const int ll = u / 768, r = u % 768, n0 = (r >> 3) * 64, ks = r & 7; const float* aw = INF(3) + (size_t)ll * DM * 6144 + n0 + lane; const float* c = INF(1);
                float a0 = 0.f, a1 = 0.f;
#pragma unroll 16
                for (int kk = 0; kk < 128; ++kk) { const int kq = ks * 128 + kk; const float w = aw[(size_t)kq * 6144]; a0 += silu_fast(c[kq]) * w; a1 += silu_fast(c[DM + kq]) * w; }
                float* mp = (float*)(ws + W_MODP) + (size_t)(ks * 2 + ll) * 2 * 6144 + n0 + lane; mp[0] = a0; mp[6144] = a1; }
#define CONV(SRC, LD, KK, NN, DST, KSC, CSC) do { const int nb_ = (NN) / 32, ni_ = ((KK) / 64) * nb_; for (int it = gw; it < ni_; it += NGW) transpose_item(SRC, LD, KK, DST, KSC, CSC, scr, it / nb_, it % nb_, lane); } while (0)
            for (int ll = 0; ll < 2; ++ll) {
                CONV((SrcWin{INF(9) + (size_t)ll * DM * INC}), INC, DM, INC, (bf16*)(ws + W_WIN + (size_t)ll * (7 * MiB / 2)), nullptr, 1.f);
                CONV((SrcWuq{INF(23) + (size_t)ll * 256 * 768}), 768, 256, 768, (bf16*)(ws + W_WUQ + (size_t)ll * 384 * 1024), INF(22) + ll * 256, QSCALE);
                CONV((SrcPlain{INF(25) + (size_t)ll * 128 * 1024}), 1024, 128, 1024, (bf16*)(ws + W_WUKV + (size_t)ll * 256 * 1024), INF(24) + ll * 128, 1.f);
                CONV((SrcPlain{INF(19) + (size_t)ll * 65536}), 256, 256, 256, (bf16*)(ws + W_GLUW + (size_t)ll * 128 * 1024), nullptr, 1.f);
            }
#undef CONV
            __syncthreads();
            { LAS float* T = (LAS float*)L; int rot = 0;
#define XPM(GU_, W0_, W1_, LD_, KK_, NN_, DST_) do { const int ni__ = ((KK_) / 64) * ((NN_) / 256); xp_matrix<GU_>(W0_, W1_, LD_, KK_, NN_, DST_, T, (bx + G - rot % G) % G, G, tid); rot += ni__; } while (0)
              for (int ll = 0; ll < 2; ++ll) XPM(false, INF(27) + (size_t)ll * DM * DM, nullptr, DM, DM, DM, (bf16*)(ws + W_WOUT + (size_t)ll * 2 * MiB));
              XPM(true, INF(28), INF(29), DFF, DM, 2 * DFF, (bf16*)(ws + W_FFUP));
              XPM(false, INF(30), nullptr, DM, DFF, DM, (bf16*)(ws + W_FFDN));
#if !MK_BG
              for (int e = 0; e < NE; ++e) {
                  XPM(true, INF(32) + (size_t)e * DM * DFF, INF(33) + (size_t)e * DM * DFF, DFF, DM, 2 * DFF, (bf16*)(ws + W_MOEUP) + (size_t)e * 2 * DFF * DM);
                  XPM(false, INF(34) + (size_t)e * DFF * DM, nullptr, DM, DFF, DM, (bf16*)(ws + W_MOEDN) + (size_t)e * DM * DFF); }
#endif
#undef XPM
            }
            { const int* pos = (const int*)INF(2); f32x2* cs = (f32x2*)(ws + W_CS);
              for (int it = gw; it < NTOK * 32 / 64; it += NGW) { const int idx = it * 64 + lane, row = idx >> 5, i = idx & 31;
                  const float inv = __builtin_amdgcn_exp2f(-(float)i * (13.287712379549449f / 32.0f)); const float ang = (float)pos[row] * inv;
                  const double rev = (double)ang * 0.15915494309189535; const float fr = (float)(rev - floor(rev));
                  cs[idx] = (f32x2){__builtin_amdgcn_cosf(fr), __builtin_amdgcn_sinf(fr)}; } }
            for (int ll = 0; ll < 2; ++ll) {
                const SsmPar P{INF(11) + ll * 1024, INF(12) + ll * 1024, INF(13) + ll * 16384, INF(14) + ll * 16384, INF(15) + ll * 16384, INF(16) + ll * 16384, INF(18) + ll * 16};
                bf16* mw = (bf16*)(ws + W_MW + (size_t)ll * 10 * MiB); bf16* we = (bf16*)(ws + W_WEND + (size_t)ll * 2 * MiB); f32x2* lc = (f32x2*)(ws + W_LAMC) + ll * 1024;
                for (int it = gw; it < 2032; it += NGW) {
                    if (it < 1008) ssm_unit_toep(P, mw, it / 63, it % 63, scr, lane);
                    else if (it < 1520) ssm_unit_cross(P, mw, lc, (it - 1008) >> 5, (it - 1008) & 31, lane);
                    else ssm_unit_end(P, we, (it - 1520) >> 5, (it - 1520) & 31, lane);
                }
            }
        } else if (k == 0 && PH_ON(1)) { LANEDEFS
            { const float* mp = (const float*)(ws + W_MODP);
              if (tid < 96) { const int idx = bx * 96 + tid, ll = idx / 12288, n = idx % 6144; float s = INF(4)[ll * 6144 + n];
#pragma unroll
                  for (int ks = 0; ks < 8; ++ks) s += mp[(size_t)ks * 24576 + idx];
                  MOD[idx] = s; }
              LAS float* ml = (LAS float*)L; const int b = (bx * 64) / SEQ;
              for (int n = tid; n < 2048; n += NWAVES * 64) { float s = INF(4)[n];
#pragma unroll
                  for (int ks = 0; ks < 8; ++ks) s += mp[(size_t)ks * 24576 + b * 6144 + n];
                  ml[n] = s; }
              __syncthreads(); }
            Row xpf0 = row_ld_f32(x_in + (size_t)(bx * 64 + wave * 8) * DM, lane);
            for (int i = 0; i < 8; ++i) { const int row = bx * 64 + wave * 8 + i; const float* md = (const float*)lds;
                const Row xr = xpf0; if (i + 1 < 8) xpf0 = row_ld_f32(x_in + (size_t)(row + 1) * DM, lane); (void)adaln(xr, INF(5) + l * DM, md + 1 * DM, md + 0 * DM, XN + (size_t)row * DM, lane); }
        } else if (k == 1 && PH_ON(2)) {
            pg8::Gemm g{DM, DM, DM}; pg8::TileOrder S; S.init(XN, DM, WIN, DM, 64, 7, G, bx);
            EpiWin E{RQ, RK, RKT, RVT, RG, UC, CQ, CKV, KPE, SSQQ, SSQKV, CS4};
            pg8::gemm_phase<EpiWin, pg8::TileOrder, true>(L, g, S, E);
            { pg8::Unit u2; if (!S.next(1, u2)) MOECONV(MK_Q2); }
        } else if (k == 2 && PH_ON(3)) {
            unsigned* ssmflag = (unsigned*)(ws + W_CTL) + 9216 + 64 * (l * 32);
            if (SUB_ON(0)) { pg8::Gemm g{256, 256, 256}; pg8::TileOrder S; S.init(CQ, 256, WUQ, 256, 64, 3, G, bx); EpiQup E{Qb, SSQQ, CS4}; pg8::gemm_phase<EpiQup, pg8::TileOrder, true, true>(L, g, S, E); }
            if (SUB_ON(1)) { pg8::Gemm g{128, 128, 128}; pg8::TileOrder S; S.init(CKV, 128, WUKV, 128, 64, 4, 192, bx < 192 ? bx : 256); EpiKVup E{KN, Vb, SSQKV}; pg8::gemm_phase<EpiKVup, pg8::TileOrder, true, true>(L, g, S, E); }
            if (SUB_ON(2) && bx >= 192) {
                const int i = bx - 192, gI = i >> 2, bI = (i >> 1) & 1, pnI = i & 1;
                const char* Ap = (const char*)UC + ((size_t)gI * SSM_NCH + (size_t)bI * 256) * SSM_K * 2;
                { pg8::Gemm g{SSM_K, 512, 512}; pg8::OneUnit S; S.has = true; S.u.pA = Ap; S.u.pB = (const char*)WEND + (size_t)gI * 128 * 512 * 2; S.u.pm = gI * 2 + bI; S.u.pn = 0;
                  EpiSsmE E{UC, LAMC, ssmflag + 64 * i}; pg8::gemm_phase<EpiSsmE, pg8::OneUnit, false, true>(L, g, S, E); }
                { pg8::Gemm g{SSM_K, SSM_K, SSM_K}; pg8::OneUnit S; S.has = true; S.u.pA = Ap; S.u.pB = (const char*)MW + ((size_t)gI * 512 + (size_t)pnI * 256) * SSM_K * 2; S.u.pm = gI * 2 + bI; S.u.pn = pnI;
                  EpiSsmZ E{GB, UC, INF(17) + l * 256}; pg8::gemm_phase<EpiSsmZ, pg8::OneUnit, false, true>(L, g, S, E); } }
            if (SUB_ON(3)) { LANEDEFS const ret::Tensors T{RQ, RK, RKT, RVT, RG, KVT, STATE, MIX, INF(10) + l * 256};
              for (int u = gw; u < 1024; u += NGW) ret::x_unit(u, T, lane); }
            if (bx < 192) MOECONV(MK_Q3);
        } else if (k == 3 && PH_ON(4)) { LANEDEFS
            { const ret::Tensors T{RQ, RK, RKT, RVT, RG, KVT, STATE, MIX, INF(10) + l * 256}; ret::scan_wg(bx * 128, T, (float*)lds, tid); }
            __syncthreads();
            { const att::Tensors T{Qb, KN, KPE, Vb, Ob}; const int bh = vcu >> 5, xx = vcu & 31;
              att::attn_unit(bh >> 2, bh & 3, 63 - xx, T, (char*)lds); att::attn_unit(bh >> 2, bh & 3, xx, T, (char*)lds); }
        } else if (k == 4 && PH_ON(5)) {
            LANEDEFS
            if (SUB_ON(5) && wave < 4) { const ret::Tensors T{RQ, RK, RKT, RVT, RG, KVT, STATE, MIX, INF(10) + l * 256}; ret::z_unit(bx + 256 * wave, T, lane); }
            if (SUB_ON(4) && (wave == 4 || wave == 5)) glu_unit(bx + 256 * (wave - 4), GB, GLUW, INF(20) + l * 256, INF(21) + l * 256, MIX, lane);
            if (SUB_ON(6)) { const int nr = wave < 4 ? 5 : (wave < 6 ? 7 : 15), r0 = bx * 64 + (wave < 4 ? wave * 5 : (wave < 6 ? 20 + (wave - 4) * 7 : 34 + (wave - 6) * 15));
              u32x4 wpf = *(const u32x4*)(Ob + (size_t)r0 * 512 + 8 * lane);
              for (int i = 0; i < nr; ++i) { const int row = r0 + i; const u32x4 w = wpf; if (i + 1 < nr) wpf = *(const u32x4*)(Ob + (size_t)(row + 1) * 512 + 8 * lane);
                const f32x4 a = {bflo(w.x), bfhi(w.x), bflo(w.y), bfhi(w.y)}, c = {bflo(w.z), bfhi(w.z), bflo(w.w), bfhi(w.w)};
                float ss = (a[0] * a[0] + a[1] * a[1]) + (a[2] * a[2] + a[3] * a[3]) + (c[0] * c[0] + c[1] * c[1]) + (c[2] * c[2] + c[3] * c[3]); ss = wave_sum(ss);
                const float rstd = __builtin_amdgcn_rsqf(ss * (1.f / 512.f) + EPS); const float* gn = INF(26) + l * 512 + 8 * lane;
                st16(MIX + (size_t)row * DM + 512 + 8 * lane, a * rstd * *(const f32x4*)gn, c * rstd * *(const f32x4*)(gn + 4)); } }
        } else if (k == 6 && PH_ON(7)) {
            pg8::Gemm g{DM, DM, DM}; pg8::TileOrder S; S.init(MIX, DM, WOUT, DM, 64, 4, G, bx); EpiStore E{Yb, DM, nullptr, 0};
            pg8::gemm_phase<EpiStore, pg8::TileOrder, false>(L, g, S, E);
        } else if (k == 7 && PH_ON(8)) { LANEDEFS
            LAS int* cnt = (LAS int*)L;
            if (l == 1) { if (tid < 8) cnt[tid] = 0; __syncthreads(); }
            const float* xsrc = l == 0 ? x_in : out;
            Row xpf = row_ld_f32(xsrc + (size_t)(bx * 64 + wave * 8) * DM, lane), ypf = row_ld_bf16(Yb + (size_t)(bx * 64 + wave * 8) * DM, lane);
            for (int i = 0; i < 8; ++i) { const int row = bx * 64 + wave * 8 + i, b = row / SEQ; const float* md = modl + b * 6144;
                const Row xr = xpf, yr = ypf;
                if (i + 1 < 8) { xpf = row_ld_f32(xsrc + (size_t)(row + 1) * DM, lane); ypf = row_ld_bf16(Yb + (size_t)(row + 1) * DM, lane); }
                const Row x1 = resid(xr, yr, INF(6) + l * DM, md + 2 * DM, out + (size_t)row * DM, lane);
                const Row h = adaln(x1, INF(7) + l * DM, md + 4 * DM, md + 3 * DM, XN + (size_t)row * DM, lane);
                if (l == 1) { int e1, e2; float w1, w2; route(h, INF(31), lane, e1, e2, w1, w2);
                    if (lane == 0) { TOPI[row * 2] = e1; TOPI[row * 2 + 1] = e2; TOPW[row * 2] = w1; TOPW[row * 2 + 1] = w2; __hip_atomic_fetch_add(&cnt[e1], 1, __ATOMIC_RELAXED, __HIP_MEMORY_SCOPE_WORKGROUP); __hip_atomic_fetch_add(&cnt[e2], 1, __ATOMIC_RELAXED, __HIP_MEMORY_SCOPE_WORKGROUP); } } }
            if (l == 1) { __syncthreads(); if (tid < 8) WGCNT[bx * 8 + tid] = cnt[tid]; }
        } else if (k == 8 && PH_ON(9)) { LANEDEFS
            MOECONV(1 << 30);
            __syncthreads();
            LAS int* sc = (LAS int*)L;
            for (int i = tid; i < 2048; i += NWAVES * 64) sc[i] = WGCNT[i];
            __syncthreads();
            { const int e = wave; int base = 0, tot = 0;
#pragma unroll
              for (int q = 0; q < 4; ++q) { const int w = q * 64 + lane; const int c = sc[w * 8 + e]; base += (w < bx) ? c : 0; tot += c; }
#pragma unroll
              for (int o = 1; o < 64; o <<= 1) { base += __shfl_xor(base, o); tot += __shfl_xor(tot, o); }
              if (lane == 0) { sc[2048 + e] = base; sc[2064 + e] = tot; } }
            __syncthreads();
            if (tid == 0) { int st = 0, nt = 0;
#pragma unroll 1
                for (int e = 0; e < 8; ++e) { sc[2056 + e] = st; const int t = (sc[2064 + e] + 255) >> 8; if (bx == 0) for (int q = 0; q < t; ++q) TILE[16 + nt + q] = e; nt += t; st += t << 8; } if (bx == 0) TILE[0] = nt; }
            __syncthreads();
            if (wave == 0) { const int row = bx * 64 + lane; const int e1 = TOPI[row * 2], e2 = TOPI[row * 2 + 1]; int p1 = 0, p2 = 0;
                const unsigned long long lt = (1ull << lane) - 1ull;
#pragma unroll
                for (int e = 0; e < 8; ++e) { const unsigned long long m1 = __ballot(e1 == e), m2 = __ballot(e2 == e); const int r = __popcll(m1 & lt) + __popcll(m2 & lt) + sc[2056 + e] + sc[2048 + e];
                    if (e1 == e) p1 = r; if (e2 == e) p2 = r; }
                sc[2080 + lane * 2] = p1; sc[2080 + lane * 2 + 1] = p2; TPOS[row * 2] = p1; TPOS[row * 2 + 1] = p2; ROWW[p1] = TOPW[row * 2]; ROWW[p2] = TOPW[row * 2 + 1]; }
            __syncthreads();
#pragma unroll
            for (int i0 = 0; i0 < 8; i0 += 4) { u32x4 a[4], c[4];
#pragma unroll
                for (int i = 0; i < 4; ++i) { const int row = bx * 64 + wave * 8 + i0 + i; a[i] = *(const u32x4*)(XN + (size_t)row * DM + 8 * lane); c[i] = *(const u32x4*)(XN + (size_t)row * DM + 512 + 8 * lane); }
#pragma unroll
                for (int i = 0; i < 4; ++i) { const int lr = wave * 8 + i0 + i; const int p1 = sc[2080 + lr * 2], p2 = sc[2080 + lr * 2 + 1];
                    *(u32x4*)(XG + (size_t)p1 * DM + 8 * lane) = a[i]; *(u32x4*)(XG + (size_t)p1 * DM + 512 + 8 * lane) = c[i];
                    *(u32x4*)(XG + (size_t)p2 * DM + 8 * lane) = a[i]; *(u32x4*)(XG + (size_t)p2 * DM + 512 + 8 * lane) = c[i]; } }
            if (bx < 8) { const int tot = sc[2064 + bx], st = sc[2056 + bx], pe = st + (((tot + 255) >> 8) << 8);
                for (int r = st + tot + wave; r < pe; r += NWAVES) { const u32x4 z = {0u, 0u, 0u, 0u}; *(u32x4*)(XG + (size_t)r * DM + 8 * lane) = z; *(u32x4*)(XG + (size_t)r * DM + 512 + 8 * lane) = z; if (lane == 0) ROWW[r] = 0.f; } }
        } else if (k == 9 && PH_ON(10)) {
            pg8::Gemm g{DM, DM, DM}; pg8::TileOrder S;
            if (l == 0) S.init(XN, DM, (bf16*)(ws + W_FFUP), DM, 64, 28, G, bx);
            else { S.init(XG, DM, (bf16*)(ws + W_MOEUP), DM, TILE[0], 28, G, bx); S.texp = TILE + 16; S.b_e = (size_t)2 * DFF * DM * 2; }
            EpiSwiglu E{l == 0 ? HB : HBM};
            pg8::gemm_phase<EpiSwiglu, pg8::TileOrder, true>(L, g, S, E);
        } else if (k == 10 && PH_ON(11)) {
            pg8::Gemm g{DFF, DFF, DFF}; pg8::TileOrder S; EpiStore E{Yb, DM, nullptr, 0};
            if (l == 0) S.init(HB, DFF, (bf16*)(ws + W_FFDN), DFF, 64, 4, G, bx);
            else { S.init(HBM, DFF, (bf16*)(ws + W_MOEDN), DFF, 128, 4, G, bx); S.texp = TILE + 16; S.b_e = (size_t)DM * DFF * 2; E.O = XG; E.rowscale = ROWW; }
            pg8::gemm_phase<EpiStore, pg8::TileOrder, true>(L, g, S, E);
            if (l == 1) {
                const int ntail = TILE[0] - 128;
                if (ntail > 0) { pg8::Gemm g2{DFF, DFF, DFF / 4}; pg8::TileOrder S2; S2.init(HBM + (size_t)32768 * DFF, DFF, (bf16*)(ws + W_MOEDN), DFF, ntail, 4, G, bx); S2.texp = TILE + 16 + 128; S2.b_e = (size_t)DM * DFF * 2;
                    S2.split_k(4, (size_t)(DFF / 4) * 2); EpiStore E2{(bf16*)(ws + W_Y2B), DM, ROWW + 32768, (size_t)7 * 256 * DM};
                    pg8::gemm_phase<EpiStore, pg8::TileOrder, true>(L, g2, S2, E2); } }
        } else if (k == 11 && PH_ON(12)) { LANEDEFS
            const bf16* Y2B = (const bf16*)(ws + W_Y2B);
#define LDP(P_, DST_) do { const int p_ = __builtin_amdgcn_readfirstlane(P_); if (p_ < 32768) DST_ = row_ld_bf16(XG + (size_t)p_ * DM, lane); else { const bf16* t_ = Y2B + (size_t)(p_ - 32768) * DM; \
                const Row a_ = row_ld_bf16(t_, lane), b_ = row_ld_bf16(t_ + (size_t)7 * 256 * DM, lane), c_ = row_ld_bf16(t_ + (size_t)14 * 256 * DM, lane), d_ = row_ld_bf16(t_ + (size_t)21 * 256 * DM, lane); \
                _Pragma("unroll") for (int j = 0; j < 4; ++j) DST_.v[j] = (a_.v[j] + b_.v[j]) + (c_.v[j] + d_.v[j]); } } while (0)
#define LDY(ROW_, DST_) do { if (l == 0) DST_ = row_ld_bf16(Yb + (size_t)(ROW_) * DM, lane); else { Row ya, yb; LDP(TPOS[(ROW_) * 2], ya); LDP(TPOS[(ROW_) * 2 + 1], yb); \
                _Pragma("unroll") for (int j = 0; j < 4; ++j) DST_.v[j] = ya.v[j] + yb.v[j]; } } while (0)
            Row xpf = row_ld_f32(out + (size_t)(bx * 64 + wave * 8) * DM, lane), ypf; LDY(bx * 64 + wave * 8, ypf);
            for (int i = 0; i < 8; ++i) { const int row = bx * 64 + wave * 8 + i, b = row / SEQ; const float* md = modl + b * 6144;
                const Row xr = xpf, yr = ypf;
                if (i + 1 < 8) { xpf = row_ld_f32(out + (size_t)(row + 1) * DM, lane); LDY(row + 1, ypf); }
                const Row x2 = resid(xr, yr, INF(8) + l * DM, md + 5 * DM, out + (size_t)row * DM, lane);
                if (l == 0) { const float* md1 = MOD + 2 * 6144 + b * 6144; (void)adaln(x2, INF(5) + DM, md1 + 1 * DM, md1 + 0 * DM, XN + (size_t)row * DM, lane); } }
#undef LDY
#undef LDP
        }
        bool more = false; for (int q = ph + 1; q < args.ph_hi; ++q) more |= phase_active(q);
        if (more) xcd_barrier(bar);
        if (MK_REP_MASK != 0) { if ((((unsigned)MK_REP_MASK >> ph) & 1u) && repcnt + 1 < MK_REP_N) { ++repcnt; --ph; } else repcnt = 0; }
    }
#undef INF
#undef MOECONV
#undef LANEDEFS
#undef MOD
#undef Qb
#undef Vb
#undef Ob
#undef Yb
#undef out
#undef modl
}
}
#ifndef MK_COOP
#define MK_COOP true
#endif
#ifndef MK_PER_PHASE
#define MK_PER_PHASE 0
#endif
static int mk_setup() {
    static int grid = 0;
    if (grid == 0) {
        int dev = 0, cus = 0, per_cu = 0;
        if (hipGetDevice(&dev) != hipSuccess || hipDeviceGetAttribute(&cus, hipDeviceAttributeMultiprocessorCount, dev) != hipSuccess) { fprintf(stderr, "kernel_launch: device query failed\n"); grid = -1; return grid; }
        if (hipFuncSetAttribute((const void*)mk::mk_fwd, hipFuncAttributeMaxDynamicSharedMemorySize, mk::LDS_BYTES) != hipSuccess) { fprintf(stderr, "kernel_launch: hipFuncSetAttribute failed\n"); grid = -1; return grid; }
        if (hipOccupancyMaxActiveBlocksPerMultiprocessor(&per_cu, (const void*)mk::mk_fwd, mk::NWAVES * 64, mk::LDS_BYTES) != hipSuccess || per_cu < 1) fprintf(stderr, "kernel_launch: occupancy query reports %d blocks per CU\n", per_cu);
        (void)hipGetLastError();
        grid = cus;
        if (grid != 256) fprintf(stderr, "kernel_launch: this kernel is written for a 256-CU device (got %d)\n", grid);
    }
    return grid;
}
static void mk_launch(void* const* d_in, void* d_out, void* d_ws, hipStream_t stream, int lo, int hi, bool coop) {
    const int grid = mk_setup(); if (grid <= 0) return;
    mk::Args a{};
    for (int i = 0; i < 35; ++i) a.in[i] = d_in[i];
    a.out = (float*)d_out; a.ws = (unsigned char*)d_ws; a.ph_lo = lo; a.ph_hi = hi; a.never = 0; a.pad = 0;
    if (coop) { void* args[] = {&a}; hipError_t e = hipLaunchCooperativeKernel((const void*)mk::mk_fwd, dim3(grid), dim3(mk::NWAVES * 64), args, mk::LDS_BYTES, stream);
        if (e != hipSuccess) fprintf(stderr, "cooperative launch failed: %s (grid %d)\n", hipGetErrorString(e), grid); }
    else hipLaunchKernelGGL(mk::mk_fwd, dim3(grid), dim3(mk::NWAVES * 64), mk::LDS_BYTES, stream, a);
}
extern "C" void kernel_launch(void* const* d_in, const int* in_sizes, int n_in, void* d_out, int out_size, void* d_ws, size_t ws_size, hipStream_t stream) {
    (void)in_sizes; (void)n_in; (void)out_size;
    if (ws_size < mk::W_END) { fprintf(stderr, "kernel_launch: workspace too small (%zu < %zu)\n", ws_size, (size_t)mk::W_END); return; }
    (void)hipMemsetAsync((char*)d_ws + mk::W_CTL, 0, mk::CTL_ZERO_BYTES, stream);
#if MK_PER_PHASE
    for (int ph = 0; ph < mk::NPHASE; ++ph) mk_launch(d_in, d_out, d_ws, stream, ph, ph + 1, false);
#else
    mk_launch(d_in, d_out, d_ws, stream, 0, mk::NPHASE, MK_COOP);
#endif
}
```

```cpp
#include <hip/hip_runtime.h>
#include <stdint.h>
#include <math.h>
#include <cstdio>
#include <hip/hip_cooperative_groups.h>
#define GAS __attribute__((address_space(1)))
#define LAS __attribute__((address_space(3)))
namespace mk {
typedef unsigned short bf16;
typedef short bf16x8 __attribute__((ext_vector_type(8)));
typedef short s16x4 __attribute__((ext_vector_type(4)));
typedef float f32x2 __attribute__((ext_vector_type(2)));
typedef float f32x4 __attribute__((ext_vector_type(4)));
typedef float f32x16 __attribute__((ext_vector_type(16)));
typedef unsigned u32x2 __attribute__((ext_vector_type(2)));
typedef unsigned u32x4 __attribute__((ext_vector_type(4)));
typedef __bf16 bf16x2_t __attribute__((ext_vector_type(2)));
typedef GAS unsigned gu32;
#define RLX_AGENT __ATOMIC_RELAXED, __HIP_MEMORY_SCOPE_AGENT
__device__ __forceinline__ unsigned cvtpk(float lo, float hi) { f32x2 v = {lo, hi}; bf16x2_t b = __builtin_convertvector(v, bf16x2_t); return __builtin_bit_cast(unsigned, b); }
__device__ __forceinline__ float bf2f(unsigned short b) { return __builtin_bit_cast(float, (unsigned)b << 16); }
__device__ __forceinline__ float bflo(unsigned w) { return __builtin_bit_cast(float, w << 16); }
__device__ __forceinline__ float bfhi(unsigned w) { return __builtin_bit_cast(float, w & 0xffff0000u); }
__device__ __forceinline__ float wave_sum(float v) {
#pragma unroll
    for (int o = 1; o < 64; o <<= 1) v += __shfl_xor(v, o);
    return v;
}
__device__ __forceinline__ float fast_sigmoid(float z) { return __builtin_amdgcn_rcpf(1.f + __builtin_amdgcn_exp2f(-1.4426950408889634f * z)); }
__device__ __forceinline__ float silu_fast(float v) { return v * fast_sigmoid(v); }
__device__ __forceinline__ float gelu_tanh_fast(float x) { const float a = 0.7978845608028654f * (x + 0.044715f * x * x * x); return x * fast_sigmoid(2.f * a); }

constexpr int NB = 2, SEQ = 8192, NTOK = 16384, DM = 1024, INC = 1728, INCP = 1792, DFF = 3584, NE = 8, NWAVES = 8;
constexpr float EPS = 1e-6f;
constexpr int SSM_C = 32, SSM_NCH = NTOK / SSM_C  , SSM_K = 640;
constexpr int RET_C = 64, RET_NCH = SEQ / RET_C  ;
constexpr int MOE_MAXT = 136;
constexpr float QSCALE = 0.07216878364870322f * 1.4426950408889634f;

#define XB_TMO      128
#define XB_XCNT(j)  (256  + 64 * (j))
#define XB_XSUB(j)  (1280 + 64 * (j))
#define XB_XGEN(j)  (2304 + 64 * (j))
#define XB_TOP      3328
#define XB_TOPGEN   3392
#define XCD_BAR_WORDS 3456
#define XB_SPIN_CAP (1u << 20)
__device__ __forceinline__ unsigned xb_ld(unsigned* p)              { return __hip_atomic_load(p, __ATOMIC_RELAXED, __HIP_MEMORY_SCOPE_AGENT); }
__device__ __forceinline__ unsigned xb_add(unsigned* p, unsigned v) { return __hip_atomic_fetch_add(p, v, __ATOMIC_RELAXED, __HIP_MEMORY_SCOPE_AGENT); }
__device__ __forceinline__ unsigned xb_xcc_id() { return (unsigned)__builtin_amdgcn_s_getreg((3 << 11) | 20) & 0xFu; }
#define XB_SPIN(cond, bar) do { unsigned _sp = 0; while (cond) { __builtin_amdgcn_s_sleep(1); \
    if ((++_sp & 255u) == 0u) { if (xb_ld(&(bar)[XB_TMO])) break; if (_sp > XB_SPIN_CAP) { atomicAdd(&(bar)[XB_TMO], 1u); break; } } } } while (0)
struct XcdBarrier { unsigned* bar; unsigned x; volatile LAS unsigned* st; };
__device__ __forceinline__ XcdBarrier xcd_barrier_post(unsigned* bar, volatile LAS unsigned* st) {
    XcdBarrier b; b.bar = bar; b.x = xb_xcc_id(); b.st = st;
    if (threadIdx.x == 0) (void)xb_add(&bar[XB_XCNT(b.x)], 1u);
    return b;
}
__device__ __forceinline__ void xcd_barrier_complete(unsigned* bar, unsigned x, unsigned& nloc, unsigned& nx) {
    const unsigned G = gridDim.x * gridDim.y * gridDim.z;
    unsigned sum, cnt, mine, sp = 0u;
    for (;;) {
        sum = 0u; cnt = 0u; mine = 0u;
#pragma unroll
        for (unsigned j = 0; j < 16; ++j) { const unsigned c = xb_ld(&bar[XB_XCNT(j)]); sum += c; cnt += (c > 0u) ? 1u : 0u; mine = (j == x) ? c : mine; }
        if (sum == G) break;
        __builtin_amdgcn_s_sleep(1);
        if ((++sp & 255u) == 0u) { if (xb_ld(&bar[XB_TMO])) break; if (sp > XB_SPIN_CAP) { atomicAdd(&bar[XB_TMO], 1u); break; } }
    }
    nloc = mine > 0u ? mine : 1u; nx = cnt > 0u ? cnt : 1u;
}
__device__ __forceinline__ void xcd_barrier(const XcdBarrier& b) {
    asm volatile("s_waitcnt vmcnt(0)" ::: "memory");
    __syncthreads();
    if (threadIdx.x == 0) {
        unsigned* bar = b.bar;
        __builtin_amdgcn_s_waitcnt(0);
        unsigned nloc = b.st[0], nx = b.st[1];
        if (nloc == 0u) { xcd_barrier_complete(bar, b.x, nloc, nx); b.st[0] = nloc; b.st[1] = nx; }
        const unsigned old = xb_add(&bar[XB_XSUB(b.x)], 1u);
        const unsigned gen = old / nloc;
        if (old + 1u == (gen + 1u) * nloc) {
            __builtin_amdgcn_fence(__ATOMIC_RELEASE, "agent");
            asm volatile("s_waitcnt vmcnt(0)" ::: "memory");
            const unsigned og = xb_add(&bar[XB_TOP], 1u);
            const unsigned tg = og / nx;
            if (og + 1u == (tg + 1u) * nx) xb_add(&bar[XB_TOPGEN], 1u);
            else XB_SPIN(xb_ld(&bar[XB_TOPGEN]) == tg, bar);
            __builtin_amdgcn_fence(__ATOMIC_ACQUIRE, "agent");
            xb_add(&bar[XB_XGEN(b.x)], 1u);
            asm volatile("s_waitcnt vmcnt(0)" ::: "memory");
        } else {
            XB_SPIN(xb_ld(&bar[XB_XGEN(b.x)]) == gen, bar);
            __builtin_amdgcn_fence(__ATOMIC_ACQUIRE, "agent");
            asm volatile("s_waitcnt vmcnt(0)" ::: "memory");
        }
    }
    __syncthreads();
}
}
#ifndef MK_WGM
#define MK_WGM 8
#endif
namespace pg8 {
#define PG8_LAS __attribute__((address_space(3)))
typedef unsigned short bf16_t;
typedef short bf16x8 __attribute__((ext_vector_type(8)));
typedef float f32x4 __attribute__((ext_vector_type(4)));
typedef unsigned u32x4 __attribute__((ext_vector_type(4)));
constexpr int BM = 256, BK = 64, HALF = 128, HTB = HALF * BK * 2, STAGE_BYTES = 8 * HTB, NXCD = 8, WGM = MK_WGM;
__host__ __device__ __forceinline__ int lds_byte(int r, int c) { const int st = (r >> 4) * 2 + (c >> 5), rr = r & 15, cc = c & 31, ob = rr * 64 + cc * 2; return st * 1024 + (ob ^ (((ob >> 9) & 1) << 5)); }
__host__ __device__ __forceinline__ void stage_rc(int b, int& R, int& C) { const int st = b / 1024, sb = b % 1024, swz = sb ^ (((sb >> 9) & 1) << 5); R = (st >> 1) * 16 + swz / 64; C = (st & 1) * 32 + (swz % 64) / 2; }
__host__ __device__ __forceinline__ int perm32(int rho) { const int n = rho >> 4, i = rho & 15; return 8 * (i >> 2) + 4 * n + (i & 3); }
struct Unit { const char* pA; const char* pB; int pm, pn; };
struct Gemm { int lda, ldb, K; };
struct TileOrder {
    static constexpr bool KHOOK = false;
    const char* A; const char* Bt; size_t a_t, b_t, b_e, k_off; const int* texp; int nM, nN, nN0, nwg, G, c;
    __device__ __forceinline__ void init(const void* A_, int lda, const void* Bt_, int ldb, int nM_, int nN_, int G_, int c_) {
        A = (const char*)A_; Bt = (const char*)Bt_; a_t = (size_t)BM * lda * 2; b_t = (size_t)BM * ldb * 2; b_e = 0; k_off = 0; texp = nullptr; nM = nM_; nN = nN_; nN0 = nN_; nwg = nM * nN; G = G_; c = c_; }
    __device__ __forceinline__ void split_k(int ks, size_t k_off_) { nN0 = nN; nN = nN * ks; nwg = nM * nN; k_off = k_off_; }
    __device__ __forceinline__ bool next(int i, Unit& u) const {
        const long L = (long)i * G + c; if (L >= nwg) return false;
        int wgid = (int)L; { const int q = nwg / NXCD, r = nwg % NXCD, xcd = wgid % NXCD, off = wgid / NXCD; wgid = (xcd < r ? xcd * (q + 1) : r * (q + 1) + (xcd - r) * q) + off; }
        const int nig = WGM * nN, gid = wgid / nig, fm = gid * WGM, gsz = (nM - fm) < WGM ? (nM - fm) : WGM;
        u.pm = fm + ((wgid % nig) % gsz); u.pn = (wgid % nig) / gsz;
        const int ks = u.pn / nN0, pn0 = u.pn - ks * nN0;
        u.pA = A + (size_t)u.pm * a_t + (size_t)ks * k_off; u.pB = Bt + (size_t)pn0 * b_t + (size_t)ks * k_off + (texp ? (size_t)texp[u.pm] * b_e : (size_t)0); return true;
    }
    __device__ __forceinline__ void a_ready(const Unit&) const {}
    __device__ __forceinline__ void done(const Unit&) const {}
};
struct GroupOrder {
    static constexpr bool KHOOK = false;
    const char* A; const char* Bt; size_t a_t, b_t, a_g, b_g; int nM, nN, nwg, G, c;
    __device__ __forceinline__ void init(const void* A_, int lda, size_t a_g_, const void* Bt_, int ldb, size_t b_g_, int ng, int nM_, int nN_, int G_, int c_) {
        A = (const char*)A_; Bt = (const char*)Bt_; a_t = (size_t)BM * lda * 2; b_t = (size_t)BM * ldb * 2; a_g = a_g_; b_g = b_g_; nM = nM_; nN = nN_; nwg = ng * nM * nN; G = G_; c = c_; }
    __device__ __forceinline__ bool next(int i, Unit& u) const {
        const long L = (long)i * G + c; if (L >= nwg) return false;
        const int per = nM * nN, g = (int)L / per, r = (int)L % per, pm = r / nN, pn = r % nN;
        u.pm = g * nM + pm; u.pn = pn; u.pA = A + (size_t)g * a_g + (size_t)pm * a_t; u.pB = Bt + (size_t)g * b_g + (size_t)pn * b_t; return true;
    }
    __device__ __forceinline__ void a_ready(const Unit&) const {}
    __device__ __forceinline__ void done(const Unit&) const {}
};
struct OneUnit {
    static constexpr bool KHOOK = false;
    Unit u; bool has;
    __device__ __forceinline__ bool next(int i, Unit& o) const { if (i > 0 || !has) return false; o = u; return true; }
    __device__ __forceinline__ void a_ready(const Unit&) const {}
    __device__ __forceinline__ void done(const Unit&) const {}
};
struct OneUnitHook {
    static constexpr bool KHOOK = true;
    Unit u; bool has; int hook_t; unsigned* flag; unsigned need; unsigned* tmo;
    __device__ __forceinline__ bool next(int i, Unit& o) const { if (i > 0 || !has) return false; o = u; return true; }
    __device__ __forceinline__ void a_ready(const Unit&) const {}
    __device__ __forceinline__ void done(const Unit&) const {}
    __device__ __forceinline__ void khook() const {
        if (threadIdx.x < 64) {
            const unsigned long long t0 = __builtin_amdgcn_s_memrealtime();
            while ((unsigned)__builtin_amdgcn_readfirstlane(__hip_atomic_load(flag, __ATOMIC_RELAXED, __HIP_MEMORY_SCOPE_AGENT)) < need) {
                if (__builtin_amdgcn_s_memrealtime() - t0 > 2000000ull) { if (threadIdx.x == 0) __hip_atomic_store(tmo, 1u, __ATOMIC_RELAXED, __HIP_MEMORY_SCOPE_AGENT); break; }
                __builtin_amdgcn_s_sleep(2); }
            __builtin_amdgcn_fence(__ATOMIC_ACQUIRE, "agent");
            asm volatile("s_waitcnt vmcnt(0)" ::: "memory");
        }
        asm volatile("" ::: "memory"); __builtin_amdgcn_s_barrier(); asm volatile("" ::: "memory");
    }
};
template <class Epi, class Sched, bool ALIGN_EPI = false, bool SMALLK = false>
__device__ __forceinline__ void gemm_phase(PG8_LAS unsigned char* lds, const Gemm g, const Sched& S, const Epi& E) {
    int tid_ = threadIdx.x; asm volatile("" : "+v"(tid_));
    const int tid = tid_, wid = __builtin_amdgcn_readfirstlane(tid >> 6), lane = tid & 63, wr = wid >> 2, wc = wid & 3, fr = lane & 15, fq = lane >> 4;
    int K_ = g.K; if constexpr (SMALLK) asm volatile("" : "+s"(K_));
    const int K = K_, nt = K / BK, lda = g.lda, ldb = g.ldb;
    unsigned voffA[2], voffB[2];
#pragma unroll
    for (int i = 0; i < 2; ++i) { int R, C; stage_rc(tid * 16 + i * 8192, R, C); const int Rb = Epi::PERM ? ((R & ~31) + perm32(R & 31)) : R;
        voffA[i] = (unsigned)(R * lda + C) * 2u; voffB[i] = (unsigned)(Rb * ldb + C) * 2u; }
    const size_t kstep = (size_t)(BK * 2);
    const size_t hstepA = (size_t)HALF * lda * 2, hstepB = (size_t)HALF * ldb * 2;
    const unsigned ldsw = (unsigned)wid * 1024u;
    const int aoff = lds_byte(wr * 64 + fr, fq * 8), boff = lds_byte(wc * 32 + fr, fq * 8);
#define PG8_SA(b, h) (((b) * 2 + (h)) * HTB)
#define PG8_SB(b, h) ((4 + (b) * 2 + (h)) * HTB)
#define PG8_STAGE(bufoff, gbase, voff) do { _Pragma("unroll") for (int _i = 0; _i < 2; ++_i) \
        __builtin_amdgcn_global_load_lds((const unsigned*)((const char*)(gbase) + (voff)[_i]), (PG8_LAS unsigned*)(lds + (bufoff) + ldsw + _i * 8192), 16, 0, 0); } while (0)
#define PG8_LDA(dst, b, h) do { _Pragma("unroll") for (int m = 0; m < 4; ++m) _Pragma("unroll") for (int k = 0; k < 2; ++k) dst[m][k] = *(const PG8_LAS bf16x8*)(lds + PG8_SA(b, h) + aoff + m * 2048 + k * 1024); } while (0)
#define PG8_LDB(dst, b, h) do { _Pragma("unroll") for (int n = 0; n < 2; ++n) _Pragma("unroll") for (int k = 0; k < 2; ++k) dst[n][k] = *(const PG8_LAS bf16x8*)(lds + PG8_SB(b, h) + boff + n * 2048 + k * 1024); } while (0)
#define PG8_MMA(ai, bj, At, Bt) do { __builtin_amdgcn_s_setprio(1); _Pragma("unroll") for (int m = 0; m < 4; ++m) _Pragma("unroll") for (int n = 0; n < 2; ++n) _Pragma("unroll") for (int k = 0; k < 2; ++k) \
        acc[ai][bj][m][n] = __builtin_amdgcn_mfma_f32_16x16x32_bf16(Bt[n][k], At[m][k], acc[ai][bj][m][n], 0, 0, 0); __builtin_amdgcn_s_setprio(0); } while (0)
#define PG8_WAIT_V(n) asm volatile("s_waitcnt vmcnt(" #n ")" ::: "memory")
#define PG8_WAIT_L(n) asm volatile("s_waitcnt lgkmcnt(" #n ")" ::: "memory")
#define PG8_BAR __builtin_amdgcn_s_barrier()
#define PG8_SCHED __builtin_amdgcn_sched_barrier(0)
    Unit cur, nxt; int ui = 0;
    if (!S.next(0, cur)) return;
    f32x4 acc[2][2][4][2];
#pragma unroll
    for (int a = 0; a < 2; ++a)
#pragma unroll
        for (int b = 0; b < 2; ++b)
#pragma unroll
            for (int m = 0; m < 4; ++m)
#pragma unroll
                for (int n = 0; n < 2; ++n) acc[a][b][m][n] = (f32x4){0.f, 0.f, 0.f, 0.f};
    bf16x8 At[4][2], B0[2][2], B1[2][2];
    const char* cA = cur.pA; const char* cB = cur.pB;
    S.a_ready(cur);
    {
        PG8_STAGE(PG8_SB(0, 0), cB, voffB); PG8_STAGE(PG8_SB(0, 1), cB + hstepB, voffB); PG8_STAGE(PG8_SA(0, 0), cA, voffA); PG8_STAGE(PG8_SA(0, 1), cA + hstepA, voffA);
        if (wr == 1) PG8_BAR;
        PG8_WAIT_V(2); PG8_BAR;
        PG8_STAGE(PG8_SB(1, 0), cB + kstep, voffB); PG8_STAGE(PG8_SA(1, 0), cA + kstep, voffA); PG8_STAGE(PG8_SB(1, 1), cB + hstepB + kstep, voffB);
        PG8_WAIT_V(6); PG8_BAR;
    }
    for (;;) {
        const bool has_next = S.next(ui + 1, nxt);
        const char* nA = has_next ? nxt.pA : cA; const char* nB = has_next ? nxt.pB : cB;
        for (int t = 0; t < nt; t += 2) {
            const bool last = (t == nt - 2);
            const char* a1 = cA + (size_t)(t + 1) * kstep;
            const char* a2 = last ? nA : cA + (size_t)(t + 2) * kstep; const char* b2 = last ? nB : cB + (size_t)(t + 2) * kstep;
            const char* a3 = a2 + kstep; const char* b3 = b2 + kstep;
            if (last && has_next) S.a_ready(nxt);
            if constexpr (Sched::KHOOK) { if (t == S.hook_t) S.khook(); }
            {
            PG8_LDB(B0, 0, 0); PG8_LDB(B1, 0, 1); PG8_SCHED; PG8_LDA(At, 0, 0); PG8_STAGE(PG8_SA(1, 1), a1 + hstepA, voffA);
            PG8_WAIT_V(8); PG8_WAIT_L(0); PG8_BAR; PG8_MMA(0, 0, At, B0); PG8_MMA(0, 1, At, B1); PG8_BAR; PG8_SCHED;
            PG8_LDA(At, 0, 1); PG8_STAGE(PG8_SB(0, 0), b2, voffB); PG8_STAGE(PG8_SB(0, 1), b2 + hstepB, voffB); PG8_STAGE(PG8_SA(0, 0), a2, voffA);
            PG8_WAIT_V(8); PG8_WAIT_L(0); PG8_BAR; PG8_MMA(1, 0, At, B0); PG8_MMA(1, 1, At, B1); PG8_BAR; PG8_SCHED;
            PG8_LDB(B0, 1, 0); PG8_LDB(B1, 1, 1); PG8_SCHED; PG8_LDA(At, 1, 0); PG8_STAGE(PG8_SA(0, 1), a2 + hstepA, voffA);
            PG8_WAIT_V(8); PG8_WAIT_L(0); PG8_BAR; PG8_MMA(0, 0, At, B0); PG8_MMA(0, 1, At, B1); PG8_BAR; PG8_SCHED;
            PG8_LDA(At, 1, 1); PG8_STAGE(PG8_SB(1, 0), b3, voffB); PG8_STAGE(PG8_SB(1, 1), b3 + hstepB, voffB); PG8_STAGE(PG8_SA(1, 0), a3, voffA);
            PG8_WAIT_V(8); PG8_WAIT_L(0); PG8_BAR; PG8_MMA(1, 0, At, B0); PG8_MMA(1, 1, At, B1); PG8_BAR; PG8_SCHED;
            }
        }
        if constexpr (ALIGN_EPI) { if (wr == 0) PG8_BAR; }
        if constexpr (!Epi::AFTER_DRAIN) { E(acc, cur, wr, wc, fr, fq); S.done(cur); }
        if (!has_next) break;
#pragma unroll
        for (int a = 0; a < 2; ++a)
#pragma unroll
            for (int b = 0; b < 2; ++b)
#pragma unroll
                for (int m = 0; m < 4; ++m)
#pragma unroll
                    for (int n = 0; n < 2; ++n) acc[a][b][m][n] = (f32x4){0.f, 0.f, 0.f, 0.f};
        cur = nxt; cA = nA; cB = nB; ++ui;
        if constexpr (ALIGN_EPI) { if (wr == 1) PG8_BAR; }
    }
    PG8_WAIT_V(0);
    if constexpr (!ALIGN_EPI) { if (wr == 0) PG8_BAR; }
    PG8_BAR;
    if constexpr (Epi::AFTER_DRAIN) { E.fused(acc, cur, wr, wc, fr, fq, lds, wid, lane); S.done(cur); }
#undef PG8_SA
#undef PG8_SB
#undef PG8_STAGE
#undef PG8_LDA
#undef PG8_LDB
#undef PG8_MMA
#undef PG8_WAIT_V
#undef PG8_WAIT_L
#undef PG8_BAR
#undef PG8_SCHED
}
}
namespace mk {
using pg8::Unit;
typedef f32x4 Acc[2][2][4][2];
__device__ __forceinline__ void st8(bf16* p, f32x4 v) { u32x2 w; w.x = cvtpk(v[0], v[1]); w.y = cvtpk(v[2], v[3]); *(u32x2*)p = w; }
__device__ __forceinline__ void st16(bf16* p, f32x4 a, f32x4 b) { u32x4 w; w.x = cvtpk(a[0], a[1]); w.y = cvtpk(a[2], a[3]); w.z = cvtpk(b[0], b[1]); w.w = cvtpk(b[2], b[3]); *(u32x4*)p = w; }
__device__ __forceinline__ f32x4 ld4bf(const bf16* p) { const u32x2 w = *(const u32x2*)p; return (f32x4){bflo(w.x), bfhi(w.x), bflo(w.y), bfhi(w.y)}; }
__device__ __forceinline__ f32x4 rope4(f32x4 v, f32x4 cs) { return (f32x4){v[0] * cs[0] - v[1] * cs[1], v[1] * cs[0] + v[0] * cs[1], v[2] * cs[2] - v[3] * cs[3], v[3] * cs[2] + v[2] * cs[3]}; }

__device__ __forceinline__ void st_tr_pairs(bf16* T, int col0, int row, f32x4 v, bool even) {
    const float s0 = even ? v[2] : v[0], s1 = even ? v[3] : v[1];
    const float r0 = __shfl_xor(s0, 1), r1 = __shfl_xor(s1, 1);
    const int c = col0 + (even ? 0 : 2), re = row & ~1;
    const unsigned w0 = even ? cvtpk(v[0], r0) : cvtpk(r0, v[2]), w1 = even ? cvtpk(v[1], r1) : cvtpk(r1, v[3]);
    *(unsigned*)(T + (size_t)c * NTOK + re) = w0; *(unsigned*)(T + (size_t)(c + 1) * NTOK + re) = w1;
}
struct EpiWin {
    static constexpr bool PERM = true, AFTER_DRAIN = false;
    bf16 *RQ, *RK, *RKT, *RVT, *RG, *UC, *CQ, *CKV, *KPE; float *SSQQ, *SSQKV; const f32x4* CS;
    __device__ __forceinline__ void operator()(const Acc& acc, const Unit& u, int wr, int wc, int fr, int fq) const { { int t_ = threadIdx.x; asm volatile("" : "+v"(t_)); fr = t_ & 15; fq = (t_ >> 4) & 3; }
        const int pn = u.pn, row0 = u.pm * 256 + wr * 64 + fr; const bool even = (fr & 1) == 0;
        if (pn <= 1) {
#pragma unroll
            for (int ai = 0; ai < 2; ++ai)
#pragma unroll
                for (int m = 0; m < 4; ++m) { const int row = row0 + ai * 128 + m * 16; const float pl = (float)(row & (RET_C - 1));
#pragma unroll
                    for (int bj = 0; bj < 2; ++bj) { const int head = 2 * bj + (wc >> 1);
                        const float lg2 = __builtin_amdgcn_logf(1.f - __builtin_amdgcn_exp2f(-5.f - (float)head));
                        const float dec = pn == 0 ? __builtin_amdgcn_exp2f(pl * lg2) : 0.125f * __builtin_amdgcn_exp2f(-pl * lg2);
                        const int i0 = 16 * (wc & 1) + 4 * fq, col = bj * 128 + wc * 32 + 8 * fq;
                        const f32x4 o0 = rope4(acc[ai][bj][m][0], CS[((row * 32 + i0) >> 1)]) * dec, o1 = rope4(acc[ai][bj][m][1], CS[((row * 32 + i0) >> 1) + 1]) * dec;
                        st16((pn == 0 ? RQ : RK) + (size_t)row * 256 + col, o0, o1);
                        if (pn == 1) { st_tr_pairs(RKT, col, row, o0, even); st_tr_pairs(RKT, col + 4, row, o1, even); } }
                    asm volatile("" ::: "memory"); }
        } else if (pn == 2) {
#pragma unroll
            for (int ai = 0; ai < 2; ++ai)
#pragma unroll
                for (int m = 0; m < 4; ++m) { const int row = row0 + ai * 128 + m * 16;
#pragma unroll
                    for (int bj = 0; bj < 2; ++bj) { const int col = bj * 128 + wc * 32 + 8 * fq; st_tr_pairs(RVT, col, row, acc[ai][bj][m][0], even); st_tr_pairs(RVT, col + 4, row, acc[ai][bj][m][1], even); } }
        } else if (pn == 3) {
#pragma unroll
            for (int ai = 0; ai < 2; ++ai)
#pragma unroll
                for (int m = 0; m < 4; ++m) { const int row = row0 + ai * 128 + m * 16;
#pragma unroll
                    for (int bj = 0; bj < 2; ++bj) { const f32x4 v = acc[ai][bj][m][0], w = acc[ai][bj][m][1];
                        st16(RG + (size_t)row * 256 + bj * 128 + wc * 32 + 8 * fq, (f32x4){silu_fast(v[0]), silu_fast(v[1]), silu_fast(v[2]), silu_fast(v[3])}, (f32x4){silu_fast(w[0]), silu_fast(w[1]), silu_fast(w[2]), silu_fast(w[3])}); } }
        } else if (pn == 4) {
#pragma unroll
            for (int ai = 0; ai < 2; ++ai)
#pragma unroll
                for (int m = 0; m < 4; ++m) { const int row = row0 + ai * 128 + m * 16, chunk = row / SSM_C, t = row % SSM_C;
#pragma unroll
                    for (int bj = 0; bj < 2; ++bj) { const int g = 8 * bj + 2 * wc + (fq >> 1);
                        st16(UC + ((size_t)g * SSM_NCH + chunk) * SSM_K + t * 16 + 8 * (fq & 1), acc[ai][bj][m][0], acc[ai][bj][m][1]); } }
        } else if (pn == 5) {
#pragma unroll
            for (int ai = 0; ai < 2; ++ai)
#pragma unroll
                for (int m = 0; m < 4; ++m) { const int row = row0 + ai * 128 + m * 16; float ss = 0.f;
#pragma unroll
                    for (int bj = 0; bj < 2; ++bj) { const f32x4 v = acc[ai][bj][m][0], w = acc[ai][bj][m][1];
                        ss += ((v[0] * v[0] + v[1] * v[1]) + (v[2] * v[2] + v[3] * v[3])) + ((w[0] * w[0] + w[1] * w[1]) + (w[2] * w[2] + w[3] * w[3]));
                        st16(CQ + (size_t)row * 256 + bj * 128 + wc * 32 + 8 * fq, v, w); }
                    ss += __shfl_xor(ss, 16); ss += __shfl_xor(ss, 32);
                    if (fq == 0) SSQQ[row * 4 + wc] = ss; }
        } else {
#pragma unroll
            for (int ai = 0; ai < 2; ++ai)
#pragma unroll
                for (int m = 0; m < 4; ++m) { const int row = row0 + ai * 128 + m * 16;
                    const f32x4 v = acc[ai][0][m][0], w = acc[ai][0][m][1];
                    float ss = ((v[0] * v[0] + v[1] * v[1]) + (v[2] * v[2] + v[3] * v[3])) + ((w[0] * w[0] + w[1] * w[1]) + (w[2] * w[2] + w[3] * w[3]));
                    st16(CKV + (size_t)row * 128 + wc * 32 + 8 * fq, v, w);
                    ss += __shfl_xor(ss, 16); ss += __shfl_xor(ss, 32);
                    if (fq == 0) SSQKV[row * 4 + wc] = ss;
                    if (wc < 2) { const int i0 = 16 * wc + 4 * fq;
                        st16(KPE + (size_t)row * 64 + wc * 32 + 8 * fq, rope4(acc[ai][1][m][0], CS[(row * 32 + i0) >> 1]), rope4(acc[ai][1][m][1], CS[((row * 32 + i0) >> 1) + 1])); } }
        }
    }
};
struct EpiQup {
    static constexpr bool PERM = false, AFTER_DRAIN = false;
    bf16* Q; const float* SSQ; const f32x4* CS;
    __device__ __forceinline__ void operator()(const Acc& acc, const Unit& u, int wr, int wc, int fr, int fq) const { { int t_ = threadIdx.x; asm volatile("" : "+v"(t_)); fr = t_ & 15; fq = (t_ >> 4) & 3; }
        const int row0 = u.pm * 256 + wr * 64 + fr;
#pragma unroll
        for (int ai = 0; ai < 2; ++ai)
#pragma unroll
            for (int m = 0; m < 4; ++m) { const int row = row0 + ai * 128 + m * 16; const f32x4 s4 = *(const f32x4*)(SSQ + row * 4);
                const float rstd = __builtin_amdgcn_rsqf(((s4[0] + s4[1]) + (s4[2] + s4[3])) * (1.f / 256.f) + EPS);
#pragma unroll
                for (int bj = 0; bj < 2; ++bj) { const bool rope = ((4 * u.pn + 2 * bj + (wc >> 1)) % 3) == 2;
#pragma unroll
                    for (int n = 0; n < 2; ++n) { f32x4 v = acc[ai][bj][m][n] * rstd;
                        if (rope) { const int i0 = 16 * (wc & 1) + 8 * n + 2 * fq; v = rope4(v, CS[(row * 32 + i0) >> 1]); }
                        st8(Q + (size_t)row * 768 + u.pn * 256 + bj * 128 + wc * 32 + n * 16 + fq * 4, v); } }
                asm volatile("" ::: "memory"); }
    }
};
struct EpiKVup {
    static constexpr bool PERM = false, AFTER_DRAIN = false;
    bf16 *KN, *V; const float* SSQ;
    __device__ __forceinline__ void operator()(const Acc& acc, const Unit& u, int wr, int wc, int fr, int fq) const { { int t_ = threadIdx.x; asm volatile("" : "+v"(t_)); fr = t_ & 15; fq = (t_ >> 4) & 3; }
        const int row0 = u.pm * 256 + wr * 64 + fr;
#pragma unroll
        for (int ai = 0; ai < 2; ++ai)
#pragma unroll
            for (int m = 0; m < 4; ++m) { const int row = row0 + ai * 128 + m * 16; const f32x4 s4 = *(const f32x4*)(SSQ + row * 4);
                const float rstd = __builtin_amdgcn_rsqf(((s4[0] + s4[1]) + (s4[2] + s4[3])) * (1.f / 128.f) + EPS);
#pragma unroll
                for (int bj = 0; bj < 2; ++bj)
#pragma unroll
                    for (int n = 0; n < 2; ++n) st8((bj == 0 ? KN : V) + (size_t)row * 512 + u.pn * 128 + wc * 32 + n * 16 + fq * 4, acc[ai][bj][m][n] * rstd);
                asm volatile("" ::: "memory"); }
    }
};
struct EpiSsmE {
    static constexpr bool PERM = false, AFTER_DRAIN = true;
    bf16* UC; const f32x2* LAMC; unsigned* flag;
    __device__ __forceinline__ void fused(Acc& acc, const Unit& u, int wr, int wc, int fr, int fq, PG8_LAS unsigned char* lds, int wid, int lane) const { { int t_ = threadIdx.x; asm volatile("" : "+v"(t_)); fr = t_ & 15; fq = (t_ >> 4) & 3; }
        PG8_LAS float* EL = (PG8_LAS float*)lds;
        const int g = u.pm >> 1, b = u.pm & 1;
#pragma unroll
        for (int ai = 0; ai < 2; ++ai)
#pragma unroll
            for (int m = 0; m < 4; ++m) { const int ch = ai * 128 + wr * 64 + m * 16 + fr;
#pragma unroll
                for (int n = 0; n < 2; ++n) *(PG8_LAS f32x4*)(EL + ch * 128 + wc * 32 + n * 16 + fq * 4) = acc[ai][0][m][n]; }
        asm volatile("s_waitcnt lgkmcnt(0)" ::: "memory"); __builtin_amdgcn_s_barrier(); asm volatile("" ::: "memory");
        {
            const f32x2 lc = LAMC[g * 64 + lane]; f32x2 c = {0.f, 0.f};
            f32x2 loc[32];
#pragma unroll
            for (int n = 0; n < 32; ++n) { const f32x2 e2 = *(const PG8_LAS f32x2*)(EL + (wid * 32 + n) * 128 + 2 * lane); loc[n] = c; c = (f32x2){lc.x * c.x - lc.y * c.y, lc.x * c.y + lc.y * c.x} + e2; }
            f32x2 pw = {1.f, 0.f};
#pragma unroll
            for (int n = 0; n < 32; ++n) pw = (f32x2){pw.x * lc.x - pw.y * lc.y, pw.x * lc.y + pw.y * lc.x};
            asm volatile("s_waitcnt lgkmcnt(0)" ::: "memory"); __builtin_amdgcn_s_barrier(); asm volatile("" ::: "memory");
            *(PG8_LAS f32x2*)(EL + wid * 128 + 2 * lane) = c;
            asm volatile("s_waitcnt lgkmcnt(0)" ::: "memory"); __builtin_amdgcn_s_barrier(); asm volatile("" ::: "memory");
            f32x2 cin = {0.f, 0.f};
            for (int s = 0; s < wid; ++s) { const f32x2 es = *(const PG8_LAS f32x2*)(EL + s * 128 + 2 * lane); cin = (f32x2){pw.x * cin.x - pw.y * cin.y, pw.x * cin.y + pw.y * cin.x} + es; }
            bf16* up = UC + ((size_t)g * SSM_NCH + b * 256 + wid * 32) * SSM_K + 512 + 2 * lane;
            f32x2 q = cin;
#pragma unroll
            for (int n = 0; n < 32; ++n) { const f32x2 v = loc[n] + q; *(unsigned*)(up + (size_t)n * SSM_K) = cvtpk(v.x, v.y); q = (f32x2){lc.x * q.x - lc.y * q.y, lc.x * q.y + lc.y * q.x}; }
        }
        asm volatile("s_waitcnt vmcnt(0)" ::: "memory");
        asm volatile("s_waitcnt lgkmcnt(0)" ::: "memory"); __builtin_amdgcn_s_barrier(); asm volatile("" ::: "memory");
        if (threadIdx.x == 0) { __builtin_amdgcn_fence(__ATOMIC_RELEASE, "agent"); asm volatile("s_waitcnt vmcnt(0)" ::: "memory"); __hip_atomic_fetch_add(flag, 1u, __ATOMIC_RELAXED, __HIP_MEMORY_SCOPE_AGENT); }
    }
};
struct EpiSsmZ {
    static constexpr bool PERM = false, AFTER_DRAIN = false;
    bf16* G; const bf16* UC; const float* dpar;
    __device__ __forceinline__ void operator()(const Acc& acc, const Unit& u, int wr, int wc, int fr, int fq) const { { int t_ = threadIdx.x; asm volatile("" : "+v"(t_)); fr = t_ & 15; fq = (t_ >> 4) & 3; }
        const int g = u.pm >> 1, ch0 = (u.pm & 1) * 256 + wr * 64 + fr;
        const f32x4 dd = *(const f32x4*)(dpar + g * 16 + 4 * fq);
#pragma unroll
        for (int ai = 0; ai < 2; ++ai)
#pragma unroll
            for (int m = 0; m < 4; ++m) { const int chunk = ch0 + ai * 128 + m * 16;
#pragma unroll
                for (int bj = 0; bj < 2; ++bj)
#pragma unroll
                    for (int n = 0; n < 2; ++n) { const int t = u.pn * 16 + bj * 8 + wc * 2 + n;
                        const f32x4 uv = ld4bf(UC + ((size_t)g * SSM_NCH + chunk) * SSM_K + t * 16 + 4 * fq);
                        const f32x4 y = acc[ai][bj][m][n] + dd * uv;
                        st8(G + (size_t)(chunk * SSM_C + t) * 256 + g * 16 + 4 * fq, (f32x4){gelu_tanh_fast(y[0]), gelu_tanh_fast(y[1]), gelu_tanh_fast(y[2]), gelu_tanh_fast(y[3])}); } }
    }
};
struct EpiStore {
    static constexpr bool PERM = true, AFTER_DRAIN = false;
    bf16* O; int ldc; const float* rowscale; size_t split_stride;
    __device__ __forceinline__ void operator()(const Acc& acc, const Unit& u, int wr, int wc, int fr, int fq) const { { int t_ = threadIdx.x; asm volatile("" : "+v"(t_)); fr = t_ & 15; fq = (t_ >> 4) & 3; }
        const int ks = u.pn >> 2, pn0 = u.pn & 3; bf16* O = this->O + (size_t)ks * split_stride;
        const int row0 = u.pm * 256 + wr * 64 + fr, col0 = pn0 * 256 + wc * 32 + 8 * fq;
#pragma unroll
        for (int ai = 0; ai < 2; ++ai)
#pragma unroll
            for (int m = 0; m < 4; ++m) { const int row = row0 + ai * 128 + m * 16; const float s = rowscale ? rowscale[row] : 1.f;
#pragma unroll
                for (int bj = 0; bj < 2; ++bj) st16(O + (size_t)row * ldc + col0 + bj * 128, acc[ai][bj][m][0] * s, acc[ai][bj][m][1] * s); }
    }
};
struct EpiSwiglu {
    static constexpr bool PERM = true, AFTER_DRAIN = false;
    bf16* H;
    __device__ __forceinline__ void operator()(const Acc& acc, const Unit& u, int wr, int wc, int fr, int fq) const { { int t_ = threadIdx.x; asm volatile("" : "+v"(t_)); fr = t_ & 15; fq = (t_ >> 4) & 3; }
        const int row0 = u.pm * 256 + wr * 64 + fr, h0 = u.pn * 128 + wc * 32 + 8 * fq;
#pragma unroll
        for (int ai = 0; ai < 2; ++ai)
#pragma unroll
            for (int m = 0; m < 4; ++m) { const int row = row0 + ai * 128 + m * 16;
                const f32x4 g0 = acc[ai][0][m][0], g1 = acc[ai][0][m][1], u0 = acc[ai][1][m][0], u1 = acc[ai][1][m][1];
                st16(H + (size_t)row * DFF + h0, (f32x4){silu_fast(g0[0]) * u0[0], silu_fast(g0[1]) * u0[1], silu_fast(g0[2]) * u0[2], silu_fast(g0[3]) * u0[3]},
                                                 (f32x4){silu_fast(g1[0]) * u1[0], silu_fast(g1[1]) * u1[1], silu_fast(g1[2]) * u1[2], silu_fast(g1[3]) * u1[3]}); }
    }
};

struct PanelSsq {
    unsigned* xbuf;
    unsigned* cnt;
    unsigned* tmo;
    __device__ __forceinline__ void run(const Acc& v, const Unit& u, int wr, int wc, int fr, int fq, PG8_LAS unsigned char* lds, int wid, int lane) const {
        PG8_LAS float* P = (PG8_LAS float*)lds;
        PG8_LAS float* S = (PG8_LAS float*)(lds + 8192);
#pragma unroll
        for (int ai = 0; ai < 2; ++ai)
#pragma unroll
            for (int m = 0; m < 4; ++m) { float s = 0.f;
#pragma unroll
                for (int bj = 0; bj < 2; ++bj)
#pragma unroll
                    for (int n = 0; n < 2; ++n) { const f32x4 x = v[ai][bj][m][n]; s += (x[0] * x[0] + x[1] * x[1]) + (x[2] * x[2] + x[3] * x[3]); }
                s += __shfl_xor(s, 16); s += __shfl_xor(s, 32);
                if (fq == 0) P[(ai * 128 + wr * 64 + m * 16 + fr) * 4 + wc] = s; }
        asm volatile("s_waitcnt lgkmcnt(0)" ::: "memory"); __builtin_amdgcn_s_barrier(); asm volatile("" ::: "memory");
        const int row = wid * 32 + (lane & 31);
        if (lane < 32) { const float t = (P[row * 4 + 0] + P[row * 4 + 1]) + (P[row * 4 + 2] + P[row * 4 + 3]);
            unsigned long long* slot = (unsigned long long*)xbuf + ((size_t)(u.pm * 256 + row) * 4 + u.pn);
            __hip_atomic_store(slot, (unsigned long long)__float_as_uint(t), __ATOMIC_RELAXED, __HIP_MEMORY_SCOPE_AGENT); }
        asm volatile("s_waitcnt vmcnt(0)" ::: "memory");
        if (lane == 0) __hip_atomic_fetch_add(cnt + 64 * u.pm, 1u, __ATOMIC_RELAXED, __HIP_MEMORY_SCOPE_AGENT);
        if (wid == 0) {
            const unsigned long long t0 = __builtin_amdgcn_s_memrealtime();
            while ((unsigned)__builtin_amdgcn_readfirstlane(__hip_atomic_load(cnt + 64 * u.pm, __ATOMIC_RELAXED, __HIP_MEMORY_SCOPE_AGENT)) < 32u) {
                if (__builtin_amdgcn_s_memrealtime() - t0 > 2000000ull) { if (lane == 0) __hip_atomic_store(tmo, 1u, __ATOMIC_RELAXED, __HIP_MEMORY_SCOPE_AGENT); break; }
                __builtin_amdgcn_s_sleep(2); }
            __builtin_amdgcn_fence(__ATOMIC_ACQUIRE, "agent");
        }
        asm volatile("s_waitcnt vmcnt(0) lgkmcnt(0)" ::: "memory"); __builtin_amdgcn_s_barrier(); asm volatile("" ::: "memory");
        if (lane < 32) { const unsigned long long* slot = (const unsigned long long*)xbuf + (size_t)(u.pm * 256 + row) * 4; float q = 0.f;
#pragma unroll
            for (int t = 0; t < 4; ++t) q += __uint_as_float((unsigned)__hip_atomic_load(slot + t, __ATOMIC_RELAXED, __HIP_MEMORY_SCOPE_AGENT));
            S[row] = __builtin_amdgcn_rsqf(q * (1.f / 1024.f) + EPS); }
        asm volatile("s_waitcnt lgkmcnt(0)" ::: "memory"); __builtin_amdgcn_s_barrier(); asm volatile("" ::: "memory");
    }
};
struct EpiResNorm {
    static constexpr bool PERM = false, AFTER_DRAIN = true;
    const float* base; float* out; bf16* xn; const float *gpost, *gpre, *modv;
    int gt_off, sc_off, sh_off, modn_off;
    PanelSsq st1, st2;
    __device__ __forceinline__ void fused(Acc& acc, const Unit& u, int wr, int wc, int fr, int fq, PG8_LAS unsigned char* lds, int wid, int lane) const { { int t_ = threadIdx.x; asm volatile("" : "+v"(t_)); fr = t_ & 15; fq = (t_ >> 4) & 3; }
        const PG8_LAS float* S = (const PG8_LAS float*)(lds + 8192);
        const int col0 = u.pn * 256 + wc * 32 + 4 * fq, b = u.pm >> 5;
        st1.run(acc, u, wr, wc, fr, fq, lds, wid, lane);
#pragma unroll
        for (int ai = 0; ai < 2; ++ai)
#pragma unroll
            for (int m = 0; m < 4; ++m) { const int r = ai * 128 + wr * 64 + m * 16 + fr; const float sr = S[r]; const size_t off = (size_t)(u.pm * 256 + r) * DM + col0;
#pragma unroll
                for (int bj = 0; bj < 2; ++bj)
#pragma unroll
                    for (int n = 0; n < 2; ++n) { const int c = col0 + bj * 128 + n * 16; const f32x4 bs = *(const f32x4*)(base + off + bj * 128 + n * 16);
                        const f32x4 g4 = *(const f32x4*)(gpost + c), t4 = *(const f32x4*)(modv + b * 6144 + gt_off + c);
                        acc[ai][bj][m][n] = bs + t4 * acc[ai][bj][m][n] * sr * g4; }
                asm volatile("" : "+v"(acc[ai][0][m][0]), "+v"(acc[ai][0][m][1]), "+v"(acc[ai][1][m][0]), "+v"(acc[ai][1][m][1]));
                if (m & 1) asm volatile("" ::: "memory"); }
        st2.run(acc, u, wr, wc, fr, fq, lds, wid, lane);
        const float* mn = modv + modn_off + b * 6144;
#pragma unroll
        for (int ai = 0; ai < 2; ++ai)
#pragma unroll
            for (int m = 0; m < 4; ++m) { const int r = ai * 128 + wr * 64 + m * 16 + fr; const float sr = S[r]; const size_t off = (size_t)(u.pm * 256 + r) * DM + col0;
#pragma unroll
                for (int bj = 0; bj < 2; ++bj)
#pragma unroll
                    for (int n = 0; n < 2; ++n) { const int c = col0 + bj * 128 + n * 16; const f32x4 x1 = acc[ai][bj][m][n]; *(f32x4*)(out + off + bj * 128 + n * 16) = x1;
                        const f32x4 g4 = *(const f32x4*)(gpre + c), s4 = *(const f32x4*)(mn + sc_off + c), h4 = *(const f32x4*)(mn + sh_off + c);
                        st8(xn + off + bj * 128 + n * 16, x1 * sr * g4 * (s4 + 1.f) + h4); }
                asm volatile("" ::: "memory"); }
    }
};
}
namespace att {
using namespace mk;
constexpr int KVBLK = 64, SHM_V = 64 * 128 * 2, SHM_KN = 64 * 128 * 2, SHM_KP = 64 * 64 * 2, KBUF = SHM_KN + SHM_KP;
constexpr int OFF_V = 0  , OFF_K = 3 * SHM_V  , OFF_WS = 3 * SHM_V + 2 * KBUF, LDS_BYTES = OFF_WS + NWAVES * 64 * 4;
constexpr float THR = 8.f;
#define KSWZ(row, colB) ((row) * 256 + ((colB) ^ (((row) & 7) << 4)))
#define KPSWZ(row, colB) ((row) * 128 + ((colB) ^ (((row) & 7) << 4)))
#define SBAR() __builtin_amdgcn_sched_barrier(0)
__device__ __forceinline__ int v_st(int k, int c) { const int kk = (k & ~0xC) | ((k & 4) << 1) | ((k & 8) >> 1); return ((kk >> 3) * 4 + (c >> 5)) * 512 + ((kk & 7) * 32 + (c & 31)) * 2; }
__device__ __forceinline__ int v_rd_base(int lane) { return ((lane & 3) << 3) | (((lane >> 2) & 3) << 6) | (((lane >> 4) & 1) << 5) | (((lane >> 5) & 1) << 8); }
constexpr int v_rd_off(int d0, int ks, int half) { return d0 * 512 + ks * 4096 + half * 2048; }
__device__ __forceinline__ int crow(int r, int hi) { return (r & 3) + 8 * (r >> 2) + 4 * hi; }

struct Tensors { const bf16* Q; const bf16* KN; const bf16* KP; const bf16* V; bf16* O; };

#define KFR(KB_, i) (*reinterpret_cast<const bf16x8*>(lds + OFF_K + (KB_) * KBUF + ((i) < 8 ? kbo[(i) & 3] + ((i) >> 2) * 128 : kpo[((i) - 8) & 3])))
#define PK4(P_, B__, OUT) do { unsigned a0 = cvtpk(P_[B__ + 0], P_[B__ + 1]), a1 = cvtpk(P_[B__ + 2], P_[B__ + 3]), b0 = cvtpk(P_[B__ + 4], P_[B__ + 5]), b1 = cvtpk(P_[B__ + 6], P_[B__ + 7]); \
        auto r0 = __builtin_amdgcn_permlane32_swap(a0, b0, false, false); auto r1 = __builtin_amdgcn_permlane32_swap(a1, b1, false, false); \
        u32x4 w = {r0[0], r1[0], r0[1], r1[1]}; OUT = *reinterpret_cast<bf16x8*>(&w); } while (0)
__device__ __forceinline__ float max3f(float a, float b, float c) { float r; asm("v_max3_f32 %0, %1, %2, %3" : "=v"(r) : "v"(a), "v"(b), "v"(c)); return r; }
__device__ __forceinline__ void glds16(const void* sbase, unsigned voff, unsigned lds_dst) { unsigned keep;
    asm volatile("s_mov_b32 %0, m0\n\ts_mov_b32 m0, %3\n\ts_nop 0\n\tglobal_load_lds_dwordx4 %1, %2\n\ts_mov_b32 m0, %0" : "=&s"(keep) : "v"(voff), "s"(sbase), "s"(lds_dst) : "memory"); }
#define WAIT_BAR(N) asm volatile("s_waitcnt vmcnt(" #N ") lgkmcnt(0)\n\ts_barrier" ::: "memory")
__device__ __forceinline__ void attn_unit(int b, int h, int qb, const Tensors& T, char* lds) {
    int tid_ = threadIdx.x; asm volatile("" : "+v"(tid_));
    const int tid = tid_, wid = __builtin_amdgcn_readfirstlane(tid >> 6), lane = tid & 63, r32 = lane & 31, hi = lane >> 5;
    const int rg = wid & 3, kh = wid >> 2;
    const size_t tok0 = (size_t)b * SEQ; const int q0 = qb * 128, NT = 2 * qb + 2;
    float* ws = (float*)(lds + OFF_WS) + wid * 64;
    const unsigned lds0 = (unsigned)(uintptr_t)lds;
    unsigned ok0, ok1, op, ov0, ov1;
    { const int ra = 4 * wid + (lane >> 4), rb = ra + 32, cc = lane & 15;
      ok0 = (unsigned)(ra * 512 + ((cc ^ (ra & 7)) << 3)) * 2u; ok1 = (unsigned)(rb * 512 + ((cc ^ (rb & 7)) << 3)) * 2u;
      const int rp = 8 * wid + (lane >> 3), cp = lane & 7; op = (unsigned)(rp * 64 + ((cp ^ (rp & 7)) << 3)) * 2u;
      const int r8 = (lane >> 2) & 7, c8 = (lane & 3) * 8;
      { const int sub = 2 * wid + (lane >> 5), kk = (sub >> 2) * 8 + r8, key = (kk & ~0xC) | ((kk & 4) << 1) | ((kk & 8) >> 1); ov0 = (unsigned)(key * 512 + (sub & 3) * 32 + c8) * 2u; }
      { const int sub = 2 * (wid + 8) + (lane >> 5), kk = (sub >> 2) * 8 + r8, key = (kk & ~0xC) | ((kk & 4) << 1) | ((kk & 8) >> 1); ov1 = (unsigned)(key * 512 + (sub & 3) * 32 + c8) * 2u; } }
    const bf16* bKN = T.KN + tok0 * 512 + h * 128; const bf16* bKP = T.KP + tok0 * 64; const bf16* bV = T.V + tok0 * 512 + h * 128;
#define DMA_K(t, kso) do { const size_t ko_ = (size_t)(t) * KVBLK; const unsigned d_ = (unsigned)__builtin_amdgcn_readfirstlane((int)(lds0 + OFF_K + (kso) + wid * 1024)); \
        const bf16* kn_ = bKN + ko_ * 512; glds16(kn_, ok0, d_); glds16(kn_, ok1, d_ + 8192); glds16(bKP + ko_ * 64, op, d_ + SHM_KN); } while (0)
#define DMA_V(t, vso) do { const size_t ko_ = (size_t)(t) * KVBLK; const unsigned d_ = (unsigned)__builtin_amdgcn_readfirstlane((int)(lds0 + OFF_V + (vso) + wid * 1024)); \
        const bf16* v_ = bV + ko_ * 512; glds16(v_, ov0, d_); glds16(v_, ov1, d_ + 8192); } while (0)
    DMA_K(0, 0); DMA_V(0, 0); DMA_K(1, KBUF); DMA_V(1, SHM_V);
    bf16x8 qr[12];
    { const bf16* qp = T.Q + (tok0 + q0 + rg * 32 + r32) * 768 + h * 192 + hi * 8;
#pragma unroll
      for (int d0 = 0; d0 < 12; ++d0) qr[d0] = *(const bf16x8*)(qp + d0 * 16);
#pragma unroll
      for (int d0 = 0; d0 < 12; ++d0) asm volatile("" : "+v"(qr[d0])); }
    float m_reg = -1e30f, l_reg = 0.f; f32x16 o[4] = {};
    const int vb0 = (int)lds0 + v_rd_base(lane) + kh * 8192;
    const int qpos = q0 + rg * 32 + r32;
    WAIT_BAR(0);
#define RESC(a) do { if (__any((a) < 1.f)) { if (hi == 0) ws[r32] = (a); asm volatile("s_waitcnt lgkmcnt(0)" ::: "memory"); \
        _Pragma("unroll") for (int d_ = 0; d_ < 4; ++d_) _Pragma("unroll") for (int r = 0; r < 16; ++r) o[d_][r] *= ws[crow(r, hi)]; } } while (0)
#define MASKT(P_, t_) do { const int kb_ = (t_) * KVBLK + kh * 32 + 4 * hi; const float NEG = -__builtin_inff(); \
        _Pragma("unroll") for (int r = 0; r < 16; ++r) { const int key = kb_ + (r & 3) + 8 * (r >> 2); if (key > qpos) P_[r] = NEG; } } while (0)
#define DECIDE(P_, AL_) do { float pa_ = max3f(P_[0], P_[1], P_[2]), pb_ = max3f(P_[3], P_[4], P_[5]); pa_ = max3f(pa_, P_[6], P_[7]); pb_ = max3f(pb_, P_[8], P_[9]); \
        pa_ = max3f(pa_, P_[10], P_[11]); pb_ = max3f(pb_, P_[12], P_[13]); float pm_ = max3f(pa_, P_[14], P_[15]); pm_ = fmaxf(pm_, pb_); \
        { auto rr = __builtin_amdgcn_permlane32_swap(__float_as_uint(pm_), __float_as_uint(pm_), false, false); pm_ = fmaxf(__uint_as_float(rr[0]), __uint_as_float(rr[1])); } \
        const bool ok_ = __all((pm_ - m_reg) <= THR); const float mn_ = ok_ ? m_reg : fmaxf(m_reg, pm_); AL_ = ok_ ? 1.f : __builtin_amdgcn_exp2f(m_reg - mn_); m_reg = mn_; } while (0)
#define DECIDE0(P_, AL_) do { float pm_ = P_[0]; _Pragma("unroll") for (int r = 1; r < 16; ++r) pm_ = fmaxf(pm_, P_[r]); \
        { auto rr = __builtin_amdgcn_permlane32_swap(__float_as_uint(pm_), __float_as_uint(pm_), false, false); pm_ = fmaxf(__uint_as_float(rr[0]), __uint_as_float(rr[1])); } \
        const bool ok_ = __all((pm_ - m_reg) <= THR); const float mn_ = ok_ ? m_reg : fmaxf(m_reg, pm_); AL_ = ok_ ? 1.f : __builtin_amdgcn_exp2f(m_reg - mn_); m_reg = mn_; } while (0)
    int kbo[4], kpo[4];
#pragma unroll
    for (int dd = 0; dd < 4; ++dd) { kbo[dd] = kh * 8192 + KSWZ(r32, (dd * 16 + hi * 8) * 2); kpo[dd] = SHM_KN + kh * 4096 + KPSWZ(r32, (dd * 16 + hi * 8) * 2); }
    f32x16 pA, pB; float alpha;
    { pA = f32x16{}; bf16x8 f0 = KFR(0, 0), f1 = KFR(0, 1), f2 = KFR(0, 2), f3 = KFR(0, 3); SBAR();
#define QS0(i, F) do { pA = __builtin_amdgcn_mfma_f32_32x32x16_bf16(F, qr[i], pA, 0, 0, 0); if ((i) + 4 < 12) F = KFR(0, (i) + 4); SBAR(); } while (0)
      QS0(0, f0); QS0(1, f1); QS0(2, f2); QS0(3, f3); QS0(4, f0); QS0(5, f1); QS0(6, f2); QS0(7, f3); QS0(8, f0); QS0(9, f1); QS0(10, f2); QS0(11, f3);
#undef QS0
      if (0 >= NT - 2) MASKT(pA, 0);
      DECIDE0(pA, alpha); }
    WAIT_BAR(0);
    int v_cur = 0, v_nxt = SHM_V, v_nxt2 = 2 * SHM_V;
#define EX2(P_, i) do { P_[2 * (i)] = __builtin_amdgcn_exp2f(P_[2 * (i)] - mn); P_[2 * (i) + 1] = __builtin_amdgcn_exp2f(P_[2 * (i) + 1] - mn); ps += P_[2 * (i)] + P_[2 * (i) + 1]; } while (0)
#define SUMFIN() do { auto rr = __builtin_amdgcn_permlane32_swap(__float_as_uint(ps), __float_as_uint(ps), false, false); ps = __uint_as_float(rr[0]) + __uint_as_float(rr[1]); l_reg = l_reg * alpha + ps; } while (0)
#define QS(KB_, PN_, i, F, FILL) do { PN_ = __builtin_amdgcn_mfma_f32_32x32x16_bf16(F, qr[i], PN_, 0, 0, 0); if ((i) + 4 < 12) F = KFR(KB_, (i) + 4); FILL; SBAR(); } while (0)
#define TRRD(dst, off) asm volatile("ds_read_b64_tr_b16 %0, %1 offset:%2" : "=&v"(dst) : "v"(vb), "i"(off) : "memory")
#define STEP(T_, KC_, PC_, PN_, MORE_, DMA_) do { const int t = (T_); constexpr bool more = (MORE_); \
        if (DMA_) DMA_K(t + 2, (KC_) * KBUF);                   \
        bf16x8 pa0, pa1; float ps = 0.f; const float mn = m_reg; \
          \
        if (more) { PN_ = f32x16{}; bf16x8 f0 = KFR(1 - (KC_), 0), f1 = KFR(1 - (KC_), 1), f2 = KFR(1 - (KC_), 2), f3 = KFR(1 - (KC_), 3); SBAR(); \
            __builtin_amdgcn_s_setprio(1); \
            QS(1 - (KC_), PN_, 0, f0, EX2(PC_, 0)); QS(1 - (KC_), PN_, 1, f1, EX2(PC_, 1)); QS(1 - (KC_), PN_, 2, f2, EX2(PC_, 2)); QS(1 - (KC_), PN_, 3, f3, EX2(PC_, 3)); \
            QS(1 - (KC_), PN_, 4, f0, EX2(PC_, 4)); QS(1 - (KC_), PN_, 5, f1, EX2(PC_, 5)); QS(1 - (KC_), PN_, 6, f2, EX2(PC_, 6)); QS(1 - (KC_), PN_, 7, f3, EX2(PC_, 7)); \
            QS(1 - (KC_), PN_, 8, f0, SUMFIN()); QS(1 - (KC_), PN_, 9, f1, PK4(PC_, 0, pa0)); QS(1 - (KC_), PN_, 10, f2, PK4(PC_, 8, pa1)); QS(1 - (KC_), PN_, 11, f3, (void)0); \
            __builtin_amdgcn_s_setprio(0); \
            if (t + 1 >= NT - 2) MASKT(PN_, t + 1); \
        } else { EX2(PC_, 0); EX2(PC_, 1); EX2(PC_, 2); EX2(PC_, 3); EX2(PC_, 4); EX2(PC_, 5); EX2(PC_, 6); EX2(PC_, 7); SUMFIN(); PK4(PC_, 0, pa0); PK4(PC_, 8, pa1); SBAR(); } \
        RESC(alpha); SBAR(); \
          \
        { const int vb = vb0 + v_cur; float alpha_n = 1.f; s16x4 l0, l1, h0, h1, l2, l3, h2, h3; \
          { constexpr int b_ = v_rd_off(0, 0, 0), c_ = v_rd_off(1, 0, 0); \
            TRRD(l0, b_); TRRD(h0, b_ + 2048); TRRD(l1, b_ + 4096); TRRD(h1, b_ + 6144); TRRD(l2, c_); TRRD(h2, c_ + 2048); TRRD(l3, c_ + 4096); TRRD(h3, c_ + 6144); } \
          if (DMA_) DMA_V(t + 2, v_nxt2);                 \
          asm volatile("s_waitcnt lgkmcnt(0)" ::: "memory"); SBAR(); \
          o[0] = __builtin_amdgcn_mfma_f32_32x32x16_bf16(pa0, (bf16x8){l0[0], l0[1], l0[2], l0[3], h0[0], h0[1], h0[2], h0[3]}, o[0], 0, 0, 0); \
          o[1] = __builtin_amdgcn_mfma_f32_32x32x16_bf16(pa0, (bf16x8){l2[0], l2[1], l2[2], l2[3], h2[0], h2[1], h2[2], h2[3]}, o[1], 0, 0, 0); \
          SBAR(); \
          o[0] = __builtin_amdgcn_mfma_f32_32x32x16_bf16(pa1, (bf16x8){l1[0], l1[1], l1[2], l1[3], h1[0], h1[1], h1[2], h1[3]}, o[0], 0, 0, 0); \
          o[1] = __builtin_amdgcn_mfma_f32_32x32x16_bf16(pa1, (bf16x8){l3[0], l3[1], l3[2], l3[3], h3[0], h3[1], h3[2], h3[3]}, o[1], 0, 0, 0); \
          { constexpr int b_ = v_rd_off(2, 0, 0), c_ = v_rd_off(3, 0, 0); \
            TRRD(l0, b_); TRRD(h0, b_ + 2048); TRRD(l1, b_ + 4096); TRRD(h1, b_ + 6144); TRRD(l2, c_); TRRD(h2, c_ + 2048); TRRD(l3, c_ + 4096); TRRD(h3, c_ + 6144); } \
          SBAR(); \
          if (more) DECIDE(PN_, alpha_n);                        \
          asm volatile("s_waitcnt lgkmcnt(0)" ::: "memory"); SBAR(); \
          o[2] = __builtin_amdgcn_mfma_f32_32x32x16_bf16(pa0, (bf16x8){l0[0], l0[1], l0[2], l0[3], h0[0], h0[1], h0[2], h0[3]}, o[2], 0, 0, 0); \
          o[3] = __builtin_amdgcn_mfma_f32_32x32x16_bf16(pa0, (bf16x8){l2[0], l2[1], l2[2], l2[3], h2[0], h2[1], h2[2], h2[3]}, o[3], 0, 0, 0); \
          o[2] = __builtin_amdgcn_mfma_f32_32x32x16_bf16(pa1, (bf16x8){l1[0], l1[1], l1[2], l1[3], h1[0], h1[1], h1[2], h1[3]}, o[2], 0, 0, 0); \
          o[3] = __builtin_amdgcn_mfma_f32_32x32x16_bf16(pa1, (bf16x8){l3[0], l3[1], l3[2], l3[3], h3[0], h3[1], h3[2], h3[3]}, o[3], 0, 0, 0); \
          alpha = alpha_n; } \
        if (DMA_) WAIT_BAR(2); else WAIT_BAR(0);        \
        v_cur = v_nxt; v_nxt = v_nxt2; v_nxt2 = (v_nxt2 == 2 * SHM_V) ? 0 : v_nxt2 + SHM_V; } while (0)
    for (int t2 = 0; t2 + 2 < NT; t2 += 2) { STEP(t2, 0, pA, pB, true, true); STEP(t2 + 1, 1, pB, pA, true, true); }
    STEP(NT - 2, 0, pA, pB, true, false); STEP(NT - 1, 1, pB, pA, false, false);
#undef STEP
#undef TRRD
#undef QS
#undef EX2
#undef SUMFIN
#undef RESC
#undef DMA_K
#undef DMA_V
#undef MASKT
#undef DECIDE
#undef DECIDE0
    float* XO = (float*)lds;
    float* XM = (float*)(lds + 65536);
    if (kh == 1) {
#pragma unroll
        for (int d0 = 0; d0 < 4; ++d0)
#pragma unroll
            for (int r = 0; r < 16; ++r) XO[((rg * 64) + d0 * 16 + r) * 64 + lane] = o[d0][r];
        if (hi == 0) { XM[rg * 32 + r32] = m_reg; XM[128 + rg * 32 + r32] = l_reg; }
    }
    __syncthreads();
    if (kh == 0) {
        const float m1 = XM[rg * 32 + r32], l1 = XM[128 + rg * 32 + r32];
        const float mn = fmaxf(m_reg, m1), a0 = __builtin_amdgcn_exp2f(m_reg - mn), a1 = __builtin_amdgcn_exp2f(m1 - mn);
        const float inv = __builtin_amdgcn_rcpf(l_reg * a0 + l1 * a1);
        if (hi == 0) { ws[r32] = a0 * inv; ws[32 + r32] = a1 * inv; }
        asm volatile("s_waitcnt lgkmcnt(0)" ::: "memory");
        bf16* Ow = T.O + (tok0 + q0 + rg * 32) * 512 + h * 128;
#pragma unroll
        for (int r = 0; r < 16; ++r) { const int orow = crow(r, hi); const float f0 = ws[orow], f1 = ws[32 + orow];
#pragma unroll
            for (int d0 = 0; d0 < 4; ++d0) { const float v = o[d0][r] * f0 + XO[((rg * 64) + d0 * 16 + r) * 64 + lane] * f1; const float vn = __shfl_xor(v, 1);
                if ((r32 & 1) == 0) *(unsigned*)(Ow + (size_t)orow * 512 + d0 * 32 + r32) = cvtpk(v, vn); } }
    }
    __syncthreads();
}
#undef WAIT_BAR
#undef KSWZ
#undef KPSWZ
#undef SBAR
}
namespace ret {
using namespace mk;
__device__ __forceinline__ int crow(int r, int hi) { return (r & 3) + 8 * (r >> 2) + 4 * hi; }
struct Tensors { const bf16 *RQ, *RK, *RKT, *RVT, *RG; float* KVT; bf16* STATE; bf16* MIX; const float* gain; };
__device__ __forceinline__ void x_unit(int u, const Tensors& T, int lane) {
    asm volatile("" : "+v"(lane));
    const int n = u & 127, bh = u >> 7, h = bh & 3, b = bh >> 2, r32 = lane & 31, hi = lane >> 5;
    const size_t tok0 = (size_t)b * SEQ + (size_t)n * RET_C;
    f32x16 acc[2][2] = {};
#pragma unroll
    for (int s = 0; s < 4; ++s) {
        bf16x8 a[2], bb[2];
#pragma unroll
        for (int i = 0; i < 2; ++i) { a[i] = *(const bf16x8*)(T.RVT + (size_t)(h * 64 + i * 32 + r32) * NTOK + tok0 + s * 16 + hi * 8);
                                      bb[i] = *(const bf16x8*)(T.RKT + (size_t)(h * 64 + i * 32 + r32) * NTOK + tok0 + s * 16 + hi * 8); }
#pragma unroll
        for (int i = 0; i < 2; ++i)
#pragma unroll
            for (int j = 0; j < 2; ++j) acc[i][j] = __builtin_amdgcn_mfma_f32_32x32x16_bf16(a[i], bb[j], acc[i][j], 0, 0, 0);
    }
    float* out = T.KVT + (size_t)u * 4096;
#pragma unroll
    for (int i = 0; i < 2; ++i)
#pragma unroll
        for (int j = 0; j < 2; ++j)
#pragma unroll
            for (int r = 0; r < 16; ++r) out[(i * 32 + crow(r, hi)) * 64 + j * 32 + r32] = acc[i][j][r];
}
__device__ __forceinline__ void scan_wg(int e0, const Tensors& T, float* xs, int tid) {
    const int q = tid >> 7, e = e0 + (tid & 127);
    const int bh = e >> 12, el = e & 4095, h = bh & 3;
    const float gam = 1.f - __builtin_amdgcn_exp2f(-5.f - (float)h), lg2 = __builtin_amdgcn_logf(gam);
    const float g64 = __builtin_amdgcn_exp2f(64.f * lg2), g63 = __builtin_amdgcn_exp2f(63.f * lg2);
    const float* kv = T.KVT + ((size_t)bh * 128 + q * 32) * 4096 + el; bf16* st = T.STATE + ((size_t)bh * 128 + q * 32) * 4096 + el;
    float v[32];
#pragma unroll
    for (int i = 0; i < 32; ++i) v[i] = kv[(size_t)i * 4096];
    float S = 0.f;
#pragma unroll
    for (int i = 0; i < 32; ++i) { const float x = v[i]; v[i] = S; S = g64 * S + g63 * x; }
    xs[q * 128 + (tid & 127)] = S;
    __syncthreads();
    const float g64_32 = __builtin_amdgcn_exp2f(64.f * 32.f * lg2);
    float cin = 0.f;
    for (int s = 0; s < q; ++s) cin = g64_32 * cin + xs[s * 128 + (tid & 127)];
    float pw = cin;
#pragma unroll
    for (int i = 0; i < 32; ++i) { st[(size_t)i * 4096] = (bf16)(cvtpk(gam * (v[i] + pw), 0.f) & 0xffffu); pw *= g64; }
    __syncthreads();
}
__device__ __forceinline__ void z_unit(int u, const Tensors& T, int lane) {
    asm volatile("" : "+v"(lane));
    const int n = u & 127, bh = u >> 7, h = bh & 3, b = bh >> 2, r32 = lane & 31, hi = lane >> 5;
    const size_t tok0 = (size_t)b * SEQ + (size_t)n * RET_C;
    bf16x8 qf[2][4], kf[2][4], sa[4][2]; u32x4 vt[2][2][2];
#pragma unroll
    for (int qb = 0; qb < 2; ++qb)
#pragma unroll
        for (int s = 0; s < 4; ++s) { qf[qb][s] = *(const bf16x8*)(T.RQ + (tok0 + qb * 32 + r32) * 256 + h * 64 + s * 16 + hi * 8); kf[qb][s] = *(const bf16x8*)(T.RK + (tok0 + qb * 32 + r32) * 256 + h * 64 + s * 16 + hi * 8); }
    const bf16* stp = T.STATE + (size_t)u * 4096;
#pragma unroll
    for (int s = 0; s < 4; ++s)
#pragma unroll
        for (int i = 0; i < 2; ++i) sa[s][i] = *(const bf16x8*)(stp + (i * 32 + r32) * 64 + s * 16 + hi * 8);
#pragma unroll
    for (int kb = 0; kb < 2; ++kb)
#pragma unroll
        for (int s2 = 0; s2 < 2; ++s2)
#pragma unroll
            for (int i = 0; i < 2; ++i) { const bf16* vp = T.RVT + (size_t)(h * 64 + i * 32 + r32) * NTOK + tok0 + kb * 32 + s2 * 16 + 4 * hi;
                const u32x2 lo = *(const u32x2*)vp, hh = *(const u32x2*)(vp + 8); vt[kb][s2][i] = (u32x4){lo.x, lo.y, hh.x, hh.y}; }
    __builtin_amdgcn_sched_barrier(0);
    f32x16 o[2][2] = {};
#pragma unroll
    for (int s = 0; s < 4; ++s)
#pragma unroll
        for (int i = 0; i < 2; ++i)
#pragma unroll
            for (int qb = 0; qb < 2; ++qb) o[i][qb] = __builtin_amdgcn_mfma_f32_32x32x16_bf16(sa[s][i], qf[qb][s], o[i][qb], 0, 0, 0);
#pragma unroll
    for (int kb = 0; kb < 2; ++kb) {
#pragma unroll
        for (int qb = kb; qb < 2; ++qb) {
            f32x16 st = {};
#pragma unroll
            for (int s = 0; s < 4; ++s) st = __builtin_amdgcn_mfma_f32_32x32x16_bf16(kf[kb][s], qf[qb][s], st, 0, 0, 0);
            if (kb == qb) {
#pragma unroll
                for (int r = 0; r < 16; ++r) if (crow(r, hi) > r32) st[r] = 0.f;
            }
#pragma unroll
            for (int s2 = 0; s2 < 2; ++s2) {
                u32x4 w; w.x = cvtpk(st[8 * s2 + 0], st[8 * s2 + 1]); w.y = cvtpk(st[8 * s2 + 2], st[8 * s2 + 3]); w.z = cvtpk(st[8 * s2 + 4], st[8 * s2 + 5]); w.w = cvtpk(st[8 * s2 + 6], st[8 * s2 + 7]);
                const bf16x8 pb = __builtin_bit_cast(bf16x8, w);
#pragma unroll
                for (int i = 0; i < 2; ++i) o[i][qb] = __builtin_amdgcn_mfma_f32_32x32x16_bf16(__builtin_bit_cast(bf16x8, vt[kb][s2][i]), pb, o[i][qb], 0, 0, 0);
            }
        }
    }
#pragma unroll
    for (int qb = 0; qb < 2; ++qb) {
        float ss = 0.f;
#pragma unroll
        for (int i = 0; i < 2; ++i)
#pragma unroll
            for (int r = 0; r < 16; ++r) ss += o[i][qb][r] * o[i][qb][r];
        { auto rr = __builtin_amdgcn_permlane32_swap(__float_as_uint(ss), __float_as_uint(ss), false, false); ss = __uint_as_float(rr[0]) + __uint_as_float(rr[1]); }
        const float rstd = __builtin_amdgcn_rsqf(ss * (1.f / 64.f) + EPS);
        const size_t row = tok0 + qb * 32 + r32;
#pragma unroll
        for (int i = 0; i < 2; ++i)
#pragma unroll
            for (int r4 = 0; r4 < 4; ++r4) { const int dv = i * 32 + 8 * r4 + 4 * hi;
                const f32x4 gt = ld4bf(T.RG + row * 256 + h * 64 + dv), gn = *(const f32x4*)(T.gain + h * 64 + dv);
                const f32x4 v = {o[i][qb][4 * r4 + 0], o[i][qb][4 * r4 + 1], o[i][qb][4 * r4 + 2], o[i][qb][4 * r4 + 3]};
                st8(T.MIX + row * DM + h * 64 + dv, v * rstd * gn * gt); }
    }
}
}
namespace mk {
constexpr size_t MiB = 1u << 20;
constexpr size_t W_CTL = 0, CTL_ZERO_BYTES = 128 * 1024;
constexpr size_t W_WGCNT = 128 * 1024;
constexpr size_t W_TILE = 192 * 1024;
constexpr size_t W_MOD = 1 * MiB;
constexpr size_t W_LAMC = 1 * MiB + 256 * 1024;
constexpr size_t W_TOP = 1 * MiB + 512 * 1024;
constexpr size_t W_CS = 2 * MiB;
constexpr size_t W_ROWW = 6 * MiB;
constexpr size_t W_MODP = 7 * MiB;
constexpr size_t W_SSQQ = 6 * MiB + 256 * 1024, W_SSQKV = 6 * MiB + 512 * 1024;
constexpr size_t W_MOEUP = 8 * MiB, W_MOEDN = 120 * MiB;
constexpr size_t W_WIN = 176 * MiB, W_WOUT = 183 * MiB, W_FFUP = 187 * MiB, W_FFDN = 201 * MiB, W_MW = 208 * MiB, W_WEND = 228 * MiB;
constexpr size_t W_WUQ = 233 * MiB, W_WUKV = 234 * MiB, W_GLUW = 235 * MiB;
constexpr size_t W_Y = 236 * MiB, W_MIX = 268 * MiB, W_T = 300 * MiB;
constexpr size_t W_RQ = W_T, W_RK = W_T + 8 * MiB, W_RKT = W_T + 16 * MiB, W_RVT = W_T + 24 * MiB, W_RG = W_T + 32 * MiB, W_UC = W_T + 40 * MiB, W_CQ = W_T + 50 * MiB,
                 W_CKV = W_T + 58 * MiB, W_KPE = W_T + 62 * MiB, W_Q = W_T + 64 * MiB, W_KN = W_T + 88 * MiB, W_V = W_T + 104 * MiB, W_O = W_T + 120 * MiB, W_G = W_T + 136 * MiB,
                 W_KVT = W_T + 144 * MiB, W_STATE = W_T + 160 * MiB, W_E = W_T + 168 * MiB;
constexpr size_t W_HB = W_T;
constexpr size_t W_XBUF = 472 * MiB;
constexpr size_t W_XN = 480 * MiB;
constexpr size_t W_XG = 176 * MiB;
constexpr size_t W_Y2B = 8 * MiB;
constexpr size_t W_HBM = 244 * MiB;
constexpr size_t W_END = 512 * MiB;

struct Args { const void* in[35]; float* out; unsigned char* ws; int ph_lo, ph_hi, never, pad; };

template <class SrcF>
__device__ __forceinline__ void transpose_item(const SrcF src, int ld, int K, bf16* WT, const float* kscale, float cscale, LAS float* scr, int kb, int nb, int lane) {
    const int k0 = 64 * kb, n0 = 32 * nb;
    const float* sp = src(n0 + (lane & 31));
    float tv[32];
#pragma unroll
    for (int i = 0; i < 32; ++i) tv[i] = sp[(size_t)(k0 + 2 * i + (lane >> 5)) * ld];
#pragma unroll
    for (int i = 0; i < 32; ++i) { const int kk = 2 * i + (lane >> 5); float v = tv[i] * cscale; if (kscale) v *= kscale[k0 + kk]; scr[kk * 33 + (lane & 31)] = v; }
    asm volatile("s_waitcnt lgkmcnt(0)" ::: "memory");
    const int c = lane & 7;
#pragma unroll
    for (int j = 0; j < 4; ++j) { const int n = (lane >> 3) + 8 * j; const LAS float* s = scr + (8 * c) * 33 + n;
        u32x4 o; o.x = cvtpk(s[0 * 33], s[1 * 33]); o.y = cvtpk(s[2 * 33], s[3 * 33]); o.z = cvtpk(s[4 * 33], s[5 * 33]); o.w = cvtpk(s[6 * 33], s[7 * 33]);
        *(u32x4*)(WT + (size_t)(n0 + n) * K + k0 + 8 * c) = o; }
    asm volatile("s_waitcnt lgkmcnt(0)" ::: "memory");
}
struct SrcPlain { const float* W; __device__ __forceinline__ const float* operator()(int n) const { return W + n; } };
struct SrcWin { const float* W; __device__ __forceinline__ const float* operator()(int n) const {
        const bool rp = (n < 512) || (n >= 1664); const int g = n & ~63, cg = n & 63; return W + (rp ? g + (cg >> 1) + 32 * (cg & 1) : n); } };
struct SrcWuq { const float* W; __device__ __forceinline__ const float* operator()(int n) const { const int hh = n / 192, w = n % 192; const int cg = w - 128; return W + (w < 128 ? n : hh * 192 + 128 + (cg >> 1) + 32 * (cg & 1)); } };
struct SrcGU { const float* Wg; const float* Wu; __device__ __forceinline__ const float* operator()(int n) const { const int hid = (n >> 3) * 4 + (n & 3);
        const long long du = (const char*)Wu - (const char*)Wg; return (const float*)((const char*)Wg + (((n >> 2) & 1) ? du : 0ll)) + hid; } };

__device__ __forceinline__ f32x2 lam_pow(float a_re, float a_im, float dt, float e) {
    const float mag = __builtin_amdgcn_exp2f(1.4426950408889634f * a_re * dt * e);
    const double rev = (double)(a_im * dt) * (double)e * 0.15915494309189535;
    const float fr = (float)(rev - floor(rev));
    return (f32x2){mag * __builtin_amdgcn_cosf(fr), mag * __builtin_amdgcn_sinf(fr)};
}
__device__ __forceinline__ f32x2 cmul(f32x2 a, f32x2 b) { return (f32x2){a.x * b.x - a.y * b.y, a.x * b.y + a.y * b.x}; }

template <bool GU>
__device__ __forceinline__ void xp_issue(f32x4 (&v)[8], const float* W0, const float* W1, int ld, int k0, int n0, int tid) {
#pragma unroll
    for (int i = 0; i < 8; ++i) { const int idx = tid + 512 * i, row = idx >> 6, c4 = idx & 63;
        const float* src = GU ? ((c4 < 32 ? W0 : W1) + (size_t)(k0 + row) * ld + (n0 >> 1) + 4 * (c4 & 31)) : (W0 + (size_t)(k0 + row) * ld + n0 + 4 * c4);
        v[i] = *(const f32x4*)src; }
}
template <bool GU>
__device__ __forceinline__ void xp_finish(const f32x4 (&v)[8], bf16* WT, int K, int k0, int n0, LAS float* T, int tid) {
#pragma unroll
    for (int i = 0; i < 8; ++i) { const int idx = tid + 512 * i, row = idx >> 6, c4 = idx & 63; *(LAS f32x4*)(T + row * 256 + ((4 * c4) ^ (((row >> 3) & 7) << 2))) = v[i]; }
    __syncthreads();
#pragma unroll
    for (int j = 0; j < 4; ++j) { const int id = tid + 512 * j, c = id & 7, n = id >> 3; const int col = n;
        const LAS float* s = T + (8 * c) * 256 + (col ^ (c << 2));
        u32x4 o; o.x = cvtpk(s[0], s[256]); o.y = cvtpk(s[512], s[768]); o.z = cvtpk(s[1024], s[1280]); o.w = cvtpk(s[1536], s[1792]);
        *(u32x4*)(WT + (size_t)(n0 + n) * K + k0 + 8 * c) = o; }
    __syncthreads();
}
template <bool GU>
__device__ __forceinline__ void xp_matrix(const float* W0, const float* W1, int ld, int K, int N, bf16* WT, LAS float* T, int bx, int G, int tid) {
    const int nb_ = N / 256, ni_ = (K / 64) * nb_;
    f32x4 v[8];
    int it = bx; if (it >= ni_) return;
    xp_issue<GU>(v, W0, W1, ld, 64 * (it / nb_), 256 * (it % nb_), tid);
    for (; it < ni_; it += G) {
        f32x4 w[8];
#pragma unroll
        for (int i = 0; i < 8; ++i) w[i] = v[i];
        const int nx = it + G;
        if (nx < ni_) xp_issue<GU>(v, W0, W1, ld, 64 * (nx / nb_), 256 * (nx % nb_), tid);
        xp_finish<GU>(w, WT, K, 64 * (it / nb_), 256 * (it % nb_), T, tid);
    }
}

constexpr int MOE_ITEMS = NE * 672;
__device__ __forceinline__ void moe_item_issue(f32x4 (&v)[8], int id, const float* wg, const float* wu, const float* wd, int tid) {
    const int e = id / 672, r = id % 672;
    if (r < 448) xp_issue<true>(v, wg + (size_t)e * DM * DFF, wu + (size_t)e * DM * DFF, DFF, 64 * (r / 28), 256 * (r % 28), tid);
    else { const int q = r - 448; xp_issue<false>(v, wd + (size_t)e * DFF * DM, nullptr, DM, 64 * (q >> 2), 256 * (q & 3), tid); }
}
__device__ __forceinline__ void moe_item_finish(const f32x4 (&v)[8], int id, bf16* up, bf16* dn, LAS float* T, int tid) {
    const int e = id / 672, r = id % 672;
    if (r < 448) xp_finish<true>(v, up + (size_t)e * 2 * DFF * DM, DM, 64 * (r / 28), 256 * (r % 28), T, tid);
    else { const int q = r - 448; xp_finish<false>(v, dn + (size_t)e * DM * DFF, DFF, 64 * (q >> 2), 256 * (q & 3), T, tid); }
}
__device__ __forceinline__ void moe_convert(int quota, unsigned* counter, const float* wg, const float* wu, const float* wd, bf16* up, bf16* dn, LAS float* T, volatile LAS int* slot, int tid) {
    if (quota <= 0) return;
    __syncthreads();
    if (tid == 0) slot[0] = (int)__hip_atomic_fetch_add(counter, 1u, __ATOMIC_RELAXED, __HIP_MEMORY_SCOPE_AGENT);
    __syncthreads();
    int cur = slot[0]; if (cur >= MOE_ITEMS) return;
    f32x4 v[8]; moe_item_issue(v, cur, wg, wu, wd, tid);
    for (int n = 1;; ++n) {
        int nxt = MOE_ITEMS;
        if (n < quota) { __syncthreads(); if (tid == 0) slot[0] = (int)__hip_atomic_fetch_add(counter, 1u, __ATOMIC_RELAXED, __HIP_MEMORY_SCOPE_AGENT); __syncthreads(); nxt = slot[0]; }
        f32x4 w[8];
#pragma unroll
        for (int i = 0; i < 8; ++i) w[i] = v[i];
        if (nxt < MOE_ITEMS) moe_item_issue(v, nxt, wg, wu, wd, tid);
        moe_item_finish(w, cur, up, dn, T, tid);
        if (nxt >= MOE_ITEMS) break;
        cur = nxt;
    }
}
}
namespace mk {
struct SsmPar { const float *a_re, *a_im, *b_re, *b_im, *c_re, *c_im, *log_dt; };
__device__ __forceinline__ f32x2 ssm_fw(const SsmPar& P, int g, int p, float e, bool with_f) {
    const float dt = __builtin_amdgcn_exp2f(1.4426950408889634f * P.log_dt[g]);
    const float ar = P.a_re[g * 64 + p], ai = P.a_im[g * 64 + p];
    f32x2 w = lam_pow(ar, ai, dt, e);
    if (with_f) { const f32x2 lb = lam_pow(ar, ai, dt, 1.f); const float nr = lb.x - 1.f, ni = lb.y, den = ar * ar + ai * ai;
        const f32x2 f = {(nr * ar + ni * ai) / den, (ni * ar - nr * ai) / den}; w = cmul(w, f); }
    return w;
}
__device__ __forceinline__ void ssm_unit_toep(const SsmPar& P, bf16* MW, int g, int dd, LAS float* scr, int lane) {
    const int d = dd - 31, h = lane >> 2, hp0 = (lane & 3) * 4;
    f32x4 acc = {0.f, 0.f, 0.f, 0.f};
    if (d >= 0) {
#pragma unroll
        for (int i = 0; i < 4; ++i) { const int o = 4 * (lane + 64 * i);
            *(LAS f32x4*)(scr + o) = *(const f32x4*)(P.c_re + g * 1024 + o); *(LAS f32x4*)(scr + 1024 + o) = *(const f32x4*)(P.c_im + g * 1024 + o);
            *(LAS f32x4*)(scr + 2048 + o) = *(const f32x4*)(P.b_re + g * 1024 + o); *(LAS f32x4*)(scr + 3072 + o) = *(const f32x4*)(P.b_im + g * 1024 + o); }
        const f32x2 w = ssm_fw(P, g, lane, (float)d, true);
        asm volatile("s_waitcnt lgkmcnt(0)" ::: "memory");
#pragma unroll 8
        for (int p = 0; p < 64; ++p) {
            const f32x2 wp = {__shfl(w.x, p), __shfl(w.y, p)};
            const f32x2 cm = {scr[h * 64 + p], scr[1024 + h * 64 + p]};
            const f32x2 t = cmul(cm, wp);
            const f32x4 br = *(const LAS f32x4*)(scr + 2048 + p * 16 + hp0), bi = *(const LAS f32x4*)(scr + 3072 + p * 16 + hp0);
            acc += br * t.x - bi * t.y;
        }
        asm volatile("s_waitcnt lgkmcnt(0)" ::: "memory");
    }
    const int tlo = d >= 0 ? d : 0, thi = d >= 0 ? 32 : 32 + d;
    for (int t = tlo; t < thi; ++t) st8(MW + ((size_t)g * 512 + t * 16 + h) * SSM_K + (t - d) * 16 + hp0, acc);
}
__device__ __forceinline__ void ssm_unit_cross(const SsmPar& P, bf16* MW, f32x2* LAMC, int g, int t, int lane) {
    const f32x2 lp = ssm_fw(P, g, lane, (float)(t + 1), false);
    if (t == 31) LAMC[g * 64 + lane] = lp;
#pragma unroll 4
    for (int h = 0; h < 16; ++h) { const f32x2 cm = {P.c_re[(g * 16 + h) * 64 + lane], P.c_im[(g * 16 + h) * 64 + lane]}; const f32x2 v = cmul(cm, lp);
        *(unsigned*)(MW + ((size_t)g * 512 + t * 16 + h) * SSM_K + 512 + 2 * lane) = cvtpk(v.x, -v.y); }
}
__device__ __forceinline__ void ssm_unit_end(const SsmPar& P, bf16* WEND, int g, int j, int lane) {
    const f32x2 w = ssm_fw(P, g, lane, (float)(31 - j), true);
    float re[16], im[16];
#pragma unroll
    for (int q = 0; q < 4; ++q) { const f32x4 br = *(const f32x4*)(P.b_re + (g * 64 + lane) * 16 + 4 * q), bi = *(const f32x4*)(P.b_im + (g * 64 + lane) * 16 + 4 * q);
#pragma unroll
        for (int k = 0; k < 4; ++k) { re[4 * q + k] = w.x * br[k] - w.y * bi[k]; im[4 * q + k] = w.x * bi[k] + w.y * br[k]; } }
    bf16* r0 = WEND + ((size_t)g * 128 + 2 * lane) * 512 + j * 16;
    st16(r0, (f32x4){re[0], re[1], re[2], re[3]}, (f32x4){re[4], re[5], re[6], re[7]}); st16(r0 + 8, (f32x4){re[8], re[9], re[10], re[11]}, (f32x4){re[12], re[13], re[14], re[15]});
    st16(r0 + 512, (f32x4){im[0], im[1], im[2], im[3]}, (f32x4){im[4], im[5], im[6], im[7]}); st16(r0 + 520, (f32x4){im[8], im[9], im[10], im[11]}, (f32x4){im[12], im[13], im[14], im[15]});
}
struct Row { f32x4 v[4]; };
__device__ __forceinline__ Row row_ld_f32(const float* p, int lane) { Row r;
#pragma unroll
    for (int j = 0; j < 4; ++j) r.v[j] = *(const f32x4*)(p + 4 * lane + 256 * j);
    return r; }
__device__ __forceinline__ Row row_ld_bf16(const bf16* p, int lane) { Row r;
#pragma unroll
    for (int j = 0; j < 4; ++j) r.v[j] = ld4bf(p + 4 * lane + 256 * j);
    return r; }
__device__ __forceinline__ float row_ssq(const Row& r) { float s = 0.f;
#pragma unroll
    for (int j = 0; j < 4; ++j) s += (r.v[j][0] * r.v[j][0] + r.v[j][1] * r.v[j][1]) + (r.v[j][2] * r.v[j][2] + r.v[j][3] * r.v[j][3]);
    return wave_sum(s); }
__device__ __forceinline__ Row adaln(const Row& x, const float* g, const float* sc, const float* sh, bf16* xn, int lane) {
    const float rstd = __builtin_amdgcn_rsqf(row_ssq(x) * (1.f / DM) + EPS); Row o;
#pragma unroll
    for (int j = 0; j < 4; ++j) { const int c = 4 * lane + 256 * j; const f32x4 g4 = *(const f32x4*)(g + c), s4 = *(const f32x4*)(sc + c), h4 = *(const f32x4*)(sh + c);
        o.v[j] = x.v[j] * rstd * g4 * (s4 + 1.f) + h4; st8(xn + c, o.v[j]); }
    return o; }
__device__ __forceinline__ Row resid(const Row& xin, const Row& y, const float* g, const float* gt, float* xout, int lane) {
    const float rstd = __builtin_amdgcn_rsqf(row_ssq(y) * (1.f / DM) + EPS); Row o;
#pragma unroll
    for (int j = 0; j < 4; ++j) { const int c = 4 * lane + 256 * j; const f32x4 g4 = *(const f32x4*)(g + c), t4 = *(const f32x4*)(gt + c);
        o.v[j] = xin.v[j] + t4 * y.v[j] * rstd * g4; *(f32x4*)(xout + c) = o.v[j]; }
    return o; }
__device__ __forceinline__ void route(const Row& h, const float* router, int lane, int& e1, int& e2, float& w1, float& w2) {
    float acc[8];
#pragma unroll
    for (int e = 0; e < 8; ++e) acc[e] = 0.f;
#pragma unroll
    for (int j = 0; j < 4; ++j)
#pragma unroll
        for (int k = 0; k < 4; ++k) { const int c = 4 * lane + 256 * j + k; const f32x4 r0 = *(const f32x4*)(router + c * 8), r1 = *(const f32x4*)(router + c * 8 + 4); const float hv = h.v[j][k];
            acc[0] += hv * r0[0]; acc[1] += hv * r0[1]; acc[2] += hv * r0[2]; acc[3] += hv * r0[3]; acc[4] += hv * r1[0]; acc[5] += hv * r1[1]; acc[6] += hv * r1[2]; acc[7] += hv * r1[3]; }
#pragma unroll
    for (int e = 0; e < 8; ++e) acc[e] = wave_sum(acc[e]);
    e1 = 0; float v1 = acc[0];
#pragma unroll
    for (int e = 1; e < 8; ++e) if (acc[e] > v1) { v1 = acc[e]; e1 = e; }
    e2 = -1; float v2 = -__builtin_inff();
#pragma unroll
    for (int e = 0; e < 8; ++e) if (e != e1 && acc[e] > v2) { v2 = acc[e]; e2 = e; }
    const float ex = __builtin_amdgcn_exp2f(1.4426950408889634f * (v2 - v1)); w1 = 1.f / (1.f + ex); w2 = ex / (1.f + ex);
}

__device__ __forceinline__ void glu_unit(int u, const bf16* G, const bf16* GLUW, const float* bias, const float* gain, bf16* MIX, int lane) {
    asm volatile("" : "+v"(lane));
    const int r32 = lane & 31, hi = lane >> 5; const size_t tok = (size_t)u * 32 + r32;
    f32x16 acc[8] = {};
#pragma unroll 2
    for (int s = 0; s < 16; ++s) {
        const bf16x8 bf = *(const bf16x8*)(G + tok * 256 + s * 16 + hi * 8);
#pragma unroll
        for (int j = 0; j < 8; ++j) { const bf16x8 a = *(const bf16x8*)(GLUW + (size_t)(j * 32 + r32) * 256 + s * 16 + hi * 8); acc[j] = __builtin_amdgcn_mfma_f32_32x32x16_bf16(a, bf, acc[j], 0, 0, 0); }
    }
    float ss = 0.f;
#pragma unroll
    for (int j = 0; j < 8; ++j)
#pragma unroll
        for (int r4 = 0; r4 < 4; ++r4) { const int ch = j * 32 + 8 * r4 + 4 * hi; const f32x4 b4 = *(const f32x4*)(bias + ch), gl = ld4bf(G + tok * 256 + ch);
#pragma unroll
            for (int k = 0; k < 4; ++k) { const float y = gl[k] * fast_sigmoid(acc[j][4 * r4 + k] + b4[k]); acc[j][4 * r4 + k] = y; ss += y * y; } }
    { auto rr = __builtin_amdgcn_permlane32_swap(__float_as_uint(ss), __float_as_uint(ss), false, false); ss = __uint_as_float(rr[0]) + __uint_as_float(rr[1]); }
    const float rstd = __builtin_amdgcn_rsqf(ss * (1.f / 256.f) + EPS);
#pragma unroll
    for (int j = 0; j < 8; ++j)
#pragma unroll
        for (int r4 = 0; r4 < 4; ++r4) { const int ch = j * 32 + 8 * r4 + 4 * hi; const f32x4 g4 = *(const f32x4*)(gain + ch);
            st8(MIX + tok * DM + 256 + ch, (f32x4){acc[j][4 * r4 + 0], acc[j][4 * r4 + 1], acc[j][4 * r4 + 2], acc[j][4 * r4 + 3]} * rstd * g4); }
}
}
#ifndef MK_MASK
#define MK_MASK 0x1fff
#endif
#define PH_ON(n) (((MK_MASK) >> (n)) & 1)
#ifndef MK_FUSE
#define MK_FUSE 0
#endif
#ifndef MK_BG
#define MK_BG 1
#endif
#ifndef MK_Q2
#define MK_Q2 10
#endif
#ifndef MK_Q3
#define MK_Q3 12
#endif
#ifndef MK_REP_MASK
#define MK_REP_MASK 0
#endif
#ifndef MK_REP_N
#define MK_REP_N 2
#endif
#ifndef MK_SUB
#define MK_SUB 0xff
#endif
#define SUB_ON(n) (((MK_SUB) >> (n)) & 1)
namespace mk {
constexpr int RING_BYTES = 131072, MISC_OFF = RING_BYTES + 320, LDS_BYTES = 147456;
constexpr int NPHASE = 25;
__device__ __forceinline__ bool phase_active(int ph) { if (ph == 0) return true; const int l = (ph - 1) / 12, k = (ph - 1) % 12; if (k == 0) return l == 0; if (k == 8) return l == 1; if (k == 5) return false; if (MK_FUSE && l == 0 && (k == 7 || k == 11)) return false; return true; }

__device__ __forceinline__ const float* inp(const Args& a, int i) { asm volatile("" : "+s"(i)); return (const float*)a.in[i]; }
__global__ void __launch_bounds__(NWAVES * 64, 2) mk_fwd(Args args) {
    extern __shared__ __attribute__((aligned(16))) unsigned char lds[];
    LAS unsigned char* L = (LAS unsigned char*)lds;
    volatile LAS unsigned* MISC = (volatile LAS unsigned*)(L + MISC_OFF);
    const int tid0 = threadIdx.x;
    const int G = gridDim.x, NGW = G * NWAVES;
    for (int u = tid0; u < (LDS_BYTES - RING_BYTES) / 4; u += NWAVES * 64) ((LAS unsigned*)(L + RING_BYTES))[u] = 0u;
    __syncthreads();
    unsigned char* ws = args.ws;
    XcdBarrier bar; bar.bar = (unsigned*)(ws + W_CTL) + 1024; bar.x = 0; bar.st = nullptr;
    if (args.ph_hi - args.ph_lo > 1) bar = xcd_barrier_post((unsigned*)(ws + W_CTL) + 1024, MISC + 8);
    if (args.never) cooperative_groups::this_grid().sync();
#define INF(i) (inp(args, (i)))
#define MOECONV(Q_) do { if (!MK_BG) break; int tidq_ = threadIdx.x; asm volatile("" : "+v"(tidq_)); moe_convert((Q_), (unsigned*)(ws + W_CTL) + 8192, INF(32), INF(33), INF(34), (bf16*)(ws + W_MOEUP), (bf16*)(ws + W_MOEDN), (LAS float*)L, (volatile LAS int*)(L + RING_BYTES + 64), tidq_); } while (0)
#define x_in INF(0)
#define out (args.out)
#define MOD ((float*)(ws + W_MOD))
#define CS4 ((const f32x4*)(ws + W_CS))
#define XN ((bf16*)(ws + W_XN))
#define Yb ((bf16*)(ws + W_Y))
#define MIX ((bf16*)(ws + W_MIX))
#define RQ ((bf16*)(ws + W_RQ))
#define RK ((bf16*)(ws + W_RK))
#define RKT ((bf16*)(ws + W_RKT))
#define RVT ((bf16*)(ws + W_RVT))
#define RG ((bf16*)(ws + W_RG))
#define UC ((bf16*)(ws + W_UC))
#define CQ ((bf16*)(ws + W_CQ))
#define CKV ((bf16*)(ws + W_CKV))
#define KPE ((bf16*)(ws + W_KPE))
#define Qb ((bf16*)(ws + W_Q))
#define KN ((bf16*)(ws + W_KN))
#define Vb ((bf16*)(ws + W_V))
#define Ob ((bf16*)(ws + W_O))
#define GB ((bf16*)(ws + W_G))
#define STATE ((bf16*)(ws + W_STATE))
#define HB ((bf16*)(ws + W_HB))
#define XG ((bf16*)(ws + W_XG))
#define HBM ((bf16*)(ws + W_HBM))
#define KVT ((float*)(ws + W_KVT))
#define EB ((float*)(ws + W_E))
#define SSQQ ((float*)(ws + W_SSQQ))
#define SSQKV ((float*)(ws + W_SSQKV))
#define ROWW ((float*)(ws + W_ROWW))
#define WGCNT ((int*)(ws + W_WGCNT))
#define TILE ((int*)(ws + W_TILE))
#define TOPI ((int*)(ws + W_TOP))
#define TOPW ((float*)(ws + W_TOP + 128 * 1024))
#define TPOS ((int*)(ws + W_TOP + 256 * 1024))
#define WIN ((bf16*)(ws + W_WIN + (size_t)l * (7 * MiB / 2)))
#define WOUT ((bf16*)(ws + W_WOUT + (size_t)l * 2 * MiB))
#define MW ((bf16*)(ws + W_MW + (size_t)l * 10 * MiB))
#define WEND ((bf16*)(ws + W_WEND + (size_t)l * 2 * MiB))
#define WUQ ((bf16*)(ws + W_WUQ + (size_t)l * 384 * 1024))
#define WUKV ((bf16*)(ws + W_WUKV + (size_t)l * 256 * 1024))
#define GLUW ((bf16*)(ws + W_GLUW + (size_t)l * 128 * 1024))
#define LAMC ((f32x2*)(ws + W_LAMC) + l * 1024)
#define modl (MOD + l * 2 * 6144)
    int repcnt = 0;
    for (int ph = args.ph_lo; ph < args.ph_hi; ++ph) {
        if (!phase_active(ph)) continue;
        int bx = blockIdx.x; asm volatile("" : "+s"(bx));
        const int vcu = (G % 8 == 0) ? (bx % 8) * (G / 8) + bx / 8 : bx;
#define LANEDEFS int tid = threadIdx.x; asm volatile("" : "+v"(tid)); const int lane = tid & 63, wave = __builtin_amdgcn_readfirstlane(tid >> 6), gw = bx * NWAVES + wave; (void)lane; (void)wave; (void)gw;
        const int l = ph == 0 ? 0 : (ph - 1) / 12, k = ph == 0 ? -1 : (ph - 1) % 12;
        if (ph == 0 && PH_ON(0)) { LANEDEFS
            LAS float* scr = (LAS float*)(L + wave * 16384);
            for (int u = gw; u < 1536; u += NGW) { const int ll = u / 768, r = u % 768, n0 = (r >> 3) * 64, ks = r & 7; const float* aw = INF(3) + (size_t)ll * DM * 6144 + n0 + lane; const float* c = INF(1);
                float a0 = 0.f, a1 = 0.f;
#pragma unroll 16
                for (int kk = 0; kk < 128; ++kk) { const int kq = ks * 128 + kk; const float w = aw[(size_t)kq * 6144]; a0 += silu_fast(c[kq]) * w; a1 += silu_fast(c[DM + kq]) * w; }
                float* mp = (float*)(ws + W_MODP) + (size_t)(ks * 2 + ll) * 2 * 6144 + n0 + lane; mp[0] = a0; mp[6144] = a1; }
#define CONV(SRC, LD, KK, NN, DST, KSC, CSC) do { const int nb_ = (NN) / 32, ni_ = ((KK) / 64) * nb_; for (int it = gw; it < ni_; it += NGW) transpose_item(SRC, LD, KK, DST, KSC, CSC, scr, it / nb_, it % nb_, lane); } while (0)
            for (int ll = 0; ll < 2; ++ll) {
                CONV((SrcWin{INF(9) + (size_t)ll * DM * INC}), INC, DM, INC, (bf16*)(ws + W_WIN + (size_t)ll * (7 * MiB / 2)), nullptr, 1.f);
                CONV((SrcWuq{INF(23) + (size_t)ll * 256 * 768}), 768, 256, 768, (bf16*)(ws + W_WUQ + (size_t)ll * 384 * 1024), INF(22) + ll * 256, QSCALE);
                CONV((SrcPlain{INF(25) + (size_t)ll * 128 * 1024}), 1024, 128, 1024, (bf16*)(ws + W_WUKV + (size_t)ll * 256 * 1024), INF(24) + ll * 128, 1.f);
                CONV((SrcPlain{INF(19) + (size_t)ll * 65536}), 256, 256, 256, (bf16*)(ws + W_GLUW + (size_t)ll * 128 * 1024), nullptr, 1.f);
            }
#undef CONV
            __syncthreads();
            { LAS float* T = (LAS float*)L; int rot = 0;
#define XPM(GU_, W0_, W1_, LD_, KK_, NN_, DST_) do { const int ni__ = ((KK_) / 64) * ((NN_) / 256); xp_matrix<GU_>(W0_, W1_, LD_, KK_, NN_, DST_, T, (bx + G - rot % G) % G, G, tid); rot += ni__; } while (0)
              for (int ll = 0; ll < 2; ++ll) XPM(false, INF(27) + (size_t)ll * DM * DM, nullptr, DM, DM, DM, (bf16*)(ws + W_WOUT + (size_t)ll * 2 * MiB));
              XPM(true, INF(28), INF(29), DFF, DM, 2 * DFF, (bf16*)(ws + W_FFUP));
              XPM(false, INF(30), nullptr, DM, DFF, DM, (bf16*)(ws + W_FFDN));
#if !MK_BG
              for (int e = 0; e < NE; ++e) {
                  XPM(true, INF(32) + (size_t)e * DM * DFF, INF(33) + (size_t)e * DM * DFF, DFF, DM, 2 * DFF, (bf16*)(ws + W_MOEUP) + (size_t)e * 2 * DFF * DM);
                  XPM(false, INF(34) + (size_t)e * DFF * DM, nullptr, DM, DFF, DM, (bf16*)(ws + W_MOEDN) + (size_t)e * DM * DFF); }
#endif
#undef XPM
            }
            { const int* pos = (const int*)INF(2); f32x2* cs = (f32x2*)(ws + W_CS);
              for (int it = gw; it < NTOK * 32 / 64; it += NGW) { const int idx = it * 64 + lane, row = idx >> 5, i = idx & 31;
                  const float inv = __builtin_amdgcn_exp2f(-(float)i * (13.287712379549449f / 32.0f)); const float ang = (float)pos[row] * inv;
                  const double rev = (double)ang * 0.15915494309189535; const float fr = (float)(rev - floor(rev));
                  cs[idx] = (f32x2){__builtin_amdgcn_cosf(fr), __builtin_amdgcn_sinf(fr)}; } }
            for (int ll = 0; ll < 2; ++ll) {
                const SsmPar P{INF(11) + ll * 1024, INF(12) + ll * 1024, INF(13) + ll * 16384, INF(14) + ll * 16384, INF(15) + ll * 16384, INF(16) + ll * 16384, INF(18) + ll * 16};
                bf16* mw = (bf16*)(ws + W_MW + (size_t)ll * 10 * MiB); bf16* we = (bf16*)(ws + W_WEND + (size_t)ll * 2 * MiB); f32x2* lc = (f32x2*)(ws + W_LAMC) + ll * 1024;
                for (int it = gw; it < 2032; it += NGW) {
                    if (it < 1008) ssm_unit_toep(P, mw, it / 63, it % 63, scr, lane);
                    else if (it < 1520) ssm_unit_cross(P, mw, lc, (it - 1008) >> 5, (it - 1008) & 31, lane);
                    else ssm_unit_end(P, we, (it - 1520) >> 5, (it - 1520) & 31, lane);
                }
            }
        } else if (k == 0 && PH_ON(1)) { LANEDEFS
            { const float* mp = (const float*)(ws + W_MODP);
              if (tid < 96) { const int idx = bx * 96 + tid, ll = idx / 12288, n = idx % 6144; float s = INF(4)[ll * 6144 + n];
#pragma unroll
                  for (int ks = 0; ks < 8; ++ks) s += mp[(size_t)ks * 24576 + idx];
                  MOD[idx] = s; }
              LAS float* ml = (LAS float*)L; const int b = (bx * 64) / SEQ;
              for (int n = tid; n < 2048; n += NWAVES * 64) { float s = INF(4)[n];
#pragma unroll
                  for (int ks = 0; ks < 8; ++ks) s += mp[(size_t)ks * 24576 + b * 6144 + n];
                  ml[n] = s; }
              __syncthreads(); }
            Row xpf0 = row_ld_f32(x_in + (size_t)(bx * 64 + wave * 8) * DM, lane);
            for (int i = 0; i < 8; ++i) { const int row = bx * 64 + wave * 8 + i; const float* md = (const float*)lds;
                const Row xr = xpf0; if (i + 1 < 8) xpf0 = row_ld_f32(x_in + (size_t)(row + 1) * DM, lane); (void)adaln(xr, INF(5) + l * DM, md + 1 * DM, md + 0 * DM, XN + (size_t)row * DM, lane); }
        } else if (k == 1 && PH_ON(2)) {
            pg8::Gemm g{DM, DM, DM}; pg8::TileOrder S; S.init(XN, DM, WIN, DM, 64, 7, G, bx);
            EpiWin E{RQ, RK, RKT, RVT, RG, UC, CQ, CKV, KPE, SSQQ, SSQKV, CS4};
            pg8::gemm_phase<EpiWin, pg8::TileOrder, true>(L, g, S, E);
            { pg8::Unit u2; if (!S.next(1, u2)) MOECONV(MK_Q2); }
        } else if (k == 2 && PH_ON(3)) {
            unsigned* ssmflag = (unsigned*)(ws + W_CTL) + 9216 + 64 * (l * 32);
            if (SUB_ON(0)) { pg8::Gemm g{256, 256, 256}; pg8::TileOrder S; S.init(CQ, 256, WUQ, 256, 64, 3, G, bx); EpiQup E{Qb, SSQQ, CS4}; pg8::gemm_phase<EpiQup, pg8::TileOrder, true, true>(L, g, S, E); }
            if (SUB_ON(1)) { pg8::Gemm g{128, 128, 128}; pg8::TileOrder S; S.init(CKV, 128, WUKV, 128, 64, 4, 192, bx < 192 ? bx : 256); EpiKVup E{KN, Vb, SSQKV}; pg8::gemm_phase<EpiKVup, pg8::TileOrder, true, true>(L, g, S, E); }
            if (SUB_ON(2) && bx >= 192) {
                const int i = bx - 192, gI = i >> 2, bI = (i >> 1) & 1, pnI = i & 1;
                const char* Ap = (const char*)UC + ((size_t)gI * SSM_NCH + (size_t)bI * 256) * SSM_K * 2;
                { pg8::Gemm g{SSM_K, 512, 512}; pg8::OneUnit S; S.has = true; S.u.pA = Ap; S.u.pB = (const char*)WEND + (size_t)gI * 128 * 512 * 2; S.u.pm = gI * 2 + bI; S.u.pn = 0;
                  EpiSsmE E{UC, LAMC, ssmflag + 64 * i}; pg8::gemm_phase<EpiSsmE, pg8::OneUnit, false, true>(L, g, S, E); }
                { pg8::Gemm g{SSM_K, SSM_K, SSM_K}; pg8::OneUnit S; S.has = true; S.u.pA = Ap; S.u.pB = (const char*)MW + ((size_t)gI * 512 + (size_t)pnI * 256) * SSM_K * 2; S.u.pm = gI * 2 + bI; S.u.pn = pnI;
                  EpiSsmZ E{GB, UC, INF(17) + l * 256}; pg8::gemm_phase<EpiSsmZ, pg8::OneUnit, false, true>(L, g, S, E); } }
            if (SUB_ON(3)) { LANEDEFS const ret::Tensors T{RQ, RK, RKT, RVT, RG, KVT, STATE, MIX, INF(10) + l * 256};
              for (int u = gw; u < 1024; u += NGW) ret::x_unit(u, T, lane); }
            if (bx < 192) MOECONV(MK_Q3);
        } else if (k == 3 && PH_ON(4)) { LANEDEFS
            { const ret::Tensors T{RQ, RK, RKT, RVT, RG, KVT, STATE, MIX, INF(10) + l * 256}; ret::scan_wg(bx * 128, T, (float*)lds, tid); }
            __syncthreads();
            { const att::Tensors T{Qb, KN, KPE, Vb, Ob}; const int bh = vcu >> 5, xx = vcu & 31;
              att::attn_unit(bh >> 2, bh & 3, 63 - xx, T, (char*)lds); att::attn_unit(bh >> 2, bh & 3, xx, T, (char*)lds); }
        } else if (k == 4 && PH_ON(5)) {
            LANEDEFS
            if (SUB_ON(5) && wave < 4) { const ret::Tensors T{RQ, RK, RKT, RVT, RG, KVT, STATE, MIX, INF(10) + l * 256}; ret::z_unit(bx + 256 * wave, T, lane); }
            if (SUB_ON(4) && (wave == 4 || wave == 5)) glu_unit(bx + 256 * (wave - 4), GB, GLUW, INF(20) + l * 256, INF(21) + l * 256, MIX, lane);
            if (SUB_ON(6)) { const int nr = wave < 4 ? 5 : (wave < 6 ? 7 : 15), r0 = bx * 64 + (wave < 4 ? wave * 5 : (wave < 6 ? 20 + (wave - 4) * 7 : 34 + (wave - 6) * 15));
              u32x4 wpf = *(const u32x4*)(Ob + (size_t)r0 * 512 + 8 * lane);
              for (int i = 0; i < nr; ++i) { const int row = r0 + i; const u32x4 w = wpf; if (i + 1 < nr) wpf = *(const u32x4*)(Ob + (size_t)(row + 1) * 512 + 8 * lane);
                const f32x4 a = {bflo(w.x), bfhi(w.x), bflo(w.y), bfhi(w.y)}, c = {bflo(w.z), bfhi(w.z), bflo(w.w), bfhi(w.w)};
                float ss = (a[0] * a[0] + a[1] * a[1]) + (a[2] * a[2] + a[3] * a[3]) + (c[0] * c[0] + c[1] * c[1]) + (c[2] * c[2] + c[3] * c[3]); ss = wave_sum(ss);
                const float rstd = __builtin_amdgcn_rsqf(ss * (1.f / 512.f) + EPS); const float* gn = INF(26) + l * 512 + 8 * lane;
                st16(MIX + (size_t)row * DM + 512 + 8 * lane, a * rstd * *(const f32x4*)gn, c * rstd * *(const f32x4*)(gn + 4)); } }
        } else if (k == 6 && PH_ON(7)) {
            pg8::Gemm g{DM, DM, DM}; pg8::TileOrder S; S.init(MIX, DM, WOUT, DM, 64, 4, G, bx);
            if (MK_FUSE && l == 0) {
                unsigned* cw = (unsigned*)(ws + W_CTL); unsigned* xb = (unsigned*)(ws + W_XBUF);
                EpiResNorm E{x_in, out, XN, INF(6), INF(7), modl, 2 * DM, 4 * DM, 3 * DM, 0, PanelSsq{xb, cw + 16384, cw + 9001}, PanelSsq{xb + 131072, cw + 16384 + 4096, cw + 9001}};
                pg8::gemm_phase<EpiResNorm, pg8::TileOrder, false>(L, g, S, E);
            } else { EpiStore E{Yb, DM, nullptr, 0}; pg8::gemm_phase<EpiStore, pg8::TileOrder, false>(L, g, S, E); }
        } else if (k == 7 && PH_ON(8)) { LANEDEFS
            LAS int* cnt = (LAS int*)L;
            if (l == 1) { if (tid < 8) cnt[tid] = 0; __syncthreads(); }
            const float* xsrc = l == 0 ? x_in : out;
            Row xpf = row_ld_f32(xsrc + (size_t)(bx * 64 + wave * 8) * DM, lane), ypf = row_ld_bf16(Yb + (size_t)(bx * 64 + wave * 8) * DM, lane);
            for (int i = 0; i < 8; ++i) { const int row = bx * 64 + wave * 8 + i, b = row / SEQ; const float* md = modl + b * 6144;
                const Row xr = xpf, yr = ypf;
                if (i + 1 < 8) { xpf = row_ld_f32(xsrc + (size_t)(row + 1) * DM, lane); ypf = row_ld_bf16(Yb + (size_t)(row + 1) * DM, lane); }
                const Row x1 = resid(xr, yr, INF(6) + l * DM, md + 2 * DM, out + (size_t)row * DM, lane);
                const Row h = adaln(x1, INF(7) + l * DM, md + 4 * DM, md + 3 * DM, XN + (size_t)row * DM, lane);
                if (l == 1) { int e1, e2; float w1, w2; route(h, INF(31), lane, e1, e2, w1, w2);
                    if (lane == 0) { TOPI[row * 2] = e1; TOPI[row * 2 + 1] = e2; TOPW[row * 2] = w1; TOPW[row * 2 + 1] = w2; __hip_atomic_fetch_add(&cnt[e1], 1, __ATOMIC_RELAXED, __HIP_MEMORY_SCOPE_WORKGROUP); __hip_atomic_fetch_add(&cnt[e2], 1, __ATOMIC_RELAXED, __HIP_MEMORY_SCOPE_WORKGROUP); } } }
            if (l == 1) { __syncthreads(); if (tid < 8) WGCNT[bx * 8 + tid] = cnt[tid]; }
        } else if (k == 8 && PH_ON(9)) { LANEDEFS
            MOECONV(1 << 30);
            __syncthreads();
            LAS int* sc = (LAS int*)L;
            for (int i = tid; i < 2048; i += NWAVES * 64) sc[i] = WGCNT[i];
            __syncthreads();
            { const int e = wave; int base = 0, tot = 0;
#pragma unroll
              for (int q = 0; q < 4; ++q) { const int w = q * 64 + lane; const int c = sc[w * 8 + e]; base += (w < bx) ? c : 0; tot += c; }
#pragma unroll
              for (int o = 1; o < 64; o <<= 1) { base += __shfl_xor(base, o); tot += __shfl_xor(tot, o); }
              if (lane == 0) { sc[2048 + e] = base; sc[2064 + e] = tot; } }
            __syncthreads();
            if (tid == 0) { int st = 0, nt = 0;
#pragma unroll 1
                for (int e = 0; e < 8; ++e) { sc[2056 + e] = st; const int t = (sc[2064 + e] + 255) >> 8; if (bx == 0) for (int q = 0; q < t; ++q) TILE[16 + nt + q] = e; nt += t; st += t << 8; } if (bx == 0) TILE[0] = nt; }
            __syncthreads();
            if (wave == 0) { const int row = bx * 64 + lane; const int e1 = TOPI[row * 2], e2 = TOPI[row * 2 + 1]; int p1 = 0, p2 = 0;
                const unsigned long long lt = (1ull << lane) - 1ull;
#pragma unroll
                for (int e = 0; e < 8; ++e) { const unsigned long long m1 = __ballot(e1 == e), m2 = __ballot(e2 == e); const int r = __popcll(m1 & lt) + __popcll(m2 & lt) + sc[2056 + e] + sc[2048 + e];
                    if (e1 == e) p1 = r; if (e2 == e) p2 = r; }
                sc[2080 + lane * 2] = p1; sc[2080 + lane * 2 + 1] = p2; TPOS[row * 2] = p1; TPOS[row * 2 + 1] = p2; ROWW[p1] = TOPW[row * 2]; ROWW[p2] = TOPW[row * 2 + 1]; }
            __syncthreads();
#pragma unroll
            for (int i0 = 0; i0 < 8; i0 += 4) { u32x4 a[4], c[4];
#pragma unroll
                for (int i = 0; i < 4; ++i) { const int row = bx * 64 + wave * 8 + i0 + i; a[i] = *(const u32x4*)(XN + (size_t)row * DM + 8 * lane); c[i] = *(const u32x4*)(XN + (size_t)row * DM + 512 + 8 * lane); }
#pragma unroll
                for (int i = 0; i < 4; ++i) { const int lr = wave * 8 + i0 + i; const int p1 = sc[2080 + lr * 2], p2 = sc[2080 + lr * 2 + 1];
                    *(u32x4*)(XG + (size_t)p1 * DM + 8 * lane) = a[i]; *(u32x4*)(XG + (size_t)p1 * DM + 512 + 8 * lane) = c[i];
                    *(u32x4*)(XG + (size_t)p2 * DM + 8 * lane) = a[i]; *(u32x4*)(XG + (size_t)p2 * DM + 512 + 8 * lane) = c[i]; } }
            if (bx < 8) { const int tot = sc[2064 + bx], st = sc[2056 + bx], pe = st + (((tot + 255) >> 8) << 8);
                for (int r = st + tot + wave; r < pe; r += NWAVES) { const u32x4 z = {0u, 0u, 0u, 0u}; *(u32x4*)(XG + (size_t)r * DM + 8 * lane) = z; *(u32x4*)(XG + (size_t)r * DM + 512 + 8 * lane) = z; if (lane == 0) ROWW[r] = 0.f; } }
        } else if (k == 9 && PH_ON(10)) {
            pg8::Gemm g{DM, DM, DM}; pg8::TileOrder S;
            if (l == 0) S.init(XN, DM, (bf16*)(ws + W_FFUP), DM, 64, 28, G, bx);
            else { S.init(XG, DM, (bf16*)(ws + W_MOEUP), DM, TILE[0], 28, G, bx); S.texp = TILE + 16; S.b_e = (size_t)2 * DFF * DM * 2; }
            EpiSwiglu E{l == 0 ? HB : HBM};
            pg8::gemm_phase<EpiSwiglu, pg8::TileOrder, true>(L, g, S, E);
        } else if (k == 10 && PH_ON(11)) {
            pg8::Gemm g{DFF, DFF, DFF}; pg8::TileOrder S; EpiStore E{Yb, DM, nullptr, 0};
            if (l == 0) S.init(HB, DFF, (bf16*)(ws + W_FFDN), DFF, 64, 4, G, bx);
            if (MK_FUSE && l == 0) {
                unsigned* cw = (unsigned*)(ws + W_CTL); unsigned* xb = (unsigned*)(ws + W_XBUF);
                EpiResNorm E2{out, out, XN, INF(8), INF(5) + DM, modl, 5 * DM, 1 * DM, 0 * DM, 2 * 6144, PanelSsq{xb + 2 * 131072, cw + 16384 + 2 * 4096, cw + 9001}, PanelSsq{xb + 3 * 131072, cw + 16384 + 3 * 4096, cw + 9001}};
                pg8::gemm_phase<EpiResNorm, pg8::TileOrder, false>(L, g, S, E2);
            } else {
            if (l == 1) { S.init(HBM, DFF, (bf16*)(ws + W_MOEDN), DFF, 128, 4, G, bx); S.texp = TILE + 16; S.b_e = (size_t)DM * DFF * 2; E.O = XG; E.rowscale = ROWW; }
            pg8::gemm_phase<EpiStore, pg8::TileOrder, true>(L, g, S, E);
            }
            if (l == 1) {
                const int ntail = TILE[0] - 128;
                if (ntail > 0) { pg8::Gemm g2{DFF, DFF, DFF / 4}; pg8::TileOrder S2; S2.init(HBM + (size_t)32768 * DFF, DFF, (bf16*)(ws + W_MOEDN), DFF, ntail, 4, G, bx); S2.texp = TILE + 16 + 128; S2.b_e = (size_t)DM * DFF * 2;
                    S2.split_k(4, (size_t)(DFF / 4) * 2); EpiStore E2{(bf16*)(ws + W_Y2B), DM, ROWW + 32768, (size_t)7 * 256 * DM};
                    pg8::gemm_phase<EpiStore, pg8::TileOrder, true>(L, g2, S2, E2); } }
        } else if (k == 11 && PH_ON(12)) { LANEDEFS
            const bf16* Y2B = (const bf16*)(ws + W_Y2B);
#define LDP(P_, DST_) do { const int p_ = __builtin_amdgcn_readfirstlane(P_); if (p_ < 32768) DST_ = row_ld_bf16(XG + (size_t)p_ * DM, lane); else { const bf16* t_ = Y2B + (size_t)(p_ - 32768) * DM; \
                const Row a_ = row_ld_bf16(t_, lane), b_ = row_ld_bf16(t_ + (size_t)7 * 256 * DM, lane), c_ = row_ld_bf16(t_ + (size_t)14 * 256 * DM, lane), d_ = row_ld_bf16(t_ + (size_t)21 * 256 * DM, lane); \
                _Pragma("unroll") for (int j = 0; j < 4; ++j) DST_.v[j] = (a_.v[j] + b_.v[j]) + (c_.v[j] + d_.v[j]); } } while (0)
#define LDY(ROW_, DST_) do { if (l == 0) DST_ = row_ld_bf16(Yb + (size_t)(ROW_) * DM, lane); else { Row ya, yb; LDP(TPOS[(ROW_) * 2], ya); LDP(TPOS[(ROW_) * 2 + 1], yb); \
                _Pragma("unroll") for (int j = 0; j < 4; ++j) DST_.v[j] = ya.v[j] + yb.v[j]; } } while (0)
            Row xpf = row_ld_f32(out + (size_t)(bx * 64 + wave * 8) * DM, lane), ypf; LDY(bx * 64 + wave * 8, ypf);
            for (int i = 0; i < 8; ++i) { const int row = bx * 64 + wave * 8 + i, b = row / SEQ; const float* md = modl + b * 6144;
                const Row xr = xpf, yr = ypf;
                if (i + 1 < 8) { xpf = row_ld_f32(out + (size_t)(row + 1) * DM, lane); LDY(row + 1, ypf); }
                const Row x2 = resid(xr, yr, INF(8) + l * DM, md + 5 * DM, out + (size_t)row * DM, lane);
                if (l == 0) { const float* md1 = MOD + 2 * 6144 + b * 6144; (void)adaln(x2, INF(5) + DM, md1 + 1 * DM, md1 + 0 * DM, XN + (size_t)row * DM, lane); } }
#undef LDY
#undef LDP
        }
        bool more = false; for (int q = ph + 1; q < args.ph_hi; ++q) more |= phase_active(q);
        if (more) xcd_barrier(bar);
        if (MK_REP_MASK != 0) { if ((((unsigned)MK_REP_MASK >> ph) & 1u) && repcnt + 1 < MK_REP_N) { ++repcnt; --ph; } else repcnt = 0; }
    }
#undef INF
#undef MOECONV
#undef LANEDEFS
#undef MOD
#undef Qb
#undef Vb
#undef Ob
#undef Yb
#undef out
#undef modl
}
}
#ifndef MK_COOP
#define MK_COOP true
#endif
#ifndef MK_PER_PHASE
#define MK_PER_PHASE 0
#endif
static int mk_setup() {
    static int grid = 0;
    if (grid == 0) {
        int dev = 0, cus = 0, per_cu = 0;
        if (hipGetDevice(&dev) != hipSuccess || hipDeviceGetAttribute(&cus, hipDeviceAttributeMultiprocessorCount, dev) != hipSuccess) { fprintf(stderr, "kernel_launch: device query failed\n"); grid = -1; return grid; }
        if (hipFuncSetAttribute((const void*)mk::mk_fwd, hipFuncAttributeMaxDynamicSharedMemorySize, mk::LDS_BYTES) != hipSuccess) { fprintf(stderr, "kernel_launch: hipFuncSetAttribute failed\n"); grid = -1; return grid; }
        if (hipOccupancyMaxActiveBlocksPerMultiprocessor(&per_cu, (const void*)mk::mk_fwd, mk::NWAVES * 64, mk::LDS_BYTES) != hipSuccess || per_cu < 1) fprintf(stderr, "kernel_launch: occupancy query reports %d blocks per CU\n", per_cu);
        (void)hipGetLastError();
        grid = cus;
        if (grid != 256) fprintf(stderr, "kernel_launch: this kernel is written for a 256-CU device (got %d)\n", grid);
    }
    return grid;
}
static void mk_launch(void* const* d_in, void* d_out, void* d_ws, hipStream_t stream, int lo, int hi, bool coop) {
    const int grid = mk_setup(); if (grid <= 0) return;
    mk::Args a{};
    for (int i = 0; i < 35; ++i) a.in[i] = d_in[i];
    a.out = (float*)d_out; a.ws = (unsigned char*)d_ws; a.ph_lo = lo; a.ph_hi = hi; a.never = 0; a.pad = 0;
    if (coop) { void* args[] = {&a}; hipError_t e = hipLaunchCooperativeKernel((const void*)mk::mk_fwd, dim3(grid), dim3(mk::NWAVES * 64), args, mk::LDS_BYTES, stream);
        if (e != hipSuccess) fprintf(stderr, "cooperative launch failed: %s (grid %d)\n", hipGetErrorString(e), grid); }
    else hipLaunchKernelGGL(mk::mk_fwd, dim3(grid), dim3(mk::NWAVES * 64), mk::LDS_BYTES, stream, a);
}
extern "C" void kernel_launch(void* const* d_in, const int* in_sizes, int n_in, void* d_out, int out_size, void* d_ws, size_t ws_size, hipStream_t stream) {
    (void)in_sizes; (void)n_in; (void)out_size;
    if (ws_size < mk::W_END) { fprintf(stderr, "kernel_launch: workspace too small (%zu < %zu)\n", ws_size, (size_t)mk::W_END); return; }
    (void)hipMemsetAsync((char*)d_ws + mk::W_CTL, 0, mk::CTL_ZERO_BYTES, stream);
#if MK_PER_PHASE
    for (int ph = 0; ph < mk::NPHASE; ++ph) mk_launch(d_in, d_out, d_ws, stream, ph, ph + 1, false);
#else
    mk_launch(d_in, d_out, d_ws, stream, 0, mk::NPHASE, MK_COOP);
#endif
}
```
